# Optimizing an MI355X kernel written in HIP

```python
import jax, jax.numpy as jnp
from jax import lax
import numpy as np

D_MODEL = 2048
BATCH = 4
SEQ = 4096
DEPTH = 4

GRID_W = 64
CTX_LEN = 256
N_MOD = 9
D_FF = 5632
EPS = 1e-6
A_HEADS = 8
A_DK = 128
A_DV = 128
A_WK = A_HEADS * A_DK
A_WV = A_HEADS * A_DV
HGRN_CHUNK = 16
B_GROUPS = 4
B_GROUP_CH = 128
B_WIDTH = B_GROUPS * B_GROUP_CH
B_CHUNK = 128
C_GROUPS = 4
C_GROUP_CH = 128
C_WIDTH = C_GROUPS * C_GROUP_CH
C_KSIZE = 3
IN_SPLITS = (A_WK, A_WV, A_WK, A_WK, A_WV, B_WIDTH, B_WIDTH, C_WIDTH, C_WIDTH, C_WIDTH, D_MODEL, D_MODEL, D_MODEL)
IN_WIDTH = sum(IN_SPLITS)

kernel_name = "hybrid_hgrn2_gmlp_shortconv_dit_block"


def rms_norm(x, g):
    xf = x.astype(jnp.float32)
    y = xf * lax.rsqrt(jnp.mean(xf * xf, axis=-1, keepdims=True) + EPS)
    return (y * g.astype(jnp.float32)).astype(x.dtype)


def layer_norm(x, g, b):
    xf = x.astype(jnp.float32)
    mu = jnp.mean(xf, axis=-1, keepdims=True)
    d = xf - mu
    var = jnp.mean(d * d, axis=-1, keepdims=True)
    return (d * lax.rsqrt(var + EPS) * g.astype(jnp.float32) + b.astype(jnp.float32)).astype(x.dtype)


def adaln_in(s, g, shift, scale):
    return rms_norm(s, g) * (1 + scale) + shift


def swiglu(h, wg, wu, wd):
    return (jax.nn.silu(h @ wg) * (h @ wu)) @ wd


def to_heads(a, n_heads):
    bsz, L, w = a.shape
    return a.reshape(bsz, L, n_heads, w // n_heads).transpose(0, 2, 1, 3)


def log_forget(z, lb):
    zf = z.astype(jnp.float32)
    return jnp.logaddexp(jnp.log1p(-lb) + jax.nn.log_sigmoid(zf), jnp.log(lb))


def gla_chunk_scan(q, k, v, logf, s0):
    bsz, nh, L, dk = q.shape
    dv = v.shape[-1]
    n = L // HGRN_CHUNK

    def blk(a):
        return a.reshape(bsz, nh, n, HGRN_CHUNK, a.shape[-1])

    q, k, v, logf = blk(q), blk(k), blk(v), blk(logf)
    cum = jnp.cumsum(logf, axis=3)
    tri = jnp.tril(jnp.ones((HGRN_CHUNK, HGRN_CHUNK), bool))[:, :, None]
    diff = cum[:, :, :, :, None, :] - cum[:, :, :, None, :, :]
    decay = jnp.where(tri, jnp.exp(jnp.where(tri, diff, 0.0)), 0.0)
    scores = jnp.einsum('bhntk,bhntsk,bhnsk->bhnts', q, decay, k)
    o_intra = jnp.einsum('bhnts,bhnsv->bhntv', scores, v)
    q_dec = q * jnp.exp(cum)
    k_dec = k * jnp.exp(cum[:, :, :, -1:, :] - cum)
    g_last = jnp.exp(cum[:, :, :, -1, :])
    xs = (jnp.moveaxis(q_dec, 2, 0), jnp.moveaxis(k_dec, 2, 0),
          jnp.moveaxis(v, 2, 0), jnp.moveaxis(g_last, 2, 0))

    def step(s, inp):
        qd, kd, vv, gl = inp
        o = jnp.einsum('bhtk,bhkv->bhtv', qd, s)
        s = gl[..., None] * s + jnp.einsum('bhsk,bhsv->bhkv', kd, vv)
        return s, o

    s_fin, o_inter = lax.scan(step, s0, xs)
    o = o_intra + jnp.moveaxis(o_inter, 0, 2)
    return o.reshape(bsz, nh, L, dv), s_fin


def hgrn2_bidir(q, i, z_f, z_b, lb_f, lb_b, s0_f, s0_b):
    qh = to_heads(q, A_HEADS).astype(jnp.float32) * (A_DK ** -0.5)
    vh = to_heads(i, A_HEADS).astype(jnp.float32)
    lf_f = log_forget(to_heads(z_f, A_HEADS), lb_f.reshape(A_HEADS, 1, A_DK))
    lf_b = log_forget(to_heads(z_b, A_HEADS), lb_b.reshape(A_HEADS, 1, A_DK))
    o_f, s_f = gla_chunk_scan(qh, -jnp.expm1(lf_f), vh, lf_f, s0_f)

    def rev(a):
        return jnp.flip(a, axis=2)

    o_b, s_b = gla_chunk_scan(rev(qh), rev(-jnp.expm1(lf_b)), rev(vh), rev(lf_b), s0_b)
    return o_f + rev(o_b), s_f, s_b


def conv3(x, w):
    xp = jnp.pad(x, [(0, 0)] * (x.ndim - 2) + [(1, 1), (0, 0)])
    return w[0] * xp[..., :-2, :] + w[1] * xp[..., 1:-1, :] + w[2] * xp[..., 2:, :]


def chunk_spatial_gate(u, v, ln_g, ln_b, w_s, b_s):
    u = jax.nn.gelu(u)
    v = layer_norm(jax.nn.gelu(v), ln_g, ln_b)
    bsz, L, _ = v.shape
    vb = v.reshape(bsz, L // B_CHUNK, B_CHUNK, B_GROUPS, B_GROUP_CH)
    mixed = jnp.einsum('gts,bnsgc->bntgc', w_s, vb) + b_s.T[:, :, None]
    return u * mixed.reshape(bsz, L, B_WIDTH)


def mixer_stream(h, s0_f, s0_b, w_in, lb_f, lb_b, a_norm_g, ln_g, ln_b, w_s, b_s,
                 conv_w, w_pa, w_pb, w_pc, w_o, grid_rows, need_out):
    bsz, L, _ = h.shape
    z = h @ w_in
    offs = [int(o) for o in np.cumsum(IN_SPLITS)[:-1]]
    (q, i, z_f, z_b, g_a, u, v, h_c, gate_b, gate_c, m_a, m_b, m_c) = jnp.split(z, offs, axis=-1)
    o, s_f, s_b = hgrn2_bidir(q, i, z_f, z_b, lb_f, lb_b, s0_f, s0_b)
    if not need_out:
        return None, s_f, s_b
    o = o.transpose(0, 2, 1, 3)
    g_a = g_a.reshape(bsz, L, A_HEADS, A_DV).astype(jnp.float32)
    y_a = (rms_norm(o, a_norm_g) * jax.nn.silu(g_a)).reshape(bsz, L, A_WV).astype(h.dtype)
    y_b = chunk_spatial_gate(u, v, ln_g, ln_b, w_s, b_s)
    t = gate_c * h_c
    if grid_rows is None:
        t = conv3(t, conv_w)
    else:
        t = conv3(t.reshape(bsz, grid_rows, GRID_W, C_WIDTH), conv_w).reshape(bsz, L, C_WIDTH)
    y_c = gate_b * t
    merged = (jax.nn.sigmoid(m_a) * (y_a @ w_pa) + jax.nn.sigmoid(m_b) * (y_b @ w_pb)
              + jax.nn.sigmoid(m_c) * (y_c @ w_pc))
    return merged @ w_o, s_f, s_b


def setup_inputs(seed: int = 0) -> dict:
    key = jax.random.key(seed)
    ks = jax.random.split(key, 24)

    def nrm(k, shape, scale):
        return jax.random.normal(k, shape, jnp.float32) * scale

    D = D_MODEL
    return {
        "x": nrm(ks[0], (BATCH, SEQ, D), 1.0),
        "c": nrm(ks[1], (BATCH, D), 1.0),
        "ctx": nrm(ks[2], (BATCH, CTX_LEN, D), 1.0),
        "c_ctx": nrm(ks[3], (D,), 1.0),
        "w_mod": nrm(ks[4], (DEPTH, D, N_MOD * D), 0.5 * D ** -0.5),
        "b_mod": nrm(ks[5], (DEPTH, N_MOD * D), 0.05),
        "norm_g": 1.0 + nrm(ks[6], (DEPTH, 3, D), 0.05),
        "final_norm_g": 1.0 + nrm(ks[7], (D,), 0.05),
        "ffn_w_gate": nrm(ks[8], (DEPTH, 2, D, D_FF), D ** -0.5),
        "ffn_w_up": nrm(ks[9], (DEPTH, 2, D, D_FF), D ** -0.5),
        "ffn_w_down": nrm(ks[10], (DEPTH, 2, D_FF, D), D_FF ** -0.5),
        "w_in": nrm(ks[11], (DEPTH, D, IN_WIDTH), D ** -0.5),
        "hgrn_lb_logits": nrm(ks[12], (DEPTH, 2, A_WK), 0.5),
        "hgrn_out_norm_g": 1.0 + nrm(ks[13], (DEPTH, A_DV), 0.05),
        "gmlp_ln_g": 1.0 + nrm(ks[14], (DEPTH, B_WIDTH), 0.05),
        "gmlp_ln_b": nrm(ks[15], (DEPTH, B_WIDTH), 0.02),
        "gmlp_w_s": nrm(ks[16], (DEPTH, B_GROUPS, B_CHUNK, B_CHUNK), B_CHUNK ** -0.5),
        "gmlp_b_s": 1.0 + nrm(ks[17], (DEPTH, B_GROUPS, B_CHUNK), 0.1),
        "conv_w": nrm(ks[18], (DEPTH, C_KSIZE, C_WIDTH), C_KSIZE ** -0.5),
        "w_proj_a": nrm(ks[19], (DEPTH, A_WV, D), A_WV ** -0.5),
        "w_proj_b": nrm(ks[20], (DEPTH, B_WIDTH, D), B_WIDTH ** -0.5),
        "w_proj_c": nrm(ks[21], (DEPTH, C_WIDTH, D), C_WIDTH ** -0.5),
        "w_out": nrm(ks[22], (DEPTH, D, D), D ** -0.5),
    }


def reference(x, c, ctx, c_ctx, w_mod, b_mod, norm_g, final_norm_g, ffn_w_gate, ffn_w_up,
              ffn_w_down, w_in, hgrn_lb_logits, hgrn_out_norm_g, gmlp_ln_g, gmlp_ln_b,
              gmlp_w_s, gmlp_b_s, conv_w, w_proj_a, w_proj_b, w_proj_c, w_out):
    bsz, L, _ = x.shape
    rows = L // GRID_W
    lb_all = jnp.cumsum(jax.nn.softmax(hgrn_lb_logits.astype(jnp.float32), axis=0), axis=0)
    lb_all = lb_all - lb_all[:1]
    s_zero = jnp.zeros((bsz, A_HEADS, A_DK, A_DV), jnp.float32)
    y, cs = x, ctx
    for l in range(DEPTH):
        last = l == DEPTH - 1
        mx = jnp.split((jax.nn.silu(c) @ w_mod[l] + b_mod[l])[:, None, :], N_MOD, axis=-1)
        mc = jnp.split((jax.nn.silu(c_ctx) @ w_mod[l] + b_mod[l])[None, None, :], N_MOD, axis=-1)
        y = y + 0.5 * mx[2] * swiglu(adaln_in(y, norm_g[l, 0], mx[0], mx[1]),
                                     ffn_w_gate[l, 0], ffn_w_up[l, 0], ffn_w_down[l, 0])
        cs = cs + 0.5 * mc[2] * swiglu(adaln_in(cs, norm_g[l, 0], mc[0], mc[1]),
                                       ffn_w_gate[l, 0], ffn_w_up[l, 0], ffn_w_down[l, 0])
        mix_w = (w_in[l], lb_all[l, 0], lb_all[l, 1], hgrn_out_norm_g[l], gmlp_ln_g[l], gmlp_ln_b[l],
                 gmlp_w_s[l], gmlp_b_s[l], conv_w[l], w_proj_a[l], w_proj_b[l], w_proj_c[l], w_out[l])
        out_c, s_f, s_b = mixer_stream(adaln_in(cs, norm_g[l, 1], mc[3], mc[4]), s_zero, s_zero,
                                       *mix_w, None, not last)
        out_x, _, _ = mixer_stream(adaln_in(y, norm_g[l, 1], mx[3], mx[4]), s_f, s_b,
                                   *mix_w, rows, True)
        y = y + mx[5] * out_x
        if not last:
            cs = cs + mc[5] * out_c
            cs = cs + 0.5 * mc[8] * swiglu(adaln_in(cs, norm_g[l, 2], mc[6], mc[7]),
                                           ffn_w_gate[l, 1], ffn_w_up[l, 1], ffn_w_down[l, 1])
        y = y + 0.5 * mx[8] * swiglu(adaln_in(y, norm_g[l, 2], mx[6], mx[7]),
                                     ffn_w_gate[l, 1], ffn_w_up[l, 1], ffn_w_down[l, 1])
    return rms_norm(y, final_norm_g)
```

```cpp
#include <hip/hip_runtime.h>
#include <cstdio>
#include <cstdint>
namespace pg8 {
#define PG8_LAS __attribute__((address_space(3)))
typedef unsigned short bf16_t;
typedef short bf16x8 __attribute__((ext_vector_type(8)));
typedef float f32x4 __attribute__((ext_vector_type(4)));
typedef float f32x2 __attribute__((ext_vector_type(2)));
typedef unsigned u32x4 __attribute__((ext_vector_type(4)));
typedef unsigned u32x2 __attribute__((ext_vector_type(2)));
constexpr int BM = 256, BK = 64, HALF = 128, HTB = HALF * BK * 2  , STAGE_BYTES = 8 * HTB, NXCD = 8, WGM = 8;

__host__ __device__ __forceinline__ int lds_byte(int r, int c) { const int st = (r >> 4) * 2 + (c >> 5), rr = r & 15, cc = c & 31, ob = rr * 64 + cc * 2; return st * 1024 + (ob ^ (((ob >> 9) & 1) << 5)); }
__host__ __device__ __forceinline__ void stage_rc(int b, int& R, int& C) { const int st = b / 1024, sb = b % 1024, swz = sb ^ (((sb >> 9) & 1) << 5); R = (st >> 1) * 16 + swz / 64; C = (st & 1) * 32 + (swz % 64) / 2; }
__host__ __device__ __forceinline__ int perm32(int rho) { const int n = rho >> 4, i = rho & 15; return 8 * (i >> 2) + 4 * n + (i & 3); }

struct Unit { int pm, pn; };
struct Gemm { const bf16_t* A; const bf16_t* Bt; int M, N, K, lda, ldb; };

struct StaticOrder {
    int nM, nN, nwg, G, c;
    __host__ __device__ void init(int M, int N, int G_, int c_) { nM = M / BM; nN = N / BM; nwg = nM * nN; G = G_; c = c_; }
    __host__ __device__ bool next(int i, Unit& u) const {
        const long L = (long)i * G + c; if (L >= nwg) return false;
        int wgid = (int)L; { const int q = nwg / NXCD, r = nwg % NXCD, xcd = wgid % NXCD, off = wgid / NXCD; wgid = (xcd < r ? xcd * (q + 1) : r * (q + 1) + (xcd - r) * q) + off; }
        const int nig = WGM * nN, gid = wgid / nig, fm = gid * WGM, gsz = (nM - fm) < WGM ? (nM - fm) : WGM;
        u.pm = fm + ((wgid % nig) % gsz); u.pn = (wgid % nig) / gsz; return true;
    }
    __device__ __forceinline__ void a_ready(const Unit&) const {}
    __device__ __forceinline__ void done(const Unit&) const {}
};

__device__ __forceinline__ unsigned cvt_pk_bf16(float lo, float hi) { unsigned r; asm volatile("v_cvt_pk_bf16_f32 %0, %1, %2" : "=v"(r) : "v"(lo), "v"(hi)); return r; }

template <class Epi, class Sched, bool ALIGN_EPI = false, bool SP2 = false>
__device__ __forceinline__ void gemm_phase(PG8_LAS unsigned char* lds, const Gemm g, const Sched& S, const Epi& E) {
    int tid_ = threadIdx.x; asm volatile("" : "+v"(tid_));
    const int tid = tid_, wid = __builtin_amdgcn_readfirstlane(tid >> 6), lane = tid & 63, wr = wid >> 2, wc = wid & 3, fr = lane & 15, fq = lane >> 4;
    const int K = g.K, nt = K / BK;
    unsigned voffA[2], voffB[2];
#pragma unroll
    for (int i = 0; i < 2; ++i) { int R, C; stage_rc(tid * 16 + i * 8192, R, C); const int Rb = Epi::PERM ? ((R & ~31) + perm32(R & 31)) : R;
        voffA[i] = (unsigned)(R * g.lda + C) * 2u; voffB[i] = (unsigned)(Rb * g.ldb + C) * 2u; }
    const size_t kstep = (size_t)(BK * 2);
    const size_t hstepA = (size_t)HALF * g.lda * 2, hstepB = (size_t)HALF * g.ldb * 2;
    const size_t tstepA = 2 * hstepA, tstepB = 2 * hstepB;
    const unsigned ldsw = (unsigned)wid * 1024u;
    const int aoff = lds_byte(wr * 64 + fr, fq * 8), boff = lds_byte(wc * 32 + fr, fq * 8);
#define PG8_SA(b, h) (((b) * 2 + (h)) * HTB)
#define PG8_SB(b, h) ((4 + (b) * 2 + (h)) * HTB)
#define PG8_STAGE(bufoff, gbase, voff) do { _Pragma("unroll") for (int _i = 0; _i < 2; ++_i) \
        __builtin_amdgcn_global_load_lds((const unsigned*)((const char*)(gbase) + (voff)[_i]), (PG8_LAS unsigned*)(lds + (bufoff) + ldsw + _i * 8192), 16, 0, 0); } while (0)
#define PG8_LDA(dst, b, h) do { _Pragma("unroll") for (int m = 0; m < 4; ++m) _Pragma("unroll") for (int k = 0; k < 2; ++k) dst[m][k] = *(const PG8_LAS bf16x8*)(lds + PG8_SA(b, h) + aoff + m * 2048 + k * 1024); } while (0)
#define PG8_LDB(dst, b, h) do { _Pragma("unroll") for (int n = 0; n < 2; ++n) _Pragma("unroll") for (int k = 0; k < 2; ++k) dst[n][k] = *(const PG8_LAS bf16x8*)(lds + PG8_SB(b, h) + boff + n * 2048 + k * 1024); } while (0)
#define PG8_MMA(ai, bj, At, Bt) do { __builtin_amdgcn_s_setprio(1); _Pragma("unroll") for (int m = 0; m < 4; ++m) _Pragma("unroll") for (int n = 0; n < 2; ++n) _Pragma("unroll") for (int k = 0; k < 2; ++k) \
        acc[ai][bj][m][n] = __builtin_amdgcn_mfma_f32_16x16x32_bf16(Bt[n][k], At[m][k], acc[ai][bj][m][n], 0, 0, 0); __builtin_amdgcn_s_setprio(0); } while (0)
#define PG8_WAIT_V(n) asm volatile("s_waitcnt vmcnt(" #n ")" ::: "memory")
#define PG8_WAIT_L(n) asm volatile("s_waitcnt lgkmcnt(" #n ")" ::: "memory")
#define PG8_BAR __builtin_amdgcn_s_barrier()
#define PG8_SCHED __builtin_amdgcn_sched_barrier(0)
    Unit cur, nxt; int ui = 0;
    if (!S.next(0, cur)) return;
    f32x4 acc[2][2][4][2];
#pragma unroll
    for (int a = 0; a < 2; ++a)
#pragma unroll
        for (int b = 0; b < 2; ++b)
#pragma unroll
            for (int m = 0; m < 4; ++m)
#pragma unroll
                for (int n = 0; n < 2; ++n) acc[a][b][m][n] = (f32x4){0.f, 0.f, 0.f, 0.f};
    bf16x8 At[4][2], B0[2][2], B1[2][2];
    const char* cA = (const char*)g.A + (size_t)cur.pm * tstepA; const char* cB = (const char*)g.Bt + (size_t)cur.pn * tstepB;
    S.a_ready(cur);
    if constexpr (SP2) {
        PG8_STAGE(PG8_SB(0, 0), cB, voffB); PG8_STAGE(PG8_SB(0, 1), cB + hstepB, voffB); PG8_STAGE(PG8_SA(0, 0), cA, voffA); PG8_STAGE(PG8_SA(0, 1), cA + hstepA, voffA);
        if (wr == 1) PG8_BAR;
        PG8_WAIT_V(2); PG8_BAR;
        PG8_STAGE(PG8_SB(1, 0), cB + kstep, voffB); PG8_STAGE(PG8_SA(1, 0), cA + kstep, voffA); PG8_STAGE(PG8_SB(1, 1), cB + hstepB + kstep, voffB);
        PG8_WAIT_V(6); PG8_BAR;
    } else {
        PG8_STAGE(PG8_SB(0, 0), cB, voffB); PG8_STAGE(PG8_SA(0, 0), cA, voffA); PG8_STAGE(PG8_SB(0, 1), cB + hstepB, voffB); PG8_STAGE(PG8_SA(0, 1), cA + hstepA, voffA);
        if (wr == 1) PG8_BAR;
        PG8_WAIT_V(4); PG8_BAR;
        PG8_STAGE(PG8_SB(1, 0), cB + kstep, voffB); PG8_STAGE(PG8_SA(1, 0), cA + kstep, voffA); PG8_STAGE(PG8_SB(1, 1), cB + hstepB + kstep, voffB);
        PG8_WAIT_V(6); PG8_BAR;
    }
    for (;;) {
        const bool has_next = S.next(ui + 1, nxt);
        const char* nA = has_next ? (const char*)g.A + (size_t)nxt.pm * tstepA : cA; const char* nB = has_next ? (const char*)g.Bt + (size_t)nxt.pn * tstepB : cB;
        for (int t = 0; t < nt; t += 2) {
            const bool last = (t == nt - 2);
            const char* a1 = cA + (size_t)(t + 1) * kstep;
            const char* a2 = last ? nA : cA + (size_t)(t + 2) * kstep; const char* b2 = last ? nB : cB + (size_t)(t + 2) * kstep;
            const char* a3 = a2 + kstep; const char* b3 = b2 + kstep;
            if (last && has_next) S.a_ready(nxt);
            if constexpr (SP2) {
            PG8_LDB(B0, 0, 0); PG8_LDB(B1, 0, 1); PG8_SCHED; PG8_LDA(At, 0, 0); PG8_STAGE(PG8_SA(1, 1), a1 + hstepA, voffA);
            PG8_WAIT_V(8); PG8_WAIT_L(0); PG8_BAR; PG8_MMA(0, 0, At, B0); PG8_MMA(0, 1, At, B1); PG8_BAR; PG8_SCHED;
            PG8_LDA(At, 0, 1); PG8_STAGE(PG8_SB(0, 0), b2, voffB); PG8_STAGE(PG8_SB(0, 1), b2 + hstepB, voffB); PG8_STAGE(PG8_SA(0, 0), a2, voffA);
            PG8_WAIT_V(8); PG8_WAIT_L(0); PG8_BAR; PG8_MMA(1, 0, At, B0); PG8_MMA(1, 1, At, B1); PG8_BAR; PG8_SCHED;
            PG8_LDB(B0, 1, 0); PG8_LDB(B1, 1, 1); PG8_SCHED; PG8_LDA(At, 1, 0); PG8_STAGE(PG8_SA(0, 1), a2 + hstepA, voffA);
            PG8_WAIT_V(8); PG8_WAIT_L(0); PG8_BAR; PG8_MMA(0, 0, At, B0); PG8_MMA(0, 1, At, B1); PG8_BAR; PG8_SCHED;
            PG8_LDA(At, 1, 1); PG8_STAGE(PG8_SB(1, 0), b3, voffB); PG8_STAGE(PG8_SB(1, 1), b3 + hstepB, voffB); PG8_STAGE(PG8_SA(1, 0), a3, voffA);
            PG8_WAIT_V(8); PG8_WAIT_L(0); PG8_BAR; PG8_MMA(1, 0, At, B0); PG8_MMA(1, 1, At, B1); PG8_BAR; PG8_SCHED;
            } else {
            PG8_LDB(B0, 0, 0); PG8_SCHED; PG8_LDA(At, 0, 0); PG8_STAGE(PG8_SA(1, 1), a1 + hstepA, voffA);
            PG8_WAIT_L(8); PG8_BAR; PG8_WAIT_L(0); PG8_MMA(0, 0, At, B0); PG8_BAR; PG8_SCHED;
            PG8_LDB(B1, 0, 1); PG8_STAGE(PG8_SB(0, 0), b2, voffB);
            PG8_BAR; PG8_WAIT_L(0); PG8_MMA(0, 1, At, B1); PG8_BAR;
            PG8_LDA(At, 0, 1); PG8_STAGE(PG8_SA(0, 0), a2, voffA);
            PG8_BAR; PG8_WAIT_L(0); PG8_MMA(1, 0, At, B0); PG8_BAR; PG8_SCHED;
            PG8_STAGE(PG8_SB(0, 1), b2 + hstepB, voffB);
            PG8_WAIT_V(6); PG8_BAR; PG8_MMA(1, 1, At, B1); PG8_BAR;
            PG8_LDB(B0, 1, 0); PG8_SCHED; PG8_LDA(At, 1, 0); PG8_STAGE(PG8_SA(0, 1), a2 + hstepA, voffA);
            PG8_WAIT_L(8); PG8_BAR; PG8_WAIT_L(0); PG8_MMA(0, 0, At, B0); PG8_BAR; PG8_SCHED;
            PG8_LDB(B1, 1, 1); PG8_STAGE(PG8_SB(1, 0), b3, voffB);
            PG8_BAR; PG8_WAIT_L(0); PG8_MMA(0, 1, At, B1); PG8_BAR;
            PG8_LDA(At, 1, 1); PG8_STAGE(PG8_SA(1, 0), a3, voffA);
            PG8_BAR; PG8_WAIT_L(0); PG8_MMA(1, 0, At, B0); PG8_BAR; PG8_SCHED;
            PG8_STAGE(PG8_SB(1, 1), b3 + hstepB, voffB);
            PG8_WAIT_V(6); PG8_BAR; PG8_MMA(1, 1, At, B1); PG8_BAR;
            }
        }
        if constexpr (ALIGN_EPI) { if (wr == 0) PG8_BAR; }
        E(acc, cur, wr, wc, fr, fq); S.done(cur);
        if (!has_next) break;
#pragma unroll
        for (int a = 0; a < 2; ++a)
#pragma unroll
            for (int b = 0; b < 2; ++b)
#pragma unroll
                for (int m = 0; m < 4; ++m)
#pragma unroll
                    for (int n = 0; n < 2; ++n) acc[a][b][m][n] = (f32x4){0.f, 0.f, 0.f, 0.f};
        cur = nxt; cA = nA; cB = nB; ++ui;
        if constexpr (ALIGN_EPI) { if (wr == 1) PG8_BAR; }
    }
    PG8_WAIT_V(0);
    if constexpr (!ALIGN_EPI) { if (wr == 0) PG8_BAR; }
    PG8_BAR;
#undef PG8_SA
#undef PG8_SB
#undef PG8_STAGE
#undef PG8_LDA
#undef PG8_LDB
#undef PG8_MMA
#undef PG8_WAIT_V
#undef PG8_WAIT_L
#undef PG8_BAR
#undef PG8_SCHED
}
}
#define XB_TMO      128
#define XB_XCNT(j)  (256  + 64 * (j))
#define XB_XSUB(j)  (1280 + 64 * (j))
#define XB_XGEN(j)  (2304 + 64 * (j))
#define XB_TOP      3328
#define XB_TOPGEN   3392
#define XCD_BAR_WORDS 3456
#define XB_SPIN_CAP (1u << 18)
#define LAS __attribute__((address_space(3)))

__device__ __forceinline__ unsigned xb_ld(unsigned* p)              { return __hip_atomic_load(p, __ATOMIC_RELAXED, __HIP_MEMORY_SCOPE_AGENT); }
__device__ __forceinline__ unsigned xb_add(unsigned* p, unsigned v) { return __hip_atomic_fetch_add(p, v, __ATOMIC_RELAXED, __HIP_MEMORY_SCOPE_AGENT); }
__device__ __forceinline__ unsigned xb_xcc_id() { return (unsigned)__builtin_amdgcn_s_getreg((3 << 11) | 20) & 0xFu; }
#define XB_SPIN(cond, bar) do { unsigned _sp = 0; while (cond) { __builtin_amdgcn_s_sleep(1); \
    if ((++_sp & 255u) == 0u) { if (xb_ld(&(bar)[XB_TMO])) break; if (_sp > XB_SPIN_CAP) { atomicAdd(&(bar)[XB_TMO], 1u); break; } } } } while (0)

struct XcdBarrier {
    unsigned* bar; unsigned x;
    volatile LAS unsigned* st;
};

__device__ __forceinline__ XcdBarrier xcd_barrier_post(unsigned* bar, volatile LAS unsigned* st) {
    XcdBarrier b; b.bar = bar; b.x = xb_xcc_id(); b.st = st;
    if (threadIdx.x == 0) (void)xb_add(&bar[XB_XCNT(b.x)], 1u);
    return b;
}
__device__ __forceinline__ void xcd_barrier_complete(unsigned* bar, unsigned x, unsigned& nloc, unsigned& nx) {
    const unsigned G = gridDim.x * gridDim.y * gridDim.z;
    unsigned sum, cnt, mine, sp = 0u;
    for (;;) {
        sum = 0u; cnt = 0u; mine = 0u;
#pragma unroll
        for (unsigned j = 0; j < 16; ++j) { const unsigned c = xb_ld(&bar[XB_XCNT(j)]); sum += c; cnt += (c > 0u) ? 1u : 0u; mine = (j == x) ? c : mine; }
        if (sum == G) break;
        __builtin_amdgcn_s_sleep(1);
        if ((++sp & 255u) == 0u) { if (xb_ld(&bar[XB_TMO])) break; if (sp > XB_SPIN_CAP) { atomicAdd(&bar[XB_TMO], 1u); break; } }
    }
    nloc = mine > 0u ? mine : 1u; nx = cnt > 0u ? cnt : 1u;
}

__device__ __forceinline__ void xcd_barrier(const XcdBarrier& b) {
    asm volatile("s_waitcnt vmcnt(0)" ::: "memory");
    __syncthreads();
    if (threadIdx.x == 0) {
        unsigned* bar = b.bar;
        __builtin_amdgcn_s_waitcnt(0);
        unsigned nloc = b.st[0], nx = b.st[1];
        if (nloc == 0u) { xcd_barrier_complete(bar, b.x, nloc, nx); b.st[0] = nloc; b.st[1] = nx; }
        const unsigned old = xb_add(&bar[XB_XSUB(b.x)], 1u);
        const unsigned gen = old / nloc;
        if (old + 1u == (gen + 1u) * nloc) {
            __builtin_amdgcn_fence(__ATOMIC_RELEASE, "agent");
            asm volatile("s_waitcnt vmcnt(0)" ::: "memory");
            const unsigned og = xb_add(&bar[XB_TOP], 1u);
            const unsigned tg = og / nx;
            if (og + 1u == (tg + 1u) * nx) xb_add(&bar[XB_TOPGEN], 1u);
            else XB_SPIN(xb_ld(&bar[XB_TOPGEN]) == tg, bar);
            __builtin_amdgcn_fence(__ATOMIC_ACQUIRE, "agent");
            xb_add(&bar[XB_XGEN(b.x)], 1u);
            asm volatile("s_waitcnt vmcnt(0)" ::: "memory");
        } else {
            XB_SPIN(xb_ld(&bar[XB_XGEN(b.x)]) == gen, bar);
            __builtin_amdgcn_fence(__ATOMIC_ACQUIRE, "agent");
            asm volatile("s_waitcnt vmcnt(0)" ::: "memory");
        }
    }
    __syncthreads();
}

constexpr int D = 2048, NB = 4, SEQ = 4096, DEPTH = 4, CTXL = 256, NMOD = 9, DFF = 5632, NH = 8, DK = 128, DV = 128, WK = 1024;
constexpr int BW = 512, CWD = 512, INW = 13824;
constexpr int M_LAT = NB * SEQ, M_CTX = NB * CTXL, M = M_LAT + M_CTX;
constexpr int MODW = NMOD * D;
constexpr int NGRP = 5;
constexpr float EPS = 1e-6f;
constexpr int Z1W = 4096, Z2W = INW - Z1W;
constexpr int Z2_GA = 0, Z2_U = 1024, Z2_V = 1536, Z2_HC = 2048, Z2_GB = 2560, Z2_GC = 3072, Z2_MA = 3584, Z2_MB = 5632, Z2_MC = 7680;

constexpr size_t MiB = 1u << 20;
constexpr size_t WS_CTL = 0ull * MiB, CTL_ZERO_BYTES = 1 * MiB;
constexpr size_t WS_MOD = 1ull * MiB;
constexpr size_t WS_LB = 3ull * MiB;
constexpr size_t WS_WGU = 4ull * MiB;
constexpr size_t WS_WD = 356ull * MiB;
constexpr size_t WS_WIN = 532ull * MiB;
constexpr size_t WS_WP = 748ull * MiB;
constexpr size_t WS_WO = 780ull * MiB;
constexpr size_t WS_Y = 812ull * MiB;
constexpr size_t WS_H = 948ull * MiB;
constexpr size_t WS_MRG = 1016ull * MiB;
constexpr size_t WS_YABC = 1084ull * MiB;
constexpr size_t WS_MF32 = 1152ull * MiB;
constexpr size_t WS_OF = 1288ull * MiB;
constexpr size_t WS_OB = 1356ull * MiB;
constexpr size_t WS_FF = 1424ull * MiB;
constexpr size_t WS_FB = 1492ull * MiB;
constexpr size_t WS_VN = 1560ull * MiB;
constexpr size_t WS_Z1 = 1577ull * MiB;
constexpr size_t WS_Z2 = 1849ull * MiB;
constexpr size_t WS_ACT = WS_Z1;
constexpr size_t WS_END = 2172ull * MiB;
constexpr int CW_BAR = 4096;

constexpr int RING_BYTES = 131072;
constexpr int LDSCTL_OFF = RING_BYTES, MISC_OFF = LDSCTL_OFF + 320;
constexpr int LDS_BYTES = 147456;

#define GAS __attribute__((address_space(1)))
typedef unsigned short bf16;
typedef unsigned v4u __attribute__((ext_vector_type(4)));
typedef unsigned v2u __attribute__((ext_vector_type(2)));
typedef float f32x4 __attribute__((ext_vector_type(4)));
#define LDS_WAIT() asm volatile("s_waitcnt lgkmcnt(0)" ::: "memory")
#define VM_WAIT() asm volatile("s_waitcnt vmcnt(0)" ::: "memory")
__device__ __forceinline__ unsigned f2bf(float f) { unsigned u = __builtin_bit_cast(unsigned, f); return (u + 0x7fffu + ((u >> 16) & 1u)) >> 16; }
__device__ __forceinline__ unsigned pk2(float lo, float hi) { return f2bf(lo) | (f2bf(hi) << 16); }
__device__ __forceinline__ float bflo(unsigned w) { return __builtin_bit_cast(float, w << 16); }
__device__ __forceinline__ float bfhi(unsigned w) { return __builtin_bit_cast(float, w & 0xffff0000u); }
__device__ __forceinline__ float sigmoidf_(float x) { return __builtin_amdgcn_rcpf(1.0f + __expf(-x)); }
__device__ __forceinline__ float siluf_(float x) { return x * sigmoidf_(x); }
__device__ __forceinline__ float gelu_tanh(float x) { const float u = 0.7978845608028654f * (x + 0.044715f * x * x * x); return x * sigmoidf_(2.0f * u); }
template <int CTRL> __device__ __forceinline__ float dppf(float x) { return __builtin_bit_cast(float, __builtin_amdgcn_mov_dpp(__builtin_bit_cast(int, x), CTRL, 0xf, 0xf, true)); }
__device__ __forceinline__ float row16_sum(float x) { x += dppf<0xB1>(x); x += dppf<0x4E>(x); x += dppf<0x124>(x); x += dppf<0x128>(x); return x; }
__device__ __forceinline__ float wave_sum(float v) {
#pragma unroll
    for (int o = 1; o < 64; o <<= 1) v += __shfl_xor(v, o);
    return v;
}
__device__ __forceinline__ int grp_of_row(int m) { return m < M_LAT ? (m >> 12) : 4; }

struct Frame {
    LAS unsigned char* lds;
    int tid, lane, wave, vcu, G;
    unsigned char* ws;
};
struct Args { const float* in[23]; float* out; unsigned char* ws; int ph_lo, ph_hi; };
typedef const __attribute__((address_space(4))) Args* KArgs;
__device__ __forceinline__ KArgs kargs() { auto p = __builtin_amdgcn_kernarg_segment_ptr(); asm volatile("" : "+s"(p)); return (KArgs)p; }
__device__ __forceinline__ Frame mkframe() {
    extern __shared__ __attribute__((aligned(16))) unsigned char lds_dyn[];
    Frame F; F.lds = (LAS unsigned char*)lds_dyn; { int t = threadIdx.x; asm volatile("" : "+v"(t)); F.tid = t; } F.lane = F.tid & 63; F.wave = __builtin_amdgcn_readfirstlane(F.tid >> 6);
    { int gg = gridDim.x; asm volatile("" : "+s"(gg)); F.G = gg; } { int bx = blockIdx.x; asm volatile("" : "+s"(bx)); F.vcu = (F.G % 8 == 0) ? (bx % 8) * (F.G / 8) + bx / 8 : bx; }
    F.ws = kargs()->ws; return F;
}

namespace pg8 {
struct EpiSwiGLU { static constexpr bool PERM = true;
    bf16_t* O;
    __device__ __forceinline__ void operator()(const f32x4 (&acc)[2][2][4][2], const Unit& u, int wr, int wc, int fr, int fq) const {
        const int row0 = u.pm * BM + wr * 64 + fr, col0 = u.pn * HALF + wc * 32 + 8 * fq;
#pragma unroll
        for (int ai = 0; ai < 2; ++ai)
#pragma unroll
            for (int m = 0; m < 4; ++m) { bf16_t* rowp = O + (size_t)(row0 + ai * HALF + m * 16) * DFF + col0;
                f32x4 g0 = acc[ai][0][m][0], g1 = acc[ai][0][m][1], u0 = acc[ai][1][m][0], u1 = acc[ai][1][m][1]; f32x4 v0, v1;
#pragma unroll
                for (int j = 0; j < 4; ++j) { v0[j] = siluf_(g0[j]) * u0[j]; v1[j] = siluf_(g1[j]) * u1[j]; }
                u32x4 w; w.x = cvt_pk_bf16(v0[0], v0[1]); w.y = cvt_pk_bf16(v0[2], v0[3]); w.z = cvt_pk_bf16(v1[0], v1[1]); w.w = cvt_pk_bf16(v1[2], v1[3]);
                *(u32x4*)rowp = w; }
    }
};
struct EpiResid { static constexpr bool PERM = false;
    float* Y; const float* gate; float coef;
    __device__ __forceinline__ void operator()(const f32x4 (&acc)[2][2][4][2], const Unit& u, int wr, int wc, int fr, int fq) const {
        const int row0 = u.pm * BM + wr * 64 + fr, col0 = u.pn * BM + wc * 32 + 4 * fq; const int grp = u.pm < 64 ? (u.pm >> 4) : 4;
        const float* gp = gate + (size_t)grp * MODW + col0; f32x4 gv[2][2];
#pragma unroll
        for (int bj = 0; bj < 2; ++bj)
#pragma unroll
            for (int n = 0; n < 2; ++n) gv[bj][n] = *(const f32x4*)(gp + bj * HALF + n * 16) * coef;
#pragma unroll
        for (int ai = 0; ai < 2; ++ai)
#pragma unroll
            for (int m = 0; m < 4; ++m) { float* rowp = Y + (size_t)(row0 + ai * HALF + m * 16) * D + col0;
#pragma unroll
                for (int bj = 0; bj < 2; ++bj)
#pragma unroll
                    for (int n = 0; n < 2; ++n) { float* p = rowp + bj * HALF + n * 16; const f32x4 o = *(const f32x4*)p; *(f32x4*)p = o + gv[bj][n] * acc[ai][bj][m][n]; }
                asm volatile("" ::: "memory"); }
    }
};
struct EpiInproj { static constexpr bool PERM = true;
    float* Z1; bf16_t* Z2;
    __device__ __forceinline__ void operator()(const f32x4 (&acc)[2][2][4][2], const Unit& u, int wr, int wc, int fr, int fq) const {
        const int row0 = u.pm * BM + wr * 64 + fr;
        if (u.pn < 16) { const int col0 = u.pn * BM + wc * 32 + 8 * fq;
#pragma unroll
            for (int ai = 0; ai < 2; ++ai)
#pragma unroll
                for (int m = 0; m < 4; ++m) { float* rowp = Z1 + (size_t)(row0 + ai * HALF + m * 16) * Z1W + col0;
#pragma unroll
                    for (int bj = 0; bj < 2; ++bj) { *(f32x4*)(rowp + bj * HALF) = acc[ai][bj][m][0]; *(f32x4*)(rowp + bj * HALF + 4) = acc[ai][bj][m][1]; } }
        } else { const int col0 = (u.pn - 16) * BM + wc * 32 + 8 * fq;
#pragma unroll
            for (int ai = 0; ai < 2; ++ai)
#pragma unroll
                for (int m = 0; m < 4; ++m) { bf16_t* rowp = Z2 + (size_t)(row0 + ai * HALF + m * 16) * Z2W + col0;
#pragma unroll
                    for (int bj = 0; bj < 2; ++bj) { const f32x4 v0 = acc[ai][bj][m][0], v1 = acc[ai][bj][m][1];
                        u32x4 w; w.x = cvt_pk_bf16(v0[0], v0[1]); w.y = cvt_pk_bf16(v0[2], v0[3]); w.z = cvt_pk_bf16(v1[0], v1[1]); w.w = cvt_pk_bf16(v1[2], v1[3]);
                        *(u32x4*)(rowp + bj * HALF) = w; } }
        }
    }
};
template <int STAGE> struct EpiProj { static constexpr bool PERM = false;
    float* MF; bf16_t* MRG; const bf16_t* Gm;
    __device__ __forceinline__ void operator()(const f32x4 (&acc)[2][2][4][2], const Unit& u, int wr, int wc, int fr, int fq) const {
        const int row0 = u.pm * BM + wr * 64 + fr, col0 = u.pn * BM + wc * 32 + 4 * fq;
#pragma unroll
        for (int ai = 0; ai < 2; ++ai)
#pragma unroll
            for (int m = 0; m < 4; ++m) { const size_t row = (size_t)(row0 + ai * HALF + m * 16);
#pragma unroll
                for (int bj = 0; bj < 2; ++bj)
#pragma unroll
                    for (int n = 0; n < 2; ++n) { const int col = col0 + bj * HALF + n * 16;
                        const u32x2 gw = *(const u32x2*)(Gm + row * Z2W + col);
                        f32x4 s; s[0] = sigmoidf_(bflo(gw.x)); s[1] = sigmoidf_(bfhi(gw.x)); s[2] = sigmoidf_(bflo(gw.y)); s[3] = sigmoidf_(bfhi(gw.y));
                        f32x4 v = s * acc[ai][bj][m][n]; float* p = MF + row * D + col;
                        if (STAGE >= 1) v = v + *(const f32x4*)p;
                        if (STAGE <= 1) *(f32x4*)p = v;
                        else { u32x2 w; w.x = cvt_pk_bf16(v[0], v[1]); w.y = cvt_pk_bf16(v[2], v[3]); *(u32x2*)(MRG + row * D + col) = w; } }
                asm volatile("" ::: "memory"); }
    }
};
}

__device__ __forceinline__ void transpose_item(const float* W, int ldw, int k0, int n0, bf16* dst, int ldk, int drow0, int dk0, LAS float* scr, int lane) {
#pragma unroll 8
    for (int i = 0; i < 32; ++i) { const int kk = 2 * i + (lane >> 5); scr[kk * 33 + (lane & 31)] = W[(size_t)(k0 + kk) * ldw + n0 + (lane & 31)]; }
    LDS_WAIT(); asm volatile("" ::: "memory");
    const int c = lane & 7;
#pragma unroll
    for (int j = 0; j < 4; ++j) { const int n = (lane >> 3) + 8 * j; const LAS float* s = scr + (8 * c) * 33 + n;
        v4u o; o.x = pk2(s[0 * 33], s[1 * 33]); o.y = pk2(s[2 * 33], s[3 * 33]); o.z = pk2(s[4 * 33], s[5 * 33]); o.w = pk2(s[6 * 33], s[7 * 33]);
        *(GAS v4u*)(dst + (size_t)(drow0 + n) * ldk + dk0 + k0 + 8 * c) = o; }
    LDS_WAIT(); asm volatile("" ::: "memory");
}

enum { IX = 0, IC, ICTX, ICCTX, IWMOD, IBMOD, INORMG, IFINALG, IWGATE, IWUP, IWDOWN, IWIN, ILB, IANORM, ILNG, ILNB, IWS, IBS, ICONV, IWPA, IWPB, IWPC, IWOUT };
#define INP(k) (kargs()->in[(k)])

__device__ __forceinline__ void phase_prologue() {
    const Frame F = mkframe(); unsigned char* ws = F.ws;
    const int gw = F.vcu * 8 + F.wave, NGW = F.G * 8;
    { float* Y = (float*)(ws + WS_Y);
      for (int m = gw; m < M; m += NGW) { const float* src = m < M_LAT ? INP(IX) + (size_t)m * D : INP(ICTX) + (size_t)(m - M_LAT) * D; const GAS f32x4* s = (const GAS f32x4*)src + F.lane; GAS f32x4* d = (GAS f32x4*)(Y + (size_t)m * D) + F.lane;
#pragma unroll
          for (int j = 0; j < 8; ++j) d[64 * j] = s[64 * j]; } }
    if (blockIdx.x == 0) { float* LB = (float*)(ws + WS_LB);
        for (int i = F.tid; i < 2 * WK; i += 512) { float lg[DEPTH], mx = -1e30f;
#pragma unroll
            for (int l = 0; l < DEPTH; ++l) { lg[l] = INP(ILB)[l * 2 * WK + i]; mx = fmaxf(mx, lg[l]); }
            float s = 0.f;
#pragma unroll
            for (int l = 0; l < DEPTH; ++l) { lg[l] = __expf(lg[l] - mx); s += lg[l]; }
            float cum = 0.f; const float inv = 1.0f / s;
#pragma unroll
            for (int l = 0; l < DEPTH; ++l) { LB[l * 2 * WK + i] = cum; if (l + 1 < DEPTH) cum += lg[l + 1] * inv; } } }
    { LAS float* sc = (LAS float*)F.lds;
      LAS float* red = (LAS float*)(F.lds + 5 * D * 4);
      for (int i = F.tid; i < NGRP * D; i += 512) { const int g = i / D, k = i % D; const float v = g < 4 ? INP(IC)[g * D + k] : INP(ICCTX)[k]; sc[i] = siluf_(v); }
      __syncthreads();
      float* MOD = (float*)(ws + WS_MOD);
      constexpr int NU = DEPTH * (MODW / 128);
      for (int u = F.vcu; u < NU; u += F.G) { const int l = u / (MODW / 128), n0 = (u % (MODW / 128)) * 128;
          const float* Wp = INP(IWMOD) + (size_t)l * D * MODW + n0 + 2 * F.lane;
          float a0[NGRP], a1[NGRP];
#pragma unroll
          for (int g = 0; g < NGRP; ++g) { a0[g] = 0.f; a1[g] = 0.f; }
          const int kb = F.wave * 256;
#pragma unroll 4
          for (int k = kb; k < kb + 256; ++k) { const float2 w = *(const float2*)(Wp + (size_t)k * MODW);
#pragma unroll
              for (int g = 0; g < NGRP; ++g) { const float s = sc[g * D + k]; a0[g] += s * w.x; a1[g] += s * w.y; } }
#pragma unroll
          for (int g = 0; g < NGRP; ++g) { red[(F.wave * NGRP + g) * 128 + 2 * F.lane] = a0[g]; red[(F.wave * NGRP + g) * 128 + 2 * F.lane + 1] = a1[g]; }
          __syncthreads();
          for (int i = F.tid; i < NGRP * 128; i += 512) { const int g = i / 128, n = i % 128; float s = 0.f;
#pragma unroll
              for (int w = 0; w < 8; ++w) s += red[(w * NGRP + g) * 128 + n];
              MOD[((size_t)l * NGRP + g) * MODW + n0 + n] = s + INP(IBMOD)[l * MODW + n0 + n]; }
          __syncthreads(); }
    }
    __syncthreads();
    { LAS float* scr = (LAS float*)(F.lds + F.wave * 16384);
      constexpr int I_FF = (D / 64) * (DFF / 32);
      constexpr int I_IN = (D / 64) * (INW / 32);
      constexpr int I_PA = (1024 / 64) * (D / 32), I_PB = (512 / 64) * (D / 32);
      constexpr int I_WO = (D / 64) * (D / 32);
      constexpr int PER_L = 6 * I_FF + I_IN + I_PA + 2 * I_PB + I_WO;
      constexpr int NITEMS = DEPTH * PER_L;
      bf16* WGU = (bf16*)(ws + WS_WGU); bf16* WD = (bf16*)(ws + WS_WD); bf16* WIN = (bf16*)(ws + WS_WIN); bf16* WP = (bf16*)(ws + WS_WP); bf16* WO = (bf16*)(ws + WS_WO);
      for (int it = gw; it < NITEMS; it += NGW) {
          const int l = it / PER_L; int r = it % PER_L;
          if (r < 6 * I_FF) { const int j = r / (3 * I_FF); r %= 3 * I_FF; const int which = r / I_FF; r %= I_FF; const size_t lj = (size_t)(l * 2 + j);
              if (which < 2) { const int nblk = DFF / 32, kb = r / nblk, nb = r % nblk, n0 = 32 * nb;
                  const float* W = (which == 0 ? INP(IWGATE) : INP(IWUP)) + lj * D * DFF;
                  transpose_item(W, DFF, 64 * kb, n0, WGU + lj * (size_t)(2 * DFF) * D, D, 256 * (n0 >> 7) + (n0 & 127) + 128 * which, 0, scr, F.lane);
              } else { const int nblk = D / 32, kb = r / nblk, nb = r % nblk;
                  transpose_item(INP(IWDOWN) + lj * DFF * D, D, 64 * kb, 32 * nb, WD + lj * (size_t)D * DFF, DFF, 32 * nb, 0, scr, F.lane); }
              continue; }
          r -= 6 * I_FF;
          if (r < I_IN) { const int nblk = INW / 32, kb = r / nblk, nb = r % nblk; transpose_item(INP(IWIN) + (size_t)l * D * INW, INW, 64 * kb, 32 * nb, WIN + (size_t)l * INW * D, D, 32 * nb, 0, scr, F.lane); continue; }
          r -= I_IN;
          if (r < I_PA) { const int nblk = D / 32, kb = r / nblk, nb = r % nblk; transpose_item(INP(IWPA) + (size_t)l * 1024 * D, D, 64 * kb, 32 * nb, WP + (size_t)l * D * 2048, 2048, 32 * nb, 0, scr, F.lane); continue; }
          r -= I_PA;
          if (r < I_PB) { const int nblk = D / 32, kb = r / nblk, nb = r % nblk; transpose_item(INP(IWPB) + (size_t)l * 512 * D, D, 64 * kb, 32 * nb, WP + (size_t)l * D * 2048, 2048, 32 * nb, 1024, scr, F.lane); continue; }
          r -= I_PB;
          if (r < I_PB) { const int nblk = D / 32, kb = r / nblk, nb = r % nblk; transpose_item(INP(IWPC) + (size_t)l * 512 * D, D, 64 * kb, 32 * nb, WP + (size_t)l * D * 2048, 2048, 32 * nb, 1536, scr, F.lane); continue; }
          r -= I_PB;
          { const int nblk = D / 32, kb = r / nblk, nb = r % nblk; transpose_item(INP(IWOUT) + (size_t)l * D * D, D, 64 * kb, 32 * nb, WO + (size_t)l * D * D, D, 32 * nb, 0, scr, F.lane); }
      }
    }
}

__device__ __forceinline__ void phase_norm(int l, int which) {
    const Frame F = mkframe(); const float* Y = (const float*)(F.ws + WS_Y); bf16* H = (bf16*)(F.ws + WS_H);
    const float* g = INP(INORMG) + (size_t)(l * 3 + which) * D; const float* mod_l = (const float*)(F.ws + WS_MOD) + (size_t)l * NGRP * MODW; const int shift_idx = 3 * which;
    const int gw = F.vcu * 8 + F.wave, NGW = F.G * 8;
    for (int m = gw; m < M; m += NGW) {
        const GAS f32x4* xr = (const GAS f32x4*)(Y + (size_t)m * D) + F.lane; f32x4 v[8]; float ss = 0.f;
#pragma unroll
        for (int j = 0; j < 8; ++j) { v[j] = xr[64 * j]; ss += (v[j].x * v[j].x + v[j].y * v[j].y) + (v[j].z * v[j].z + v[j].w * v[j].w); }
        const float rstd = 1.0f / sqrtf(wave_sum(ss) * (1.0f / D) + EPS);
        const float* mp = mod_l + (size_t)grp_of_row(m) * MODW + shift_idx * D;
        GAS unsigned long long* o8 = (GAS unsigned long long*)(H + (size_t)m * D) + F.lane;
#pragma unroll
        for (int j = 0; j < 8; ++j) { const f32x4 gg = ((const GAS f32x4*)g)[64 * j + F.lane], sh = ((const GAS f32x4*)mp)[64 * j + F.lane], sc = ((const GAS f32x4*)(mp + D))[64 * j + F.lane];
            const f32x4 h = v[j] * rstd * gg * (1.0f + sc) + sh;
            o8[64 * j] = (unsigned long long)pk2(h.x, h.y) | ((unsigned long long)pk2(h.z, h.w) << 32); }
    }
}

__device__ __forceinline__ void phase_final() {
    const Frame F = mkframe(); const float* Y = (const float*)(F.ws + WS_Y); float* out = kargs()->out; const float* g = INP(IFINALG);
    const int gw = F.vcu * 8 + F.wave, NGW = F.G * 8;
    for (int m = gw; m < M_LAT; m += NGW) {
        const GAS f32x4* xr = (const GAS f32x4*)(Y + (size_t)m * D) + F.lane; f32x4 v[8]; float ss = 0.f;
#pragma unroll
        for (int j = 0; j < 8; ++j) { v[j] = xr[64 * j]; ss += (v[j].x * v[j].x + v[j].y * v[j].y) + (v[j].z * v[j].z + v[j].w * v[j].w); }
        const float rstd = 1.0f / sqrtf(wave_sum(ss) * (1.0f / D) + EPS);
        GAS f32x4* o = (GAS f32x4*)(out + (size_t)m * D) + F.lane;
#pragma unroll
        for (int j = 0; j < 8; ++j) o[64 * j] = v[j] * rstd * ((const GAS f32x4*)g)[64 * j + F.lane];
    }
}

__device__ __forceinline__ void phase_mix_elem(int l) {
    const Frame F = mkframe(); unsigned char* ws = F.ws;
    const float* Z1 = (const float*)(ws + WS_Z1); const bf16* Z2 = (const bf16*)(ws + WS_Z2);
    float* FFp = (float*)(ws + WS_FF); float* FBp = (float*)(ws + WS_FB); bf16* VN = (bf16*)(ws + WS_VN); bf16* YABC = (bf16*)(ws + WS_YABC);
    const float* LB = (const float*)(ws + WS_LB) + (size_t)l * 2 * WK;
    const int gw = F.vcu * 8 + F.wave, NGW = F.G * 8, lane = F.lane;
    for (int m = gw; m < M; m += NGW) {
#pragma unroll
        for (int dir = 0; dir < 2; ++dir) { const GAS f32x4* zp = (const GAS f32x4*)(Z1 + (size_t)m * Z1W + 2048 + dir * WK) + lane; const GAS f32x4* lp = (const GAS f32x4*)(LB + dir * WK) + lane;
            GAS f32x4* op = (GAS f32x4*)((dir ? FBp : FFp) + (size_t)m * WK) + lane;
#pragma unroll
            for (int j = 0; j < 4; ++j) { const f32x4 z = zp[64 * j], lb = lp[64 * j]; f32x4 f;
#pragma unroll
                for (int e = 0; e < 4; ++e) f[e] = lb[e] + (1.0f - lb[e]) * sigmoidf_(z[e]);
                op[64 * j] = f; } }
        { const v4u raw = *(const GAS v4u*)(Z2 + (size_t)m * Z2W + Z2_V + 8 * lane); float x[8];
          x[0] = gelu_tanh(bflo(raw.x)); x[1] = gelu_tanh(bfhi(raw.x)); x[2] = gelu_tanh(bflo(raw.y)); x[3] = gelu_tanh(bfhi(raw.y));
          x[4] = gelu_tanh(bflo(raw.z)); x[5] = gelu_tanh(bfhi(raw.z)); x[6] = gelu_tanh(bflo(raw.w)); x[7] = gelu_tanh(bfhi(raw.w));
          float s = 0.f;
#pragma unroll
          for (int e = 0; e < 8; ++e) s += x[e];
          const float mean = wave_sum(s) * (1.0f / BW); float q = 0.f;
#pragma unroll
          for (int e = 0; e < 8; ++e) { x[e] -= mean; q += x[e] * x[e]; }
          const float rstd = 1.0f / sqrtf(wave_sum(q) * (1.0f / BW) + EPS);
          const float* gp = INP(ILNG) + l * BW + 8 * lane; const float* bp = INP(ILNB) + l * BW + 8 * lane; float y[8];
#pragma unroll
          for (int e = 0; e < 8; ++e) y[e] = x[e] * rstd * gp[e] + bp[e];
          v4u o; o.x = pk2(y[0], y[1]); o.y = pk2(y[2], y[3]); o.z = pk2(y[4], y[5]); o.w = pk2(y[6], y[7]);
          *(GAS v4u*)(VN + (size_t)m * BW + 8 * lane) = o; }
        { bool hp, hn; if (m < M_LAT) { const int p = m & 63; hp = p != 0; hn = p != 63; } else { const int p = (m - M_LAT) & 255; hp = p != 0; hn = p != 255; }
          float t[3][8];
#pragma unroll
          for (int d = 0; d < 3; ++d) { const bool ok = d == 1 || (d == 0 ? hp : hn); const size_t mm = (size_t)(ok ? m + d - 1 : m);
              const v4u hc = *(const GAS v4u*)(Z2 + mm * Z2W + Z2_HC + 8 * lane), gc = *(const GAS v4u*)(Z2 + mm * Z2W + Z2_GC + 8 * lane); const float z = ok ? 1.0f : 0.0f;
              t[d][0] = z * bflo(hc.x) * bflo(gc.x); t[d][1] = z * bfhi(hc.x) * bfhi(gc.x); t[d][2] = z * bflo(hc.y) * bflo(gc.y); t[d][3] = z * bfhi(hc.y) * bfhi(gc.y);
              t[d][4] = z * bflo(hc.z) * bflo(gc.z); t[d][5] = z * bfhi(hc.z) * bfhi(gc.z); t[d][6] = z * bflo(hc.w) * bflo(gc.w); t[d][7] = z * bfhi(hc.w) * bfhi(gc.w); }
          const v4u gbr = *(const GAS v4u*)(Z2 + (size_t)m * Z2W + Z2_GB + 8 * lane); float gb[8];
          gb[0] = bflo(gbr.x); gb[1] = bfhi(gbr.x); gb[2] = bflo(gbr.y); gb[3] = bfhi(gbr.y); gb[4] = bflo(gbr.z); gb[5] = bfhi(gbr.z); gb[6] = bflo(gbr.w); gb[7] = bfhi(gbr.w);
          const float* cw = INP(ICONV) + (size_t)l * 3 * CWD + 8 * lane; float y[8];
#pragma unroll
          for (int e = 0; e < 8; ++e) y[e] = gb[e] * (cw[e] * t[0][e] + cw[CWD + e] * t[1][e] + cw[2 * CWD + e] * t[2][e]);
          v4u o; o.x = pk2(y[0], y[1]); o.y = pk2(y[2], y[3]); o.z = pk2(y[4], y[5]); o.w = pk2(y[6], y[7]);
          *(GAS v4u*)(YABC + (size_t)m * 2048 + 1536 + 8 * lane) = o; }
    }
}

__device__ __forceinline__ int scan_row(int step, int b, int dir) { return step < CTXL ? (M_LAT + b * CTXL + (dir ? CTXL - 1 - step : step)) : (b * SEQ + (dir ? SEQ - 1 - (step - CTXL) : (step - CTXL))); }
__device__ __forceinline__ void phase_scan_v1() {
    const Frame F = mkframe(); unsigned char* ws = F.ws;
    const float* Z1 = (const float*)(ws + WS_Z1);
    const int lane = F.lane, v = 4 * F.wave + (lane >> 4), kg = lane & 15;
    constexpr int TOT = CTXL + SEQ;
    for (int u = blockIdx.x; u < 256; u += F.G) {
        const int b = u >> 6, h = (u >> 3) & 7, dir = (u >> 2) & 1, vs = u & 3;
        const float* Fp = (const float*)(ws + (dir ? WS_FB : WS_FF)) + h * DK + 8 * kg;
        const float* Qp = Z1 + h * DK + 8 * kg;
        const float* Vp = Z1 + 1024 + h * DV + vs * 32 + v;
        float* Op = (float*)(ws + (dir ? WS_OB : WS_OF)) + h * DV + vs * 32 + v;
        float S[8];
#pragma unroll
        for (int j = 0; j < 8; ++j) S[j] = 0.f;
#define rowof(step) scan_row((step), b, dir)
        f32x4 fa[4][2], qa[4][2]; float va[4];
#pragma unroll
        for (int i = 0; i < 4; ++i) { const size_t r = (size_t)rowof(i); fa[i][0] = *(const f32x4*)(Fp + r * WK); fa[i][1] = *(const f32x4*)(Fp + r * WK + 4); qa[i][0] = *(const f32x4*)(Qp + r * Z1W); qa[i][1] = *(const f32x4*)(Qp + r * Z1W + 4); va[i] = Vp[r * Z1W]; }
        for (int s0 = 0; s0 < TOT; s0 += 4) {
            f32x4 fn[4][2], qn[4][2]; float vn[4];
            const int sn = (s0 + 4 < TOT) ? s0 + 4 : s0;
#pragma unroll
            for (int i = 0; i < 4; ++i) { const size_t r = (size_t)rowof(sn + i); fn[i][0] = *(const f32x4*)(Fp + r * WK); fn[i][1] = *(const f32x4*)(Fp + r * WK + 4); qn[i][0] = *(const f32x4*)(Qp + r * Z1W); qn[i][1] = *(const f32x4*)(Qp + r * Z1W + 4); vn[i] = Vp[r * Z1W]; }
            float po[4];
#pragma unroll
            for (int i = 0; i < 4; ++i) { float p = 0.f;
#pragma unroll
                for (int j = 0; j < 8; ++j) { const float f = fa[i][j >> 2][j & 3]; S[j] = f * S[j] + (1.0f - f) * va[i]; p += qa[i][j >> 2][j & 3] * S[j]; }
                po[i] = p; }
#pragma unroll
            for (int i = 0; i < 4; ++i) po[i] = row16_sum(po[i]);
            if (kg == 0) {
#pragma unroll
                for (int i = 0; i < 4; ++i) Op[(size_t)rowof(s0 + i) * WK] = po[i] * 0.08838834764831845f; }
#pragma unroll
            for (int i = 0; i < 4; ++i) { fa[i][0] = fn[i][0]; fa[i][1] = fn[i][1]; qa[i][0] = qn[i][0]; qa[i][1] = qn[i][1]; va[i] = vn[i]; }
        }
    }
#undef rowof
}

__device__ __forceinline__ void phase_gmlp_v1(int l) {
    const Frame F = mkframe(); unsigned char* ws = F.ws;
    const bf16* Z2 = (const bf16*)(ws + WS_Z2); const bf16* VN = (const bf16*)(ws + WS_VN); bf16* YABC = (bf16*)(ws + WS_YABC);
    LAS float* Wt = (LAS float*)F.lds;
    LAS float* Vt = (LAS float*)(F.lds + 65536);
    constexpr int NU = (M / 128) * 4;
    const int tt = F.tid >> 4, cc = F.tid & 15, t0 = 4 * tt, ch0 = 8 * cc;
    for (int u = F.vcu; u < NU; u += F.G) { const int chunk = u >> 2, g = u & 3; const size_t r0 = (size_t)chunk * 128;
        __syncthreads();
        const float* wsrc = INP(IWS) + ((size_t)l * 4 + g) * 128 * 128;
        for (int i = F.tid; i < 128 * 128; i += 512) { const int t = i >> 7, s = i & 127; Wt[s * 128 + t] = wsrc[i]; }
        for (int i = F.tid; i < 128 * 16; i += 512) { const int s = i >> 4, c8 = i & 15; const v4u raw = *(const GAS v4u*)(VN + (r0 + s) * BW + g * 128 + 8 * c8); LAS float* d = Vt + s * 128 + 8 * c8;
            d[0] = bflo(raw.x); d[1] = bfhi(raw.x); d[2] = bflo(raw.y); d[3] = bfhi(raw.y); d[4] = bflo(raw.z); d[5] = bfhi(raw.z); d[6] = bflo(raw.w); d[7] = bfhi(raw.w); }
        __syncthreads();
        float acc[4][8];
#pragma unroll
        for (int i = 0; i < 4; ++i)
#pragma unroll
            for (int e = 0; e < 8; ++e) acc[i][e] = 0.f;
#pragma unroll 4
        for (int s = 0; s < 128; ++s) { const f32x4 a = *(const LAS f32x4*)(Wt + s * 128 + t0); const f32x4 b0 = *(const LAS f32x4*)(Vt + s * 128 + ch0), b1 = *(const LAS f32x4*)(Vt + s * 128 + ch0 + 4);
#pragma unroll
            for (int i = 0; i < 4; ++i) {
#pragma unroll
                for (int e = 0; e < 4; ++e) { acc[i][e] += a[i] * b0[e]; acc[i][4 + e] += a[i] * b1[e]; } } }
#pragma unroll
        for (int i = 0; i < 4; ++i) { const int t = t0 + i; const float bs = INP(IBS)[((size_t)l * 4 + g) * 128 + t];
            const v4u ur = *(const GAS v4u*)(Z2 + (r0 + t) * Z2W + Z2_U + g * 128 + ch0); float uu[8];
            uu[0] = bflo(ur.x); uu[1] = bfhi(ur.x); uu[2] = bflo(ur.y); uu[3] = bfhi(ur.y); uu[4] = bflo(ur.z); uu[5] = bfhi(ur.z); uu[6] = bflo(ur.w); uu[7] = bfhi(ur.w);
            float y[8];
#pragma unroll
            for (int e = 0; e < 8; ++e) y[e] = gelu_tanh(uu[e]) * (acc[i][e] + bs);
            v4u o; o.x = pk2(y[0], y[1]); o.y = pk2(y[2], y[3]); o.z = pk2(y[4], y[5]); o.w = pk2(y[6], y[7]);
            *(GAS v4u*)(YABC + (r0 + t) * 2048 + 1024 + g * 128 + ch0) = o; }
    }
    __syncthreads();
}

__device__ __forceinline__ void phase_readout(int l) {
    const Frame F = mkframe(); unsigned char* ws = F.ws;
    const float* OFp = (const float*)(ws + WS_OF); const float* OBp = (const float*)(ws + WS_OB); const bf16* Z2 = (const bf16*)(ws + WS_Z2); bf16* YABC = (bf16*)(ws + WS_YABC);
    const int gw = F.vcu * 8 + F.wave, NGW = F.G * 8, lane = F.lane;
    const float* ag = INP(IANORM) + l * DV + (16 * lane & 127);
    for (int m = gw; m < M; m += NGW) {
        float o[16]; float ss = 0.f;
#pragma unroll
        for (int j = 0; j < 4; ++j) { const f32x4 a = *(const GAS f32x4*)(OFp + (size_t)m * WK + 16 * lane + 4 * j), b = *(const GAS f32x4*)(OBp + (size_t)m * WK + 16 * lane + 4 * j);
#pragma unroll
            for (int e = 0; e < 4; ++e) { o[4 * j + e] = a[e] + b[e]; ss += o[4 * j + e] * o[4 * j + e]; } }
        ss += dppf<0xB1>(ss); ss += dppf<0x4E>(ss); ss += dppf<0x141>(ss);
        const float rstd = 1.0f / sqrtf(ss * (1.0f / DV) + EPS);
        const v4u g0 = *(const GAS v4u*)(Z2 + (size_t)m * Z2W + Z2_GA + 16 * lane), g1 = *(const GAS v4u*)(Z2 + (size_t)m * Z2W + Z2_GA + 16 * lane + 8); float ga[16];
        ga[0] = bflo(g0.x); ga[1] = bfhi(g0.x); ga[2] = bflo(g0.y); ga[3] = bfhi(g0.y); ga[4] = bflo(g0.z); ga[5] = bfhi(g0.z); ga[6] = bflo(g0.w); ga[7] = bfhi(g0.w);
        ga[8] = bflo(g1.x); ga[9] = bfhi(g1.x); ga[10] = bflo(g1.y); ga[11] = bfhi(g1.y); ga[12] = bflo(g1.z); ga[13] = bfhi(g1.z); ga[14] = bflo(g1.w); ga[15] = bfhi(g1.w);
        float y[16];
#pragma unroll
        for (int e = 0; e < 16; ++e) y[e] = o[e] * rstd * ag[e] * siluf_(ga[e]);
        v4u w0, w1; w0.x = pk2(y[0], y[1]); w0.y = pk2(y[2], y[3]); w0.z = pk2(y[4], y[5]); w0.w = pk2(y[6], y[7]); w1.x = pk2(y[8], y[9]); w1.y = pk2(y[10], y[11]); w1.z = pk2(y[12], y[13]); w1.w = pk2(y[14], y[15]);
        *(GAS v4u*)(YABC + (size_t)m * 2048 + 16 * lane) = w0; *(GAS v4u*)(YABC + (size_t)m * 2048 + 16 * lane + 8) = w1;
    }
}

constexpr int PH_PER_LAYER = 13, N_PHASES = 1 + DEPTH * PH_PER_LAYER + 1;
__device__ __forceinline__ void grid_seam() {
    extern __shared__ __attribute__((aligned(16))) unsigned char lds_dyn[];
    XcdBarrier bar; bar.bar = (unsigned*)(kargs()->ws + WS_CTL) + CW_BAR; bar.x = xb_xcc_id(); bar.st = (volatile LAS unsigned*)((LAS unsigned char*)lds_dyn + MISC_OFF) + 8;
    xcd_barrier(bar);
}
__global__ void __launch_bounds__(512, 2) fwd_kernel(Args args_unused) {
    extern __shared__ __attribute__((aligned(16))) unsigned char lds_dyn[];
    { LAS unsigned char* lds = (LAS unsigned char*)lds_dyn;
      for (int u = threadIdx.x; u < (LDS_BYTES - LDSCTL_OFF) / 4; u += 512) ((LAS unsigned*)(lds + LDSCTL_OFF))[u] = 0u;
      __syncthreads();
      if (kargs()->ph_hi - kargs()->ph_lo > 1) (void)xcd_barrier_post((unsigned*)(kargs()->ws + WS_CTL) + CW_BAR, (volatile LAS unsigned*)(lds + MISC_OFF) + 8); }
    const int lo = kargs()->ph_lo, hi = kargs()->ph_hi;
#define IN(k) (lo <= (k) && (k) < hi)
#define SEAM(k) do { if (IN((k) + 1)) grid_seam(); } while (0)
#define LDSP ((LAS unsigned char*)lds_dyn)
#define WSP(off) (kargs()->ws + (off))

#ifndef NO_PRO
    if (IN(0)) { phase_prologue(); __syncthreads(); SEAM(0); }
#endif

#pragma unroll 1
    for (int l = 0; l < DEPTH; ++l) {
        const int pb = 1 + l * PH_PER_LAYER;
        if (hi <= pb || lo >= pb + PH_PER_LAYER) continue;
#pragma unroll 1
        for (int j = 0; j < 2; ++j) {
            const int p0 = pb + (j ? 10 : 0);
            if (IN(p0)) { phase_norm(l, j ? 2 : 0); SEAM(p0); }
#ifndef NO_G1
            if (IN(p0 + 1)) { pg8::Gemm g{(const bf16*)WSP(WS_H), (const bf16*)WSP(WS_WGU) + (size_t)(l * 2 + j) * (2 * DFF) * D, M, 2 * DFF, D, D, D};
                pg8::StaticOrder S; S.init(M, 2 * DFF, (int)gridDim.x, (int)blockIdx.x); pg8::EpiSwiGLU E{(bf16*)WSP(WS_ACT)};
                pg8::gemm_phase<pg8::EpiSwiGLU, pg8::StaticOrder, true, true>(LDSP, g, S, E); SEAM(p0 + 1); }
#endif
#ifndef NO_G2
            if (IN(p0 + 2)) { pg8::Gemm g{(const bf16*)WSP(WS_ACT), (const bf16*)WSP(WS_WD) + (size_t)(l * 2 + j) * D * DFF, M, D, DFF, DFF, DFF};
                pg8::StaticOrder S; S.init(M, D, (int)gridDim.x, (int)blockIdx.x); pg8::EpiResid E{(float*)WSP(WS_Y), (const float*)WSP(WS_MOD) + (size_t)l * NGRP * MODW + (j ? 8 : 2) * D, 0.5f};
                pg8::gemm_phase<pg8::EpiResid, pg8::StaticOrder, true, true>(LDSP, g, S, E); SEAM(p0 + 2); }
#endif
            if (j == 0) {
                if (IN(pb + 3)) { phase_norm(l, 1); SEAM(pb + 3); }
#ifndef NO_G3
                if (IN(pb + 4)) { pg8::Gemm g{(const bf16*)WSP(WS_H), (const bf16*)WSP(WS_WIN) + (size_t)l * INW * D, M, INW, D, D, D};
                    pg8::StaticOrder S; S.init(M, INW, (int)gridDim.x, (int)blockIdx.x); pg8::EpiInproj E{(float*)WSP(WS_Z1), (bf16*)WSP(WS_Z2)};
                    pg8::gemm_phase<pg8::EpiInproj, pg8::StaticOrder, true, true>(LDSP, g, S, E); SEAM(pb + 4); }
#endif
#ifndef NO_ELEM
                if (IN(pb + 5)) { phase_mix_elem(l); SEAM(pb + 5); }
#endif
                if (IN(pb + 6)) {
#ifndef NO_SCAN
                    phase_scan_v1();
#endif
#ifndef NO_GMLP
                    phase_gmlp_v1(l);
#endif
                    SEAM(pb + 6); }
#ifndef NO_READ
                if (IN(pb + 7)) { phase_readout(l); SEAM(pb + 7); }
#endif
#ifndef NO_G4
                if (IN(pb + 8)) {
                    { pg8::Gemm g{(const bf16*)WSP(WS_YABC), (const bf16*)WSP(WS_WP) + (size_t)l * D * 2048, M, D, 1024, 2048, 2048};
                      pg8::StaticOrder S; S.init(M, D, (int)gridDim.x, (int)blockIdx.x); pg8::EpiProj<0> E{(float*)WSP(WS_MF32), (bf16*)WSP(WS_MRG), (const bf16*)WSP(WS_Z2) + Z2_MA};
                      pg8::gemm_phase<pg8::EpiProj<0>, pg8::StaticOrder, true, true>(LDSP, g, S, E); }
                    { pg8::Gemm g{(const bf16*)WSP(WS_YABC) + 1024, (const bf16*)WSP(WS_WP) + (size_t)l * D * 2048 + 1024, M, D, 512, 2048, 2048};
                      pg8::StaticOrder S; S.init(M, D, (int)gridDim.x, (int)blockIdx.x); pg8::EpiProj<1> E{(float*)WSP(WS_MF32), (bf16*)WSP(WS_MRG), (const bf16*)WSP(WS_Z2) + Z2_MB};
                      pg8::gemm_phase<pg8::EpiProj<1>, pg8::StaticOrder, true, true>(LDSP, g, S, E); }
                    { pg8::Gemm g{(const bf16*)WSP(WS_YABC) + 1536, (const bf16*)WSP(WS_WP) + (size_t)l * D * 2048 + 1536, M, D, 512, 2048, 2048};
                      pg8::StaticOrder S; S.init(M, D, (int)gridDim.x, (int)blockIdx.x); pg8::EpiProj<2> E{(float*)WSP(WS_MF32), (bf16*)WSP(WS_MRG), (const bf16*)WSP(WS_Z2) + Z2_MC};
                      pg8::gemm_phase<pg8::EpiProj<2>, pg8::StaticOrder, true, true>(LDSP, g, S, E); }
                    SEAM(pb + 8); }
#endif
#ifndef NO_G5
                if (IN(pb + 9)) { pg8::Gemm g{(const bf16*)WSP(WS_MRG), (const bf16*)WSP(WS_WO) + (size_t)l * D * D, M, D, D, D, D};
                    pg8::StaticOrder S; S.init(M, D, (int)gridDim.x, (int)blockIdx.x); pg8::EpiResid E{(float*)WSP(WS_Y), (const float*)WSP(WS_MOD) + (size_t)l * NGRP * MODW + 5 * D, 1.0f};
                    pg8::gemm_phase<pg8::EpiResid, pg8::StaticOrder, true, true>(LDSP, g, S, E); SEAM(pb + 9); }
#endif
            }
        }
    }
    if (IN(N_PHASES - 1)) phase_final();
#undef IN
#undef SEAM
}

#ifndef MK_PER_PHASE
#define MK_PER_PHASE 1
#endif
extern "C" void kernel_launch(void* const* d_in, const int* in_sizes, int n_in, void* d_out, int out_size, void* d_ws, size_t ws_size, hipStream_t stream) {
    static int grid = 0;
    if (grid == 0) {
        if (n_in != 23 || out_size != M_LAT * D || ws_size < WS_END) { fprintf(stderr, "kernel_launch: unexpected sizes n_in %d out %d ws %zu (need %zu)\n", n_in, out_size, ws_size, (size_t)WS_END); grid = -1; return; }
        int dev = 0, cus = 0, per_cu = 0;
        if (hipGetDevice(&dev) != hipSuccess || hipDeviceGetAttribute(&cus, hipDeviceAttributeMultiprocessorCount, dev) != hipSuccess) { grid = -1; return; }
        if (hipFuncSetAttribute((const void*)fwd_kernel, hipFuncAttributeMaxDynamicSharedMemorySize, LDS_BYTES) != hipSuccess) { fprintf(stderr, "kernel_launch: hipFuncSetAttribute failed\n"); grid = -1; return; }
        if (hipOccupancyMaxActiveBlocksPerMultiprocessor(&per_cu, (const void*)fwd_kernel, 512, LDS_BYTES) != hipSuccess || per_cu < 1) { fprintf(stderr, "kernel_launch: occupancy query says %d\n", per_cu); }
        (void)hipGetLastError();
        grid = cus;
    }
    if (grid < 0) return;
    (void)hipMemsetAsync((char*)d_ws + WS_CTL, 0, CTL_ZERO_BYTES, stream);
    Args a{};
    for (int i = 0; i < 23; ++i) a.in[i] = (const float*)d_in[i];
    a.out = (float*)d_out; a.ws = (unsigned char*)d_ws;
#if MK_PER_PHASE
    for (int p = 0; p < N_PHASES; ++p) { a.ph_lo = p; a.ph_hi = p + 1; hipLaunchKernelGGL(fwd_kernel, dim3(grid), dim3(512), LDS_BYTES, stream, a); }
#else
    a.ph_lo = 0; a.ph_hi = N_PHASES; hipLaunchKernelGGL(fwd_kernel, dim3(grid), dim3(512), LDS_BYTES, stream, a);
#endif
}
```

```cpp
#include <hip/hip_runtime.h>
#include <cstdio>
#include <cstdint>
namespace pg8 {
#define PG8_LAS __attribute__((address_space(3)))
typedef unsigned short bf16_t;
typedef short bf16x8 __attribute__((ext_vector_type(8)));
typedef float f32x4 __attribute__((ext_vector_type(4)));
typedef float f32x2 __attribute__((ext_vector_type(2)));
typedef unsigned u32x4 __attribute__((ext_vector_type(4)));
typedef unsigned u32x2 __attribute__((ext_vector_type(2)));
constexpr int BM = 256, BK = 64, HALF = 128, HTB = HALF * BK * 2  , STAGE_BYTES = 8 * HTB, NXCD = 8, WGM = 8;

__host__ __device__ __forceinline__ int lds_byte(int r, int c) { const int st = (r >> 4) * 2 + (c >> 5), rr = r & 15, cc = c & 31, ob = rr * 64 + cc * 2; return st * 1024 + (ob ^ (((ob >> 9) & 1) << 5)); }
__host__ __device__ __forceinline__ void stage_rc(int b, int& R, int& C) { const int st = b / 1024, sb = b % 1024, swz = sb ^ (((sb >> 9) & 1) << 5); R = (st >> 1) * 16 + swz / 64; C = (st & 1) * 32 + (swz % 64) / 2; }
__host__ __device__ __forceinline__ int perm32(int rho) { const int n = rho >> 4, i = rho & 15; return 8 * (i >> 2) + 4 * n + (i & 3); }

struct Unit { int pm, pn; };
struct Gemm { const bf16_t* A; const bf16_t* Bt; int M, N, K, lda, ldb; };

struct StaticOrder {
    int nM, nN, nwg, G, c;
    __host__ __device__ void init(int M, int N, int G_, int c_) { nM = M / BM; nN = N / BM; nwg = nM * nN; G = G_; c = c_; }
    __host__ __device__ bool next(int i, Unit& u) const {
        const long L = (long)i * G + c; if (L >= nwg) return false;
        int wgid = (int)L; { const int q = nwg / NXCD, r = nwg % NXCD, xcd = wgid % NXCD, off = wgid / NXCD; wgid = (xcd < r ? xcd * (q + 1) : r * (q + 1) + (xcd - r) * q) + off; }
        const int nig = WGM * nN, gid = wgid / nig, fm = gid * WGM, gsz = (nM - fm) < WGM ? (nM - fm) : WGM;
        u.pm = fm + ((wgid % nig) % gsz); u.pn = (wgid % nig) / gsz; return true;
    }
    __device__ __forceinline__ void a_ready(const Unit&) const {}
    __device__ __forceinline__ void done(const Unit&) const {}
};

__device__ __forceinline__ unsigned cvt_pk_bf16(float lo, float hi) { unsigned r; asm volatile("v_cvt_pk_bf16_f32 %0, %1, %2" : "=v"(r) : "v"(lo), "v"(hi)); return r; }

template <class Epi, class Sched, bool ALIGN_EPI = false, bool SP2 = false>
__device__ __forceinline__ void gemm_phase(PG8_LAS unsigned char* lds, const Gemm g, const Sched& S, const Epi& E) {
    int tid_ = threadIdx.x; asm volatile("" : "+v"(tid_));
    const int tid = tid_, wid = __builtin_amdgcn_readfirstlane(tid >> 6), lane = tid & 63, wr = wid >> 2, wc = wid & 3, fr = lane & 15, fq = lane >> 4;
    const int K = g.K, nt = K / BK;
    unsigned voffA[2], voffB[2];
#pragma unroll
    for (int i = 0; i < 2; ++i) { int R, C; stage_rc(tid * 16 + i * 8192, R, C); const int Rb = Epi::PERM ? ((R & ~31) + perm32(R & 31)) : R;
        voffA[i] = (unsigned)(R * g.lda + C) * 2u; voffB[i] = (unsigned)(Rb * g.ldb + C) * 2u; }
    const size_t kstep = (size_t)(BK * 2);
    const size_t hstepA = (size_t)HALF * g.lda * 2, hstepB = (size_t)HALF * g.ldb * 2;
    const size_t tstepA = 2 * hstepA, tstepB = 2 * hstepB;
    const unsigned ldsw = (unsigned)wid * 1024u;
    const int aoff = lds_byte(wr * 64 + fr, fq * 8), boff = lds_byte(wc * 32 + fr, fq * 8);
#define PG8_SA(b, h) (((b) * 2 + (h)) * HTB)
#define PG8_SB(b, h) ((4 + (b) * 2 + (h)) * HTB)
#define PG8_STAGE(bufoff, gbase, voff) do { _Pragma("unroll") for (int _i = 0; _i < 2; ++_i) \
        __builtin_amdgcn_global_load_lds((const unsigned*)((const char*)(gbase) + (voff)[_i]), (PG8_LAS unsigned*)(lds + (bufoff) + ldsw + _i * 8192), 16, 0, 0); } while (0)
#define PG8_LDA(dst, b, h) do { _Pragma("unroll") for (int m = 0; m < 4; ++m) _Pragma("unroll") for (int k = 0; k < 2; ++k) dst[m][k] = *(const PG8_LAS bf16x8*)(lds + PG8_SA(b, h) + aoff + m * 2048 + k * 1024); } while (0)
#define PG8_LDB(dst, b, h) do { _Pragma("unroll") for (int n = 0; n < 2; ++n) _Pragma("unroll") for (int k = 0; k < 2; ++k) dst[n][k] = *(const PG8_LAS bf16x8*)(lds + PG8_SB(b, h) + boff + n * 2048 + k * 1024); } while (0)
#define PG8_MMA(ai, bj, At, Bt) do { __builtin_amdgcn_s_setprio(1); _Pragma("unroll") for (int m = 0; m < 4; ++m) _Pragma("unroll") for (int n = 0; n < 2; ++n) _Pragma("unroll") for (int k = 0; k < 2; ++k) \
        acc[ai][bj][m][n] = __builtin_amdgcn_mfma_f32_16x16x32_bf16(Bt[n][k], At[m][k], acc[ai][bj][m][n], 0, 0, 0); __builtin_amdgcn_s_setprio(0); } while (0)
#define PG8_WAIT_V(n) asm volatile("s_waitcnt vmcnt(" #n ")" ::: "memory")
#define PG8_WAIT_L(n) asm volatile("s_waitcnt lgkmcnt(" #n ")" ::: "memory")
#define PG8_BAR __builtin_amdgcn_s_barrier()
#define PG8_SCHED __builtin_amdgcn_sched_barrier(0)
    Unit cur, nxt; int ui = 0;
    if (!S.next(0, cur)) return;
    f32x4 acc[2][2][4][2];
#pragma unroll
    for (int a = 0; a < 2; ++a)
#pragma unroll
        for (int b = 0; b < 2; ++b)
#pragma unroll
            for (int m = 0; m < 4; ++m)
#pragma unroll
                for (int n = 0; n < 2; ++n) acc[a][b][m][n] = (f32x4){0.f, 0.f, 0.f, 0.f};
    bf16x8 At[4][2], B0[2][2], B1[2][2];
    const char* cA = (const char*)g.A + (size_t)cur.pm * tstepA; const char* cB = (const char*)g.Bt + (size_t)cur.pn * tstepB;
    S.a_ready(cur);
    if constexpr (SP2) {
        PG8_STAGE(PG8_SB(0, 0), cB, voffB); PG8_STAGE(PG8_SB(0, 1), cB + hstepB, voffB); PG8_STAGE(PG8_SA(0, 0), cA, voffA); PG8_STAGE(PG8_SA(0, 1), cA + hstepA, voffA);
        if (wr == 1) PG8_BAR;
        PG8_WAIT_V(2); PG8_BAR;
        PG8_STAGE(PG8_SB(1, 0), cB + kstep, voffB); PG8_STAGE(PG8_SA(1, 0), cA + kstep, voffA); PG8_STAGE(PG8_SB(1, 1), cB + hstepB + kstep, voffB);
        PG8_WAIT_V(6); PG8_BAR;
    } else {
        PG8_STAGE(PG8_SB(0, 0), cB, voffB); PG8_STAGE(PG8_SA(0, 0), cA, voffA); PG8_STAGE(PG8_SB(0, 1), cB + hstepB, voffB); PG8_STAGE(PG8_SA(0, 1), cA + hstepA, voffA);
        if (wr == 1) PG8_BAR;
        PG8_WAIT_V(4); PG8_BAR;
        PG8_STAGE(PG8_SB(1, 0), cB + kstep, voffB); PG8_STAGE(PG8_SA(1, 0), cA + kstep, voffA); PG8_STAGE(PG8_SB(1, 1), cB + hstepB + kstep, voffB);
        PG8_WAIT_V(6); PG8_BAR;
    }
    for (;;) {
        const bool has_next = S.next(ui + 1, nxt);
        const char* nA = has_next ? (const char*)g.A + (size_t)nxt.pm * tstepA : cA; const char* nB = has_next ? (const char*)g.Bt + (size_t)nxt.pn * tstepB : cB;
        for (int t = 0; t < nt; t += 2) {
            const bool last = (t == nt - 2);
            const char* a1 = cA + (size_t)(t + 1) * kstep;
            const char* a2 = last ? nA : cA + (size_t)(t + 2) * kstep; const char* b2 = last ? nB : cB + (size_t)(t + 2) * kstep;
            const char* a3 = a2 + kstep; const char* b3 = b2 + kstep;
            if (last && has_next) S.a_ready(nxt);
            if constexpr (SP2) {
            PG8_LDB(B0, 0, 0); PG8_LDB(B1, 0, 1); PG8_SCHED; PG8_LDA(At, 0, 0); PG8_STAGE(PG8_SA(1, 1), a1 + hstepA, voffA);
            PG8_WAIT_V(8); PG8_WAIT_L(0); PG8_BAR; PG8_MMA(0, 0, At, B0); PG8_MMA(0, 1, At, B1); PG8_BAR; PG8_SCHED;
            PG8_LDA(At, 0, 1); PG8_STAGE(PG8_SB(0, 0), b2, voffB); PG8_STAGE(PG8_SB(0, 1), b2 + hstepB, voffB); PG8_STAGE(PG8_SA(0, 0), a2, voffA);
            PG8_WAIT_V(8); PG8_WAIT_L(0); PG8_BAR; PG8_MMA(1, 0, At, B0); PG8_MMA(1, 1, At, B1); PG8_BAR; PG8_SCHED;
            PG8_LDB(B0, 1, 0); PG8_LDB(B1, 1, 1); PG8_SCHED; PG8_LDA(At, 1, 0); PG8_STAGE(PG8_SA(0, 1), a2 + hstepA, voffA);
            PG8_WAIT_V(8); PG8_WAIT_L(0); PG8_BAR; PG8_MMA(0, 0, At, B0); PG8_MMA(0, 1, At, B1); PG8_BAR; PG8_SCHED;
            PG8_LDA(At, 1, 1); PG8_STAGE(PG8_SB(1, 0), b3, voffB); PG8_STAGE(PG8_SB(1, 1), b3 + hstepB, voffB); PG8_STAGE(PG8_SA(1, 0), a3, voffA);
            PG8_WAIT_V(8); PG8_WAIT_L(0); PG8_BAR; PG8_MMA(1, 0, At, B0); PG8_MMA(1, 1, At, B1); PG8_BAR; PG8_SCHED;
            } else {
            PG8_LDB(B0, 0, 0); PG8_SCHED; PG8_LDA(At, 0, 0); PG8_STAGE(PG8_SA(1, 1), a1 + hstepA, voffA);
            PG8_WAIT_L(8); PG8_BAR; PG8_WAIT_L(0); PG8_MMA(0, 0, At, B0); PG8_BAR; PG8_SCHED;
            PG8_LDB(B1, 0, 1); PG8_STAGE(PG8_SB(0, 0), b2, voffB);
            PG8_BAR; PG8_WAIT_L(0); PG8_MMA(0, 1, At, B1); PG8_BAR;
            PG8_LDA(At, 0, 1); PG8_STAGE(PG8_SA(0, 0), a2, voffA);
            PG8_BAR; PG8_WAIT_L(0); PG8_MMA(1, 0, At, B0); PG8_BAR; PG8_SCHED;
            PG8_STAGE(PG8_SB(0, 1), b2 + hstepB, voffB);
            PG8_WAIT_V(6); PG8_BAR; PG8_MMA(1, 1, At, B1); PG8_BAR;
            PG8_LDB(B0, 1, 0); PG8_SCHED; PG8_LDA(At, 1, 0); PG8_STAGE(PG8_SA(0, 1), a2 + hstepA, voffA);
            PG8_WAIT_L(8); PG8_BAR; PG8_WAIT_L(0); PG8_MMA(0, 0, At, B0); PG8_BAR; PG8_SCHED;
            PG8_LDB(B1, 1, 1); PG8_STAGE(PG8_SB(1, 0), b3, voffB);
            PG8_BAR; PG8_WAIT_L(0); PG8_MMA(0, 1, At, B1); PG8_BAR;
            PG8_LDA(At, 1, 1); PG8_STAGE(PG8_SA(1, 0), a3, voffA);
            PG8_BAR; PG8_WAIT_L(0); PG8_MMA(1, 0, At, B0); PG8_BAR; PG8_SCHED;
            PG8_STAGE(PG8_SB(1, 1), b3 + hstepB, voffB);
            PG8_WAIT_V(6); PG8_BAR; PG8_MMA(1, 1, At, B1); PG8_BAR;
            }
        }
        if constexpr (ALIGN_EPI) { if (wr == 0) PG8_BAR; }
        E(acc, cur, wr, wc, fr, fq); S.done(cur);
        if (!has_next) break;
#pragma unroll
        for (int a = 0; a < 2; ++a)
#pragma unroll
            for (int b = 0; b < 2; ++b)
#pragma unroll
                for (int m = 0; m < 4; ++m)
#pragma unroll
                    for (int n = 0; n < 2; ++n) acc[a][b][m][n] = (f32x4){0.f, 0.f, 0.f, 0.f};
        cur = nxt; cA = nA; cB = nB; ++ui;
        if constexpr (ALIGN_EPI) { if (wr == 1) PG8_BAR; }
    }
    PG8_WAIT_V(0);
    if constexpr (!ALIGN_EPI) { if (wr == 0) PG8_BAR; }
    PG8_BAR;
#undef PG8_SA
#undef PG8_SB
#undef PG8_STAGE
#undef PG8_LDA
#undef PG8_LDB
#undef PG8_MMA
#undef PG8_WAIT_V
#undef PG8_WAIT_L
#undef PG8_BAR
#undef PG8_SCHED
}
}
#define XB_TMO      128
#define XB_XCNT(j)  (256  + 64 * (j))
#define XB_XSUB(j)  (1280 + 64 * (j))
#define XB_XGEN(j)  (2304 + 64 * (j))
#define XB_TOP      3328
#define XB_TOPGEN   3392
#define XCD_BAR_WORDS 3456
#define XB_SPIN_CAP (1u << 18)
#define LAS __attribute__((address_space(3)))

__device__ __forceinline__ unsigned xb_ld(unsigned* p)              { return __hip_atomic_load(p, __ATOMIC_RELAXED, __HIP_MEMORY_SCOPE_AGENT); }
__device__ __forceinline__ unsigned xb_add(unsigned* p, unsigned v) { return __hip_atomic_fetch_add(p, v, __ATOMIC_RELAXED, __HIP_MEMORY_SCOPE_AGENT); }
__device__ __forceinline__ unsigned xb_xcc_id() { return (unsigned)__builtin_amdgcn_s_getreg((3 << 11) | 20) & 0xFu; }
#define XB_SPIN(cond, bar) do { unsigned _sp = 0; while (cond) { __builtin_amdgcn_s_sleep(1); \
    if ((++_sp & 255u) == 0u) { if (xb_ld(&(bar)[XB_TMO])) break; if (_sp > XB_SPIN_CAP) { atomicAdd(&(bar)[XB_TMO], 1u); break; } } } } while (0)

struct XcdBarrier {
    unsigned* bar; unsigned x;
    volatile LAS unsigned* st;
};

__device__ __forceinline__ XcdBarrier xcd_barrier_post(unsigned* bar, volatile LAS unsigned* st) {
    XcdBarrier b; b.bar = bar; b.x = xb_xcc_id(); b.st = st;
    if (threadIdx.x == 0) (void)xb_add(&bar[XB_XCNT(b.x)], 1u);
    return b;
}
__device__ __forceinline__ void xcd_barrier_complete(unsigned* bar, unsigned x, unsigned& nloc, unsigned& nx) {
    const unsigned G = gridDim.x * gridDim.y * gridDim.z;
    unsigned sum, cnt, mine, sp = 0u;
    for (;;) {
        sum = 0u; cnt = 0u; mine = 0u;
#pragma unroll
        for (unsigned j = 0; j < 16; ++j) { const unsigned c = xb_ld(&bar[XB_XCNT(j)]); sum += c; cnt += (c > 0u) ? 1u : 0u; mine = (j == x) ? c : mine; }
        if (sum == G) break;
        __builtin_amdgcn_s_sleep(1);
        if ((++sp & 255u) == 0u) { if (xb_ld(&bar[XB_TMO])) break; if (sp > XB_SPIN_CAP) { atomicAdd(&bar[XB_TMO], 1u); break; } }
    }
    nloc = mine > 0u ? mine : 1u; nx = cnt > 0u ? cnt : 1u;
}

__device__ __forceinline__ void xcd_barrier(const XcdBarrier& b) {
    asm volatile("s_waitcnt vmcnt(0)" ::: "memory");
    __syncthreads();
    if (threadIdx.x == 0) {
        unsigned* bar = b.bar;
        __builtin_amdgcn_s_waitcnt(0);
        unsigned nloc = b.st[0], nx = b.st[1];
        if (nloc == 0u) { xcd_barrier_complete(bar, b.x, nloc, nx); b.st[0] = nloc; b.st[1] = nx; }
        const unsigned old = xb_add(&bar[XB_XSUB(b.x)], 1u);
        const unsigned gen = old / nloc;
        if (old + 1u == (gen + 1u) * nloc) {
            __builtin_amdgcn_fence(__ATOMIC_RELEASE, "agent");
            asm volatile("s_waitcnt vmcnt(0)" ::: "memory");
            const unsigned og = xb_add(&bar[XB_TOP], 1u);
            const unsigned tg = og / nx;
            if (og + 1u == (tg + 1u) * nx) xb_add(&bar[XB_TOPGEN], 1u);
            else XB_SPIN(xb_ld(&bar[XB_TOPGEN]) == tg, bar);
            __builtin_amdgcn_fence(__ATOMIC_ACQUIRE, "agent");
            xb_add(&bar[XB_XGEN(b.x)], 1u);
            asm volatile("s_waitcnt vmcnt(0)" ::: "memory");
        } else {
            XB_SPIN(xb_ld(&bar[XB_XGEN(b.x)]) == gen, bar);
            __builtin_amdgcn_fence(__ATOMIC_ACQUIRE, "agent");
            asm volatile("s_waitcnt vmcnt(0)" ::: "memory");
        }
    }
    __syncthreads();
}

constexpr int D = 2048, NB = 4, SEQ = 4096, DEPTH = 4, CTXL = 256, NMOD = 9, DFF = 5632, NH = 8, DK = 128, DV = 128, WK = 1024;
constexpr int BW = 512, CWD = 512, INW = 13824;
constexpr int M_LAT = NB * SEQ, M_CTX = NB * CTXL, M = M_LAT + M_CTX;
constexpr int MODW = NMOD * D;
constexpr int NGRP = 5;
constexpr float EPS = 1e-6f;
constexpr int Z1W = 4096, Z2W = INW - Z1W;
constexpr int Z2_GA = 0, Z2_U = 1024, Z2_V = 1536, Z2_HC = 2048, Z2_GB = 2560, Z2_GC = 3072, Z2_MA = 3584, Z2_MB = 5632, Z2_MC = 7680;

constexpr size_t MiB = 1u << 20;
constexpr size_t WS_CTL = 0ull * MiB, CTL_ZERO_BYTES = 1 * MiB;
constexpr size_t WS_MOD = 1ull * MiB;
constexpr size_t WS_LB = 3ull * MiB;
constexpr size_t WS_WGU = 4ull * MiB;
constexpr size_t WS_WD = 356ull * MiB;
constexpr size_t WS_WIN = 532ull * MiB;
constexpr size_t WS_WP = 748ull * MiB;
constexpr size_t WS_WO = 780ull * MiB;
constexpr size_t WS_Y = 812ull * MiB;
constexpr size_t WS_H = 948ull * MiB;
constexpr size_t WS_MRG = 1016ull * MiB;
constexpr size_t WS_YABC = 1084ull * MiB;
constexpr size_t WS_MF32 = 1152ull * MiB;
constexpr size_t WS_OF = 1288ull * MiB;
constexpr size_t WS_OB = 1356ull * MiB;
constexpr size_t WS_FF = 1424ull * MiB;
constexpr size_t WS_FB = 1492ull * MiB;
constexpr size_t WS_VN = 1560ull * MiB;
constexpr size_t WS_Z1 = 1577ull * MiB;
constexpr size_t WS_Z2 = 1849ull * MiB;
constexpr size_t WS_ACT = WS_Z1;
constexpr size_t WS_END = 2172ull * MiB;
constexpr int CW_BAR = 4096;

constexpr int RING_BYTES = 131072;
constexpr int LDSCTL_OFF = RING_BYTES, MISC_OFF = LDSCTL_OFF + 320;
constexpr int LDS_BYTES = 147456;

#define GAS __attribute__((address_space(1)))
typedef unsigned short bf16;
typedef unsigned v4u __attribute__((ext_vector_type(4)));
typedef unsigned v2u __attribute__((ext_vector_type(2)));
typedef float f32x4 __attribute__((ext_vector_type(4)));
#define LDS_WAIT() asm volatile("s_waitcnt lgkmcnt(0)" ::: "memory")
#define VM_WAIT() asm volatile("s_waitcnt vmcnt(0)" ::: "memory")
__device__ __forceinline__ unsigned f2bf(float f) { unsigned u = __builtin_bit_cast(unsigned, f); return (u + 0x7fffu + ((u >> 16) & 1u)) >> 16; }
__device__ __forceinline__ unsigned pk2(float lo, float hi) { return f2bf(lo) | (f2bf(hi) << 16); }
__device__ __forceinline__ float bflo(unsigned w) { return __builtin_bit_cast(float, w << 16); }
__device__ __forceinline__ float bfhi(unsigned w) { return __builtin_bit_cast(float, w & 0xffff0000u); }
__device__ __forceinline__ float sigmoidf_(float x) { return __builtin_amdgcn_rcpf(1.0f + __expf(-x)); }
__device__ __forceinline__ float siluf_(float x) { return x * sigmoidf_(x); }
__device__ __forceinline__ float gelu_tanh(float x) { const float u = 0.7978845608028654f * (x + 0.044715f * x * x * x); return x * sigmoidf_(2.0f * u); }
template <int CTRL> __device__ __forceinline__ float dppf(float x) { return __builtin_bit_cast(float, __builtin_amdgcn_mov_dpp(__builtin_bit_cast(int, x), CTRL, 0xf, 0xf, true)); }
__device__ __forceinline__ float row16_sum(float x) { x += dppf<0xB1>(x); x += dppf<0x4E>(x); x += dppf<0x124>(x); x += dppf<0x128>(x); return x; }
__device__ __forceinline__ float wave_sum(float v) {
#pragma unroll
    for (int o = 1; o < 64; o <<= 1) v += __shfl_xor(v, o);
    return v;
}
__device__ __forceinline__ int grp_of_row(int m) { return m < M_LAT ? (m >> 12) : 4; }

struct Frame {
    LAS unsigned char* lds;
    int tid, lane, wave, vcu, G;
    unsigned char* ws;
};
struct Args { const float* in[23]; float* out; unsigned char* ws; int ph_lo, ph_hi; };
typedef const __attribute__((address_space(4))) Args* KArgs;
__device__ __forceinline__ KArgs kargs() { auto p = __builtin_amdgcn_kernarg_segment_ptr(); asm volatile("" : "+s"(p)); return (KArgs)p; }
__device__ __forceinline__ Frame mkframe() {
    extern __shared__ __attribute__((aligned(16))) unsigned char lds_dyn[];
    Frame F; F.lds = (LAS unsigned char*)lds_dyn; { int t = threadIdx.x; asm volatile("" : "+v"(t)); F.tid = t; } F.lane = F.tid & 63; F.wave = __builtin_amdgcn_readfirstlane(F.tid >> 6);
    { int gg = gridDim.x; asm volatile("" : "+s"(gg)); F.G = gg; } { int bx = blockIdx.x; asm volatile("" : "+s"(bx)); F.vcu = (F.G % 8 == 0) ? (bx % 8) * (F.G / 8) + bx / 8 : bx; }
    F.ws = kargs()->ws; return F;
}

namespace pg8 {
struct EpiSwiGLU { static constexpr bool PERM = true;
    bf16_t* O;
    __device__ __forceinline__ void operator()(const f32x4 (&acc)[2][2][4][2], const Unit& u, int wr, int wc, int fr, int fq) const {
        const int row0 = u.pm * BM + wr * 64 + fr, col0 = u.pn * HALF + wc * 32 + 8 * fq;
#pragma unroll
        for (int ai = 0; ai < 2; ++ai)
#pragma unroll
            for (int m = 0; m < 4; ++m) { bf16_t* rowp = O + (size_t)(row0 + ai * HALF + m * 16) * DFF + col0;
                f32x4 g0 = acc[ai][0][m][0], g1 = acc[ai][0][m][1], u0 = acc[ai][1][m][0], u1 = acc[ai][1][m][1]; f32x4 v0, v1;
#pragma unroll
                for (int j = 0; j < 4; ++j) { v0[j] = siluf_(g0[j]) * u0[j]; v1[j] = siluf_(g1[j]) * u1[j]; }
                u32x4 w; w.x = cvt_pk_bf16(v0[0], v0[1]); w.y = cvt_pk_bf16(v0[2], v0[3]); w.z = cvt_pk_bf16(v1[0], v1[1]); w.w = cvt_pk_bf16(v1[2], v1[3]);
                *(u32x4*)rowp = w; }
    }
};
struct EpiResid { static constexpr bool PERM = false;
    float* Y; const float* gate; float coef;
    __device__ __forceinline__ void operator()(const f32x4 (&acc)[2][2][4][2], const Unit& u, int wr, int wc, int fr, int fq) const {
        const int row0 = u.pm * BM + wr * 64 + fr, col0 = u.pn * BM + wc * 32 + 4 * fq; const int grp = u.pm < 64 ? (u.pm >> 4) : 4;
        const float* gp = gate + (size_t)grp * MODW + col0; f32x4 gv[2][2];
#pragma unroll
        for (int bj = 0; bj < 2; ++bj)
#pragma unroll
            for (int n = 0; n < 2; ++n) gv[bj][n] = *(const f32x4*)(gp + bj * HALF + n * 16) * coef;
#pragma unroll
        for (int ai = 0; ai < 2; ++ai)
#pragma unroll
            for (int m = 0; m < 4; ++m) { float* rowp = Y + (size_t)(row0 + ai * HALF + m * 16) * D + col0;
#pragma unroll
                for (int bj = 0; bj < 2; ++bj)
#pragma unroll
                    for (int n = 0; n < 2; ++n) { float* p = rowp + bj * HALF + n * 16; const f32x4 o = *(const f32x4*)p; *(f32x4*)p = o + gv[bj][n] * acc[ai][bj][m][n]; }
                asm volatile("" ::: "memory"); }
    }
};
struct EpiInproj { static constexpr bool PERM = true;
    float* Z1; bf16_t* Z2;
    __device__ __forceinline__ void operator()(const f32x4 (&acc)[2][2][4][2], const Unit& u, int wr, int wc, int fr, int fq) const {
        const int row0 = u.pm * BM + wr * 64 + fr;
        if (u.pn < 16) { const int col0 = u.pn * BM + wc * 32 + 8 * fq;
#pragma unroll
            for (int ai = 0; ai < 2; ++ai)
#pragma unroll
                for (int m = 0; m < 4; ++m) { float* rowp = Z1 + (size_t)(row0 + ai * HALF + m * 16) * Z1W + col0;
#pragma unroll
                    for (int bj = 0; bj < 2; ++bj) { *(f32x4*)(rowp + bj * HALF) = acc[ai][bj][m][0]; *(f32x4*)(rowp + bj * HALF + 4) = acc[ai][bj][m][1]; } }
        } else { const int col0 = (u.pn - 16) * BM + wc * 32 + 8 * fq;
#pragma unroll
            for (int ai = 0; ai < 2; ++ai)
#pragma unroll
                for (int m = 0; m < 4; ++m) { bf16_t* rowp = Z2 + (size_t)(row0 + ai * HALF + m * 16) * Z2W + col0;
#pragma unroll
                    for (int bj = 0; bj < 2; ++bj) { const f32x4 v0 = acc[ai][bj][m][0], v1 = acc[ai][bj][m][1];
                        u32x4 w; w.x = cvt_pk_bf16(v0[0], v0[1]); w.y = cvt_pk_bf16(v0[2], v0[3]); w.z = cvt_pk_bf16(v1[0], v1[1]); w.w = cvt_pk_bf16(v1[2], v1[3]);
                        *(u32x4*)(rowp + bj * HALF) = w; } }
        }
    }
};
template <int STAGE> struct EpiProj { static constexpr bool PERM = false;
    float* MF; bf16_t* MRG; const bf16_t* Gm;
    __device__ __forceinline__ void operator()(const f32x4 (&acc)[2][2][4][2], const Unit& u, int wr, int wc, int fr, int fq) const {
        const int row0 = u.pm * BM + wr * 64 + fr, col0 = u.pn * BM + wc * 32 + 4 * fq;
#pragma unroll
        for (int ai = 0; ai < 2; ++ai)
#pragma unroll
            for (int m = 0; m < 4; ++m) { const size_t row = (size_t)(row0 + ai * HALF + m * 16);
#pragma unroll
                for (int bj = 0; bj < 2; ++bj)
#pragma unroll
                    for (int n = 0; n < 2; ++n) { const int col = col0 + bj * HALF + n * 16;
                        const u32x2 gw = *(const u32x2*)(Gm + row * Z2W + col);
                        f32x4 s; s[0] = sigmoidf_(bflo(gw.x)); s[1] = sigmoidf_(bfhi(gw.x)); s[2] = sigmoidf_(bflo(gw.y)); s[3] = sigmoidf_(bfhi(gw.y));
                        f32x4 v = s * acc[ai][bj][m][n]; float* p = MF + row * D + col;
                        if (STAGE >= 1) v = v + *(const f32x4*)p;
                        if (STAGE <= 1) *(f32x4*)p = v;
                        else { u32x2 w; w.x = cvt_pk_bf16(v[0], v[1]); w.y = cvt_pk_bf16(v[2], v[3]); *(u32x2*)(MRG + row * D + col) = w; } }
                asm volatile("" ::: "memory"); }
    }
};
}

__device__ __forceinline__ void transpose_item(const float* W, int ldw, int k0, int n0, bf16* dst, int ldk, int drow0, int dk0, LAS float* scr, int lane) {
#pragma unroll 8
    for (int i = 0; i < 32; ++i) { const int kk = 2 * i + (lane >> 5); scr[kk * 33 + (lane & 31)] = W[(size_t)(k0 + kk) * ldw + n0 + (lane & 31)]; }
    LDS_WAIT(); asm volatile("" ::: "memory");
    const int c = lane & 7;
#pragma unroll
    for (int j = 0; j < 4; ++j) { const int n = (lane >> 3) + 8 * j; const LAS float* s = scr + (8 * c) * 33 + n;
        v4u o; o.x = pk2(s[0 * 33], s[1 * 33]); o.y = pk2(s[2 * 33], s[3 * 33]); o.z = pk2(s[4 * 33], s[5 * 33]); o.w = pk2(s[6 * 33], s[7 * 33]);
        *(GAS v4u*)(dst + (size_t)(drow0 + n) * ldk + dk0 + k0 + 8 * c) = o; }
    LDS_WAIT(); asm volatile("" ::: "memory");
}

enum { IX = 0, IC, ICTX, ICCTX, IWMOD, IBMOD, INORMG, IFINALG, IWGATE, IWUP, IWDOWN, IWIN, ILB, IANORM, ILNG, ILNB, IWS, IBS, ICONV, IWPA, IWPB, IWPC, IWOUT };
#define INP(k) (kargs()->in[(k)])

__device__ __forceinline__ void phase_prologue() {
    const Frame F = mkframe(); unsigned char* ws = F.ws;
    const int gw = F.vcu * 8 + F.wave, NGW = F.G * 8;
    { float* Y = (float*)(ws + WS_Y);
      for (int m = gw; m < M; m += NGW) { const float* src = m < M_LAT ? INP(IX) + (size_t)m * D : INP(ICTX) + (size_t)(m - M_LAT) * D; const GAS f32x4* s = (const GAS f32x4*)src + F.lane; GAS f32x4* d = (GAS f32x4*)(Y + (size_t)m * D) + F.lane;
#pragma unroll
          for (int j = 0; j < 8; ++j) d[64 * j] = s[64 * j]; } }
    if (blockIdx.x == 0) { float* LB = (float*)(ws + WS_LB);
        for (int i = F.tid; i < 2 * WK; i += 512) { float lg[DEPTH], mx = -1e30f;
#pragma unroll
            for (int l = 0; l < DEPTH; ++l) { lg[l] = INP(ILB)[l * 2 * WK + i]; mx = fmaxf(mx, lg[l]); }
            float s = 0.f;
#pragma unroll
            for (int l = 0; l < DEPTH; ++l) { lg[l] = __expf(lg[l] - mx); s += lg[l]; }
            float cum = 0.f; const float inv = 1.0f / s;
#pragma unroll
            for (int l = 0; l < DEPTH; ++l) { LB[l * 2 * WK + i] = cum; if (l + 1 < DEPTH) cum += lg[l + 1] * inv; } } }
    { LAS float* sc = (LAS float*)F.lds;
      LAS float* red = (LAS float*)(F.lds + 5 * D * 4);
      for (int i = F.tid; i < NGRP * D; i += 512) { const int g = i / D, k = i % D; const float v = g < 4 ? INP(IC)[g * D + k] : INP(ICCTX)[k]; sc[i] = siluf_(v); }
      __syncthreads();
      float* MOD = (float*)(ws + WS_MOD);
      constexpr int NU = DEPTH * (MODW / 128);
      for (int u = F.vcu; u < NU; u += F.G) { const int l = u / (MODW / 128), n0 = (u % (MODW / 128)) * 128;
          const float* Wp = INP(IWMOD) + (size_t)l * D * MODW + n0 + 2 * F.lane;
          float a0[NGRP], a1[NGRP];
#pragma unroll
          for (int g = 0; g < NGRP; ++g) { a0[g] = 0.f; a1[g] = 0.f; }
          const int kb = F.wave * 256;
#pragma unroll 4
          for (int k = kb; k < kb + 256; ++k) { const float2 w = *(const float2*)(Wp + (size_t)k * MODW);
#pragma unroll
              for (int g = 0; g < NGRP; ++g) { const float s = sc[g * D + k]; a0[g] += s * w.x; a1[g] += s * w.y; } }
#pragma unroll
          for (int g = 0; g < NGRP; ++g) { red[(F.wave * NGRP + g) * 128 + 2 * F.lane] = a0[g]; red[(F.wave * NGRP + g) * 128 + 2 * F.lane + 1] = a1[g]; }
          __syncthreads();
          for (int i = F.tid; i < NGRP * 128; i += 512) { const int g = i / 128, n = i % 128; float s = 0.f;
#pragma unroll
              for (int w = 0; w < 8; ++w) s += red[(w * NGRP + g) * 128 + n];
              MOD[((size_t)l * NGRP + g) * MODW + n0 + n] = s + INP(IBMOD)[l * MODW + n0 + n]; }
          __syncthreads(); }
    }
    __syncthreads();
    { LAS float* scr = (LAS float*)(F.lds + F.wave * 16384);
      constexpr int I_FF = (D / 64) * (DFF / 32);
      constexpr int I_IN = (D / 64) * (INW / 32);
      constexpr int I_PA = (1024 / 64) * (D / 32), I_PB = (512 / 64) * (D / 32);
      constexpr int I_WO = (D / 64) * (D / 32);
      constexpr int PER_L = 6 * I_FF + I_IN + I_PA + 2 * I_PB + I_WO;
      constexpr int NITEMS = DEPTH * PER_L;
      bf16* WGU = (bf16*)(ws + WS_WGU); bf16* WD = (bf16*)(ws + WS_WD); bf16* WIN = (bf16*)(ws + WS_WIN); bf16* WP = (bf16*)(ws + WS_WP); bf16* WO = (bf16*)(ws + WS_WO);
      for (int it = gw; it < NITEMS; it += NGW) {
          const int l = it / PER_L; int r = it % PER_L;
          if (r < 6 * I_FF) { const int j = r / (3 * I_FF); r %= 3 * I_FF; const int which = r / I_FF; r %= I_FF; const size_t lj = (size_t)(l * 2 + j);
              if (which < 2) { const int nblk = DFF / 32, kb = r / nblk, nb = r % nblk, n0 = 32 * nb;
                  const float* W = (which == 0 ? INP(IWGATE) : INP(IWUP)) + lj * D * DFF;
                  transpose_item(W, DFF, 64 * kb, n0, WGU + lj * (size_t)(2 * DFF) * D, D, 256 * (n0 >> 7) + (n0 & 127) + 128 * which, 0, scr, F.lane);
              } else { const int nblk = D / 32, kb = r / nblk, nb = r % nblk;
                  transpose_item(INP(IWDOWN) + lj * DFF * D, D, 64 * kb, 32 * nb, WD + lj * (size_t)D * DFF, DFF, 32 * nb, 0, scr, F.lane); }
              continue; }
          r -= 6 * I_FF;
          if (r < I_IN) { const int nblk = INW / 32, kb = r / nblk, nb = r % nblk; transpose_item(INP(IWIN) + (size_t)l * D * INW, INW, 64 * kb, 32 * nb, WIN + (size_t)l * INW * D, D, 32 * nb, 0, scr, F.lane); continue; }
          r -= I_IN;
          if (r < I_PA) { const int nblk = D / 32, kb = r / nblk, nb = r % nblk; transpose_item(INP(IWPA) + (size_t)l * 1024 * D, D, 64 * kb, 32 * nb, WP + (size_t)l * D * 2048, 2048, 32 * nb, 0, scr, F.lane); continue; }
          r -= I_PA;
          if (r < I_PB) { const int nblk = D / 32, kb = r / nblk, nb = r % nblk; transpose_item(INP(IWPB) + (size_t)l * 512 * D, D, 64 * kb, 32 * nb, WP + (size_t)l * D * 2048, 2048, 32 * nb, 1024, scr, F.lane); continue; }
          r -= I_PB;
          if (r < I_PB) { const int nblk = D / 32, kb = r / nblk, nb = r % nblk; transpose_item(INP(IWPC) + (size_t)l * 512 * D, D, 64 * kb, 32 * nb, WP + (size_t)l * D * 2048, 2048, 32 * nb, 1536, scr, F.lane); continue; }
          r -= I_PB;
          { const int nblk = D / 32, kb = r / nblk, nb = r % nblk; transpose_item(INP(IWOUT) + (size_t)l * D * D, D, 64 * kb, 32 * nb, WO + (size_t)l * D * D, D, 32 * nb, 0, scr, F.lane); }
      }
    }
}

__device__ __forceinline__ void phase_norm(int l, int which) {
    const Frame F = mkframe(); const float* Y = (const float*)(F.ws + WS_Y); bf16* H = (bf16*)(F.ws + WS_H);
    const float* g = INP(INORMG) + (size_t)(l * 3 + which) * D; const float* mod_l = (const float*)(F.ws + WS_MOD) + (size_t)l * NGRP * MODW; const int shift_idx = 3 * which;
    const int gw = F.vcu * 8 + F.wave, NGW = F.G * 8;
    for (int m = gw; m < M; m += NGW) {
        const GAS f32x4* xr = (const GAS f32x4*)(Y + (size_t)m * D) + F.lane; f32x4 v[8]; float ss = 0.f;
#pragma unroll
        for (int j = 0; j < 8; ++j) { v[j] = xr[64 * j]; ss += (v[j].x * v[j].x + v[j].y * v[j].y) + (v[j].z * v[j].z + v[j].w * v[j].w); }
        const float rstd = 1.0f / sqrtf(wave_sum(ss) * (1.0f / D) + EPS);
        const float* mp = mod_l + (size_t)grp_of_row(m) * MODW + shift_idx * D;
        GAS unsigned long long* o8 = (GAS unsigned long long*)(H + (size_t)m * D) + F.lane;
#pragma unroll
        for (int j = 0; j < 8; ++j) { const f32x4 gg = ((const GAS f32x4*)g)[64 * j + F.lane], sh = ((const GAS f32x4*)mp)[64 * j + F.lane], sc = ((const GAS f32x4*)(mp + D))[64 * j + F.lane];
            const f32x4 h = v[j] * rstd * gg * (1.0f + sc) + sh;
            o8[64 * j] = (unsigned long long)pk2(h.x, h.y) | ((unsigned long long)pk2(h.z, h.w) << 32); }
    }
}

__device__ __forceinline__ void phase_final() {
    const Frame F = mkframe(); const float* Y = (const float*)(F.ws + WS_Y); float* out = kargs()->out; const float* g = INP(IFINALG);
    const int gw = F.vcu * 8 + F.wave, NGW = F.G * 8;
    for (int m = gw; m < M_LAT; m += NGW) {
        const GAS f32x4* xr = (const GAS f32x4*)(Y + (size_t)m * D) + F.lane; f32x4 v[8]; float ss = 0.f;
#pragma unroll
        for (int j = 0; j < 8; ++j) { v[j] = xr[64 * j]; ss += (v[j].x * v[j].x + v[j].y * v[j].y) + (v[j].z * v[j].z + v[j].w * v[j].w); }
        const float rstd = 1.0f / sqrtf(wave_sum(ss) * (1.0f / D) + EPS);
        GAS f32x4* o = (GAS f32x4*)(out + (size_t)m * D) + F.lane;
#pragma unroll
        for (int j = 0; j < 8; ++j) o[64 * j] = v[j] * rstd * ((const GAS f32x4*)g)[64 * j + F.lane];
    }
}

__device__ __forceinline__ void phase_mix_elem(int l) {
    const Frame F = mkframe(); unsigned char* ws = F.ws;
    const float* Z1 = (const float*)(ws + WS_Z1); const bf16* Z2 = (const bf16*)(ws + WS_Z2);
    float* FFp = (float*)(ws + WS_FF); float* FBp = (float*)(ws + WS_FB); bf16* VN = (bf16*)(ws + WS_VN); bf16* YABC = (bf16*)(ws + WS_YABC);
    const float* LB = (const float*)(ws + WS_LB) + (size_t)l * 2 * WK;
    const int gw = F.vcu * 8 + F.wave, NGW = F.G * 8, lane = F.lane;
    for (int m = gw; m < M; m += NGW) {
#pragma unroll
        for (int dir = 0; dir < 2; ++dir) { const GAS f32x4* zp = (const GAS f32x4*)(Z1 + (size_t)m * Z1W + 2048 + dir * WK) + lane; const GAS f32x4* lp = (const GAS f32x4*)(LB + dir * WK) + lane;
            GAS f32x4* op = (GAS f32x4*)((dir ? FBp : FFp) + (size_t)m * WK) + lane;
#pragma unroll
            for (int j = 0; j < 4; ++j) { const f32x4 z = zp[64 * j], lb = lp[64 * j]; f32x4 f;
#pragma unroll
                for (int e = 0; e < 4; ++e) f[e] = lb[e] + (1.0f - lb[e]) * sigmoidf_(z[e]);
                op[64 * j] = f; } }
        { const v4u raw = *(const GAS v4u*)(Z2 + (size_t)m * Z2W + Z2_V + 8 * lane); float x[8];
          x[0] = gelu_tanh(bflo(raw.x)); x[1] = gelu_tanh(bfhi(raw.x)); x[2] = gelu_tanh(bflo(raw.y)); x[3] = gelu_tanh(bfhi(raw.y));
          x[4] = gelu_tanh(bflo(raw.z)); x[5] = gelu_tanh(bfhi(raw.z)); x[6] = gelu_tanh(bflo(raw.w)); x[7] = gelu_tanh(bfhi(raw.w));
          float s = 0.f;
#pragma unroll
          for (int e = 0; e < 8; ++e) s += x[e];
          const float mean = wave_sum(s) * (1.0f / BW); float q = 0.f;
#pragma unroll
          for (int e = 0; e < 8; ++e) { x[e] -= mean; q += x[e] * x[e]; }
          const float rstd = 1.0f / sqrtf(wave_sum(q) * (1.0f / BW) + EPS);
          const float* gp = INP(ILNG) + l * BW + 8 * lane; const float* bp = INP(ILNB) + l * BW + 8 * lane; float y[8];
#pragma unroll
          for (int e = 0; e < 8; ++e) y[e] = x[e] * rstd * gp[e] + bp[e];
          v4u o; o.x = pk2(y[0], y[1]); o.y = pk2(y[2], y[3]); o.z = pk2(y[4], y[5]); o.w = pk2(y[6], y[7]);
          *(GAS v4u*)(VN + (size_t)m * BW + 8 * lane) = o; }
        { bool hp, hn; if (m < M_LAT) { const int p = m & 63; hp = p != 0; hn = p != 63; } else { const int p = (m - M_LAT) & 255; hp = p != 0; hn = p != 255; }
          float t[3][8];
#pragma unroll
          for (int d = 0; d < 3; ++d) { const bool ok = d == 1 || (d == 0 ? hp : hn); const size_t mm = (size_t)(ok ? m + d - 1 : m);
              const v4u hc = *(const GAS v4u*)(Z2 + mm * Z2W + Z2_HC + 8 * lane), gc = *(const GAS v4u*)(Z2 + mm * Z2W + Z2_GC + 8 * lane); const float z = ok ? 1.0f : 0.0f;
              t[d][0] = z * bflo(hc.x) * bflo(gc.x); t[d][1] = z * bfhi(hc.x) * bfhi(gc.x); t[d][2] = z * bflo(hc.y) * bflo(gc.y); t[d][3] = z * bfhi(hc.y) * bfhi(gc.y);
              t[d][4] = z * bflo(hc.z) * bflo(gc.z); t[d][5] = z * bfhi(hc.z) * bfhi(gc.z); t[d][6] = z * bflo(hc.w) * bflo(gc.w); t[d][7] = z * bfhi(hc.w) * bfhi(gc.w); }
          const v4u gbr = *(const GAS v4u*)(Z2 + (size_t)m * Z2W + Z2_GB + 8 * lane); float gb[8];
          gb[0] = bflo(gbr.x); gb[1] = bfhi(gbr.x); gb[2] = bflo(gbr.y); gb[3] = bfhi(gbr.y); gb[4] = bflo(gbr.z); gb[5] = bfhi(gbr.z); gb[6] = bflo(gbr.w); gb[7] = bfhi(gbr.w);
          const float* cw = INP(ICONV) + (size_t)l * 3 * CWD + 8 * lane; float y[8];
#pragma unroll
          for (int e = 0; e < 8; ++e) y[e] = gb[e] * (cw[e] * t[0][e] + cw[CWD + e] * t[1][e] + cw[2 * CWD + e] * t[2][e]);
          v4u o; o.x = pk2(y[0], y[1]); o.y = pk2(y[2], y[3]); o.z = pk2(y[4], y[5]); o.w = pk2(y[6], y[7]);
          *(GAS v4u*)(YABC + (size_t)m * 2048 + 1536 + 8 * lane) = o; }
    }
}

__device__ __forceinline__ int scan_row(int step, int b, int dir) { return step < CTXL ? (M_LAT + b * CTXL + (dir ? CTXL - 1 - step : step)) : (b * SEQ + (dir ? SEQ - 1 - (step - CTXL) : (step - CTXL))); }
__device__ __forceinline__ void phase_scan_v1() {
    const Frame F = mkframe(); unsigned char* ws = F.ws;
    const float* Z1 = (const float*)(ws + WS_Z1);
    const int lane = F.lane, v = 4 * F.wave + (lane >> 4), kg = lane & 15;
    constexpr int TOT = CTXL + SEQ;
    for (int u = blockIdx.x; u < 256; u += F.G) {
        const int b = u >> 6, h = (u >> 3) & 7, dir = (u >> 2) & 1, vs = u & 3;
        const float* Fp = (const float*)(ws + (dir ? WS_FB : WS_FF)) + h * DK + 8 * kg;
        const float* Qp = Z1 + h * DK + 8 * kg;
        const float* Vp = Z1 + 1024 + h * DV + vs * 32 + v;
        float* Op = (float*)(ws + (dir ? WS_OB : WS_OF)) + h * DV + vs * 32 + v;
        float S[8];
#pragma unroll
        for (int j = 0; j < 8; ++j) S[j] = 0.f;
#define rowof(step) scan_row((step), b, dir)
        f32x4 fa[4][2], qa[4][2]; float va[4];
#pragma unroll
        for (int i = 0; i < 4; ++i) { const size_t r = (size_t)rowof(i); fa[i][0] = *(const f32x4*)(Fp + r * WK); fa[i][1] = *(const f32x4*)(Fp + r * WK + 4); qa[i][0] = *(const f32x4*)(Qp + r * Z1W); qa[i][1] = *(const f32x4*)(Qp + r * Z1W + 4); va[i] = Vp[r * Z1W]; }
        for (int s0 = 0; s0 < TOT; s0 += 4) {
            f32x4 fn[4][2], qn[4][2]; float vn[4];
            const int sn = (s0 + 4 < TOT) ? s0 + 4 : s0;
#pragma unroll
            for (int i = 0; i < 4; ++i) { const size_t r = (size_t)rowof(sn + i); fn[i][0] = *(const f32x4*)(Fp + r * WK); fn[i][1] = *(const f32x4*)(Fp + r * WK + 4); qn[i][0] = *(const f32x4*)(Qp + r * Z1W); qn[i][1] = *(const f32x4*)(Qp + r * Z1W + 4); vn[i] = Vp[r * Z1W]; }
            float po[4];
#pragma unroll
            for (int i = 0; i < 4; ++i) { float p = 0.f;
#pragma unroll
                for (int j = 0; j < 8; ++j) { const float f = fa[i][j >> 2][j & 3]; S[j] = f * S[j] + (1.0f - f) * va[i]; p += qa[i][j >> 2][j & 3] * S[j]; }
                po[i] = p; }
#pragma unroll
            for (int i = 0; i < 4; ++i) po[i] = row16_sum(po[i]);
            if (kg == 0) {
#pragma unroll
                for (int i = 0; i < 4; ++i) Op[(size_t)rowof(s0 + i) * WK] = po[i] * 0.08838834764831845f; }
#pragma unroll
            for (int i = 0; i < 4; ++i) { fa[i][0] = fn[i][0]; fa[i][1] = fn[i][1]; qa[i][0] = qn[i][0]; qa[i][1] = qn[i][1]; va[i] = vn[i]; }
        }
    }
#undef rowof
}

__device__ __forceinline__ void phase_gmlp_v1(int l) {
    const Frame F = mkframe(); unsigned char* ws = F.ws;
    const bf16* Z2 = (const bf16*)(ws + WS_Z2); const bf16* VN = (const bf16*)(ws + WS_VN); bf16* YABC = (bf16*)(ws + WS_YABC);
    LAS float* Wt = (LAS float*)F.lds;
    LAS float* Vt = (LAS float*)(F.lds + 65536);
    constexpr int NU = (M / 128) * 4;
    const int tt = F.tid >> 4, cc = F.tid & 15, t0 = 4 * tt, ch0 = 8 * cc;
    for (int u = F.vcu; u < NU; u += F.G) { const int chunk = u >> 2, g = u & 3; const size_t r0 = (size_t)chunk * 128;
        __syncthreads();
        const float* wsrc = INP(IWS) + ((size_t)l * 4 + g) * 128 * 128;
        for (int i = F.tid; i < 128 * 128; i += 512) { const int t = i >> 7, s = i & 127; Wt[s * 128 + t] = wsrc[i]; }
        for (int i = F.tid; i < 128 * 16; i += 512) { const int s = i >> 4, c8 = i & 15; const v4u raw = *(const GAS v4u*)(VN + (r0 + s) * BW + g * 128 + 8 * c8); LAS float* d = Vt + s * 128 + 8 * c8;
            d[0] = bflo(raw.x); d[1] = bfhi(raw.x); d[2] = bflo(raw.y); d[3] = bfhi(raw.y); d[4] = bflo(raw.z); d[5] = bfhi(raw.z); d[6] = bflo(raw.w); d[7] = bfhi(raw.w); }
        __syncthreads();
        float acc[4][8];
#pragma unroll
        for (int i = 0; i < 4; ++i)
#pragma unroll
            for (int e = 0; e < 8; ++e) acc[i][e] = 0.f;
#pragma unroll 4
        for (int s = 0; s < 128; ++s) { const f32x4 a = *(const LAS f32x4*)(Wt + s * 128 + t0); const f32x4 b0 = *(const LAS f32x4*)(Vt + s * 128 + ch0), b1 = *(const LAS f32x4*)(Vt + s * 128 + ch0 + 4);
#pragma unroll
            for (int i = 0; i < 4; ++i) {
#pragma unroll
                for (int e = 0; e < 4; ++e) { acc[i][e] += a[i] * b0[e]; acc[i][4 + e] += a[i] * b1[e]; } } }
#pragma unroll
        for (int i = 0; i < 4; ++i) { const int t = t0 + i; const float bs = INP(IBS)[((size_t)l * 4 + g) * 128 + t];
            const v4u ur = *(const GAS v4u*)(Z2 + (r0 + t) * Z2W + Z2_U + g * 128 + ch0); float uu[8];
            uu[0] = bflo(ur.x); uu[1] = bfhi(ur.x); uu[2] = bflo(ur.y); uu[3] = bfhi(ur.y); uu[4] = bflo(ur.z); uu[5] = bfhi(ur.z); uu[6] = bflo(ur.w); uu[7] = bfhi(ur.w);
            float y[8];
#pragma unroll
            for (int e = 0; e < 8; ++e) y[e] = gelu_tanh(uu[e]) * (acc[i][e] + bs);
            v4u o; o.x = pk2(y[0], y[1]); o.y = pk2(y[2], y[3]); o.z = pk2(y[4], y[5]); o.w = pk2(y[6], y[7]);
            *(GAS v4u*)(YABC + (r0 + t) * 2048 + 1024 + g * 128 + ch0) = o; }
    }
    __syncthreads();
}

__device__ __forceinline__ void phase_readout(int l) {
    const Frame F = mkframe(); unsigned char* ws = F.ws;
    const float* OFp = (const float*)(ws + WS_OF); const float* OBp = (const float*)(ws + WS_OB); const bf16* Z2 = (const bf16*)(ws + WS_Z2); bf16* YABC = (bf16*)(ws + WS_YABC);
    const int gw = F.vcu * 8 + F.wave, NGW = F.G * 8, lane = F.lane;
    const float* ag = INP(IANORM) + l * DV + (16 * lane & 127);
    for (int m = gw; m < M; m += NGW) {
        float o[16]; float ss = 0.f;
#pragma unroll
        for (int j = 0; j < 4; ++j) { const f32x4 a = *(const GAS f32x4*)(OFp + (size_t)m * WK + 16 * lane + 4 * j), b = *(const GAS f32x4*)(OBp + (size_t)m * WK + 16 * lane + 4 * j);
#pragma unroll
            for (int e = 0; e < 4; ++e) { o[4 * j + e] = a[e] + b[e]; ss += o[4 * j + e] * o[4 * j + e]; } }
        ss += dppf<0xB1>(ss); ss += dppf<0x4E>(ss); ss += dppf<0x141>(ss);
        const float rstd = 1.0f / sqrtf(ss * (1.0f / DV) + EPS);
        const v4u g0 = *(const GAS v4u*)(Z2 + (size_t)m * Z2W + Z2_GA + 16 * lane), g1 = *(const GAS v4u*)(Z2 + (size_t)m * Z2W + Z2_GA + 16 * lane + 8); float ga[16];
        ga[0] = bflo(g0.x); ga[1] = bfhi(g0.x); ga[2] = bflo(g0.y); ga[3] = bfhi(g0.y); ga[4] = bflo(g0.z); ga[5] = bfhi(g0.z); ga[6] = bflo(g0.w); ga[7] = bfhi(g0.w);
        ga[8] = bflo(g1.x); ga[9] = bfhi(g1.x); ga[10] = bflo(g1.y); ga[11] = bfhi(g1.y); ga[12] = bflo(g1.z); ga[13] = bfhi(g1.z); ga[14] = bflo(g1.w); ga[15] = bfhi(g1.w);
        float y[16];
#pragma unroll
        for (int e = 0; e < 16; ++e) y[e] = o[e] * rstd * ag[e] * siluf_(ga[e]);
        v4u w0, w1; w0.x = pk2(y[0], y[1]); w0.y = pk2(y[2], y[3]); w0.z = pk2(y[4], y[5]); w0.w = pk2(y[6], y[7]); w1.x = pk2(y[8], y[9]); w1.y = pk2(y[10], y[11]); w1.z = pk2(y[12], y[13]); w1.w = pk2(y[14], y[15]);
        *(GAS v4u*)(YABC + (size_t)m * 2048 + 16 * lane) = w0; *(GAS v4u*)(YABC + (size_t)m * 2048 + 16 * lane + 8) = w1;
    }
}

constexpr int PH_PER_LAYER = 13, N_PHASES = 1 + DEPTH * PH_PER_LAYER + 1;
__device__ __forceinline__ void grid_seam() {
    extern __shared__ __attribute__((aligned(16))) unsigned char lds_dyn[];
    XcdBarrier bar; bar.bar = (unsigned*)(kargs()->ws + WS_CTL) + CW_BAR; bar.x = xb_xcc_id(); bar.st = (volatile LAS unsigned*)((LAS unsigned char*)lds_dyn + MISC_OFF) + 8;
    xcd_barrier(bar);
}
__global__ void __launch_bounds__(512, 2) fwd_kernel(Args args_unused) {
    extern __shared__ __attribute__((aligned(16))) unsigned char lds_dyn[];
    { LAS unsigned char* lds = (LAS unsigned char*)lds_dyn;
      for (int u = threadIdx.x; u < (LDS_BYTES - LDSCTL_OFF) / 4; u += 512) ((LAS unsigned*)(lds + LDSCTL_OFF))[u] = 0u;
      __syncthreads();
      if (kargs()->ph_hi - kargs()->ph_lo > 1) (void)xcd_barrier_post((unsigned*)(kargs()->ws + WS_CTL) + CW_BAR, (volatile LAS unsigned*)(lds + MISC_OFF) + 8); }
    const int lo = kargs()->ph_lo, hi = kargs()->ph_hi;
#define IN(k) (lo <= (k) && (k) < hi)
#define SEAM(k) do { if (IN((k) + 1)) grid_seam(); } while (0)
#define LDSP ((LAS unsigned char*)lds_dyn)
#define WSP(off) (kargs()->ws + (off))

#ifndef NO_PRO
    if (IN(0)) { phase_prologue(); __syncthreads(); SEAM(0); }
#endif

#pragma unroll 1
    for (int l = 0; l < DEPTH; ++l) {
        const int pb = 1 + l * PH_PER_LAYER;
        if (hi <= pb || lo >= pb + PH_PER_LAYER) continue;
#pragma unroll 1
        for (int j = 0; j < 2; ++j) {
            const int p0 = pb + (j ? 10 : 0);
            if (IN(p0)) { phase_norm(l, j ? 2 : 0); SEAM(p0); }
#ifndef NO_G1
            if (IN(p0 + 1)) { pg8::Gemm g{(const bf16*)WSP(WS_H), (const bf16*)WSP(WS_WGU) + (size_t)(l * 2 + j) * (2 * DFF) * D, M, 2 * DFF, D, D, D};
                pg8::StaticOrder S; S.init(M, 2 * DFF, (int)gridDim.x, (int)blockIdx.x); pg8::EpiSwiGLU E{(bf16*)WSP(WS_ACT)};
                pg8::gemm_phase<pg8::EpiSwiGLU, pg8::StaticOrder, true, true>(LDSP, g, S, E); SEAM(p0 + 1); }
#endif
#ifndef NO_G2
            if (IN(p0 + 2)) { pg8::Gemm g{(const bf16*)WSP(WS_ACT), (const bf16*)WSP(WS_WD) + (size_t)(l * 2 + j) * D * DFF, M, D, DFF, DFF, DFF};
                pg8::StaticOrder S; S.init(M, D, (int)gridDim.x, (int)blockIdx.x); pg8::EpiResid E{(float*)WSP(WS_Y), (const float*)WSP(WS_MOD) + (size_t)l * NGRP * MODW + (j ? 8 : 2) * D, 0.5f};
                pg8::gemm_phase<pg8::EpiResid, pg8::StaticOrder, true, true>(LDSP, g, S, E); SEAM(p0 + 2); }
#endif
            if (j == 0) {
                if (IN(pb + 3)) { phase_norm(l, 1); SEAM(pb + 3); }
#ifndef NO_G3
                if (IN(pb + 4)) { pg8::Gemm g{(const bf16*)WSP(WS_H), (const bf16*)WSP(WS_WIN) + (size_t)l * INW * D, M, INW, D, D, D};
                    pg8::StaticOrder S; S.init(M, INW, (int)gridDim.x, (int)blockIdx.x); pg8::EpiInproj E{(float*)WSP(WS_Z1), (bf16*)WSP(WS_Z2)};
                    pg8::gemm_phase<pg8::EpiInproj, pg8::StaticOrder, true, true>(LDSP, g, S, E); SEAM(pb + 4); }
#endif
#ifndef NO_ELEM
                if (IN(pb + 5)) { phase_mix_elem(l); SEAM(pb + 5); }
#endif
                if (IN(pb + 6)) {
#ifndef NO_SCAN
                    phase_scan_v1();
#endif
#ifndef NO_GMLP
                    phase_gmlp_v1(l);
#endif
                    SEAM(pb + 6); }
#ifndef NO_READ
                if (IN(pb + 7)) { phase_readout(l); SEAM(pb + 7); }
#endif
#ifndef NO_G4
                if (IN(pb + 8)) {
                    { pg8::Gemm g{(const bf16*)WSP(WS_YABC), (const bf16*)WSP(WS_WP) + (size_t)l * D * 2048, M, D, 1024, 2048, 2048};
                      pg8::StaticOrder S; S.init(M, D, (int)gridDim.x, (int)blockIdx.x); pg8::EpiProj<0> E{(float*)WSP(WS_MF32), (bf16*)WSP(WS_MRG), (const bf16*)WSP(WS_Z2) + Z2_MA};
                      pg8::gemm_phase<pg8::EpiProj<0>, pg8::StaticOrder, true, true>(LDSP, g, S, E); }
                    { pg8::Gemm g{(const bf16*)WSP(WS_YABC) + 1024, (const bf16*)WSP(WS_WP) + (size_t)l * D * 2048 + 1024, M, D, 512, 2048, 2048};
                      pg8::StaticOrder S; S.init(M, D, (int)gridDim.x, (int)blockIdx.x); pg8::EpiProj<1> E{(float*)WSP(WS_MF32), (bf16*)WSP(WS_MRG), (const bf16*)WSP(WS_Z2) + Z2_MB};
                      pg8::gemm_phase<pg8::EpiProj<1>, pg8::StaticOrder, true, true>(LDSP, g, S, E); }
                    { pg8::Gemm g{(const bf16*)WSP(WS_YABC) + 1536, (const bf16*)WSP(WS_WP) + (size_t)l * D * 2048 + 1536, M, D, 512, 2048, 2048};
                      pg8::StaticOrder S; S.init(M, D, (int)gridDim.x, (int)blockIdx.x); pg8::EpiProj<2> E{(float*)WSP(WS_MF32), (bf16*)WSP(WS_MRG), (const bf16*)WSP(WS_Z2) + Z2_MC};
                      pg8::gemm_phase<pg8::EpiProj<2>, pg8::StaticOrder, true, true>(LDSP, g, S, E); }
                    SEAM(pb + 8); }
#endif
#ifndef NO_G5
                if (IN(pb + 9)) { pg8::Gemm g{(const bf16*)WSP(WS_MRG), (const bf16*)WSP(WS_WO) + (size_t)l * D * D, M, D, D, D, D};
                    pg8::StaticOrder S; S.init(M, D, (int)gridDim.x, (int)blockIdx.x); pg8::EpiResid E{(float*)WSP(WS_Y), (const float*)WSP(WS_MOD) + (size_t)l * NGRP * MODW + 5 * D, 1.0f};
                    pg8::gemm_phase<pg8::EpiResid, pg8::StaticOrder, true, true>(LDSP, g, S, E); SEAM(pb + 9); }
#endif
            }
        }
    }
    if (IN(N_PHASES - 1)) phase_final();
#undef IN
#undef SEAM
}

#ifndef MK_PER_PHASE
#define MK_PER_PHASE 0
#endif
extern "C" void kernel_launch(void* const* d_in, const int* in_sizes, int n_in, void* d_out, int out_size, void* d_ws, size_t ws_size, hipStream_t stream) {
    static int grid = 0;
    if (grid == 0) {
        if (n_in != 23 || out_size != M_LAT * D || ws_size < WS_END) { fprintf(stderr, "kernel_launch: unexpected sizes n_in %d out %d ws %zu (need %zu)\n", n_in, out_size, ws_size, (size_t)WS_END); grid = -1; return; }
        int dev = 0, cus = 0, per_cu = 0;
        if (hipGetDevice(&dev) != hipSuccess || hipDeviceGetAttribute(&cus, hipDeviceAttributeMultiprocessorCount, dev) != hipSuccess) { grid = -1; return; }
        if (hipFuncSetAttribute((const void*)fwd_kernel, hipFuncAttributeMaxDynamicSharedMemorySize, LDS_BYTES) != hipSuccess) { fprintf(stderr, "kernel_launch: hipFuncSetAttribute failed\n"); grid = -1; return; }
        if (hipOccupancyMaxActiveBlocksPerMultiprocessor(&per_cu, (const void*)fwd_kernel, 512, LDS_BYTES) != hipSuccess || per_cu < 1) { fprintf(stderr, "kernel_launch: occupancy query says %d\n", per_cu); }
        (void)hipGetLastError();
        grid = cus;
    }
    if (grid < 0) return;
    (void)hipMemsetAsync((char*)d_ws + WS_CTL, 0, CTL_ZERO_BYTES, stream);
    Args a{};
    for (int i = 0; i < 23; ++i) a.in[i] = (const float*)d_in[i];
    a.out = (float*)d_out; a.ws = (unsigned char*)d_ws;
#if MK_PER_PHASE
    for (int p = 0; p < N_PHASES; ++p) { a.ph_lo = p; a.ph_hi = p + 1; hipLaunchKernelGGL(fwd_kernel, dim3(grid), dim3(512), LDS_BYTES, stream, a); }
#else
    a.ph_lo = 0; a.ph_hi = N_PHASES; hipLaunchKernelGGL(fwd_kernel, dim3(grid), dim3(512), LDS_BYTES, stream, a);
#endif
}
```

```cpp
#include <hip/hip_runtime.h>
#include <cstdio>
#include <cstdint>
namespace pg8 {
#define PG8_LAS __attribute__((address_space(3)))
typedef unsigned short bf16_t;
typedef short bf16x8 __attribute__((ext_vector_type(8)));
typedef float f32x4 __attribute__((ext_vector_type(4)));
typedef float f32x2 __attribute__((ext_vector_type(2)));
typedef unsigned u32x4 __attribute__((ext_vector_type(4)));
typedef unsigned u32x2 __attribute__((ext_vector_type(2)));
constexpr int BM = 256, BK = 64, HALF = 128, HTB = HALF * BK * 2  , STAGE_BYTES = 8 * HTB, NXCD = 8, WGM = 8;

__host__ __device__ __forceinline__ int lds_byte(int r, int c) { const int st = (r >> 4) * 2 + (c >> 5), rr = r & 15, cc = c & 31, ob = rr * 64 + cc * 2; return st * 1024 + (ob ^ (((ob >> 9) & 1) << 5)); }
__host__ __device__ __forceinline__ void stage_rc(int b, int& R, int& C) { const int st = b / 1024, sb = b % 1024, swz = sb ^ (((sb >> 9) & 1) << 5); R = (st >> 1) * 16 + swz / 64; C = (st & 1) * 32 + (swz % 64) / 2; }
__host__ __device__ __forceinline__ int perm32(int rho) { const int n = rho >> 4, i = rho & 15; return 8 * (i >> 2) + 4 * n + (i & 3); }

struct Unit { int pm, pn; };
struct Gemm { const bf16_t* A; const bf16_t* Bt; int M, N, K, lda, ldb; };

struct StaticOrder {
    int nM, nN, nwg, G, c;
    __host__ __device__ void init(int M, int N, int G_, int c_) { nM = M / BM; nN = N / BM; nwg = nM * nN; G = G_; c = c_; }
    __host__ __device__ bool next(int i, Unit& u) const {
        const long L = (long)i * G + c; if (L >= nwg) return false;
        int wgid = (int)L; { const int q = nwg / NXCD, r = nwg % NXCD, xcd = wgid % NXCD, off = wgid / NXCD; wgid = (xcd < r ? xcd * (q + 1) : r * (q + 1) + (xcd - r) * q) + off; }
        const int nig = WGM * nN, gid = wgid / nig, fm = gid * WGM, gsz = (nM - fm) < WGM ? (nM - fm) : WGM;
        u.pm = fm + ((wgid % nig) % gsz); u.pn = (wgid % nig) / gsz; return true;
    }
    __device__ __forceinline__ void a_ready(const Unit&) const {}
    __device__ __forceinline__ void done(const Unit&) const {}
};

__device__ __forceinline__ unsigned cvt_pk_bf16(float lo, float hi) { unsigned r; asm volatile("v_cvt_pk_bf16_f32 %0, %1, %2" : "=v"(r) : "v"(lo), "v"(hi)); return r; }

template <class Epi, class Sched, bool ALIGN_EPI = false, bool SP2 = false>
__device__ __forceinline__ void gemm_phase(PG8_LAS unsigned char* lds, const Gemm g, const Sched& S, const Epi& E) {
    int tid_ = threadIdx.x; asm volatile("" : "+v"(tid_));
    const int tid = tid_, wid = __builtin_amdgcn_readfirstlane(tid >> 6), lane = tid & 63, wr = wid >> 2, wc = wid & 3, fr = lane & 15, fq = lane >> 4;
    const int K = g.K, nt = K / BK;
    unsigned voffA[2], voffB[2];
#pragma unroll
    for (int i = 0; i < 2; ++i) { int R, C; stage_rc(tid * 16 + i * 8192, R, C); const int Rb = Epi::PERM ? ((R & ~31) + perm32(R & 31)) : R;
        voffA[i] = (unsigned)(R * g.lda + C) * 2u; voffB[i] = (unsigned)(Rb * g.ldb + C) * 2u; }
    const size_t kstep = (size_t)(BK * 2);
    const size_t hstepA = (size_t)HALF * g.lda * 2, hstepB = (size_t)HALF * g.ldb * 2;
    const size_t tstepA = 2 * hstepA, tstepB = 2 * hstepB;
    const unsigned ldsw = (unsigned)wid * 1024u;
    const int aoff = lds_byte(wr * 64 + fr, fq * 8), boff = lds_byte(wc * 32 + fr, fq * 8);
#define PG8_SA(b, h) (((b) * 2 + (h)) * HTB)
#define PG8_SB(b, h) ((4 + (b) * 2 + (h)) * HTB)
#define PG8_STAGE(bufoff, gbase, voff) do { _Pragma("unroll") for (int _i = 0; _i < 2; ++_i) \
        __builtin_amdgcn_global_load_lds((const unsigned*)((const char*)(gbase) + (voff)[_i]), (PG8_LAS unsigned*)(lds + (bufoff) + ldsw + _i * 8192), 16, 0, 0); } while (0)
#define PG8_LDA(dst, b, h) do { _Pragma("unroll") for (int m = 0; m < 4; ++m) _Pragma("unroll") for (int k = 0; k < 2; ++k) dst[m][k] = *(const PG8_LAS bf16x8*)(lds + PG8_SA(b, h) + aoff + m * 2048 + k * 1024); } while (0)
#define PG8_LDB(dst, b, h) do { _Pragma("unroll") for (int n = 0; n < 2; ++n) _Pragma("unroll") for (int k = 0; k < 2; ++k) dst[n][k] = *(const PG8_LAS bf16x8*)(lds + PG8_SB(b, h) + boff + n * 2048 + k * 1024); } while (0)
#define PG8_MMA(ai, bj, At, Bt) do { __builtin_amdgcn_s_setprio(1); _Pragma("unroll") for (int m = 0; m < 4; ++m) _Pragma("unroll") for (int n = 0; n < 2; ++n) _Pragma("unroll") for (int k = 0; k < 2; ++k) \
        acc[ai][bj][m][n] = __builtin_amdgcn_mfma_f32_16x16x32_bf16(Bt[n][k], At[m][k], acc[ai][bj][m][n], 0, 0, 0); __builtin_amdgcn_s_setprio(0); } while (0)
#define PG8_WAIT_V(n) asm volatile("s_waitcnt vmcnt(" #n ")" ::: "memory")
#define PG8_WAIT_L(n) asm volatile("s_waitcnt lgkmcnt(" #n ")" ::: "memory")
#define PG8_BAR __builtin_amdgcn_s_barrier()
#define PG8_SCHED __builtin_amdgcn_sched_barrier(0)
    Unit cur, nxt; int ui = 0;
    if (!S.next(0, cur)) return;
    f32x4 acc[2][2][4][2];
#pragma unroll
    for (int a = 0; a < 2; ++a)
#pragma unroll
        for (int b = 0; b < 2; ++b)
#pragma unroll
            for (int m = 0; m < 4; ++m)
#pragma unroll
                for (int n = 0; n < 2; ++n) acc[a][b][m][n] = (f32x4){0.f, 0.f, 0.f, 0.f};
    bf16x8 At[4][2], B0[2][2], B1[2][2];
    const char* cA = (const char*)g.A + (size_t)cur.pm * tstepA; const char* cB = (const char*)g.Bt + (size_t)cur.pn * tstepB;
    S.a_ready(cur);
    if constexpr (SP2) {
        PG8_STAGE(PG8_SB(0, 0), cB, voffB); PG8_STAGE(PG8_SB(0, 1), cB + hstepB, voffB); PG8_STAGE(PG8_SA(0, 0), cA, voffA); PG8_STAGE(PG8_SA(0, 1), cA + hstepA, voffA);
        if (wr == 1) PG8_BAR;
        PG8_WAIT_V(2); PG8_BAR;
        PG8_STAGE(PG8_SB(1, 0), cB + kstep, voffB); PG8_STAGE(PG8_SA(1, 0), cA + kstep, voffA); PG8_STAGE(PG8_SB(1, 1), cB + hstepB + kstep, voffB);
        PG8_WAIT_V(6); PG8_BAR;
    } else {
        PG8_STAGE(PG8_SB(0, 0), cB, voffB); PG8_STAGE(PG8_SA(0, 0), cA, voffA); PG8_STAGE(PG8_SB(0, 1), cB + hstepB, voffB); PG8_STAGE(PG8_SA(0, 1), cA + hstepA, voffA);
        if (wr == 1) PG8_BAR;
        PG8_WAIT_V(4); PG8_BAR;
        PG8_STAGE(PG8_SB(1, 0), cB + kstep, voffB); PG8_STAGE(PG8_SA(1, 0), cA + kstep, voffA); PG8_STAGE(PG8_SB(1, 1), cB + hstepB + kstep, voffB);
        PG8_WAIT_V(6); PG8_BAR;
    }
    for (;;) {
        const bool has_next = S.next(ui + 1, nxt);
        const char* nA = has_next ? (const char*)g.A + (size_t)nxt.pm * tstepA : cA; const char* nB = has_next ? (const char*)g.Bt + (size_t)nxt.pn * tstepB : cB;
        for (int t = 0; t < nt; t += 2) {
            const bool last = (t == nt - 2);
            const char* a1 = cA + (size_t)(t + 1) * kstep;
            const char* a2 = last ? nA : cA + (size_t)(t + 2) * kstep; const char* b2 = last ? nB : cB + (size_t)(t + 2) * kstep;
            const char* a3 = a2 + kstep; const char* b3 = b2 + kstep;
            if (last && has_next) S.a_ready(nxt);
            if constexpr (SP2) {
            PG8_LDB(B0, 0, 0); PG8_LDB(B1, 0, 1); PG8_SCHED; PG8_LDA(At, 0, 0); PG8_STAGE(PG8_SA(1, 1), a1 + hstepA, voffA);
            PG8_WAIT_V(8); PG8_WAIT_L(0); PG8_BAR; PG8_MMA(0, 0, At, B0); PG8_MMA(0, 1, At, B1); PG8_BAR; PG8_SCHED;
            PG8_LDA(At, 0, 1); PG8_STAGE(PG8_SB(0, 0), b2, voffB); PG8_STAGE(PG8_SB(0, 1), b2 + hstepB, voffB); PG8_STAGE(PG8_SA(0, 0), a2, voffA);
            PG8_WAIT_V(8); PG8_WAIT_L(0); PG8_BAR; PG8_MMA(1, 0, At, B0); PG8_MMA(1, 1, At, B1); PG8_BAR; PG8_SCHED;
            PG8_LDB(B0, 1, 0); PG8_LDB(B1, 1, 1); PG8_SCHED; PG8_LDA(At, 1, 0); PG8_STAGE(PG8_SA(0, 1), a2 + hstepA, voffA);
            PG8_WAIT_V(8); PG8_WAIT_L(0); PG8_BAR; PG8_MMA(0, 0, At, B0); PG8_MMA(0, 1, At, B1); PG8_BAR; PG8_SCHED;
            PG8_LDA(At, 1, 1); PG8_STAGE(PG8_SB(1, 0), b3, voffB); PG8_STAGE(PG8_SB(1, 1), b3 + hstepB, voffB); PG8_STAGE(PG8_SA(1, 0), a3, voffA);
            PG8_WAIT_V(8); PG8_WAIT_L(0); PG8_BAR; PG8_MMA(1, 0, At, B0); PG8_MMA(1, 1, At, B1); PG8_BAR; PG8_SCHED;
            } else {
            PG8_LDB(B0, 0, 0); PG8_SCHED; PG8_LDA(At, 0, 0); PG8_STAGE(PG8_SA(1, 1), a1 + hstepA, voffA);
            PG8_WAIT_L(8); PG8_BAR; PG8_WAIT_L(0); PG8_MMA(0, 0, At, B0); PG8_BAR; PG8_SCHED;
            PG8_LDB(B1, 0, 1); PG8_STAGE(PG8_SB(0, 0), b2, voffB);
            PG8_BAR; PG8_WAIT_L(0); PG8_MMA(0, 1, At, B1); PG8_BAR;
            PG8_LDA(At, 0, 1); PG8_STAGE(PG8_SA(0, 0), a2, voffA);
            PG8_BAR; PG8_WAIT_L(0); PG8_MMA(1, 0, At, B0); PG8_BAR; PG8_SCHED;
            PG8_STAGE(PG8_SB(0, 1), b2 + hstepB, voffB);
            PG8_WAIT_V(6); PG8_BAR; PG8_MMA(1, 1, At, B1); PG8_BAR;
            PG8_LDB(B0, 1, 0); PG8_SCHED; PG8_LDA(At, 1, 0); PG8_STAGE(PG8_SA(0, 1), a2 + hstepA, voffA);
            PG8_WAIT_L(8); PG8_BAR; PG8_WAIT_L(0); PG8_MMA(0, 0, At, B0); PG8_BAR; PG8_SCHED;
            PG8_LDB(B1, 1, 1); PG8_STAGE(PG8_SB(1, 0), b3, voffB);
            PG8_BAR; PG8_WAIT_L(0); PG8_MMA(0, 1, At, B1); PG8_BAR;
            PG8_LDA(At, 1, 1); PG8_STAGE(PG8_SA(1, 0), a3, voffA);
            PG8_BAR; PG8_WAIT_L(0); PG8_MMA(1, 0, At, B0); PG8_BAR; PG8_SCHED;
            PG8_STAGE(PG8_SB(1, 1), b3 + hstepB, voffB);
            PG8_WAIT_V(6); PG8_BAR; PG8_MMA(1, 1, At, B1); PG8_BAR;
            }
        }
        if constexpr (ALIGN_EPI) { if (wr == 0) PG8_BAR; }
        E(acc, cur, wr, wc, fr, fq); S.done(cur);
        if (!has_next) break;
#pragma unroll
        for (int a = 0; a < 2; ++a)
#pragma unroll
            for (int b = 0; b < 2; ++b)
#pragma unroll
                for (int m = 0; m < 4; ++m)
#pragma unroll
                    for (int n = 0; n < 2; ++n) acc[a][b][m][n] = (f32x4){0.f, 0.f, 0.f, 0.f};
        cur = nxt; cA = nA; cB = nB; ++ui;
        if constexpr (ALIGN_EPI) { if (wr == 1) PG8_BAR; }
    }
    PG8_WAIT_V(0);
    if constexpr (!ALIGN_EPI) { if (wr == 0) PG8_BAR; }
    PG8_BAR;
#undef PG8_SA
#undef PG8_SB
#undef PG8_STAGE
#undef PG8_LDA
#undef PG8_LDB
#undef PG8_MMA
#undef PG8_WAIT_V
#undef PG8_WAIT_L
#undef PG8_BAR
#undef PG8_SCHED
}
}
#define XB_TMO      128
#define XB_XCNT(j)  (256  + 64 * (j))
#define XB_XSUB(j)  (1280 + 64 * (j))
#define XB_XGEN(j)  (2304 + 64 * (j))
#define XB_TOP      3328
#define XB_TOPGEN   3392
#define XCD_BAR_WORDS 3456
#define XB_SPIN_CAP (1u << 18)
#define LAS __attribute__((address_space(3)))

__device__ __forceinline__ unsigned xb_ld(unsigned* p)              { return __hip_atomic_load(p, __ATOMIC_RELAXED, __HIP_MEMORY_SCOPE_AGENT); }
__device__ __forceinline__ unsigned xb_add(unsigned* p, unsigned v) { return __hip_atomic_fetch_add(p, v, __ATOMIC_RELAXED, __HIP_MEMORY_SCOPE_AGENT); }
__device__ __forceinline__ unsigned xb_xcc_id() { return (unsigned)__builtin_amdgcn_s_getreg((3 << 11) | 20) & 0xFu; }
#define XB_SPIN(cond, bar) do { unsigned _sp = 0; while (cond) { __builtin_amdgcn_s_sleep(1); \
    if ((++_sp & 255u) == 0u) { if (xb_ld(&(bar)[XB_TMO])) break; if (_sp > XB_SPIN_CAP) { atomicAdd(&(bar)[XB_TMO], 1u); break; } } } } while (0)

struct XcdBarrier {
    unsigned* bar; unsigned x;
    volatile LAS unsigned* st;
};

__device__ __forceinline__ XcdBarrier xcd_barrier_post(unsigned* bar, volatile LAS unsigned* st) {
    XcdBarrier b; b.bar = bar; b.x = xb_xcc_id(); b.st = st;
    if (threadIdx.x == 0) (void)xb_add(&bar[XB_XCNT(b.x)], 1u);
    return b;
}
__device__ __forceinline__ void xcd_barrier_complete(unsigned* bar, unsigned x, unsigned& nloc, unsigned& nx) {
    const unsigned G = gridDim.x * gridDim.y * gridDim.z;
    unsigned sum, cnt, mine, sp = 0u;
    for (;;) {
        sum = 0u; cnt = 0u; mine = 0u;
#pragma unroll
        for (unsigned j = 0; j < 16; ++j) { const unsigned c = xb_ld(&bar[XB_XCNT(j)]); sum += c; cnt += (c > 0u) ? 1u : 0u; mine = (j == x) ? c : mine; }
        if (sum == G) break;
        __builtin_amdgcn_s_sleep(1);
        if ((++sp & 255u) == 0u) { if (xb_ld(&bar[XB_TMO])) break; if (sp > XB_SPIN_CAP) { atomicAdd(&bar[XB_TMO], 1u); break; } }
    }
    nloc = mine > 0u ? mine : 1u; nx = cnt > 0u ? cnt : 1u;
}

__device__ __forceinline__ void xcd_barrier(const XcdBarrier& b) {
    asm volatile("s_waitcnt vmcnt(0)" ::: "memory");
    __syncthreads();
    if (threadIdx.x == 0) {
        unsigned* bar = b.bar;
        __builtin_amdgcn_s_waitcnt(0);
        unsigned nloc = b.st[0], nx = b.st[1];
        if (nloc == 0u) { xcd_barrier_complete(bar, b.x, nloc, nx); b.st[0] = nloc; b.st[1] = nx; }
        const unsigned old = xb_add(&bar[XB_XSUB(b.x)], 1u);
        const unsigned gen = old / nloc;
        if (old + 1u == (gen + 1u) * nloc) {
            __builtin_amdgcn_fence(__ATOMIC_RELEASE, "agent");
            asm volatile("s_waitcnt vmcnt(0)" ::: "memory");
            const unsigned og = xb_add(&bar[XB_TOP], 1u);
            const unsigned tg = og / nx;
            if (og + 1u == (tg + 1u) * nx) xb_add(&bar[XB_TOPGEN], 1u);
            else XB_SPIN(xb_ld(&bar[XB_TOPGEN]) == tg, bar);
            __builtin_amdgcn_fence(__ATOMIC_ACQUIRE, "agent");
            xb_add(&bar[XB_XGEN(b.x)], 1u);
            asm volatile("s_waitcnt vmcnt(0)" ::: "memory");
        } else {
            XB_SPIN(xb_ld(&bar[XB_XGEN(b.x)]) == gen, bar);
            __builtin_amdgcn_fence(__ATOMIC_ACQUIRE, "agent");
            asm volatile("s_waitcnt vmcnt(0)" ::: "memory");
        }
    }
    __syncthreads();
}

constexpr int D = 2048, NB = 4, SEQ = 4096, DEPTH = 4, CTXL = 256, NMOD = 9, DFF = 5632, NH = 8, DK = 128, DV = 128, WK = 1024;
constexpr int BW = 512, CWD = 512, INW = 13824;
constexpr int M_LAT = NB * SEQ, M_CTX = NB * CTXL, M = M_LAT + M_CTX;
constexpr int MODW = NMOD * D;
constexpr int NGRP = 5;
constexpr float EPS = 1e-6f;
constexpr int Z1W = 4096, Z2W = INW - Z1W;
constexpr int Z2_GA = 0, Z2_U = 1024, Z2_V = 1536, Z2_HC = 2048, Z2_GB = 2560, Z2_GC = 3072, Z2_MA = 3584, Z2_MB = 5632, Z2_MC = 7680;

constexpr size_t MiB = 1u << 20;
constexpr size_t WS_CTL = 0ull * MiB, CTL_ZERO_BYTES = 1 * MiB;
constexpr size_t WS_MOD = 1ull * MiB;
constexpr size_t WS_LB = 3ull * MiB;
constexpr size_t WS_WGU = 4ull * MiB;
constexpr size_t WS_WD = 356ull * MiB;
constexpr size_t WS_WIN = 532ull * MiB;
constexpr size_t WS_WP = 748ull * MiB;
constexpr size_t WS_WO = 780ull * MiB;
constexpr size_t WS_Y = 812ull * MiB;
constexpr size_t WS_H = 948ull * MiB;
constexpr size_t WS_MRG = 1016ull * MiB;
constexpr size_t WS_YABC = 1084ull * MiB;
constexpr size_t WS_MF32 = 1152ull * MiB;
constexpr size_t WS_OF = 1288ull * MiB;
constexpr size_t WS_OB = 1356ull * MiB;
constexpr size_t WS_FF = 1424ull * MiB;
constexpr size_t WS_FB = 1492ull * MiB;
constexpr size_t WS_VN = 1560ull * MiB;
constexpr size_t WS_Z1 = 1577ull * MiB;
constexpr size_t WS_Z2 = 1849ull * MiB;
constexpr size_t WS_ACT = WS_Z1;
constexpr size_t WS_QF = WS_FF, WS_KF = WS_FF + 34ull * MiB, WS_QB = WS_FB, WS_KB = WS_FB + 34ull * MiB;
constexpr size_t WS_VV = 2172ull * MiB;
constexpr size_t WS_GF = 2206ull * MiB;
constexpr size_t WS_GB = 2211ull * MiB;
constexpr size_t WS_END = 2216ull * MiB;
constexpr int CW_BAR = 4096;

constexpr int RING_BYTES = 131072;
constexpr int LDSCTL_OFF = RING_BYTES, MISC_OFF = LDSCTL_OFF + 320;
constexpr int LDS_BYTES = 147456;

#define GAS __attribute__((address_space(1)))
typedef unsigned short bf16;
typedef unsigned v4u __attribute__((ext_vector_type(4)));
typedef unsigned v2u __attribute__((ext_vector_type(2)));
typedef float f32x4 __attribute__((ext_vector_type(4)));
#define LDS_WAIT() asm volatile("s_waitcnt lgkmcnt(0)" ::: "memory")
#define VM_WAIT() asm volatile("s_waitcnt vmcnt(0)" ::: "memory")
__device__ __forceinline__ unsigned f2bf(float f) { unsigned u = __builtin_bit_cast(unsigned, f); return (u + 0x7fffu + ((u >> 16) & 1u)) >> 16; }
__device__ __forceinline__ unsigned pk2(float lo, float hi) { return f2bf(lo) | (f2bf(hi) << 16); }
__device__ __forceinline__ float bflo(unsigned w) { return __builtin_bit_cast(float, w << 16); }
__device__ __forceinline__ float bfhi(unsigned w) { return __builtin_bit_cast(float, w & 0xffff0000u); }
__device__ __forceinline__ float sigmoidf_(float x) { return __builtin_amdgcn_rcpf(1.0f + __expf(-x)); }
__device__ __forceinline__ float siluf_(float x) { return x * sigmoidf_(x); }
__device__ __forceinline__ float gelu_tanh(float x) { const float u = 0.7978845608028654f * (x + 0.044715f * x * x * x); return x * sigmoidf_(2.0f * u); }
template <int CTRL> __device__ __forceinline__ float dppf(float x) { return __builtin_bit_cast(float, __builtin_amdgcn_mov_dpp(__builtin_bit_cast(int, x), CTRL, 0xf, 0xf, true)); }
__device__ __forceinline__ float row16_sum(float x) { x += dppf<0xB1>(x); x += dppf<0x4E>(x); x += dppf<0x124>(x); x += dppf<0x128>(x); return x; }
__device__ __forceinline__ float wave_sum(float v) {
#pragma unroll
    for (int o = 1; o < 64; o <<= 1) v += __shfl_xor(v, o);
    return v;
}
__device__ __forceinline__ int grp_of_row(int m) { return m < M_LAT ? (m >> 12) : 4; }

struct Frame {
    LAS unsigned char* lds;
    int tid, lane, wave, vcu, G;
    unsigned char* ws;
};
struct Args { const float* in[23]; float* out; unsigned char* ws; int ph_lo, ph_hi; };
typedef const __attribute__((address_space(4))) Args* KArgs;
__device__ __forceinline__ KArgs kargs() { auto p = __builtin_amdgcn_kernarg_segment_ptr(); asm volatile("" : "+s"(p)); return (KArgs)p; }
__device__ __forceinline__ Frame mkframe() {
    extern __shared__ __attribute__((aligned(16))) unsigned char lds_dyn[];
    Frame F; F.lds = (LAS unsigned char*)lds_dyn; { int t = threadIdx.x; asm volatile("" : "+v"(t)); F.tid = t; } F.lane = F.tid & 63; F.wave = __builtin_amdgcn_readfirstlane(F.tid >> 6);
    { int gg = gridDim.x; asm volatile("" : "+s"(gg)); F.G = gg; } { int bx = blockIdx.x; asm volatile("" : "+s"(bx)); F.vcu = (F.G % 8 == 0) ? (bx % 8) * (F.G / 8) + bx / 8 : bx; }
    F.ws = kargs()->ws; return F;
}

namespace pg8 {
struct EpiSwiGLU { static constexpr bool PERM = true;
    bf16_t* O;
    __device__ __forceinline__ void operator()(const f32x4 (&acc)[2][2][4][2], const Unit& u, int wr, int wc, int fr, int fq) const {
        const int row0 = u.pm * BM + wr * 64 + fr, col0 = u.pn * HALF + wc * 32 + 8 * fq;
#pragma unroll
        for (int ai = 0; ai < 2; ++ai)
#pragma unroll
            for (int m = 0; m < 4; ++m) { bf16_t* rowp = O + (size_t)(row0 + ai * HALF + m * 16) * DFF + col0;
                f32x4 g0 = acc[ai][0][m][0], g1 = acc[ai][0][m][1], u0 = acc[ai][1][m][0], u1 = acc[ai][1][m][1]; f32x4 v0, v1;
#pragma unroll
                for (int j = 0; j < 4; ++j) { v0[j] = siluf_(g0[j]) * u0[j]; v1[j] = siluf_(g1[j]) * u1[j]; }
                u32x4 w; w.x = cvt_pk_bf16(v0[0], v0[1]); w.y = cvt_pk_bf16(v0[2], v0[3]); w.z = cvt_pk_bf16(v1[0], v1[1]); w.w = cvt_pk_bf16(v1[2], v1[3]);
                *(u32x4*)rowp = w; }
    }
};
struct EpiResid { static constexpr bool PERM = false;
    float* Y; const float* gate; float coef;
    __device__ __forceinline__ void operator()(const f32x4 (&acc)[2][2][4][2], const Unit& u, int wr, int wc, int fr, int fq) const {
        const int row0 = u.pm * BM + wr * 64 + fr, col0 = u.pn * BM + wc * 32 + 4 * fq; const int grp = u.pm < 64 ? (u.pm >> 4) : 4;
        const float* gp = gate + (size_t)grp * MODW + col0; f32x4 gv[2][2];
#pragma unroll
        for (int bj = 0; bj < 2; ++bj)
#pragma unroll
            for (int n = 0; n < 2; ++n) gv[bj][n] = *(const f32x4*)(gp + bj * HALF + n * 16) * coef;
#pragma unroll
        for (int ai = 0; ai < 2; ++ai)
#pragma unroll
            for (int m = 0; m < 4; ++m) { float* rowp = Y + (size_t)(row0 + ai * HALF + m * 16) * D + col0;
#pragma unroll
                for (int bj = 0; bj < 2; ++bj)
#pragma unroll
                    for (int n = 0; n < 2; ++n) { float* p = rowp + bj * HALF + n * 16; const f32x4 o = *(const f32x4*)p; *(f32x4*)p = o + gv[bj][n] * acc[ai][bj][m][n]; }
                asm volatile("" ::: "memory"); }
    }
};
struct EpiInproj { static constexpr bool PERM = true;
    float* Z1; bf16_t* Z2;
    __device__ __forceinline__ void operator()(const f32x4 (&acc)[2][2][4][2], const Unit& u, int wr, int wc, int fr, int fq) const {
        const int row0 = u.pm * BM + wr * 64 + fr;
        if (u.pn < 16) { const int col0 = u.pn * BM + wc * 32 + 8 * fq;
#pragma unroll
            for (int ai = 0; ai < 2; ++ai)
#pragma unroll
                for (int m = 0; m < 4; ++m) { float* rowp = Z1 + (size_t)(row0 + ai * HALF + m * 16) * Z1W + col0;
#pragma unroll
                    for (int bj = 0; bj < 2; ++bj) { *(f32x4*)(rowp + bj * HALF) = acc[ai][bj][m][0]; *(f32x4*)(rowp + bj * HALF + 4) = acc[ai][bj][m][1]; } }
        } else { const int col0 = (u.pn - 16) * BM + wc * 32 + 8 * fq;
#pragma unroll
            for (int ai = 0; ai < 2; ++ai)
#pragma unroll
                for (int m = 0; m < 4; ++m) { bf16_t* rowp = Z2 + (size_t)(row0 + ai * HALF + m * 16) * Z2W + col0;
#pragma unroll
                    for (int bj = 0; bj < 2; ++bj) { const f32x4 v0 = acc[ai][bj][m][0], v1 = acc[ai][bj][m][1];
                        u32x4 w; w.x = cvt_pk_bf16(v0[0], v0[1]); w.y = cvt_pk_bf16(v0[2], v0[3]); w.z = cvt_pk_bf16(v1[0], v1[1]); w.w = cvt_pk_bf16(v1[2], v1[3]);
                        *(u32x4*)(rowp + bj * HALF) = w; } }
        }
    }
};
template <int STAGE> struct EpiProj { static constexpr bool PERM = false;
    float* MF; bf16_t* MRG; const bf16_t* Gm;
    __device__ __forceinline__ void operator()(const f32x4 (&acc)[2][2][4][2], const Unit& u, int wr, int wc, int fr, int fq) const {
        const int row0 = u.pm * BM + wr * 64 + fr, col0 = u.pn * BM + wc * 32 + 4 * fq;
#pragma unroll
        for (int ai = 0; ai < 2; ++ai)
#pragma unroll
            for (int m = 0; m < 4; ++m) { const size_t row = (size_t)(row0 + ai * HALF + m * 16);
#pragma unroll
                for (int bj = 0; bj < 2; ++bj)
#pragma unroll
                    for (int n = 0; n < 2; ++n) { const int col = col0 + bj * HALF + n * 16;
                        const u32x2 gw = *(const u32x2*)(Gm + row * Z2W + col);
                        f32x4 s; s[0] = sigmoidf_(bflo(gw.x)); s[1] = sigmoidf_(bfhi(gw.x)); s[2] = sigmoidf_(bflo(gw.y)); s[3] = sigmoidf_(bfhi(gw.y));
                        f32x4 v = s * acc[ai][bj][m][n]; float* p = MF + row * D + col;
                        if (STAGE >= 1) v = v + *(const f32x4*)p;
                        if (STAGE <= 1) *(f32x4*)p = v;
                        else { u32x2 w; w.x = cvt_pk_bf16(v[0], v[1]); w.y = cvt_pk_bf16(v[2], v[3]); *(u32x2*)(MRG + row * D + col) = w; } }
                asm volatile("" ::: "memory"); }
    }
};
}

__device__ __forceinline__ void transpose_item(const float* W, int ldw, int k0, int n0, bf16* dst, int ldk, int drow0, int dk0, LAS float* scr, int lane) {
#pragma unroll 8
    for (int i = 0; i < 32; ++i) { const int kk = 2 * i + (lane >> 5); scr[kk * 33 + (lane & 31)] = W[(size_t)(k0 + kk) * ldw + n0 + (lane & 31)]; }
    LDS_WAIT(); asm volatile("" ::: "memory");
    const int c = lane & 7;
#pragma unroll
    for (int j = 0; j < 4; ++j) { const int n = (lane >> 3) + 8 * j; const LAS float* s = scr + (8 * c) * 33 + n;
        v4u o; o.x = pk2(s[0 * 33], s[1 * 33]); o.y = pk2(s[2 * 33], s[3 * 33]); o.z = pk2(s[4 * 33], s[5 * 33]); o.w = pk2(s[6 * 33], s[7 * 33]);
        *(GAS v4u*)(dst + (size_t)(drow0 + n) * ldk + dk0 + k0 + 8 * c) = o; }
    LDS_WAIT(); asm volatile("" ::: "memory");
}

enum { IX = 0, IC, ICTX, ICCTX, IWMOD, IBMOD, INORMG, IFINALG, IWGATE, IWUP, IWDOWN, IWIN, ILB, IANORM, ILNG, ILNB, IWS, IBS, ICONV, IWPA, IWPB, IWPC, IWOUT };
#define INP(k) (kargs()->in[(k)])

__device__ __forceinline__ void phase_prologue() {
    const Frame F = mkframe(); unsigned char* ws = F.ws;
    const int gw = F.vcu * 8 + F.wave, NGW = F.G * 8;
    { float* Y = (float*)(ws + WS_Y);
      for (int m = gw; m < M; m += NGW) { const float* src = m < M_LAT ? INP(IX) + (size_t)m * D : INP(ICTX) + (size_t)(m - M_LAT) * D; const GAS f32x4* s = (const GAS f32x4*)src + F.lane; GAS f32x4* d = (GAS f32x4*)(Y + (size_t)m * D) + F.lane;
#pragma unroll
          for (int j = 0; j < 8; ++j) d[64 * j] = s[64 * j]; } }
    if (blockIdx.x == 0) { float* LB = (float*)(ws + WS_LB);
        for (int i = F.tid; i < 2 * WK; i += 512) { float lg[DEPTH], mx = -1e30f;
#pragma unroll
            for (int l = 0; l < DEPTH; ++l) { lg[l] = INP(ILB)[l * 2 * WK + i]; mx = fmaxf(mx, lg[l]); }
            float s = 0.f;
#pragma unroll
            for (int l = 0; l < DEPTH; ++l) { lg[l] = __expf(lg[l] - mx); s += lg[l]; }
            float cum = 0.f; const float inv = 1.0f / s;
#pragma unroll
            for (int l = 0; l < DEPTH; ++l) { LB[l * 2 * WK + i] = cum; if (l + 1 < DEPTH) cum += lg[l + 1] * inv; } } }
    { LAS float* sc = (LAS float*)F.lds;
      LAS float* red = (LAS float*)(F.lds + 5 * D * 4);
      for (int i = F.tid; i < NGRP * D; i += 512) { const int g = i / D, k = i % D; const float v = g < 4 ? INP(IC)[g * D + k] : INP(ICCTX)[k]; sc[i] = siluf_(v); }
      __syncthreads();
      float* MOD = (float*)(ws + WS_MOD);
      constexpr int NU = DEPTH * (MODW / 128);
      for (int u = F.vcu; u < NU; u += F.G) { const int l = u / (MODW / 128), n0 = (u % (MODW / 128)) * 128;
          const float* Wp = INP(IWMOD) + (size_t)l * D * MODW + n0 + 2 * F.lane;
          float a0[NGRP], a1[NGRP];
#pragma unroll
          for (int g = 0; g < NGRP; ++g) { a0[g] = 0.f; a1[g] = 0.f; }
          const int kb = F.wave * 256;
#pragma unroll 4
          for (int k = kb; k < kb + 256; ++k) { const float2 w = *(const float2*)(Wp + (size_t)k * MODW);
#pragma unroll
              for (int g = 0; g < NGRP; ++g) { const float s = sc[g * D + k]; a0[g] += s * w.x; a1[g] += s * w.y; } }
#pragma unroll
          for (int g = 0; g < NGRP; ++g) { red[(F.wave * NGRP + g) * 128 + 2 * F.lane] = a0[g]; red[(F.wave * NGRP + g) * 128 + 2 * F.lane + 1] = a1[g]; }
          __syncthreads();
          for (int i = F.tid; i < NGRP * 128; i += 512) { const int g = i / 128, n = i % 128; float s = 0.f;
#pragma unroll
              for (int w = 0; w < 8; ++w) s += red[(w * NGRP + g) * 128 + n];
              MOD[((size_t)l * NGRP + g) * MODW + n0 + n] = s + INP(IBMOD)[l * MODW + n0 + n]; }
          __syncthreads(); }
    }
    __syncthreads();
    { LAS float* scr = (LAS float*)(F.lds + F.wave * 16384);
      constexpr int I_FF = (D / 64) * (DFF / 32);
      constexpr int I_IN = (D / 64) * (INW / 32);
      constexpr int I_PA = (1024 / 64) * (D / 32), I_PB = (512 / 64) * (D / 32);
      constexpr int I_WO = (D / 64) * (D / 32);
      constexpr int PER_L = 6 * I_FF + I_IN + I_PA + 2 * I_PB + I_WO;
      constexpr int NITEMS = DEPTH * PER_L;
      bf16* WGU = (bf16*)(ws + WS_WGU); bf16* WD = (bf16*)(ws + WS_WD); bf16* WIN = (bf16*)(ws + WS_WIN); bf16* WP = (bf16*)(ws + WS_WP); bf16* WO = (bf16*)(ws + WS_WO);
      for (int it = gw; it < NITEMS; it += NGW) {
          const int l = it / PER_L; int r = it % PER_L;
          if (r < 6 * I_FF) { const int j = r / (3 * I_FF); r %= 3 * I_FF; const int which = r / I_FF; r %= I_FF; const size_t lj = (size_t)(l * 2 + j);
              if (which < 2) { const int nblk = DFF / 32, kb = r / nblk, nb = r % nblk, n0 = 32 * nb;
                  const float* W = (which == 0 ? INP(IWGATE) : INP(IWUP)) + lj * D * DFF;
                  transpose_item(W, DFF, 64 * kb, n0, WGU + lj * (size_t)(2 * DFF) * D, D, 256 * (n0 >> 7) + (n0 & 127) + 128 * which, 0, scr, F.lane);
              } else { const int nblk = D / 32, kb = r / nblk, nb = r % nblk;
                  transpose_item(INP(IWDOWN) + lj * DFF * D, D, 64 * kb, 32 * nb, WD + lj * (size_t)D * DFF, DFF, 32 * nb, 0, scr, F.lane); }
              continue; }
          r -= 6 * I_FF;
          if (r < I_IN) { const int nblk = INW / 32, kb = r / nblk, nb = r % nblk; transpose_item(INP(IWIN) + (size_t)l * D * INW, INW, 64 * kb, 32 * nb, WIN + (size_t)l * INW * D, D, 32 * nb, 0, scr, F.lane); continue; }
          r -= I_IN;
          if (r < I_PA) { const int nblk = D / 32, kb = r / nblk, nb = r % nblk; transpose_item(INP(IWPA) + (size_t)l * 1024 * D, D, 64 * kb, 32 * nb, WP + (size_t)l * D * 2048, 2048, 32 * nb, 0, scr, F.lane); continue; }
          r -= I_PA;
          if (r < I_PB) { const int nblk = D / 32, kb = r / nblk, nb = r % nblk; transpose_item(INP(IWPB) + (size_t)l * 512 * D, D, 64 * kb, 32 * nb, WP + (size_t)l * D * 2048, 2048, 32 * nb, 1024, scr, F.lane); continue; }
          r -= I_PB;
          if (r < I_PB) { const int nblk = D / 32, kb = r / nblk, nb = r % nblk; transpose_item(INP(IWPC) + (size_t)l * 512 * D, D, 64 * kb, 32 * nb, WP + (size_t)l * D * 2048, 2048, 32 * nb, 1536, scr, F.lane); continue; }
          r -= I_PB;
          { const int nblk = D / 32, kb = r / nblk, nb = r % nblk; transpose_item(INP(IWOUT) + (size_t)l * D * D, D, 64 * kb, 32 * nb, WO + (size_t)l * D * D, D, 32 * nb, 0, scr, F.lane); }
      }
    }
}

__device__ __forceinline__ void phase_norm(int l, int which) {
    const Frame F = mkframe(); const float* Y = (const float*)(F.ws + WS_Y); bf16* H = (bf16*)(F.ws + WS_H);
    const float* g = INP(INORMG) + (size_t)(l * 3 + which) * D; const float* mod_l = (const float*)(F.ws + WS_MOD) + (size_t)l * NGRP * MODW; const int shift_idx = 3 * which;
    const int gw = F.vcu * 8 + F.wave, NGW = F.G * 8;
    for (int m = gw; m < M; m += NGW) {
        const GAS f32x4* xr = (const GAS f32x4*)(Y + (size_t)m * D) + F.lane; f32x4 v[8]; float ss = 0.f;
#pragma unroll
        for (int j = 0; j < 8; ++j) { v[j] = xr[64 * j]; ss += (v[j].x * v[j].x + v[j].y * v[j].y) + (v[j].z * v[j].z + v[j].w * v[j].w); }
        const float rstd = 1.0f / sqrtf(wave_sum(ss) * (1.0f / D) + EPS);
        const float* mp = mod_l + (size_t)grp_of_row(m) * MODW + shift_idx * D;
        GAS unsigned long long* o8 = (GAS unsigned long long*)(H + (size_t)m * D) + F.lane;
#pragma unroll
        for (int j = 0; j < 8; ++j) { const f32x4 gg = ((const GAS f32x4*)g)[64 * j + F.lane], sh = ((const GAS f32x4*)mp)[64 * j + F.lane], sc = ((const GAS f32x4*)(mp + D))[64 * j + F.lane];
            const f32x4 h = v[j] * rstd * gg * (1.0f + sc) + sh;
            o8[64 * j] = (unsigned long long)pk2(h.x, h.y) | ((unsigned long long)pk2(h.z, h.w) << 32); }
    }
}

__device__ __forceinline__ void phase_final() {
    const Frame F = mkframe(); const float* Y = (const float*)(F.ws + WS_Y); float* out = kargs()->out; const float* g = INP(IFINALG);
    const int gw = F.vcu * 8 + F.wave, NGW = F.G * 8;
    for (int m = gw; m < M_LAT; m += NGW) {
        const GAS f32x4* xr = (const GAS f32x4*)(Y + (size_t)m * D) + F.lane; f32x4 v[8]; float ss = 0.f;
#pragma unroll
        for (int j = 0; j < 8; ++j) { v[j] = xr[64 * j]; ss += (v[j].x * v[j].x + v[j].y * v[j].y) + (v[j].z * v[j].z + v[j].w * v[j].w); }
        const float rstd = 1.0f / sqrtf(wave_sum(ss) * (1.0f / D) + EPS);
        GAS f32x4* o = (GAS f32x4*)(out + (size_t)m * D) + F.lane;
#pragma unroll
        for (int j = 0; j < 8; ++j) o[64 * j] = v[j] * rstd * ((const GAS f32x4*)g)[64 * j + F.lane];
    }
}

__device__ __forceinline__ void phase_mix_elem(int l) {
    const Frame F = mkframe(); unsigned char* ws = F.ws;
    const float* Z1 = (const float*)(ws + WS_Z1); const bf16* Z2 = (const bf16*)(ws + WS_Z2);
    float* FFp = (float*)(ws + WS_FF); float* FBp = (float*)(ws + WS_FB); bf16* VN = (bf16*)(ws + WS_VN); bf16* YABC = (bf16*)(ws + WS_YABC);
    const float* LB = (const float*)(ws + WS_LB) + (size_t)l * 2 * WK;
    const int gw = F.vcu * 8 + F.wave, NGW = F.G * 8, lane = F.lane;
    for (int m = gw; m < M; m += NGW) {
#ifdef HG_V1
#pragma unroll
        for (int dir = 0; dir < 2; ++dir) { const GAS f32x4* zp = (const GAS f32x4*)(Z1 + (size_t)m * Z1W + 2048 + dir * WK) + lane; const GAS f32x4* lp = (const GAS f32x4*)(LB + dir * WK) + lane;
            GAS f32x4* op = (GAS f32x4*)((dir ? FBp : FFp) + (size_t)m * WK) + lane;
#pragma unroll
            for (int j = 0; j < 4; ++j) { const f32x4 z = zp[64 * j], lb = lp[64 * j]; f32x4 f;
#pragma unroll
                for (int e = 0; e < 4; ++e) f[e] = lb[e] + (1.0f - lb[e]) * sigmoidf_(z[e]);
                op[64 * j] = f; } }
#endif
        { const v4u raw = *(const GAS v4u*)(Z2 + (size_t)m * Z2W + Z2_V + 8 * lane); float x[8];
          x[0] = gelu_tanh(bflo(raw.x)); x[1] = gelu_tanh(bfhi(raw.x)); x[2] = gelu_tanh(bflo(raw.y)); x[3] = gelu_tanh(bfhi(raw.y));
          x[4] = gelu_tanh(bflo(raw.z)); x[5] = gelu_tanh(bfhi(raw.z)); x[6] = gelu_tanh(bflo(raw.w)); x[7] = gelu_tanh(bfhi(raw.w));
          float s = 0.f;
#pragma unroll
          for (int e = 0; e < 8; ++e) s += x[e];
          const float mean = wave_sum(s) * (1.0f / BW); float q = 0.f;
#pragma unroll
          for (int e = 0; e < 8; ++e) { x[e] -= mean; q += x[e] * x[e]; }
          const float rstd = 1.0f / sqrtf(wave_sum(q) * (1.0f / BW) + EPS);
          const float* gp = INP(ILNG) + l * BW + 8 * lane; const float* bp = INP(ILNB) + l * BW + 8 * lane; float y[8];
#pragma unroll
          for (int e = 0; e < 8; ++e) y[e] = x[e] * rstd * gp[e] + bp[e];
          v4u o; o.x = pk2(y[0], y[1]); o.y = pk2(y[2], y[3]); o.z = pk2(y[4], y[5]); o.w = pk2(y[6], y[7]);
          *(GAS v4u*)(VN + (size_t)m * BW + 8 * lane) = o; }
        { bool hp, hn; if (m < M_LAT) { const int p = m & 63; hp = p != 0; hn = p != 63; } else { const int p = (m - M_LAT) & 255; hp = p != 0; hn = p != 255; }
          float t[3][8];
#pragma unroll
          for (int d = 0; d < 3; ++d) { const bool ok = d == 1 || (d == 0 ? hp : hn); const size_t mm = (size_t)(ok ? m + d - 1 : m);
              const v4u hc = *(const GAS v4u*)(Z2 + mm * Z2W + Z2_HC + 8 * lane), gc = *(const GAS v4u*)(Z2 + mm * Z2W + Z2_GC + 8 * lane); const float z = ok ? 1.0f : 0.0f;
              t[d][0] = z * bflo(hc.x) * bflo(gc.x); t[d][1] = z * bfhi(hc.x) * bfhi(gc.x); t[d][2] = z * bflo(hc.y) * bflo(gc.y); t[d][3] = z * bfhi(hc.y) * bfhi(gc.y);
              t[d][4] = z * bflo(hc.z) * bflo(gc.z); t[d][5] = z * bfhi(hc.z) * bfhi(gc.z); t[d][6] = z * bflo(hc.w) * bflo(gc.w); t[d][7] = z * bfhi(hc.w) * bfhi(gc.w); }
          const v4u gbr = *(const GAS v4u*)(Z2 + (size_t)m * Z2W + Z2_GB + 8 * lane); float gb[8];
          gb[0] = bflo(gbr.x); gb[1] = bfhi(gbr.x); gb[2] = bflo(gbr.y); gb[3] = bfhi(gbr.y); gb[4] = bflo(gbr.z); gb[5] = bfhi(gbr.z); gb[6] = bflo(gbr.w); gb[7] = bfhi(gbr.w);
          const float* cw = INP(ICONV) + (size_t)l * 3 * CWD + 8 * lane; float y[8];
#pragma unroll
          for (int e = 0; e < 8; ++e) y[e] = gb[e] * (cw[e] * t[0][e] + cw[CWD + e] * t[1][e] + cw[2 * CWD + e] * t[2][e]);
          v4u o; o.x = pk2(y[0], y[1]); o.y = pk2(y[2], y[3]); o.z = pk2(y[4], y[5]); o.w = pk2(y[6], y[7]);
          *(GAS v4u*)(YABC + (size_t)m * 2048 + 1536 + 8 * lane) = o; }
    }
}


template <int N> __device__ __forceinline__ float row_shr(float v) { return __builtin_bit_cast(float, __builtin_amdgcn_update_dpp(0, __builtin_bit_cast(int, v), 0x110 + N, 0xf, 0xf, true)); }
__device__ __forceinline__ void phase_hgrn_prep(int l) {
    const Frame F = mkframe(); unsigned char* ws = F.ws;
    const float* Z1 = (const float*)(ws + WS_Z1); const float* LB = (const float*)(ws + WS_LB) + (size_t)l * 2 * WK;
    bf16* VV = (bf16*)(ws + WS_VV);
    const int gw = F.vcu * 8 + F.wave, NGW = F.G * 8, lane = F.lane, fr = lane & 15, cq = lane >> 4;
    for (int t = gw; t < (M / 16) * 4; t += NGW) { const int sc = t >> 2, jq = t & 3; const size_t row = (size_t)sc * 16 + fr;
#pragma unroll 1
        for (int jj = 8 * jq; jj < 8 * jq + 8; ++jj) { const int c0 = 32 * jj + 8 * cq;
            const f32x4 q0 = *(const GAS f32x4*)(Z1 + row * Z1W + c0), q1 = *(const GAS f32x4*)(Z1 + row * Z1W + c0 + 4);
            { const f32x4 i0 = *(const GAS f32x4*)(Z1 + row * Z1W + 1024 + c0), i1 = *(const GAS f32x4*)(Z1 + row * Z1W + 1024 + c0 + 4);
              v4u o; o.x = pk2(i0[0], i0[1]); o.y = pk2(i0[2], i0[3]); o.z = pk2(i1[0], i1[1]); o.w = pk2(i1[2], i1[3]); *(GAS v4u*)(VV + row * WK + c0) = o; }
#pragma unroll
            for (int dir = 0; dir < 2; ++dir) {
                const f32x4 z0 = *(const GAS f32x4*)(Z1 + row * Z1W + 2048 + dir * WK + c0), z1 = *(const GAS f32x4*)(Z1 + row * Z1W + 2048 + dir * WK + c0 + 4);
                const f32x4 b0 = *(const GAS f32x4*)(LB + dir * WK + c0), b1 = *(const GAS f32x4*)(LB + dir * WK + c0 + 4);
                float qt[8], kt[8], gt[8];
#pragma unroll
                for (int e = 0; e < 8; ++e) { const float z = e < 4 ? z0[e] : z1[e - 4], lb = e < 4 ? b0[e] : b1[e - 4], q = e < 4 ? q0[e] : q1[e - 4];
                    const float f = lb + (1.0f - lb) * sigmoidf_(z); const float lf = fmaxf(__logf(f), -80.0f);
                    float p = lf; p += row_shr<1>(p); p += row_shr<2>(p); p += row_shr<4>(p); p += row_shr<8>(p);
                    const float tot = row16_sum(lf);
                    const float ex = dir == 0 ? tot - p : p - lf;
                    kt[e] = (1.0f - f) * __expf(ex); qt[e] = q * 0.08838834764831845f * __expf(fminf(-ex, 80.0f)); gt[e] = __expf(tot); }
                bf16* Qd = (bf16*)(ws + (dir ? WS_QB : WS_QF)); bf16* Kd = (bf16*)(ws + (dir ? WS_KB : WS_KF)); float* Gd = (float*)(ws + (dir ? WS_GB : WS_GF));
                v4u o; o.x = pk2(qt[0], qt[1]); o.y = pk2(qt[2], qt[3]); o.z = pk2(qt[4], qt[5]); o.w = pk2(qt[6], qt[7]); *(GAS v4u*)(Qd + row * WK + c0) = o;
                o.x = pk2(kt[0], kt[1]); o.y = pk2(kt[2], kt[3]); o.z = pk2(kt[4], kt[5]); o.w = pk2(kt[6], kt[7]); *(GAS v4u*)(Kd + row * WK + c0) = o;
                if (fr == 0) { *(GAS f32x4*)(Gd + (size_t)sc * WK + c0) = (f32x4){gt[0], gt[1], gt[2], gt[3]}; *(GAS f32x4*)(Gd + (size_t)sc * WK + c0 + 4) = (f32x4){gt[4], gt[5], gt[6], gt[7]}; }
            } }
    }
}

typedef short s16x4 __attribute__((ext_vector_type(4)));
typedef short hb16x8 __attribute__((ext_vector_type(8)));
struct HgIn { v2u q[8], k[8], v; float g0, g1; };
constexpr int HG_KP = 264, HG_KIMG = 0, HG_VIMG = 16 * HG_KP, HG_GIMG = HG_VIMG + 512, HG_WAVE_LDS = 6144;
__device__ __forceinline__ int hg_row0(int s, int cstep, int cbase, int lbase2) { return cstep * s + (s < 16 ? cbase : lbase2); }
__device__ __forceinline__ void hg_load(HgIn& X, int r0, const bf16* Qp, const bf16* Kp, const bf16* Vp, const float* Gp, int lane) {
    const int idx = lane & 15, rq = lane >> 4;
    const bf16* qr = Qp + (size_t)(r0 + idx) * WK + 4 * rq; const bf16* kr = Kp + (size_t)(r0 + idx) * WK + 4 * rq;
#pragma unroll
    for (int j = 0; j < 8; ++j) { X.q[j] = *(const GAS v2u*)(qr + 16 * j); X.k[j] = *(const GAS v2u*)(kr + 16 * j); }
    X.v = *(const GAS v2u*)(Vp + (size_t)(r0 + (lane >> 2)) * WK + 4 * (lane & 3));
    const float* gr = Gp + (size_t)(r0 >> 4) * WK; X.g0 = gr[lane]; X.g1 = gr[64 + lane];
}
__device__ __forceinline__ void hg_step(const HgIn& X, int r0, f32x4 (&S)[8], LAS unsigned char* wl, float* Op, int lane, int dir) {
    const int idx = lane & 15, rq = lane >> 4;
#pragma unroll
    for (int j = 0; j < 8; ++j) *(LAS v2u*)(wl + HG_KIMG + idx * HG_KP + (16 * j + 4 * rq) * 2) = X.k[j];
    *(LAS v2u*)(wl + HG_VIMG + 8 * lane) = X.v;
    *(LAS float*)(wl + HG_GIMG + 4 * lane) = X.g0; *(LAS float*)(wl + HG_GIMG + 256 + 4 * lane) = X.g1;
    f32x4 P = (f32x4){0.f, 0.f, 0.f, 0.f};
#pragma unroll
    for (int ks = 0; ks < 4; ++ks) { v4u a, b; a.x = X.k[2 * ks].x; a.y = X.k[2 * ks].y; a.z = X.k[2 * ks + 1].x; a.w = X.k[2 * ks + 1].y; b.x = X.q[2 * ks].x; b.y = X.q[2 * ks].y; b.z = X.q[2 * ks + 1].x; b.w = X.q[2 * ks + 1].y;
        P = __builtin_amdgcn_mfma_f32_16x16x32_bf16(__builtin_bit_cast(hb16x8, a), __builtin_bit_cast(hb16x8, b), P, 0, 0, 0); }
#pragma unroll
    for (int kb = 0; kb < 8; ++kb) { const f32x4 gv = *(const LAS f32x4*)(wl + HG_GIMG + (16 * kb + 4 * rq) * 4); S[kb] = S[kb] * gv; }
    f32x4 o = (f32x4){0.f, 0.f, 0.f, 0.f};
#pragma unroll
    for (int ks = 0; ks < 4; ++ks) { v4u a, b; a.x = pg8::cvt_pk_bf16(S[2 * ks][0], S[2 * ks][1]); a.y = pg8::cvt_pk_bf16(S[2 * ks][2], S[2 * ks][3]); a.z = pg8::cvt_pk_bf16(S[2 * ks + 1][0], S[2 * ks + 1][1]); a.w = pg8::cvt_pk_bf16(S[2 * ks + 1][2], S[2 * ks + 1][3]);
        b.x = X.q[2 * ks].x; b.y = X.q[2 * ks].y; b.z = X.q[2 * ks + 1].x; b.w = X.q[2 * ks + 1].y;
        o = __builtin_amdgcn_mfma_f32_16x16x32_bf16(__builtin_bit_cast(hb16x8, a), __builtin_bit_cast(hb16x8, b), o, 0, 0, 0); }
    s16x4 vt, kt[8];
    { const unsigned q_ = (unsigned)(idx >> 2), p_ = (unsigned)(idx & 3);
      const unsigned va = (unsigned)(size_t)(wl + HG_VIMG) + (4u * rq + q_) * 32u + 8u * p_, ka = (unsigned)(size_t)(wl + HG_KIMG) + (4u * rq + q_) * HG_KP + 8u * p_;
      asm volatile("s_waitcnt lgkmcnt(0)\n\t"
                   "ds_read_b64_tr_b16 %0, %9\n\t"
                   "ds_read_b64_tr_b16 %1, %10\n\t"
                   "ds_read_b64_tr_b16 %2, %10 offset:32\n\t"
                   "ds_read_b64_tr_b16 %3, %10 offset:64\n\t"
                   "ds_read_b64_tr_b16 %4, %10 offset:96\n\t"
                   "ds_read_b64_tr_b16 %5, %10 offset:128\n\t"
                   "ds_read_b64_tr_b16 %6, %10 offset:160\n\t"
                   "ds_read_b64_tr_b16 %7, %10 offset:192\n\t"
                   "ds_read_b64_tr_b16 %8, %10 offset:224\n\t"
                   "s_waitcnt lgkmcnt(0)"
                   : "=&v"(vt), "=&v"(kt[0]), "=&v"(kt[1]), "=&v"(kt[2]), "=&v"(kt[3]), "=&v"(kt[4]), "=&v"(kt[5]), "=&v"(kt[6]), "=&v"(kt[7])
                   : "v"(va), "v"(ka) : "memory"); }
    const hb16x8 vfrag = __builtin_shufflevector(vt, (s16x4){0, 0, 0, 0}, 0, 1, 2, 3, 4, 5, 6, 7);
    { v4u pb; float pm[4];
#pragma unroll
      for (int i = 0; i < 4; ++i) { const int s_ = 4 * rq + i; const bool keep = dir ? (s_ >= idx) : (s_ <= idx); pm[i] = keep ? P[i] : 0.f; }
      pb.x = pg8::cvt_pk_bf16(pm[0], pm[1]); pb.y = pg8::cvt_pk_bf16(pm[2], pm[3]); pb.z = 0u; pb.w = 0u;
      o = __builtin_amdgcn_mfma_f32_16x16x32_bf16(vfrag, __builtin_bit_cast(hb16x8, pb), o, 0, 0, 0); }
#pragma unroll
    for (int kb = 0; kb < 8; ++kb) { const hb16x8 kfrag = __builtin_shufflevector(kt[kb], (s16x4){0, 0, 0, 0}, 0, 1, 2, 3, 4, 5, 6, 7);
        S[kb] = __builtin_amdgcn_mfma_f32_16x16x32_bf16(kfrag, vfrag, S[kb], 0, 0, 0); }
    *(GAS f32x4*)(Op + (size_t)(r0 + idx) * WK + 4 * rq) = o;
}
__device__ __forceinline__ void phase_hgrn() {
    const Frame F = mkframe(); unsigned char* ws = F.ws;
    if (F.wave >= 2) return;
    constexpr int NSTEP = (CTXL + SEQ) / 16;
    for (int task = 2 * F.vcu + F.wave; task < 512; task += 2 * F.G) {
        const int chain = task >> 3, w = task & 7, b = chain >> 4, h = (chain >> 1) & 7, dir = chain & 1, lane = F.lane;
        const bf16* Qp = (const bf16*)(ws + (dir ? WS_QB : WS_QF)) + h * DK; const bf16* Kp = (const bf16*)(ws + (dir ? WS_KB : WS_KF)) + h * DK;
        const bf16* Vp = (const bf16*)(ws + WS_VV) + h * DV + 16 * w; const float* Gp = (const float*)(ws + (dir ? WS_GB : WS_GF)) + h * DK;
        float* Op = (float*)(ws + (dir ? WS_OB : WS_OF)) + h * DV + 16 * w;
        LAS unsigned char* wl = F.lds + F.wave * HG_WAVE_LDS;
        const int cstep = dir ? -16 : 16, cbase = M_LAT + b * CTXL + (dir ? CTXL - 16 : 0), lbase2 = b * SEQ + (dir ? SEQ - 16 : 0) - 16 * cstep;
        f32x4 S[8];
#pragma unroll
        for (int kb = 0; kb < 8; ++kb) S[kb] = (f32x4){0.f, 0.f, 0.f, 0.f};
        HgIn X0, X1, X2;
        hg_load(X0, hg_row0(0, cstep, cbase, lbase2), Qp, Kp, Vp, Gp, lane); hg_load(X1, hg_row0(1, cstep, cbase, lbase2), Qp, Kp, Vp, Gp, lane);
        static_assert(NSTEP % 3 == 2, "tail below assumes two leftover steps");
#pragma unroll 1
        for (int s = 0; s < NSTEP - 2; s += 3) {
            hg_load(X2, hg_row0(s + 2, cstep, cbase, lbase2), Qp, Kp, Vp, Gp, lane);
            hg_step(X0, hg_row0(s, cstep, cbase, lbase2), S, wl, Op, lane, dir);
            hg_load(X0, hg_row0(s + 3, cstep, cbase, lbase2), Qp, Kp, Vp, Gp, lane);
            hg_step(X1, hg_row0(s + 1, cstep, cbase, lbase2), S, wl, Op, lane, dir);
            hg_load(X1, hg_row0(s + 4, cstep, cbase, lbase2), Qp, Kp, Vp, Gp, lane);
            hg_step(X2, hg_row0(s + 2, cstep, cbase, lbase2), S, wl, Op, lane, dir);
        }
        hg_step(X0, hg_row0(NSTEP - 2, cstep, cbase, lbase2), S, wl, Op, lane, dir);
        hg_step(X1, hg_row0(NSTEP - 1, cstep, cbase, lbase2), S, wl, Op, lane, dir);
    }
}

__device__ __forceinline__ int scan_row(int step, int b, int dir) { return step < CTXL ? (M_LAT + b * CTXL + (dir ? CTXL - 1 - step : step)) : (b * SEQ + (dir ? SEQ - 1 - (step - CTXL) : (step - CTXL))); }
__device__ __forceinline__ void phase_scan_v1() {
    const Frame F = mkframe(); unsigned char* ws = F.ws;
    const float* Z1 = (const float*)(ws + WS_Z1);
    const int lane = F.lane, v = 4 * F.wave + (lane >> 4), kg = lane & 15;
    constexpr int TOT = CTXL + SEQ;
    for (int u = blockIdx.x; u < 256; u += F.G) {
        const int b = u >> 6, h = (u >> 3) & 7, dir = (u >> 2) & 1, vs = u & 3;
        const float* Fp = (const float*)(ws + (dir ? WS_FB : WS_FF)) + h * DK + 8 * kg;
        const float* Qp = Z1 + h * DK + 8 * kg;
        const float* Vp = Z1 + 1024 + h * DV + vs * 32 + v;
        float* Op = (float*)(ws + (dir ? WS_OB : WS_OF)) + h * DV + vs * 32 + v;
        float S[8];
#pragma unroll
        for (int j = 0; j < 8; ++j) S[j] = 0.f;
#define rowof(step) scan_row((step), b, dir)
        f32x4 fa[4][2], qa[4][2]; float va[4];
#pragma unroll
        for (int i = 0; i < 4; ++i) { const size_t r = (size_t)rowof(i); fa[i][0] = *(const f32x4*)(Fp + r * WK); fa[i][1] = *(const f32x4*)(Fp + r * WK + 4); qa[i][0] = *(const f32x4*)(Qp + r * Z1W); qa[i][1] = *(const f32x4*)(Qp + r * Z1W + 4); va[i] = Vp[r * Z1W]; }
        for (int s0 = 0; s0 < TOT; s0 += 4) {
            f32x4 fn[4][2], qn[4][2]; float vn[4];
            const int sn = (s0 + 4 < TOT) ? s0 + 4 : s0;
#pragma unroll
            for (int i = 0; i < 4; ++i) { const size_t r = (size_t)rowof(sn + i); fn[i][0] = *(const f32x4*)(Fp + r * WK); fn[i][1] = *(const f32x4*)(Fp + r * WK + 4); qn[i][0] = *(const f32x4*)(Qp + r * Z1W); qn[i][1] = *(const f32x4*)(Qp + r * Z1W + 4); vn[i] = Vp[r * Z1W]; }
            float po[4];
#pragma unroll
            for (int i = 0; i < 4; ++i) { float p = 0.f;
#pragma unroll
                for (int j = 0; j < 8; ++j) { const float f = fa[i][j >> 2][j & 3]; S[j] = f * S[j] + (1.0f - f) * va[i]; p += qa[i][j >> 2][j & 3] * S[j]; }
                po[i] = p; }
#pragma unroll
            for (int i = 0; i < 4; ++i) po[i] = row16_sum(po[i]);
            if (kg == 0) {
#pragma unroll
                for (int i = 0; i < 4; ++i) Op[(size_t)rowof(s0 + i) * WK] = po[i] * 0.08838834764831845f; }
#pragma unroll
            for (int i = 0; i < 4; ++i) { fa[i][0] = fn[i][0]; fa[i][1] = fn[i][1]; qa[i][0] = qn[i][0]; qa[i][1] = qn[i][1]; va[i] = vn[i]; }
        }
    }
#undef rowof
}

__device__ __forceinline__ void phase_gmlp_v1(int l) {
    const Frame F = mkframe(); unsigned char* ws = F.ws;
    const bf16* Z2 = (const bf16*)(ws + WS_Z2); const bf16* VN = (const bf16*)(ws + WS_VN); bf16* YABC = (bf16*)(ws + WS_YABC);
    LAS float* Wt = (LAS float*)F.lds;
    LAS float* Vt = (LAS float*)(F.lds + 65536);
    constexpr int NU = (M / 128) * 4;
    const int tt = F.tid >> 4, cc = F.tid & 15, t0 = 4 * tt, ch0 = 8 * cc;
    for (int u = F.vcu; u < NU; u += F.G) { const int chunk = u >> 2, g = u & 3; const size_t r0 = (size_t)chunk * 128;
        __syncthreads();
        const float* wsrc = INP(IWS) + ((size_t)l * 4 + g) * 128 * 128;
        for (int i = F.tid; i < 128 * 128; i += 512) { const int t = i >> 7, s = i & 127; Wt[s * 128 + t] = wsrc[i]; }
        for (int i = F.tid; i < 128 * 16; i += 512) { const int s = i >> 4, c8 = i & 15; const v4u raw = *(const GAS v4u*)(VN + (r0 + s) * BW + g * 128 + 8 * c8); LAS float* d = Vt + s * 128 + 8 * c8;
            d[0] = bflo(raw.x); d[1] = bfhi(raw.x); d[2] = bflo(raw.y); d[3] = bfhi(raw.y); d[4] = bflo(raw.z); d[5] = bfhi(raw.z); d[6] = bflo(raw.w); d[7] = bfhi(raw.w); }
        __syncthreads();
        float acc[4][8];
#pragma unroll
        for (int i = 0; i < 4; ++i)
#pragma unroll
            for (int e = 0; e < 8; ++e) acc[i][e] = 0.f;
#pragma unroll 4
        for (int s = 0; s < 128; ++s) { const f32x4 a = *(const LAS f32x4*)(Wt + s * 128 + t0); const f32x4 b0 = *(const LAS f32x4*)(Vt + s * 128 + ch0), b1 = *(const LAS f32x4*)(Vt + s * 128 + ch0 + 4);
#pragma unroll
            for (int i = 0; i < 4; ++i) {
#pragma unroll
                for (int e = 0; e < 4; ++e) { acc[i][e] += a[i] * b0[e]; acc[i][4 + e] += a[i] * b1[e]; } } }
#pragma unroll
        for (int i = 0; i < 4; ++i) { const int t = t0 + i; const float bs = INP(IBS)[((size_t)l * 4 + g) * 128 + t];
            const v4u ur = *(const GAS v4u*)(Z2 + (r0 + t) * Z2W + Z2_U + g * 128 + ch0); float uu[8];
            uu[0] = bflo(ur.x); uu[1] = bfhi(ur.x); uu[2] = bflo(ur.y); uu[3] = bfhi(ur.y); uu[4] = bflo(ur.z); uu[5] = bfhi(ur.z); uu[6] = bflo(ur.w); uu[7] = bfhi(ur.w);
            float y[8];
#pragma unroll
            for (int e = 0; e < 8; ++e) y[e] = gelu_tanh(uu[e]) * (acc[i][e] + bs);
            v4u o; o.x = pk2(y[0], y[1]); o.y = pk2(y[2], y[3]); o.z = pk2(y[4], y[5]); o.w = pk2(y[6], y[7]);
            *(GAS v4u*)(YABC + (r0 + t) * 2048 + 1024 + g * 128 + ch0) = o; }
    }
    __syncthreads();
}

__device__ __forceinline__ void phase_readout(int l) {
    const Frame F = mkframe(); unsigned char* ws = F.ws;
    const float* OFp = (const float*)(ws + WS_OF); const float* OBp = (const float*)(ws + WS_OB); const bf16* Z2 = (const bf16*)(ws + WS_Z2); bf16* YABC = (bf16*)(ws + WS_YABC);
    const int gw = F.vcu * 8 + F.wave, NGW = F.G * 8, lane = F.lane;
    const float* ag = INP(IANORM) + l * DV + (16 * lane & 127);
    for (int m = gw; m < M; m += NGW) {
        float o[16]; float ss = 0.f;
#pragma unroll
        for (int j = 0; j < 4; ++j) { const f32x4 a = *(const GAS f32x4*)(OFp + (size_t)m * WK + 16 * lane + 4 * j), b = *(const GAS f32x4*)(OBp + (size_t)m * WK + 16 * lane + 4 * j);
#pragma unroll
            for (int e = 0; e < 4; ++e) { o[4 * j + e] = a[e] + b[e]; ss += o[4 * j + e] * o[4 * j + e]; } }
        ss += dppf<0xB1>(ss); ss += dppf<0x4E>(ss); ss += dppf<0x141>(ss);
        const float rstd = 1.0f / sqrtf(ss * (1.0f / DV) + EPS);
        const v4u g0 = *(const GAS v4u*)(Z2 + (size_t)m * Z2W + Z2_GA + 16 * lane), g1 = *(const GAS v4u*)(Z2 + (size_t)m * Z2W + Z2_GA + 16 * lane + 8); float ga[16];
        ga[0] = bflo(g0.x); ga[1] = bfhi(g0.x); ga[2] = bflo(g0.y); ga[3] = bfhi(g0.y); ga[4] = bflo(g0.z); ga[5] = bfhi(g0.z); ga[6] = bflo(g0.w); ga[7] = bfhi(g0.w);
        ga[8] = bflo(g1.x); ga[9] = bfhi(g1.x); ga[10] = bflo(g1.y); ga[11] = bfhi(g1.y); ga[12] = bflo(g1.z); ga[13] = bfhi(g1.z); ga[14] = bflo(g1.w); ga[15] = bfhi(g1.w);
        float y[16];
#pragma unroll
        for (int e = 0; e < 16; ++e) y[e] = o[e] * rstd * ag[e] * siluf_(ga[e]);
        v4u w0, w1; w0.x = pk2(y[0], y[1]); w0.y = pk2(y[2], y[3]); w0.z = pk2(y[4], y[5]); w0.w = pk2(y[6], y[7]); w1.x = pk2(y[8], y[9]); w1.y = pk2(y[10], y[11]); w1.z = pk2(y[12], y[13]); w1.w = pk2(y[14], y[15]);
        *(GAS v4u*)(YABC + (size_t)m * 2048 + 16 * lane) = w0; *(GAS v4u*)(YABC + (size_t)m * 2048 + 16 * lane + 8) = w1;
    }
}

constexpr int PH_PER_LAYER = 13, N_PHASES = 1 + DEPTH * PH_PER_LAYER + 1;
__device__ __forceinline__ void grid_seam() {
    extern __shared__ __attribute__((aligned(16))) unsigned char lds_dyn[];
    XcdBarrier bar; bar.bar = (unsigned*)(kargs()->ws + WS_CTL) + CW_BAR; bar.x = xb_xcc_id(); bar.st = (volatile LAS unsigned*)((LAS unsigned char*)lds_dyn + MISC_OFF) + 8;
    xcd_barrier(bar);
}
__global__ void __launch_bounds__(512, 2) fwd_kernel(Args args_unused) {
    extern __shared__ __attribute__((aligned(16))) unsigned char lds_dyn[];
    { LAS unsigned char* lds = (LAS unsigned char*)lds_dyn;
      for (int u = threadIdx.x; u < (LDS_BYTES - LDSCTL_OFF) / 4; u += 512) ((LAS unsigned*)(lds + LDSCTL_OFF))[u] = 0u;
      __syncthreads();
      if (kargs()->ph_hi - kargs()->ph_lo > 1) (void)xcd_barrier_post((unsigned*)(kargs()->ws + WS_CTL) + CW_BAR, (volatile LAS unsigned*)(lds + MISC_OFF) + 8); }
    const int lo = kargs()->ph_lo, hi = kargs()->ph_hi;
#define IN(k) (lo <= (k) && (k) < hi)
#define SEAM(k) do { if (IN((k) + 1)) grid_seam(); } while (0)
#define LDSP ((LAS unsigned char*)lds_dyn)
#define WSP(off) (kargs()->ws + (off))

#ifndef NO_PRO
    if (IN(0)) { phase_prologue(); __syncthreads(); SEAM(0); }
#endif

#pragma unroll 1
    for (int l = 0; l < DEPTH; ++l) {
        const int pb = 1 + l * PH_PER_LAYER;
        if (hi <= pb || lo >= pb + PH_PER_LAYER) continue;
#pragma unroll 1
        for (int j = 0; j < 2; ++j) {
            const int p0 = pb + (j ? 10 : 0);
            if (IN(p0)) { phase_norm(l, j ? 2 : 0); SEAM(p0); }
#ifndef NO_G1
            if (IN(p0 + 1)) { pg8::Gemm g{(const bf16*)WSP(WS_H), (const bf16*)WSP(WS_WGU) + (size_t)(l * 2 + j) * (2 * DFF) * D, M, 2 * DFF, D, D, D};
                pg8::StaticOrder S; S.init(M, 2 * DFF, (int)gridDim.x, (int)blockIdx.x); pg8::EpiSwiGLU E{(bf16*)WSP(WS_ACT)};
                pg8::gemm_phase<pg8::EpiSwiGLU, pg8::StaticOrder, true, true>(LDSP, g, S, E); SEAM(p0 + 1); }
#endif
#ifndef NO_G2
            if (IN(p0 + 2)) { pg8::Gemm g{(const bf16*)WSP(WS_ACT), (const bf16*)WSP(WS_WD) + (size_t)(l * 2 + j) * D * DFF, M, D, DFF, DFF, DFF};
                pg8::StaticOrder S; S.init(M, D, (int)gridDim.x, (int)blockIdx.x); pg8::EpiResid E{(float*)WSP(WS_Y), (const float*)WSP(WS_MOD) + (size_t)l * NGRP * MODW + (j ? 8 : 2) * D, 0.5f};
                pg8::gemm_phase<pg8::EpiResid, pg8::StaticOrder, true, true>(LDSP, g, S, E); SEAM(p0 + 2); }
#endif
            if (j == 0) {
                if (IN(pb + 3)) { phase_norm(l, 1); SEAM(pb + 3); }
#ifndef NO_G3
                if (IN(pb + 4)) { pg8::Gemm g{(const bf16*)WSP(WS_H), (const bf16*)WSP(WS_WIN) + (size_t)l * INW * D, M, INW, D, D, D};
                    pg8::StaticOrder S; S.init(M, INW, (int)gridDim.x, (int)blockIdx.x); pg8::EpiInproj E{(float*)WSP(WS_Z1), (bf16*)WSP(WS_Z2)};
                    pg8::gemm_phase<pg8::EpiInproj, pg8::StaticOrder, true, true>(LDSP, g, S, E); SEAM(pb + 4); }
#endif
#ifndef NO_ELEM
                if (IN(pb + 5)) {
#ifndef HG_V1
 phase_hgrn_prep(l);
#endif
 phase_mix_elem(l); SEAM(pb + 5); }
#endif
                if (IN(pb + 6)) {
#ifndef NO_SCAN
#ifdef HG_V1
                    phase_scan_v1();
#else
                    phase_hgrn(); __syncthreads();
#endif
#endif
#ifndef NO_GMLP
                    phase_gmlp_v1(l);
#endif
                    SEAM(pb + 6); }
#ifndef NO_READ
                if (IN(pb + 7)) { phase_readout(l); SEAM(pb + 7); }
#endif
#ifndef NO_G4
                if (IN(pb + 8)) {
                    { pg8::Gemm g{(const bf16*)WSP(WS_YABC), (const bf16*)WSP(WS_WP) + (size_t)l * D * 2048, M, D, 1024, 2048, 2048};
                      pg8::StaticOrder S; S.init(M, D, (int)gridDim.x, (int)blockIdx.x); pg8::EpiProj<0> E{(float*)WSP(WS_MF32), (bf16*)WSP(WS_MRG), (const bf16*)WSP(WS_Z2) + Z2_MA};
                      pg8::gemm_phase<pg8::EpiProj<0>, pg8::StaticOrder, true, true>(LDSP, g, S, E); }
                    { pg8::Gemm g{(const bf16*)WSP(WS_YABC) + 1024, (const bf16*)WSP(WS_WP) + (size_t)l * D * 2048 + 1024, M, D, 512, 2048, 2048};
                      pg8::StaticOrder S; S.init(M, D, (int)gridDim.x, (int)blockIdx.x); pg8::EpiProj<1> E{(float*)WSP(WS_MF32), (bf16*)WSP(WS_MRG), (const bf16*)WSP(WS_Z2) + Z2_MB};
                      pg8::gemm_phase<pg8::EpiProj<1>, pg8::StaticOrder, true, true>(LDSP, g, S, E); }
                    { pg8::Gemm g{(const bf16*)WSP(WS_YABC) + 1536, (const bf16*)WSP(WS_WP) + (size_t)l * D * 2048 + 1536, M, D, 512, 2048, 2048};
                      pg8::StaticOrder S; S.init(M, D, (int)gridDim.x, (int)blockIdx.x); pg8::EpiProj<2> E{(float*)WSP(WS_MF32), (bf16*)WSP(WS_MRG), (const bf16*)WSP(WS_Z2) + Z2_MC};
                      pg8::gemm_phase<pg8::EpiProj<2>, pg8::StaticOrder, true, true>(LDSP, g, S, E); }
                    SEAM(pb + 8); }
#endif
#ifndef NO_G5
                if (IN(pb + 9)) { pg8::Gemm g{(const bf16*)WSP(WS_MRG), (const bf16*)WSP(WS_WO) + (size_t)l * D * D, M, D, D, D, D};
                    pg8::StaticOrder S; S.init(M, D, (int)gridDim.x, (int)blockIdx.x); pg8::EpiResid E{(float*)WSP(WS_Y), (const float*)WSP(WS_MOD) + (size_t)l * NGRP * MODW + 5 * D, 1.0f};
                    pg8::gemm_phase<pg8::EpiResid, pg8::StaticOrder, true, true>(LDSP, g, S, E); SEAM(pb + 9); }
#endif
            }
        }
    }
    if (IN(N_PHASES - 1)) phase_final();
#undef IN
#undef SEAM
}

#ifndef MK_PER_PHASE
#define MK_PER_PHASE 0
#endif
extern "C" void kernel_launch(void* const* d_in, const int* in_sizes, int n_in, void* d_out, int out_size, void* d_ws, size_t ws_size, hipStream_t stream) {
    static int grid = 0;
    if (grid == 0) {
        if (n_in != 23 || out_size != M_LAT * D || ws_size < WS_END) { fprintf(stderr, "kernel_launch: unexpected sizes n_in %d out %d ws %zu (need %zu)\n", n_in, out_size, ws_size, (size_t)WS_END); grid = -1; return; }
        int dev = 0, cus = 0, per_cu = 0;
        if (hipGetDevice(&dev) != hipSuccess || hipDeviceGetAttribute(&cus, hipDeviceAttributeMultiprocessorCount, dev) != hipSuccess) { grid = -1; return; }
        if (hipFuncSetAttribute((const void*)fwd_kernel, hipFuncAttributeMaxDynamicSharedMemorySize, LDS_BYTES) != hipSuccess) { fprintf(stderr, "kernel_launch: hipFuncSetAttribute failed\n"); grid = -1; return; }
        if (hipOccupancyMaxActiveBlocksPerMultiprocessor(&per_cu, (const void*)fwd_kernel, 512, LDS_BYTES) != hipSuccess || per_cu < 1) { fprintf(stderr, "kernel_launch: occupancy query says %d\n", per_cu); }
        (void)hipGetLastError();
        grid = cus;
    }
    if (grid < 0) return;
    (void)hipMemsetAsync((char*)d_ws + WS_CTL, 0, CTL_ZERO_BYTES, stream);
    Args a{};
    for (int i = 0; i < 23; ++i) a.in[i] = (const float*)d_in[i];
    a.out = (float*)d_out; a.ws = (unsigned char*)d_ws;
#if MK_PER_PHASE
    for (int p = 0; p < N_PHASES; ++p) { a.ph_lo = p; a.ph_hi = p + 1; hipLaunchKernelGGL(fwd_kernel, dim3(grid), dim3(512), LDS_BYTES, stream, a); }
#else
    a.ph_lo = 0; a.ph_hi = N_PHASES; hipLaunchKernelGGL(fwd_kernel, dim3(grid), dim3(512), LDS_BYTES, stream, a);
#endif
}
```

```cpp
#include <hip/hip_runtime.h>
#include <cstdio>
#include <cstdint>
namespace pg8 {
#define PG8_LAS __attribute__((address_space(3)))
typedef unsigned short bf16_t;
typedef short bf16x8 __attribute__((ext_vector_type(8)));
typedef float f32x4 __attribute__((ext_vector_type(4)));
typedef float f32x2 __attribute__((ext_vector_type(2)));
typedef unsigned u32x4 __attribute__((ext_vector_type(4)));
typedef unsigned u32x2 __attribute__((ext_vector_type(2)));
constexpr int BM = 256, BK = 64, HALF = 128, HTB = HALF * BK * 2  , STAGE_BYTES = 8 * HTB, NXCD = 8, WGM = 8;

__host__ __device__ __forceinline__ int lds_byte(int r, int c) { const int st = (r >> 4) * 2 + (c >> 5), rr = r & 15, cc = c & 31, ob = rr * 64 + cc * 2; return st * 1024 + (ob ^ (((ob >> 9) & 1) << 5)); }
__host__ __device__ __forceinline__ void stage_rc(int b, int& R, int& C) { const int st = b / 1024, sb = b % 1024, swz = sb ^ (((sb >> 9) & 1) << 5); R = (st >> 1) * 16 + swz / 64; C = (st & 1) * 32 + (swz % 64) / 2; }
__host__ __device__ __forceinline__ int perm32(int rho) { const int n = rho >> 4, i = rho & 15; return 8 * (i >> 2) + 4 * n + (i & 3); }

struct Unit { int pm, pn, meta;
    __host__ __device__ __forceinline__ int kt0() const { return meta & 255; } __host__ __device__ __forceinline__ int nt() const { return (meta >> 8) & 255; } __host__ __device__ __forceinline__ int part() const { return meta >> 16; }
    __host__ __device__ __forceinline__ void set(int kt0_, int nt_, int part_) { meta = kt0_ | (nt_ << 8) | (part_ << 16); } };
struct Gemm { const bf16_t* A; const bf16_t* Bt; int M, N, K, lda, ldb; };

__host__ __device__ __forceinline__ int xcd_block_pos(int L, int nwg, int G) {
    if (G != 256) return L;
    const int i = L >> 8, c = L & 255;
    if (((i + 1) << 8) <= nwg) return (i << 8) + ((c & 7) << 5) + (c >> 3);
    const int rem = nwg - (i << 8);
    return (rem & 7) ? L : (i << 8) + (c & 7) * (rem >> 3) + (c >> 3);
}
__host__ __device__ __forceinline__ void tile_of(int wgid, int nM, int nN, int& pm, int& pn) {
    const int nig = WGM * nN, gid = wgid / nig, fm = gid * WGM, gsz = (nM - fm) < WGM ? (nM - fm) : WGM;
    pm = fm + ((wgid % nig) % gsz); pn = (wgid % nig) / gsz;
}
struct StaticOrder {
    int nM, nN, nwg, G, c, ntK;
    __host__ __device__ void init(int M, int N, int G_, int c_, int K) { nM = M / BM; nN = N / BM; nwg = nM * nN; G = G_; c = c_; ntK = K / BK; }
    __host__ __device__ bool next(int i, Unit& u) const {
        const long L = (long)i * G + c; if (L >= nwg) return false;
        u.set(0, ntK, 0);
        const int wgid = xcd_block_pos((int)L, nwg, G);
        const int nig = WGM * nN, gid = wgid / nig, fm = gid * WGM, gsz = (nM - fm) < WGM ? (nM - fm) : WGM;
        u.pm = fm + ((wgid % nig) % gsz); u.pn = (wgid % nig) / gsz; return true;
    }
    __device__ __forceinline__ void a_ready(const Unit&) const {}
    __device__ __forceinline__ void done(const Unit&) const {}
};

struct SplitOrder {
    int G, c, ntK, nctx;
    __host__ __device__ void init(int G_, int c_, int K, bool with_ctx) { G = G_; c = c_; ntK = K / BK; nctx = with_ctx ? 256 : 0; }
    __host__ __device__ bool next(int i, Unit& u) const {
        const long L = (long)i * G + c; if (L >= 512 + nctx) return false;
        if (L < 512) { tile_of(xcd_block_pos((int)L, 512, G), 64, 8, u.pm, u.pn); u.set(0, ntK, 0); return true; }
        const int q = (int)L - 512, tile = q >> 3, p = q & 7; u.pm = 64 + (tile >> 3); u.pn = tile & 7;
        if (ntK == 88) u.set((p >> 1) * 22 + (p & 1) * 12, (p & 1) ? 10 : 12, 1 + p); else u.set(p * (ntK >> 3), ntK >> 3, 1 + p);
        return true;
    }
    __device__ __forceinline__ void a_ready(const Unit&) const {}
    __device__ __forceinline__ void done(const Unit&) const {}
};

struct InprojOrder {
    int G, c, ntK, nctx;
    __host__ __device__ void init(int G_, int c_, int K, int nctx_pn) { G = G_; c = c_; ntK = K / BK; nctx = 4 * nctx_pn; }
    __host__ __device__ bool next(int i, Unit& u) const {
        const long L = (long)i * G + c; if (L >= 64 * 54 + nctx) return false;
        u.set(0, ntK, 0);
        if (L < 64 * 54) { tile_of(xcd_block_pos((int)L, 64 * 54, G), 64, 54, u.pm, u.pn); return true; }
        const int q = (int)L - 64 * 54; u.pm = 64 + (q & 3); u.pn = q >> 2; return true;
    }
    __device__ __forceinline__ void a_ready(const Unit&) const {}
    __device__ __forceinline__ void done(const Unit&) const {}
};

__device__ __forceinline__ unsigned cvt_pk_bf16(float lo, float hi) { unsigned r; asm volatile("v_cvt_pk_bf16_f32 %0, %1, %2" : "=v"(r) : "v"(lo), "v"(hi)); return r; }

template <class Epi, class Sched, bool ALIGN_EPI = false, bool SP2 = false>
__device__ __forceinline__ void gemm_phase(PG8_LAS unsigned char* lds, const Gemm g, const Sched& S, const Epi& E) {
    int tid_ = threadIdx.x; asm volatile("" : "+v"(tid_));
    const int tid = tid_, wid = __builtin_amdgcn_readfirstlane(tid >> 6), lane = tid & 63, wr = wid >> 2, wc = wid & 3, fr = lane & 15, fq = lane >> 4;
    unsigned voffA[2], voffB[2];
#pragma unroll
    for (int i = 0; i < 2; ++i) { int R, C; stage_rc(tid * 16 + i * 8192, R, C); const int Rb = Epi::PERM ? ((R & ~31) + perm32(R & 31)) : R;
        voffA[i] = (unsigned)(R * g.lda + C) * 2u; voffB[i] = (unsigned)(Rb * g.ldb + C) * 2u; }
    const unsigned kstep = (unsigned)(BK * 2);
    const unsigned hstepA = (unsigned)HALF * g.lda * 2u, hstepB = (unsigned)HALF * g.ldb * 2u;
    const unsigned tstepA = 2u * hstepA, tstepB = 2u * hstepB;
    const unsigned ldsw = (unsigned)wid * 1024u;
    const int aoff = lds_byte(wr * 64 + fr, fq * 8), boff = lds_byte(wc * 32 + fr, fq * 8);
#define PG8_SA(b, h) (((b) * 2 + (h)) * HTB)
#define PG8_SB(b, h) ((4 + (b) * 2 + (h)) * HTB)
#define PG8_STAGE(bufoff, gbase, voff) do { _Pragma("unroll") for (int _i = 0; _i < 2; ++_i) \
        __builtin_amdgcn_global_load_lds((const unsigned*)((const char*)(gbase) + (voff)[_i]), (PG8_LAS unsigned*)(lds + (bufoff) + ldsw + _i * 8192), 16, 0, 0); } while (0)
#define PG8_LDA(dst, b, h) do { _Pragma("unroll") for (int m = 0; m < 4; ++m) _Pragma("unroll") for (int k = 0; k < 2; ++k) dst[m][k] = *(const PG8_LAS bf16x8*)(lds + PG8_SA(b, h) + aoff + m * 2048 + k * 1024); } while (0)
#define PG8_LDB(dst, b, h) do { _Pragma("unroll") for (int n = 0; n < 2; ++n) _Pragma("unroll") for (int k = 0; k < 2; ++k) dst[n][k] = *(const PG8_LAS bf16x8*)(lds + PG8_SB(b, h) + boff + n * 2048 + k * 1024); } while (0)
#define PG8_MMA(ai, bj, At, Bt) do { __builtin_amdgcn_s_setprio(1); _Pragma("unroll") for (int m = 0; m < 4; ++m) _Pragma("unroll") for (int n = 0; n < 2; ++n) _Pragma("unroll") for (int k = 0; k < 2; ++k) \
        acc[ai][bj][m][n] = __builtin_amdgcn_mfma_f32_16x16x32_bf16(Bt[n][k], At[m][k], acc[ai][bj][m][n], 0, 0, 0); __builtin_amdgcn_s_setprio(0); } while (0)
#define PG8_WAIT_V(n) asm volatile("s_waitcnt vmcnt(" #n ")" ::: "memory")
#define PG8_WAIT_L(n) asm volatile("s_waitcnt lgkmcnt(" #n ")" ::: "memory")
#define PG8_BAR __builtin_amdgcn_s_barrier()
#define PG8_SCHED __builtin_amdgcn_sched_barrier(0)
    Unit cur, nxt; int ui = 0;
    if (!S.next(0, cur)) return;
    f32x4 acc[2][2][4][2];
#pragma unroll
    for (int a = 0; a < 2; ++a)
#pragma unroll
        for (int b = 0; b < 2; ++b)
#pragma unroll
            for (int m = 0; m < 4; ++m)
#pragma unroll
                for (int n = 0; n < 2; ++n) acc[a][b][m][n] = (f32x4){0.f, 0.f, 0.f, 0.f};
    bf16x8 At[4][2], B0[2][2], B1[2][2];
    const char* cA = (const char*)g.A + (size_t)((unsigned)cur.pm * tstepA) + (size_t)((unsigned)cur.kt0() * kstep); const char* cB = (const char*)g.Bt + (size_t)((unsigned)cur.pn * tstepB) + (size_t)((unsigned)cur.kt0() * kstep);
    S.a_ready(cur);
    if constexpr (SP2) {
        PG8_STAGE(PG8_SB(0, 0), cB, voffB); PG8_STAGE(PG8_SB(0, 1), cB + hstepB, voffB); PG8_STAGE(PG8_SA(0, 0), cA, voffA); PG8_STAGE(PG8_SA(0, 1), cA + hstepA, voffA);
        if (wr == 1) PG8_BAR;
        PG8_WAIT_V(2); PG8_BAR;
        PG8_STAGE(PG8_SB(1, 0), cB + kstep, voffB); PG8_STAGE(PG8_SA(1, 0), cA + kstep, voffA); PG8_STAGE(PG8_SB(1, 1), cB + hstepB + kstep, voffB);
        PG8_WAIT_V(6); PG8_BAR;
    } else {
        PG8_STAGE(PG8_SB(0, 0), cB, voffB); PG8_STAGE(PG8_SA(0, 0), cA, voffA); PG8_STAGE(PG8_SB(0, 1), cB + hstepB, voffB); PG8_STAGE(PG8_SA(0, 1), cA + hstepA, voffA);
        if (wr == 1) PG8_BAR;
        PG8_WAIT_V(4); PG8_BAR;
        PG8_STAGE(PG8_SB(1, 0), cB + kstep, voffB); PG8_STAGE(PG8_SA(1, 0), cA + kstep, voffA); PG8_STAGE(PG8_SB(1, 1), cB + hstepB + kstep, voffB);
        PG8_WAIT_V(6); PG8_BAR;
    }
    for (;;) {
        const bool has_next = S.next(ui + 1, nxt);
        const char* nA = has_next ? (const char*)g.A + (size_t)((unsigned)nxt.pm * tstepA) + (size_t)((unsigned)nxt.kt0() * kstep) : cA; const char* nB = has_next ? (const char*)g.Bt + (size_t)((unsigned)nxt.pn * tstepB) + (size_t)((unsigned)nxt.kt0() * kstep) : cB;
        const int nt = cur.nt();
        for (int t = 0; t < nt; t += 2) {
            if constexpr (Epi::HOOK) { if (t == Epi::H1 || t == Epi::H2) E.khook(acc, cur, t, wr, wc, fr, fq); }
            const bool last = (t == nt - 2);
            const char* a1 = cA + (size_t)((unsigned)(t + 1) * kstep);
            const char* a2 = last ? nA : cA + (size_t)((unsigned)(t + 2) * kstep); const char* b2 = last ? nB : cB + (size_t)((unsigned)(t + 2) * kstep);
            const char* a3 = a2 + kstep; const char* b3 = b2 + kstep;
            if (last && has_next) S.a_ready(nxt);
            if constexpr (SP2) {
            PG8_LDB(B0, 0, 0); PG8_LDB(B1, 0, 1); PG8_SCHED; PG8_LDA(At, 0, 0); PG8_STAGE(PG8_SA(1, 1), a1 + hstepA, voffA);
            PG8_WAIT_V(8); PG8_WAIT_L(0); PG8_BAR; PG8_MMA(0, 0, At, B0); PG8_MMA(0, 1, At, B1); PG8_BAR; PG8_SCHED;
            PG8_LDA(At, 0, 1); PG8_STAGE(PG8_SB(0, 0), b2, voffB); PG8_STAGE(PG8_SB(0, 1), b2 + hstepB, voffB); PG8_STAGE(PG8_SA(0, 0), a2, voffA);
            PG8_WAIT_V(8); PG8_WAIT_L(0); PG8_BAR; PG8_MMA(1, 0, At, B0); PG8_MMA(1, 1, At, B1); PG8_BAR; PG8_SCHED;
            PG8_LDB(B0, 1, 0); PG8_LDB(B1, 1, 1); PG8_SCHED; PG8_LDA(At, 1, 0); PG8_STAGE(PG8_SA(0, 1), a2 + hstepA, voffA);
            PG8_WAIT_V(8); PG8_WAIT_L(0); PG8_BAR; PG8_MMA(0, 0, At, B0); PG8_MMA(0, 1, At, B1); PG8_BAR; PG8_SCHED;
            PG8_LDA(At, 1, 1); PG8_STAGE(PG8_SB(1, 0), b3, voffB); PG8_STAGE(PG8_SB(1, 1), b3 + hstepB, voffB); PG8_STAGE(PG8_SA(1, 0), a3, voffA);
            PG8_WAIT_V(8); PG8_WAIT_L(0); PG8_BAR; PG8_MMA(1, 0, At, B0); PG8_MMA(1, 1, At, B1); PG8_BAR; PG8_SCHED;
            } else {
            PG8_LDB(B0, 0, 0); PG8_SCHED; PG8_LDA(At, 0, 0); PG8_STAGE(PG8_SA(1, 1), a1 + hstepA, voffA);
            PG8_WAIT_L(8); PG8_BAR; PG8_WAIT_L(0); PG8_MMA(0, 0, At, B0); PG8_BAR; PG8_SCHED;
            PG8_LDB(B1, 0, 1); PG8_STAGE(PG8_SB(0, 0), b2, voffB);
            PG8_BAR; PG8_WAIT_L(0); PG8_MMA(0, 1, At, B1); PG8_BAR;
            PG8_LDA(At, 0, 1); PG8_STAGE(PG8_SA(0, 0), a2, voffA);
            PG8_BAR; PG8_WAIT_L(0); PG8_MMA(1, 0, At, B0); PG8_BAR; PG8_SCHED;
            PG8_STAGE(PG8_SB(0, 1), b2 + hstepB, voffB);
            PG8_WAIT_V(6); PG8_BAR; PG8_MMA(1, 1, At, B1); PG8_BAR;
            PG8_LDB(B0, 1, 0); PG8_SCHED; PG8_LDA(At, 1, 0); PG8_STAGE(PG8_SA(0, 1), a2 + hstepA, voffA);
            PG8_WAIT_L(8); PG8_BAR; PG8_WAIT_L(0); PG8_MMA(0, 0, At, B0); PG8_BAR; PG8_SCHED;
            PG8_LDB(B1, 1, 1); PG8_STAGE(PG8_SB(1, 0), b3, voffB);
            PG8_BAR; PG8_WAIT_L(0); PG8_MMA(0, 1, At, B1); PG8_BAR;
            PG8_LDA(At, 1, 1); PG8_STAGE(PG8_SA(1, 0), a3, voffA);
            PG8_BAR; PG8_WAIT_L(0); PG8_MMA(1, 0, At, B0); PG8_BAR; PG8_SCHED;
            PG8_STAGE(PG8_SB(1, 1), b3 + hstepB, voffB);
            PG8_WAIT_V(6); PG8_BAR; PG8_MMA(1, 1, At, B1); PG8_BAR;
            }
        }
        if constexpr (ALIGN_EPI) { if (wr == 0) PG8_BAR; }
        E(acc, cur, wr, wc, fr, fq); S.done(cur);
        if (!has_next) break;
#pragma unroll
        for (int a = 0; a < 2; ++a)
#pragma unroll
            for (int b = 0; b < 2; ++b)
#pragma unroll
                for (int m = 0; m < 4; ++m)
#pragma unroll
                    for (int n = 0; n < 2; ++n) acc[a][b][m][n] = (f32x4){0.f, 0.f, 0.f, 0.f};
        cur = nxt; cA = nA; cB = nB; ++ui;
        if constexpr (ALIGN_EPI) { if (wr == 1) PG8_BAR; }
    }
    PG8_WAIT_V(0);
    if constexpr (!ALIGN_EPI) { if (wr == 0) PG8_BAR; }
    PG8_BAR;
#undef PG8_SA
#undef PG8_SB
#undef PG8_STAGE
#undef PG8_LDA
#undef PG8_LDB
#undef PG8_MMA
#undef PG8_WAIT_V
#undef PG8_WAIT_L
#undef PG8_BAR
#undef PG8_SCHED
}
}
#define XB_TMO      128
#define XB_XCNT(j)  (256  + 64 * (j))
#define XB_XSUB(j)  (1280 + 64 * (j))
#define XB_XGEN(j)  (2304 + 64 * (j))
#define XB_TOP      3328
#define XB_TOPGEN   3392
#define XCD_BAR_WORDS 3456
#define XB_SPIN_CAP (1u << 18)
#define LAS __attribute__((address_space(3)))

__device__ __forceinline__ unsigned xb_ld(unsigned* p)              { return __hip_atomic_load(p, __ATOMIC_RELAXED, __HIP_MEMORY_SCOPE_AGENT); }
__device__ __forceinline__ unsigned xb_add(unsigned* p, unsigned v) { return __hip_atomic_fetch_add(p, v, __ATOMIC_RELAXED, __HIP_MEMORY_SCOPE_AGENT); }
__device__ __forceinline__ unsigned xb_xcc_id() { return (unsigned)__builtin_amdgcn_s_getreg((3 << 11) | 20) & 0xFu; }
#define XB_SPIN(cond, bar) do { unsigned _sp = 0; while (cond) { __builtin_amdgcn_s_sleep(1); \
    if ((++_sp & 255u) == 0u) { if (xb_ld(&(bar)[XB_TMO])) break; if (_sp > XB_SPIN_CAP) { atomicAdd(&(bar)[XB_TMO], 1u); break; } } } } while (0)

struct XcdBarrier {
    unsigned* bar; unsigned x;
    volatile LAS unsigned* st;
};

__device__ __forceinline__ XcdBarrier xcd_barrier_post(unsigned* bar, volatile LAS unsigned* st) {
    XcdBarrier b; b.bar = bar; b.x = xb_xcc_id(); b.st = st;
    if (threadIdx.x == 0) (void)xb_add(&bar[XB_XCNT(b.x)], 1u);
    return b;
}
__device__ __forceinline__ void xcd_barrier_complete(unsigned* bar, unsigned x, unsigned& nloc, unsigned& nx) {
    const unsigned G = gridDim.x * gridDim.y * gridDim.z;
    unsigned sum, cnt, mine, sp = 0u;
    for (;;) {
        sum = 0u; cnt = 0u; mine = 0u;
#pragma unroll
        for (unsigned j = 0; j < 16; ++j) { const unsigned c = xb_ld(&bar[XB_XCNT(j)]); sum += c; cnt += (c > 0u) ? 1u : 0u; mine = (j == x) ? c : mine; }
        if (sum == G) break;
        __builtin_amdgcn_s_sleep(1);
        if ((++sp & 255u) == 0u) { if (xb_ld(&bar[XB_TMO])) break; if (sp > XB_SPIN_CAP) { atomicAdd(&bar[XB_TMO], 1u); break; } }
    }
    nloc = mine > 0u ? mine : 1u; nx = cnt > 0u ? cnt : 1u;
}

__device__ __forceinline__ void xcd_barrier(const XcdBarrier& b) {
    asm volatile("s_waitcnt vmcnt(0)" ::: "memory");
    __syncthreads();
    if (threadIdx.x == 0) {
        unsigned* bar = b.bar;
        __builtin_amdgcn_s_waitcnt(0);
        unsigned nloc = b.st[0], nx = b.st[1];
        if (nloc == 0u) { xcd_barrier_complete(bar, b.x, nloc, nx); b.st[0] = nloc; b.st[1] = nx; }
        const unsigned old = xb_add(&bar[XB_XSUB(b.x)], 1u);
        const unsigned gen = old / nloc;
        if (old + 1u == (gen + 1u) * nloc) {
            __builtin_amdgcn_fence(__ATOMIC_RELEASE, "agent");
            asm volatile("s_waitcnt vmcnt(0)" ::: "memory");
            const unsigned og = xb_add(&bar[XB_TOP], 1u);
            const unsigned tg = og / nx;
            if (og + 1u == (tg + 1u) * nx) xb_add(&bar[XB_TOPGEN], 1u);
            else XB_SPIN(xb_ld(&bar[XB_TOPGEN]) == tg, bar);
            __builtin_amdgcn_fence(__ATOMIC_ACQUIRE, "agent");
            xb_add(&bar[XB_XGEN(b.x)], 1u);
            asm volatile("s_waitcnt vmcnt(0)" ::: "memory");
        } else {
            XB_SPIN(xb_ld(&bar[XB_XGEN(b.x)]) == gen, bar);
            __builtin_amdgcn_fence(__ATOMIC_ACQUIRE, "agent");
            asm volatile("s_waitcnt vmcnt(0)" ::: "memory");
        }
    }
    __syncthreads();
}

constexpr int D = 2048, NB = 4, SEQ = 4096, DEPTH = 4, CTXL = 256, NMOD = 9, DFF = 5632, NH = 8, DK = 128, DV = 128, WK = 1024;
constexpr int BW = 512, CWD = 512, INW = 13824;
constexpr int M_LAT = NB * SEQ, M_CTX = NB * CTXL, M = M_LAT + M_CTX;
constexpr int MODW = NMOD * D;
constexpr int NGRP = 5;
constexpr float EPS = 1e-6f;
constexpr int Z1W = 4096, Z2W = INW - Z1W;
constexpr int Z2_GA = 0, Z2_U = 1024, Z2_V = 1536, Z2_HC = 2048, Z2_GB = 2560, Z2_GC = 3072, Z2_MA = 3584, Z2_MB = 5632, Z2_MC = 7680;

constexpr size_t MiB = 1u << 20;
constexpr size_t WS_CTL = 0ull * MiB, CTL_ZERO_BYTES = 32 * 1024;
constexpr size_t WS_MOD = 1ull * MiB;
constexpr size_t WS_LB = 3ull * MiB;
constexpr size_t WS_WGU = 4ull * MiB;
constexpr size_t WS_WD = 356ull * MiB;
constexpr size_t WS_WIN = 532ull * MiB;
constexpr size_t WS_WP = 748ull * MiB;
constexpr size_t WS_WO = 780ull * MiB;
constexpr size_t WS_Y = 812ull * MiB;
constexpr size_t WS_H = 948ull * MiB;
constexpr size_t WS_MRG = 1016ull * MiB;
constexpr size_t WS_YABC = 1084ull * MiB;
constexpr size_t WS_MF32 = 1152ull * MiB;
constexpr size_t WS_OF = 1288ull * MiB;
constexpr size_t WS_OB = 1356ull * MiB;
constexpr size_t WS_FF = 1424ull * MiB;
constexpr size_t WS_FB = 1492ull * MiB;
constexpr size_t WS_VN = 1560ull * MiB;
constexpr size_t WS_Z1 = 1577ull * MiB;
constexpr size_t WS_ZF = WS_Z1, WS_QS = WS_Z1 + 68ull * MiB;
constexpr size_t WS_Z2 = 1849ull * MiB;
constexpr size_t WS_ACT = WS_Z1;
constexpr size_t WS_QF = WS_FF, WS_KF = WS_FF + 34ull * MiB, WS_QB = WS_FB, WS_KB = WS_FB + 34ull * MiB;
constexpr size_t WS_VV = 2172ull * MiB;
constexpr size_t WS_GF = 2206ull * MiB;
constexpr size_t WS_GB = 2211ull * MiB;
constexpr size_t WS_SLOC = 2216ull * MiB;
constexpr size_t WS_END = 2248ull * MiB;
constexpr int CW_BAR = 4096;
static_assert((CW_BAR + 3456) * 4 <= (int)CTL_ZERO_BYTES, "barrier words inside the per-call memset");

constexpr int RING_BYTES = 131072;
constexpr int LDSCTL_OFF = RING_BYTES, MISC_OFF = LDSCTL_OFF + 320;
constexpr int LDS_BYTES = 147456;

#define GAS __attribute__((address_space(1)))
typedef unsigned short bf16;
typedef unsigned v4u __attribute__((ext_vector_type(4)));
typedef unsigned v2u __attribute__((ext_vector_type(2)));
typedef float f32x4 __attribute__((ext_vector_type(4)));
#define LDS_WAIT() asm volatile("s_waitcnt lgkmcnt(0)" ::: "memory")
#define VM_WAIT() asm volatile("s_waitcnt vmcnt(0)" ::: "memory")
__device__ __forceinline__ unsigned f2bf(float f) { unsigned u = __builtin_bit_cast(unsigned, f); return (u + 0x7fffu + ((u >> 16) & 1u)) >> 16; }
__device__ __forceinline__ unsigned pk2(float lo, float hi) { unsigned r; asm("v_cvt_pk_bf16_f32 %0, %1, %2" : "=v"(r) : "v"(lo), "v"(hi)); return r; }
__device__ __forceinline__ float bflo(unsigned w) { return __builtin_bit_cast(float, w << 16); }
__device__ __forceinline__ float bfhi(unsigned w) { return __builtin_bit_cast(float, w & 0xffff0000u); }
__device__ __forceinline__ float sigmoidf_(float x) { return __builtin_amdgcn_rcpf(1.0f + __expf(-x)); }
__device__ __forceinline__ float siluf_(float x) { return x * sigmoidf_(x); }
__device__ __forceinline__ float gelu_tanh(float x) { const float u = 0.7978845608028654f * (x + 0.044715f * x * x * x); return x * sigmoidf_(2.0f * u); }
template <int CTRL> __device__ __forceinline__ float dppf(float x) { return __builtin_bit_cast(float, __builtin_amdgcn_mov_dpp(__builtin_bit_cast(int, x), CTRL, 0xf, 0xf, true)); }
__device__ __forceinline__ float row16_sum(float x) { x += dppf<0xB1>(x); x += dppf<0x4E>(x); x += dppf<0x124>(x); x += dppf<0x128>(x); return x; }
__device__ __forceinline__ float wave_sum(float v) {
#pragma unroll
    for (int o = 1; o < 64; o <<= 1) v += __shfl_xor(v, o);
    return v;
}
__device__ __forceinline__ int grp_of_row(int m) { return m < M_LAT ? (m >> 12) : 4; }
#ifndef YBF16
#define YBF16 1
#endif
#if YBF16
typedef _Float16 ytype;
typedef _Float16 h16x4 __attribute__((ext_vector_type(4)));
__device__ __forceinline__ f32x4 y_ld4(const ytype* p) { const h16x4 w = *(const GAS h16x4*)p; return __builtin_convertvector(w, f32x4); }
__device__ __forceinline__ void y_st4(ytype* p, f32x4 v) { *(GAS h16x4*)p = __builtin_convertvector(v, h16x4); }
#else
typedef float ytype;
__device__ __forceinline__ f32x4 y_ld4(const ytype* p) { return *(const GAS f32x4*)p; }
__device__ __forceinline__ void y_st4(ytype* p, f32x4 v) { *(GAS f32x4*)p = v; }
#endif

struct Frame {
    LAS unsigned char* lds;
    int tid, lane, wave, vcu, G;
    unsigned char* ws;
};
struct Args { const float* in[23]; float* out; unsigned char* ws; int ph_lo, ph_hi; };
typedef const __attribute__((address_space(4))) Args* KArgs;
__device__ __forceinline__ KArgs kargs() { auto p = __builtin_amdgcn_kernarg_segment_ptr(); asm volatile("" : "+s"(p)); return (KArgs)p; }
__device__ __forceinline__ Frame mkframe() {
    extern __shared__ __attribute__((aligned(16))) unsigned char lds_dyn[];
    Frame F; F.lds = (LAS unsigned char*)lds_dyn; { int t = threadIdx.x; asm volatile("" : "+v"(t)); F.tid = t; } F.lane = F.tid & 63; F.wave = __builtin_amdgcn_readfirstlane(F.tid >> 6);
    { int gg = gridDim.x; asm volatile("" : "+s"(gg)); F.G = gg; } { int bx = blockIdx.x; asm volatile("" : "+s"(bx)); F.vcu = (F.G % 8 == 0) ? (bx % 8) * (F.G / 8) + bx / 8 : bx; }
    F.ws = kargs()->ws; return F;
}

namespace pg8 {
#define TRANS8(op, a) asm(op " %0, %0\n\t" op " %1, %1\n\t" op " %2, %2\n\t" op " %3, %3\n\t" op " %4, %4\n\t" op " %5, %5\n\t" op " %6, %6\n\t" op " %7, %7\n\ts_nop 0" \
    : "+v"(a##0), "+v"(a##1), "+v"(a##2), "+v"(a##3), "+v"(a##4), "+v"(a##5), "+v"(a##6), "+v"(a##7))
struct EpiSwiGLU { static constexpr bool PERM = true, HOOK = false; static constexpr int H1 = -1, H2 = -1;
    bf16_t* O;
    __device__ __forceinline__ void operator()(const f32x4 (&acc)[2][2][4][2], const Unit& u, int wr, int wc, int fr, int fq) const {
        const int row0 = u.pm * BM + wr * 64 + fr, col0 = u.pn * HALF + wc * 32 + 8 * fq;
#pragma unroll
        for (int ai = 0; ai < 2; ++ai)
#pragma unroll
            for (int m = 0; m < 4; ++m) { bf16_t* rowp = O + (size_t)(row0 + ai * HALF + m * 16) * DFF + col0;
                const f32x4 g0 = acc[ai][0][m][0], g1 = acc[ai][0][m][1], u0 = acc[ai][1][m][0], u1 = acc[ai][1][m][1];
                constexpr float NL2E = -1.4426950408889634f;
                float t0 = g0[0] * NL2E, t1 = g0[1] * NL2E, t2 = g0[2] * NL2E, t3 = g0[3] * NL2E, t4 = g1[0] * NL2E, t5 = g1[1] * NL2E, t6 = g1[2] * NL2E, t7 = g1[3] * NL2E;
                TRANS8("v_exp_f32", t);
                t0 += 1.0f; t1 += 1.0f; t2 += 1.0f; t3 += 1.0f; t4 += 1.0f; t5 += 1.0f; t6 += 1.0f; t7 += 1.0f;
                TRANS8("v_rcp_f32", t);
                u32x4 w; w.x = cvt_pk_bf16(g0[0] * u0[0] * t0, g0[1] * u0[1] * t1); w.y = cvt_pk_bf16(g0[2] * u0[2] * t2, g0[3] * u0[3] * t3);
                w.z = cvt_pk_bf16(g1[0] * u1[0] * t4, g1[1] * u1[1] * t5); w.w = cvt_pk_bf16(g1[2] * u1[2] * t6, g1[3] * u1[3] * t7);
                *(u32x4*)rowp = w; }
    }
};
#if YBF16
typedef _Float16 yh16x8 __attribute__((ext_vector_type(8)));
typedef float yf32x8 __attribute__((ext_vector_type(8)));
#endif
struct EpiResid { static constexpr bool PERM = true, HOOK = false; static constexpr int H1 = -1, H2 = -1;
    ytype* Y; const float* gate; float coef; float* slab;
    __device__ __forceinline__ void operator()(const f32x4 (&acc)[2][2][4][2], const Unit& u, int wr, int wc, int fr, int fq) const {
        const int row0 = u.pm * BM + wr * 64 + fr, col0 = u.pn * BM + wc * 32 + 8 * fq; const int grp = u.pm < 64 ? (u.pm >> 4) : 4;
        if (u.part() == 0) {
        const float* gp = gate + (size_t)grp * MODW + col0; f32x4 gv[2][2];
#pragma unroll
        for (int bj = 0; bj < 2; ++bj)
#pragma unroll
            for (int n = 0; n < 2; ++n) gv[bj][n] = *(const f32x4*)(gp + bj * HALF + 4 * n) * coef;
#if YBF16
#pragma unroll
        for (int ai = 0; ai < 2; ++ai) { yh16x8 old[4][2];
#pragma unroll
            for (int m = 0; m < 4; ++m)
#pragma unroll
                for (int bj = 0; bj < 2; ++bj) old[m][bj] = *(const yh16x8*)(Y + (size_t)(row0 + ai * HALF + m * 16) * D + col0 + bj * HALF);
#pragma unroll
            for (int m = 0; m < 4; ++m)
#pragma unroll
                for (int bj = 0; bj < 2; ++bj) { const yf32x8 o = __builtin_convertvector(old[m][bj], yf32x8); const f32x4 a0 = gv[bj][0] * acc[ai][bj][m][0], a1 = gv[bj][1] * acc[ai][bj][m][1];
                    const yf32x8 r = {o[0] + a0[0], o[1] + a0[1], o[2] + a0[2], o[3] + a0[3], o[4] + a1[0], o[5] + a1[1], o[6] + a1[2], o[7] + a1[3]};
                    *(yh16x8*)(Y + (size_t)(row0 + ai * HALF + m * 16) * D + col0 + bj * HALF) = __builtin_convertvector(r, yh16x8); }
            asm volatile("" ::: "memory"); }
#else
#pragma unroll
        for (int ai = 0; ai < 2; ++ai)
#pragma unroll
            for (int m = 0; m < 4; ++m) { float* rowp = Y + (size_t)(row0 + ai * HALF + m * 16) * D + col0;
#pragma unroll
                for (int bj = 0; bj < 2; ++bj)
#pragma unroll
                    for (int n = 0; n < 2; ++n) { float* p = rowp + bj * HALF + 4 * n; const f32x4 o = *(const f32x4*)p; *(f32x4*)p = o + gv[bj][n] * acc[ai][bj][m][n]; }
                asm volatile("" ::: "memory"); }
#endif
        } else {
#pragma unroll
        for (int ai = 0; ai < 2; ++ai)
#pragma unroll
            for (int m = 0; m < 4; ++m) { _Float16* rowp = (_Float16*)slab + ((size_t)(u.part() - 1) * M_CTX + (size_t)(row0 + ai * HALF + m * 16 - M_LAT)) * D + col0;
#pragma unroll
                for (int bj = 0; bj < 2; ++bj) { const f32x4 v0 = acc[ai][bj][m][0], v1 = acc[ai][bj][m][1]; const yf32x8 v = {v0[0], v0[1], v0[2], v0[3], v1[0], v1[1], v1[2], v1[3]};
                    *(yh16x8*)(rowp + bj * HALF) = __builtin_convertvector(v, yh16x8); } }
        }
    }
};
typedef _Float16 eh16x8 __attribute__((ext_vector_type(8)));
typedef float ef32x8 __attribute__((ext_vector_type(8)));
struct EpiInproj { static constexpr bool PERM = true, HOOK = false; static constexpr int H1 = -1, H2 = -1;
    bf16_t* QS; bf16_t* VV; _Float16* ZF; bf16_t* Z2;
    __device__ __forceinline__ void operator()(const f32x4 (&acc)[2][2][4][2], const Unit& u, int wr, int wc, int fr, int fq) const {
        const int row0 = u.pm * BM + wr * 64 + fr;
        if (u.pn < 8) { bf16_t* base = u.pn < 4 ? QS : VV; const float sc = u.pn < 4 ? 0.08838834764831845f : 1.0f; const int col0 = (u.pn & 3) * BM + wc * 32 + 8 * fq;
#pragma unroll
            for (int ai = 0; ai < 2; ++ai)
#pragma unroll
                for (int m = 0; m < 4; ++m) { bf16_t* rowp = base + (size_t)(row0 + ai * HALF + m * 16) * WK + col0;
#pragma unroll
                    for (int bj = 0; bj < 2; ++bj) { const f32x4 v0 = acc[ai][bj][m][0] * sc, v1 = acc[ai][bj][m][1] * sc;
                        u32x4 w; w.x = cvt_pk_bf16(v0[0], v0[1]); w.y = cvt_pk_bf16(v0[2], v0[3]); w.z = cvt_pk_bf16(v1[0], v1[1]); w.w = cvt_pk_bf16(v1[2], v1[3]);
                        *(u32x4*)(rowp + bj * HALF) = w; } }
        } else if (u.pn < 16) { const int col0 = (u.pn - 8) * BM + wc * 32 + 8 * fq;
#pragma unroll
            for (int ai = 0; ai < 2; ++ai)
#pragma unroll
                for (int m = 0; m < 4; ++m) { _Float16* rowp = ZF + (size_t)(row0 + ai * HALF + m * 16) * 2048 + col0;
#pragma unroll
                    for (int bj = 0; bj < 2; ++bj) { const f32x4 v0 = acc[ai][bj][m][0], v1 = acc[ai][bj][m][1];
                        const ef32x8 v = {v0[0], v0[1], v0[2], v0[3], v1[0], v1[1], v1[2], v1[3]}; *(eh16x8*)(rowp + bj * HALF) = __builtin_convertvector(v * -1.4426950408889634f, eh16x8); } }
        } else if (u.pn < 30) { const int col0 = (u.pn - 16) * BM + wc * 32 + 8 * fq;
#pragma unroll
            for (int ai = 0; ai < 2; ++ai)
#pragma unroll
                for (int m = 0; m < 4; ++m) { bf16_t* rowp = Z2 + (size_t)(row0 + ai * HALF + m * 16) * Z2W + col0;
#pragma unroll
                    for (int bj = 0; bj < 2; ++bj) { const f32x4 v0 = acc[ai][bj][m][0], v1 = acc[ai][bj][m][1];
                        u32x4 w; w.x = cvt_pk_bf16(v0[0], v0[1]); w.y = cvt_pk_bf16(v0[2], v0[3]); w.z = cvt_pk_bf16(v1[0], v1[1]); w.w = cvt_pk_bf16(v1[2], v1[3]);
                        *(u32x4*)(rowp + bj * HALF) = w; } }
        } else { const int col0 = (u.pn - 16) * BM + wc * 32 + 8 * fq;
            constexpr float NL2E = -1.4426950408889634f;
#pragma unroll
            for (int ai = 0; ai < 2; ++ai)
#pragma unroll
                for (int m = 0; m < 4; ++m) { bf16_t* rowp = Z2 + (size_t)(row0 + ai * HALF + m * 16) * Z2W + col0;
#pragma unroll
                    for (int bj = 0; bj < 2; ++bj) { const f32x4 v0 = acc[ai][bj][m][0], v1 = acc[ai][bj][m][1];
                        float t0 = __builtin_amdgcn_fmed3f(v0[0], -30.f, 30.f) * NL2E, t1 = __builtin_amdgcn_fmed3f(v0[1], -30.f, 30.f) * NL2E, t2 = __builtin_amdgcn_fmed3f(v0[2], -30.f, 30.f) * NL2E, t3 = __builtin_amdgcn_fmed3f(v0[3], -30.f, 30.f) * NL2E;
                        float t4 = __builtin_amdgcn_fmed3f(v1[0], -30.f, 30.f) * NL2E, t5 = __builtin_amdgcn_fmed3f(v1[1], -30.f, 30.f) * NL2E, t6 = __builtin_amdgcn_fmed3f(v1[2], -30.f, 30.f) * NL2E, t7 = __builtin_amdgcn_fmed3f(v1[3], -30.f, 30.f) * NL2E;
                        TRANS8("v_exp_f32", t);
                        u32x4 w; w.x = cvt_pk_bf16(t0 + 1.0f, t1 + 1.0f); w.y = cvt_pk_bf16(t2 + 1.0f, t3 + 1.0f); w.z = cvt_pk_bf16(t4 + 1.0f, t5 + 1.0f); w.w = cvt_pk_bf16(t6 + 1.0f, t7 + 1.0f);
                        *(u32x4*)(rowp + bj * HALF) = w; } }
        }
    }
};
struct EpiProjF { static constexpr bool PERM = true, HOOK = true; static constexpr int H1 = 16, H2 = 24;
    bf16_t* MRG; const bf16_t* Z2;
    __device__ __forceinline__ void khook(f32x4 (&acc)[2][2][4][2], const Unit& u, int t, int wr, int wc, int fr_, int fq_) const {
        int fr = fr_, fq = fq_; asm volatile("" : "+v"(fr), "+v"(fq));
        const int row0 = u.pm * BM + wr * 64 + fr, col0 = u.pn * BM + wc * 32 + 8 * fq; const int onum = (t == H1) ? Z2_MB : Z2_MC, oden = (t == H1) ? Z2_MA : Z2_MB;
#pragma unroll
        for (int ai = 0; ai < 2; ++ai) { u32x4 wn[4][2], wd[4][2];
#pragma unroll
            for (int m = 0; m < 4; ++m) { const bf16_t* rp = Z2 + (size_t)(row0 + ai * HALF + m * 16) * Z2W + col0;
#pragma unroll
                for (int bj = 0; bj < 2; ++bj) { wn[m][bj] = __builtin_nontemporal_load((const GAS u32x4*)(rp + onum + bj * HALF)); wd[m][bj] = __builtin_nontemporal_load((const GAS u32x4*)(rp + oden + bj * HALF)); } }
#pragma unroll
            for (int m = 0; m < 4; ++m)
#pragma unroll
                for (int bj = 0; bj < 2; ++bj) { const u32x4 a = wn[m][bj], b = wd[m][bj]; f32x4 r0, r1;
                    r0[0] = bflo(a.x) * __builtin_amdgcn_rcpf(bflo(b.x)); r0[1] = bfhi(a.x) * __builtin_amdgcn_rcpf(bfhi(b.x)); r0[2] = bflo(a.y) * __builtin_amdgcn_rcpf(bflo(b.y)); r0[3] = bfhi(a.y) * __builtin_amdgcn_rcpf(bfhi(b.y));
                    r1[0] = bflo(a.z) * __builtin_amdgcn_rcpf(bflo(b.z)); r1[1] = bfhi(a.z) * __builtin_amdgcn_rcpf(bfhi(b.z)); r1[2] = bflo(a.w) * __builtin_amdgcn_rcpf(bflo(b.w)); r1[3] = bfhi(a.w) * __builtin_amdgcn_rcpf(bfhi(b.w));
                    acc[ai][bj][m][0] = acc[ai][bj][m][0] * r0; acc[ai][bj][m][1] = acc[ai][bj][m][1] * r1; }
            asm volatile("" ::: "memory"); }
    }
    __device__ __forceinline__ void operator()(const f32x4 (&acc)[2][2][4][2], const Unit& u, int wr, int wc, int fr, int fq) const {
        const int row0 = u.pm * BM + wr * 64 + fr, col0 = u.pn * BM + wc * 32 + 8 * fq;
#pragma unroll
        for (int ai = 0; ai < 2; ++ai) { u32x4 wc_[4][2];
#pragma unroll
            for (int m = 0; m < 4; ++m)
#pragma unroll
                for (int bj = 0; bj < 2; ++bj) wc_[m][bj] = __builtin_nontemporal_load((const GAS u32x4*)(Z2 + (size_t)(row0 + ai * HALF + m * 16) * Z2W + Z2_MC + col0 + bj * HALF));
#pragma unroll
            for (int m = 0; m < 4; ++m)
#pragma unroll
                for (int bj = 0; bj < 2; ++bj) { const u32x4 c = wc_[m][bj]; const f32x4 v0 = acc[ai][bj][m][0], v1 = acc[ai][bj][m][1]; u32x4 w;
                    w.x = cvt_pk_bf16(v0[0] * __builtin_amdgcn_rcpf(bflo(c.x)), v0[1] * __builtin_amdgcn_rcpf(bfhi(c.x))); w.y = cvt_pk_bf16(v0[2] * __builtin_amdgcn_rcpf(bflo(c.y)), v0[3] * __builtin_amdgcn_rcpf(bfhi(c.y)));
                    w.z = cvt_pk_bf16(v1[0] * __builtin_amdgcn_rcpf(bflo(c.z)), v1[1] * __builtin_amdgcn_rcpf(bfhi(c.z))); w.w = cvt_pk_bf16(v1[2] * __builtin_amdgcn_rcpf(bflo(c.w)), v1[3] * __builtin_amdgcn_rcpf(bfhi(c.w)));
                    *(u32x4*)(MRG + (size_t)(row0 + ai * HALF + m * 16) * D + col0 + bj * HALF) = w; }
            asm volatile("" ::: "memory"); }
    }
};
}

struct CvItem { const float* W; bf16* dst; int ldw, k0, n0, ldk, drow0, dk0; };
__device__ __forceinline__ void transpose_load(const CvItem& I, float (&wv)[32], int lane) {
#pragma unroll
    for (int i = 0; i < 32; ++i) wv[i] = __builtin_nontemporal_load(I.W + (size_t)(I.k0 + 2 * i + (lane >> 5)) * I.ldw + I.n0 + (lane & 31));
}
__device__ __forceinline__ void transpose_store(const CvItem& I, const float (&wv)[32], LAS float* scr, int lane) {
#pragma unroll
    for (int i = 0; i < 32; ++i) scr[(2 * i + (lane >> 5)) * 33 + (lane & 31)] = wv[i];
    LDS_WAIT(); asm volatile("" ::: "memory");
    const int c = lane & 7;
#pragma unroll
    for (int j = 0; j < 4; ++j) { const int n = (lane >> 3) + 8 * j; const LAS float* s = scr + (8 * c) * 33 + n;
        v4u o; o.x = pk2(s[0 * 33], s[1 * 33]); o.y = pk2(s[2 * 33], s[3 * 33]); o.z = pk2(s[4 * 33], s[5 * 33]); o.w = pk2(s[6 * 33], s[7 * 33]);
        __builtin_nontemporal_store(o, (GAS v4u*)(I.dst + (size_t)(I.drow0 + n) * I.ldk + I.dk0 + I.k0 + 8 * c)); }
    LDS_WAIT(); asm volatile("" ::: "memory");
}

enum { IX = 0, IC, ICTX, ICCTX, IWMOD, IBMOD, INORMG, IFINALG, IWGATE, IWUP, IWDOWN, IWIN, ILB, IANORM, ILNG, ILNB, IWS, IBS, ICONV, IWPA, IWPB, IWPC, IWOUT };
#define INP(k) (kargs()->in[(k)])

constexpr int CV_I_FF = (D / 64) * (DFF / 32);
constexpr int CV_I_IN = (D / 64) * (INW / 32);
constexpr int CV_I_PA = (1024 / 64) * (D / 32), CV_I_PB = (512 / 64) * (D / 32);
constexpr int CV_I_WO = (D / 64) * (D / 32);
constexpr int CV_PER_L = 6 * CV_I_FF + CV_I_IN + CV_I_PA + 2 * CV_I_PB + CV_I_WO;
__device__ __forceinline__ CvItem cv_decode(int l, int r) {
    unsigned char* ws = kargs()->ws; CvItem I;
    if (r < 6 * CV_I_FF) { const int j = r / (3 * CV_I_FF); r %= 3 * CV_I_FF; const int which = r / CV_I_FF; r %= CV_I_FF; const size_t lj = (size_t)(l * 2 + j);
        if (which < 2) { const int nblk = DFF / 32, kb = r / nblk, nb = r % nblk, n0 = 32 * nb;
            I.W = (which == 0 ? INP(IWGATE) : INP(IWUP)) + lj * D * DFF; I.ldw = DFF; I.k0 = 64 * kb; I.n0 = n0; I.dst = (bf16*)(ws + WS_WGU) + lj * (size_t)(2 * DFF) * D; I.ldk = D; I.drow0 = 256 * (n0 >> 7) + (n0 & 127) + 128 * which; I.dk0 = 0;
        } else { const int nblk = D / 32, kb = r / nblk, nb = r % nblk;
            I.W = INP(IWDOWN) + lj * DFF * D; I.ldw = D; I.k0 = 64 * kb; I.n0 = 32 * nb; I.dst = (bf16*)(ws + WS_WD) + lj * (size_t)D * DFF; I.ldk = DFF; I.drow0 = 32 * nb; I.dk0 = 0; }
        return I; }
    r -= 6 * CV_I_FF;
    if (r < CV_I_IN) { const int nblk = INW / 32, kb = r / nblk, nb = r % nblk; I.W = INP(IWIN) + (size_t)l * D * INW; I.ldw = INW; I.k0 = 64 * kb; I.n0 = 32 * nb; I.dst = (bf16*)(ws + WS_WIN) + (size_t)l * INW * D; I.ldk = D; I.drow0 = 32 * nb; I.dk0 = 0; return I; }
    r -= CV_I_IN;
    bf16* WP = (bf16*)(ws + WS_WP) + (size_t)l * D * 2048; const int nblk = D / 32;
    if (r < CV_I_PA) { const int kb = r / nblk, nb = r % nblk; I.W = INP(IWPA) + (size_t)l * 1024 * D; I.ldw = D; I.k0 = 64 * kb; I.n0 = 32 * nb; I.dst = WP; I.ldk = 2048; I.drow0 = 32 * nb; I.dk0 = 0; return I; }
    r -= CV_I_PA;
    if (r < CV_I_PB) { const int kb = r / nblk, nb = r % nblk; I.W = INP(IWPB) + (size_t)l * 512 * D; I.ldw = D; I.k0 = 64 * kb; I.n0 = 32 * nb; I.dst = WP; I.ldk = 2048; I.drow0 = 32 * nb; I.dk0 = 1024; return I; }
    r -= CV_I_PB;
    if (r < CV_I_PB) { const int kb = r / nblk, nb = r % nblk; I.W = INP(IWPC) + (size_t)l * 512 * D; I.ldw = D; I.k0 = 64 * kb; I.n0 = 32 * nb; I.dst = WP; I.ldk = 2048; I.drow0 = 32 * nb; I.dk0 = 1536; return I; }
    r -= CV_I_PB;
    { const int kb = r / nblk, nb = r % nblk; I.W = INP(IWOUT) + (size_t)l * D * D; I.ldw = D; I.k0 = 64 * kb; I.n0 = 32 * nb; I.dst = (bf16*)(ws + WS_WO) + (size_t)l * D * D; I.ldk = D; I.drow0 = 32 * nb; I.dk0 = 0; }
    return I;
}
__device__ __forceinline__ void convert_run(int l, int first, int end, int stride, LAS float* scr, int lane) {
#pragma unroll 1
    for (int it = first; it < end; it += 2 * stride) { const bool two = it + stride < end;
        const CvItem A = cv_decode(l, it), B = cv_decode(l, two ? it + stride : it);
        float wa[32], wb[32];
        transpose_load(A, wa, lane); if (two) transpose_load(B, wb, lane);
        transpose_store(A, wa, scr, lane); if (two) transpose_store(B, wb, scr, lane); }
}
constexpr int CV_Q_GU = 64, CV_Q_IN = 64, CV_Q_PJ = 96;
__device__ __forceinline__ int cv_nidle(int nwg, int G) { const int rem = nwg % G; return rem ? G - rem : 0; }
__device__ __forceinline__ int cv_base(int slot, int G) {
    const int n_gu = cv_nidle((M / 256) * (2 * DFF / 256), G), n_in = cv_nidle(64 * 54 + 4 * 54, G), n_pj = cv_nidle((M / 256) * (D / 256), G);
    int b = 0; if (slot > 0) b += n_gu * CV_Q_GU; if (slot > 1) b += n_in * CV_Q_IN; if (slot > 2) b += n_pj * CV_Q_PJ; if (slot > 3) b += n_gu * CV_Q_GU; return b < CV_PER_L ? b : CV_PER_L;
}
__device__ __forceinline__ void convert_slot(int l, int slot, int nwg, int q) {
    int G = gridDim.x, c = blockIdx.x; asm volatile("" : "+s"(G), "+s"(c));
    const int rem = nwg % G; if (rem == 0 || c < rem) return;
    const Frame F = mkframe(); LAS float* scr = (LAS float*)(F.lds + F.wave * 16384);
    const int first = cv_base(slot, G) + (c - rem) * q; int end = first + q; if (end > CV_PER_L) end = CV_PER_L;
    convert_run(l, first + F.wave, end, 8, scr, F.lane);
}
__device__ __forceinline__ void convert_rest(int l) {
    const Frame F = mkframe(); LAS float* scr = (LAS float*)(F.lds + F.wave * 16384);
    const int gw = F.vcu * 8 + F.wave, NGW = F.G * 8;
    convert_run(l, cv_base(4, F.G) + gw, CV_PER_L, NGW, scr, F.lane);
}

__device__ __forceinline__ void phase_prologue() {
    const Frame F = mkframe(); unsigned char* ws = F.ws;
    const int gw = F.vcu * 8 + F.wave, NGW = F.G * 8;
    { ytype* Y = (ytype*)(ws + WS_Y);
      for (int m = gw; m < M; m += NGW) { const float* src = m < M_LAT ? INP(IX) + (size_t)m * D : INP(ICTX) + (size_t)(m - M_LAT) * D; const GAS f32x4* s = (const GAS f32x4*)src + F.lane;
#pragma unroll
          for (int j = 0; j < 8; ++j) y_st4(Y + (size_t)m * D + 4 * (64 * j + F.lane), s[64 * j]); } }
    if (blockIdx.x == 0) { float* LB = (float*)(ws + WS_LB);
        for (int i = F.tid; i < 2 * WK; i += 512) { float lg[DEPTH], mx = -1e30f;
#pragma unroll
            for (int l = 0; l < DEPTH; ++l) { lg[l] = INP(ILB)[l * 2 * WK + i]; mx = fmaxf(mx, lg[l]); }
            float s = 0.f;
#pragma unroll
            for (int l = 0; l < DEPTH; ++l) { lg[l] = __expf(lg[l] - mx); s += lg[l]; }
            float cum = 0.f; const float inv = 1.0f / s;
#pragma unroll
            for (int l = 0; l < DEPTH; ++l) { LB[l * 2 * WK + i] = cum; if (l + 1 < DEPTH) cum += lg[l + 1] * inv; } } }
    { LAS float* sc = (LAS float*)F.lds;
      LAS float* red = (LAS float*)(F.lds + 5 * D * 4);
      for (int i = F.tid; i < NGRP * D; i += 512) { const int g = i / D, k = i % D; const float v = g < 4 ? INP(IC)[g * D + k] : INP(ICCTX)[k]; sc[i] = siluf_(v); }
      __syncthreads();
      float* MOD = (float*)(ws + WS_MOD);
      constexpr int NU = DEPTH * (MODW / 128);
      for (int u = F.vcu; u < NU; u += F.G) { const int l = u / (MODW / 128), n0 = (u % (MODW / 128)) * 128;
          const float* Wp = INP(IWMOD) + (size_t)l * D * MODW + n0 + 2 * F.lane;
          float a0[NGRP], a1[NGRP];
#pragma unroll
          for (int g = 0; g < NGRP; ++g) { a0[g] = 0.f; a1[g] = 0.f; }
          const int kb = F.wave * 256;
#pragma unroll 16
          for (int k = kb; k < kb + 256; ++k) { typedef float f32x2v __attribute__((ext_vector_type(2))); const f32x2v w = __builtin_nontemporal_load((const GAS f32x2v*)(Wp + (size_t)k * MODW));
#pragma unroll
              for (int g = 0; g < NGRP; ++g) { const float s = sc[g * D + k]; a0[g] += s * w.x; a1[g] += s * w.y; } }
#pragma unroll
          for (int g = 0; g < NGRP; ++g) { red[(F.wave * NGRP + g) * 128 + 2 * F.lane] = a0[g]; red[(F.wave * NGRP + g) * 128 + 2 * F.lane + 1] = a1[g]; }
          __syncthreads();
          for (int i = F.tid; i < NGRP * 128; i += 512) { const int g = i / 128, n = i % 128; float s = 0.f;
#pragma unroll
              for (int w = 0; w < 8; ++w) s += red[(w * NGRP + g) * 128 + n];
              MOD[((size_t)l * NGRP + g) * MODW + n0 + n] = s + INP(IBMOD)[l * MODW + n0 + n]; }
          __syncthreads(); }
    }
    __syncthreads();
    { LAS float* scr = (LAS float*)(F.lds + F.wave * 16384);
      convert_run(0, gw, CV_PER_L, NGW, scr, F.lane); }
}

__device__ __forceinline__ float wave_sum_fast(float x) {
    x = row16_sum(x);
    const float a = __builtin_bit_cast(float, __builtin_amdgcn_readlane(__builtin_bit_cast(int, x), 0)), b = __builtin_bit_cast(float, __builtin_amdgcn_readlane(__builtin_bit_cast(int, x), 16));
    const float c = __builtin_bit_cast(float, __builtin_amdgcn_readlane(__builtin_bit_cast(int, x), 32)), d = __builtin_bit_cast(float, __builtin_amdgcn_readlane(__builtin_bit_cast(int, x), 48));
    return (a + b) + (c + d);
}
__device__ __forceinline__ void phase_norm(int l, int which, int mlim, int red, int rgate_l, int rgate_idx, float rcoef) {
    const Frame F = mkframe(); ytype* Y = (ytype*)(F.ws + WS_Y); bf16* H = (bf16*)(F.ws + WS_H);
    const float* g = INP(INORMG) + (size_t)(l * 3 + which) * D; const float* mod_l = (const float*)(F.ws + WS_MOD) + (size_t)l * NGRP * MODW; const int shift_idx = 3 * which;
    const int gw = F.vcu * 8 + F.wave, NGW = F.G * 8, lane = F.lane;
    typedef pg8::eh16x8 h8; typedef pg8::ef32x8 f8;
    f32x4 gs[4][2], sh[4][2];
    auto load_vecs = [&](int grp) { const float* mp = mod_l + (size_t)grp * MODW + shift_idx * D;
#pragma unroll
        for (int j = 0; j < 4; ++j)
#pragma unroll
            for (int e = 0; e < 2; ++e) { const int c = 8 * lane + 512 * j + 4 * e; gs[j][e] = *(const GAS f32x4*)(g + c) * (1.0f + *(const GAS f32x4*)(mp + D + c)); sh[j][e] = *(const GAS f32x4*)(mp + c); } };
    auto finish_row = [&](int m, f8 (&v)[4]) { float ss = 0.f;
#pragma unroll
        for (int j = 0; j < 4; ++j)
#pragma unroll
            for (int e = 0; e < 8; ++e) ss += v[j][e] * v[j][e];
        const float rstd = 1.0f / sqrtf(wave_sum_fast(ss) * (1.0f / D) + EPS);
#pragma unroll
        for (int j = 0; j < 4; ++j) { v4u o; const f32x4 a = (f32x4){v[j][0], v[j][1], v[j][2], v[j][3]} * rstd * gs[j][0] + sh[j][0], b = (f32x4){v[j][4], v[j][5], v[j][6], v[j][7]} * rstd * gs[j][1] + sh[j][1];
            o.x = pk2(a[0], a[1]); o.y = pk2(a[2], a[3]); o.z = pk2(b[0], b[1]); o.w = pk2(b[2], b[3]); *(GAS v4u*)(H + (size_t)m * D + 8 * lane + 512 * j) = o; } };
    if (NGW * 8 == M_LAT) {
        load_vecs(gw >> 9);
        h8 cur[4], nxt[4];
#pragma unroll
        for (int j = 0; j < 4; ++j) cur[j] = *(const GAS h8*)(Y + (size_t)(8 * gw) * D + 8 * lane + 512 * j);
#pragma unroll 1
        for (int r = 0; r < 8; ++r) { const int m = 8 * gw + r, mn = r < 7 ? m + 1 : m;
#pragma unroll
            for (int j = 0; j < 4; ++j) nxt[j] = *(const GAS h8*)(Y + (size_t)mn * D + 8 * lane + 512 * j);
            f8 v[4];
#pragma unroll
            for (int j = 0; j < 4; ++j) v[j] = __builtin_convertvector(cur[j], f8);
            finish_row(m, v);
#pragma unroll
            for (int j = 0; j < 4; ++j) cur[j] = nxt[j]; }
    } else {
        for (int m = gw; m < M_LAT; m += NGW) { load_vecs(m >> 12); f8 v[4];
#pragma unroll
            for (int j = 0; j < 4; ++j) v[j] = __builtin_convertvector(*(const GAS h8*)(Y + (size_t)m * D + 8 * lane + 512 * j), f8);
            finish_row(m, v); } }
    if (mlim > M_LAT) {
        load_vecs(4);
        for (int m = M_LAT + (gw >> 1) + ((gw & 1) ? (NGW >> 1) : 0); m < mlim; m += NGW) { f8 v[4];
#pragma unroll
            for (int j = 0; j < 4; ++j) v[j] = __builtin_convertvector(*(const GAS h8*)(Y + (size_t)m * D + 8 * lane + 512 * j), f8);
            if (red) { const _Float16* sl = (const _Float16*)(F.ws + WS_MF32) + (size_t)(m - M_LAT) * D; const float* rg = (const float*)(F.ws + WS_MOD) + ((size_t)rgate_l * NGRP + 4) * MODW + rgate_idx * D;
#pragma unroll
                for (int jh = 0; jh < 2; ++jh) { h8 part[2][8];
#pragma unroll
                    for (int jj = 0; jj < 2; ++jj)
#pragma unroll
                        for (int p = 0; p < 8; ++p) part[jj][p] = *(const GAS h8*)(sl + (size_t)p * M_CTX * D + 8 * lane + 512 * (2 * jh + jj));
#pragma unroll
                    for (int jj = 0; jj < 2; ++jj) { const int j = 2 * jh + jj, c = 8 * lane + 512 * j; f8 a = __builtin_convertvector(part[jj][0], f8);
#pragma unroll
                        for (int p = 1; p < 8; ++p) a = a + __builtin_convertvector(part[jj][p], f8);
                        const f32x4 g0 = *(const GAS f32x4*)(rg + c) * rcoef, g1 = *(const GAS f32x4*)(rg + c + 4) * rcoef;
#pragma unroll
                        for (int e = 0; e < 4; ++e) { v[j][e] += g0[e] * a[e]; v[j][4 + e] += g1[e] * a[4 + e]; }
                        *(GAS h8*)(Y + (size_t)m * D + c) = __builtin_convertvector(v[j], h8); }
                    asm volatile("" ::: "memory"); } }
            finish_row(m, v); } }
}

__device__ __forceinline__ void phase_final() {
    const Frame F = mkframe(); const ytype* Y = (const ytype*)(F.ws + WS_Y); float* out = kargs()->out; const float* g = INP(IFINALG);
    const int gw = F.vcu * 8 + F.wave, NGW = F.G * 8, lane = F.lane;
    typedef pg8::eh16x8 h8; typedef pg8::ef32x8 f8;
    f32x4 gs[4][2];
#pragma unroll
    for (int j = 0; j < 4; ++j)
#pragma unroll
        for (int e = 0; e < 2; ++e) gs[j][e] = *(const GAS f32x4*)(g + 8 * lane + 512 * j + 4 * e);
    const int per = (M_LAT + NGW - 1) / NGW, m0 = gw * per, m1 = (m0 + per < M_LAT) ? m0 + per : M_LAT;
    if (m0 >= m1) return;
    h8 cur[4], nxt[4];
#pragma unroll
    for (int j = 0; j < 4; ++j) cur[j] = *(const GAS h8*)(Y + (size_t)m0 * D + 8 * lane + 512 * j);
#pragma unroll 1
    for (int m = m0; m < m1; ++m) { const int mn = m + 1 < m1 ? m + 1 : m;
#pragma unroll
        for (int j = 0; j < 4; ++j) nxt[j] = *(const GAS h8*)(Y + (size_t)mn * D + 8 * lane + 512 * j);
        f8 v[4]; float ss = 0.f;
#pragma unroll
        for (int j = 0; j < 4; ++j) { v[j] = __builtin_convertvector(cur[j], f8);
#pragma unroll
            for (int e = 0; e < 8; ++e) ss += v[j][e] * v[j][e]; }
        const float rstd = 1.0f / sqrtf(wave_sum_fast(ss) * (1.0f / D) + EPS);
#pragma unroll
        for (int j = 0; j < 4; ++j) { float* o = out + (size_t)m * D + 8 * lane + 512 * j;
            *(GAS f32x4*)o = (f32x4){v[j][0], v[j][1], v[j][2], v[j][3]} * rstd * gs[j][0]; *(GAS f32x4*)(o + 4) = (f32x4){v[j][4], v[j][5], v[j][6], v[j][7]} * rstd * gs[j][1]; }
#pragma unroll
        for (int j = 0; j < 4; ++j) cur[j] = nxt[j]; }
}

struct ElemC { float lg[8], lbv[8], cw0[8], cw1[8], cw2[8]; };
__device__ __forceinline__ void elem_vn(const v4u raw, const ElemC& C, bf16* VN, int m, int lane) {
    float x[8];
    x[0] = gelu_tanh(bflo(raw.x)); x[1] = gelu_tanh(bfhi(raw.x)); x[2] = gelu_tanh(bflo(raw.y)); x[3] = gelu_tanh(bfhi(raw.y));
    x[4] = gelu_tanh(bflo(raw.z)); x[5] = gelu_tanh(bfhi(raw.z)); x[6] = gelu_tanh(bflo(raw.w)); x[7] = gelu_tanh(bfhi(raw.w));
    float s = 0.f;
#pragma unroll
    for (int e = 0; e < 8; ++e) s += x[e];
    const float mean = wave_sum_fast(s) * (1.0f / BW); float q = 0.f;
#pragma unroll
    for (int e = 0; e < 8; ++e) { x[e] -= mean; q += x[e] * x[e]; }
    const float rstd = 1.0f / sqrtf(wave_sum_fast(q) * (1.0f / BW) + EPS); float y[8];
#pragma unroll
    for (int e = 0; e < 8; ++e) y[e] = x[e] * rstd * C.lg[e] + C.lbv[e];
    v4u o; o.x = pk2(y[0], y[1]); o.y = pk2(y[2], y[3]); o.z = pk2(y[4], y[5]); o.w = pk2(y[6], y[7]);
    *(GAS v4u*)(VN + (size_t)m * BW + 8 * lane) = o;
}
__device__ __forceinline__ void elem_t(const v4u hc, const v4u gc, float zz, float (&t)[8]) {
    t[0] = zz * bflo(hc.x) * bflo(gc.x); t[1] = zz * bfhi(hc.x) * bfhi(gc.x); t[2] = zz * bflo(hc.y) * bflo(gc.y); t[3] = zz * bfhi(hc.y) * bfhi(gc.y);
    t[4] = zz * bflo(hc.z) * bflo(gc.z); t[5] = zz * bfhi(hc.z) * bfhi(gc.z); t[6] = zz * bflo(hc.w) * bflo(gc.w); t[7] = zz * bfhi(hc.w) * bfhi(gc.w);
}
__device__ __forceinline__ void elem_conv(const float (&t0)[8], const float (&t1)[8], const float (&t2)[8], const v4u gbr, const ElemC& C, bf16* YABC, int m, int lane) {
    float gb[8], y[8];
    gb[0] = bflo(gbr.x); gb[1] = bfhi(gbr.x); gb[2] = bflo(gbr.y); gb[3] = bfhi(gbr.y); gb[4] = bflo(gbr.z); gb[5] = bfhi(gbr.z); gb[6] = bflo(gbr.w); gb[7] = bfhi(gbr.w);
#pragma unroll
    for (int e = 0; e < 8; ++e) y[e] = gb[e] * (C.cw0[e] * t0[e] + C.cw1[e] * t1[e] + C.cw2[e] * t2[e]);
    v4u o; o.x = pk2(y[0], y[1]); o.y = pk2(y[2], y[3]); o.z = pk2(y[4], y[5]); o.w = pk2(y[6], y[7]);
    *(GAS v4u*)(YABC + (size_t)m * 2048 + 1536 + 8 * lane) = o;
}
__device__ __forceinline__ void elem_row(const bf16* Z2, const ElemC& C, bf16* VN, bf16* YABC, int m, int lane) {
    bool hp, hn; if (m < M_LAT) { const int p = m & 63; hp = p != 0; hn = p != 63; } else { const int p = (m - M_LAT) & 255; hp = p != 0; hn = p != 255; }
    const size_t mp = (size_t)(hp ? m - 1 : m), mn = (size_t)(hn ? m + 1 : m);
    const v4u raw = *(const GAS v4u*)(Z2 + (size_t)m * Z2W + Z2_V + 8 * lane);
    const v4u hc0 = *(const GAS v4u*)(Z2 + mp * Z2W + Z2_HC + 8 * lane), gc0 = *(const GAS v4u*)(Z2 + mp * Z2W + Z2_GC + 8 * lane);
    const v4u hc1 = *(const GAS v4u*)(Z2 + (size_t)m * Z2W + Z2_HC + 8 * lane), gc1 = *(const GAS v4u*)(Z2 + (size_t)m * Z2W + Z2_GC + 8 * lane);
    const v4u hc2 = *(const GAS v4u*)(Z2 + mn * Z2W + Z2_HC + 8 * lane), gc2 = *(const GAS v4u*)(Z2 + mn * Z2W + Z2_GC + 8 * lane);
    const v4u gbr = *(const GAS v4u*)(Z2 + (size_t)m * Z2W + Z2_GB + 8 * lane);
    elem_vn(raw, C, VN, m, lane);
    float t0[8], t1[8], t2[8]; elem_t(hc0, gc0, hp ? 1.0f : 0.0f, t0); elem_t(hc1, gc1, 1.0f, t1); elem_t(hc2, gc2, hn ? 1.0f : 0.0f, t2);
    elem_conv(t0, t1, t2, gbr, C, YABC, m, lane);
}
__device__ __forceinline__ void phase_mix_elem(int l) {
    const Frame F = mkframe(); unsigned char* ws = F.ws;
    const bf16* Z2 = (const bf16*)(ws + WS_Z2);
    bf16* VN = (bf16*)(ws + WS_VN); bf16* YABC = (bf16*)(ws + WS_YABC);
    const int gw = F.vcu * 8 + F.wave, NGW = F.G * 8, lane = F.lane;
    ElemC C;
    { const float* gp = INP(ILNG) + l * BW + 8 * lane; const float* bp = INP(ILNB) + l * BW + 8 * lane; const float* cw = INP(ICONV) + (size_t)l * 3 * CWD + 8 * lane;
#pragma unroll
      for (int e = 0; e < 8; ++e) { C.lg[e] = gp[e]; C.lbv[e] = bp[e]; C.cw0[e] = cw[e]; C.cw1[e] = cw[CWD + e]; C.cw2[e] = cw[2 * CWD + e]; } }
    if (NGW * 8 == M_LAT) {
#pragma unroll 1
        for (int h = 0; h < 4; ++h) { const int r0 = 8 * gw + 2 * h; const bool vp = (r0 & 63) != 0, vn = ((r0 + 1) & 63) != 63;
            v4u hc[4], gc[4], vv[2], gb[2];
#pragma unroll
            for (int i = 0; i < 4; ++i) { const int row = (i == 0 && !vp) ? r0 : (i == 3 && !vn) ? r0 + 1 : r0 - 1 + i;
                hc[i] = *(const GAS v4u*)(Z2 + (size_t)row * Z2W + Z2_HC + 8 * lane); gc[i] = *(const GAS v4u*)(Z2 + (size_t)row * Z2W + Z2_GC + 8 * lane); }
#pragma unroll
            for (int i = 0; i < 2; ++i) { vv[i] = *(const GAS v4u*)(Z2 + (size_t)(r0 + i) * Z2W + Z2_V + 8 * lane); gb[i] = *(const GAS v4u*)(Z2 + (size_t)(r0 + i) * Z2W + Z2_GB + 8 * lane); }
            float t[4][8];
#pragma unroll
            for (int i = 0; i < 4; ++i) elem_t(hc[i], gc[i], (i == 0 && !vp) || (i == 3 && !vn) ? 0.0f : 1.0f, t[i]);
#pragma unroll
            for (int i = 0; i < 2; ++i) { elem_vn(vv[i], C, VN, r0 + i, lane); elem_conv(t[i], t[i + 1], t[i + 2], gb[i], C, YABC, r0 + i, lane); } }
    } else {
        for (int m = gw; m < M_LAT; m += NGW) elem_row(Z2, C, VN, YABC, m, lane); }
    for (int m = M_LAT + (gw >> 1) + ((gw & 1) ? (NGW >> 1) : 0); m < M; m += NGW) elem_row(Z2, C, VN, YABC, m, lane);
}

template <int N> __device__ __forceinline__ float row_shl1(float v) { return __builtin_bit_cast(float, __builtin_amdgcn_update_dpp(0x3f800000, __builtin_bit_cast(int, v), 0x100 + N, 0xf, 0xf, false)); }
template <int N> __device__ __forceinline__ float row_shr1(float v) { return __builtin_bit_cast(float, __builtin_amdgcn_update_dpp(0x3f800000, __builtin_bit_cast(int, v), 0x110 + N, 0xf, 0xf, false)); }
template <int N> __device__ __forceinline__ float row_shr(float v) { return __builtin_bit_cast(float, __builtin_amdgcn_update_dpp(0, __builtin_bit_cast(int, v), 0x110 + N, 0xf, 0xf, true)); }
__device__ __forceinline__ float row16_prod(float x) { x *= dppf<0xB1>(x); x *= dppf<0x4E>(x); x *= dppf<0x124>(x); x *= dppf<0x128>(x); return x; }
__device__ __forceinline__ void phase_hgrn_prep(int l) {
    const Frame F = mkframe(); unsigned char* ws = F.ws;
    const _Float16* ZF = (const _Float16*)(ws + WS_ZF); const bf16* QS = (const bf16*)(ws + WS_QS); const float* LB = (const float*)(ws + WS_LB) + (size_t)l * 2 * WK;
    const int gw = F.vcu * 8 + F.wave, NGW = F.G * 8, lane = F.lane, fr = lane & 15, cq = lane >> 4;
    constexpr int NIT = (M / 32) * 32;
    const int per = (NIT + NGW - 1) / NGW, it0 = gw * per, it1 = (it0 + per < NIT) ? it0 + per : NIT;
#pragma unroll 2
    for (int it = it0; it < it1; ++it) { const int sc = it >> 5, jj = it & 31; const size_t rlo = (size_t)sc * 32 + fr, rhi = rlo + 16; const int c0 = 32 * jj + 8 * cq;
        const v4u qlo_r = *(const GAS v4u*)(QS + rlo * WK + c0), qhi_r = *(const GAS v4u*)(QS + rhi * WK + c0);
        const float qlo[8] = {bflo(qlo_r.x), bfhi(qlo_r.x), bflo(qlo_r.y), bfhi(qlo_r.y), bflo(qlo_r.z), bfhi(qlo_r.z), bflo(qlo_r.w), bfhi(qlo_r.w)};
        const float qhi[8] = {bflo(qhi_r.x), bfhi(qhi_r.x), bflo(qhi_r.y), bfhi(qhi_r.y), bflo(qhi_r.z), bfhi(qhi_r.z), bflo(qhi_r.w), bfhi(qhi_r.w)};
#pragma unroll
        for (int dir = 0; dir < 2; ++dir) {
            const pg8::ef32x8 zlo = __builtin_convertvector(*(const GAS pg8::eh16x8*)(ZF + rlo * 2048 + dir * WK + c0), pg8::ef32x8), zhi = __builtin_convertvector(*(const GAS pg8::eh16x8*)(ZF + rhi * 2048 + dir * WK + c0), pg8::ef32x8);
            const f32x4 b0 = *(const GAS f32x4*)(LB + dir * WK + c0), b1 = *(const GAS f32x4*)(LB + dir * WK + c0 + 4);
            float qtl[8], qth[8], ktl[8], kth[8], gt[8];
            float fl0, fl1, fl2, fl3, fl4, fl5, fl6, fl7, fh0, fh1, fh2, fh3, fh4, fh5, fh6, fh7;
#define HP_F(e_, dl, dh) { const float lb = (e_) < 4 ? b0[(e_) & 3] : b1[(e_) & 3]; const float oml = 1.0f - lb; dl = fmaxf(__builtin_fmaf(oml, __builtin_amdgcn_rcpf(1.0f + __builtin_amdgcn_exp2f(zlo[e_])), lb), 1e-30f); dh = fmaxf(__builtin_fmaf(oml, __builtin_amdgcn_rcpf(1.0f + __builtin_amdgcn_exp2f(zhi[e_])), lb), 1e-30f); }
            HP_F(0, fl0, fh0) HP_F(1, fl1, fh1) HP_F(2, fl2, fh2) HP_F(3, fl3, fh3) HP_F(4, fl4, fh4) HP_F(5, fl5, fh5) HP_F(6, fl6, fh6) HP_F(7, fl7, fh7)
#undef HP_F
#define HP_STEP(ctrl) "v_mul_f32_dpp %0, %0, %0 " ctrl " row_mask:0xf bank_mask:0xf\n\tv_mul_f32_dpp %1, %1, %1 " ctrl " row_mask:0xf bank_mask:0xf\n\tv_mul_f32_dpp %2, %2, %2 " ctrl " row_mask:0xf bank_mask:0xf\n\t" \
                      "v_mul_f32_dpp %3, %3, %3 " ctrl " row_mask:0xf bank_mask:0xf\n\tv_mul_f32_dpp %4, %4, %4 " ctrl " row_mask:0xf bank_mask:0xf\n\tv_mul_f32_dpp %5, %5, %5 " ctrl " row_mask:0xf bank_mask:0xf\n\t" \
                      "v_mul_f32_dpp %6, %6, %6 " ctrl " row_mask:0xf bank_mask:0xf\n\tv_mul_f32_dpp %7, %7, %7 " ctrl " row_mask:0xf bank_mask:0xf\n\t"
#define HP_OPS8(a) "+v"(a##0), "+v"(a##1), "+v"(a##2), "+v"(a##3), "+v"(a##4), "+v"(a##5), "+v"(a##6), "+v"(a##7)
#define HP_PROD8(a) asm("s_nop 1\n\t" HP_STEP("quad_perm:[1,0,3,2]") HP_STEP("quad_perm:[2,3,0,1]") HP_STEP("row_ror:4") HP_STEP("row_ror:8") "s_nop 1" : HP_OPS8(a))
#define HP_SCANL8(a) asm("s_nop 1\n\t" HP_STEP("row_shl:1") HP_STEP("row_shl:2") HP_STEP("row_shl:4") HP_STEP("row_shl:8") "s_nop 1" : HP_OPS8(a))
#define HP_SCANR8(a) asm("s_nop 1\n\t" HP_STEP("row_shr:1") HP_STEP("row_shr:2") HP_STEP("row_shr:4") HP_STEP("row_shr:8") "s_nop 1" : HP_OPS8(a))
#define HP_FIN8(ctrl, X, p, m) asm("s_nop 1\n\t" \
                "v_mul_f32_dpp %0, %8, %16 " ctrl " row_mask:0xf bank_mask:0xf\n\tv_mul_f32_dpp %1, %9, %17 " ctrl " row_mask:0xf bank_mask:0xf\n\tv_mul_f32_dpp %2, %10, %18 " ctrl " row_mask:0xf bank_mask:0xf\n\t" \
                "v_mul_f32_dpp %3, %11, %19 " ctrl " row_mask:0xf bank_mask:0xf\n\tv_mul_f32_dpp %4, %12, %20 " ctrl " row_mask:0xf bank_mask:0xf\n\tv_mul_f32_dpp %5, %13, %21 " ctrl " row_mask:0xf bank_mask:0xf\n\t" \
                "v_mul_f32_dpp %6, %14, %22 " ctrl " row_mask:0xf bank_mask:0xf\n\tv_mul_f32_dpp %7, %15, %23 " ctrl " row_mask:0xf bank_mask:0xf\n\ts_nop 1" \
                : "+&v"(X##0), "+&v"(X##1), "+&v"(X##2), "+&v"(X##3), "+&v"(X##4), "+&v"(X##5), "+&v"(X##6), "+&v"(X##7) : "v"(p##0), "v"(p##1), "v"(p##2), "v"(p##3), "v"(p##4), "v"(p##5), "v"(p##6), "v"(p##7), "v"(m##0), "v"(m##1), "v"(m##2), "v"(m##3), "v"(m##4), "v"(m##5), "v"(m##6), "v"(m##7))
            float tl0 = fl0, tl1 = fl1, tl2 = fl2, tl3 = fl3, tl4 = fl4, tl5 = fl5, tl6 = fl6, tl7 = fl7, th0 = fh0, th1 = fh1, th2 = fh2, th3 = fh3, th4 = fh4, th5 = fh5, th6 = fh6, th7 = fh7;
            HP_PROD8(tl); HP_PROD8(th);
            float pl0 = fl0, pl1 = fl1, pl2 = fl2, pl3 = fl3, pl4 = fl4, pl5 = fl5, pl6 = fl6, pl7 = fl7, ph0 = fh0, ph1 = fh1, ph2 = fh2, ph3 = fh3, ph4 = fh4, ph5 = fh5, ph6 = fh6, ph7 = fh7;
            const float one0 = 1.0f, one1 = 1.0f, one2 = 1.0f, one3 = 1.0f, one4 = 1.0f, one5 = 1.0f, one6 = 1.0f, one7 = 1.0f;
            float Xl0, Xl1, Xl2, Xl3, Xl4, Xl5, Xl6, Xl7, Xh0, Xh1, Xh2, Xh3, Xh4, Xh5, Xh6, Xh7;
            if (dir == 0) { HP_SCANL8(pl); HP_SCANL8(ph);
                Xl0 = th0; Xl1 = th1; Xl2 = th2; Xl3 = th3; Xl4 = th4; Xl5 = th5; Xl6 = th6; Xl7 = th7; HP_FIN8("row_shl:1", Xl, pl, th);
                Xh0 = 1.0f; Xh1 = 1.0f; Xh2 = 1.0f; Xh3 = 1.0f; Xh4 = 1.0f; Xh5 = 1.0f; Xh6 = 1.0f; Xh7 = 1.0f; HP_FIN8("row_shl:1", Xh, ph, one); }
            else { HP_SCANR8(pl); HP_SCANR8(ph);
                Xl0 = 1.0f; Xl1 = 1.0f; Xl2 = 1.0f; Xl3 = 1.0f; Xl4 = 1.0f; Xl5 = 1.0f; Xl6 = 1.0f; Xl7 = 1.0f; HP_FIN8("row_shr:1", Xl, pl, one);
                Xh0 = tl0; Xh1 = tl1; Xh2 = tl2; Xh3 = tl3; Xh4 = tl4; Xh5 = tl5; Xh6 = tl6; Xh7 = tl7; HP_FIN8("row_shr:1", Xh, ph, tl); }
#define HP_OUT(e_) ktl[e_] = __builtin_fmaf(-fl##e_, Xl##e_, Xl##e_); kth[e_] = __builtin_fmaf(-fh##e_, Xh##e_, Xh##e_); qtl[e_] = qlo[e_] * __builtin_amdgcn_rcpf(fmaxf(Xl##e_, 1e-35f)); qth[e_] = qhi[e_] * __builtin_amdgcn_rcpf(fmaxf(Xh##e_, 1e-35f)); gt[e_] = tl##e_ * th##e_;
            HP_OUT(0) HP_OUT(1) HP_OUT(2) HP_OUT(3) HP_OUT(4) HP_OUT(5) HP_OUT(6) HP_OUT(7)
#undef HP_OUT
#undef HP_FIN8
#undef HP_SCANR8
#undef HP_SCANL8
#undef HP_PROD8
#undef HP_OPS8
#undef HP_STEP
            bf16* Qd = (bf16*)(ws + (dir ? WS_QB : WS_QF)); bf16* Kd = (bf16*)(ws + (dir ? WS_KB : WS_KF)); float* Gd = (float*)(ws + (dir ? WS_GB : WS_GF));
            v4u o; o.x = pk2(qtl[0], qtl[1]); o.y = pk2(qtl[2], qtl[3]); o.z = pk2(qtl[4], qtl[5]); o.w = pk2(qtl[6], qtl[7]); *(GAS v4u*)(Qd + rlo * WK + c0) = o;
            o.x = pk2(qth[0], qth[1]); o.y = pk2(qth[2], qth[3]); o.z = pk2(qth[4], qth[5]); o.w = pk2(qth[6], qth[7]); *(GAS v4u*)(Qd + rhi * WK + c0) = o;
            o.x = pk2(ktl[0], ktl[1]); o.y = pk2(ktl[2], ktl[3]); o.z = pk2(ktl[4], ktl[5]); o.w = pk2(ktl[6], ktl[7]); *(GAS v4u*)(Kd + rlo * WK + c0) = o;
            o.x = pk2(kth[0], kth[1]); o.y = pk2(kth[2], kth[3]); o.z = pk2(kth[4], kth[5]); o.w = pk2(kth[6], kth[7]); *(GAS v4u*)(Kd + rhi * WK + c0) = o;
            if (fr == 0) { *(GAS f32x4*)(Gd + (size_t)sc * WK + c0) = (f32x4){gt[0], gt[1], gt[2], gt[3]}; *(GAS f32x4*)(Gd + (size_t)sc * WK + c0 + 4) = (f32x4){gt[4], gt[5], gt[6], gt[7]}; }
        } }
}

typedef short s16x4 __attribute__((ext_vector_type(4)));
typedef short hb16x8 __attribute__((ext_vector_type(8)));
constexpr int HG_P = 272;
constexpr int HG_QI = 0, HG_KI = 32 * HG_P, HG_VI = 64 * HG_P, HG_GI = 96 * HG_P, HG_BUF = 96 * HG_P + 512 + 256;
constexpr int HG_NSTEP = (CTXL + SEQ) / 32, HG_NSEG = 4, HG_SEGLEN = HG_NSTEP / HG_NSEG, HG_NCTX = CTXL / 32;
static_assert(HG_SEGLEN * HG_NSEG == HG_NSTEP && HG_SEGLEN % 2 == 0, "segment loop below is unrolled by 2");
__device__ __forceinline__ int hg_row0(int s, int cstep, int cbase, int lbase2) { return cstep * s + (s < HG_NCTX ? cbase : lbase2); }
struct HgReg { v4u a, b, c, d; };
template <bool FULL> __device__ __forceinline__ void hg_gload(HgReg& R, int r0, const bf16* Qp, const bf16* Kp, const bf16* Vp, const float* Gp, int tid) {
    const int row = tid >> 4, ch = tid & 15; const size_t o = (size_t)(r0 + row) * WK + 8 * ch;
    if (FULL) R.a = *(const GAS v4u*)(Qp + o);
    R.b = *(const GAS v4u*)(Kp + o); R.c = *(const GAS v4u*)(Vp + o);
    R.d = *(const GAS v4u*)(Gp + (size_t)(r0 >> 5) * WK + 4 * (tid & 31));
}
template <bool FULL> __device__ __forceinline__ void hg_lwrite(const HgReg& R, LAS unsigned char* buf, int tid) {
    const int row = tid >> 4, ch = tid & 15;
    if (FULL) *(LAS v4u*)(buf + HG_QI + row * HG_P + 16 * ch) = R.a;
    *(LAS v4u*)(buf + HG_KI + row * HG_P + 16 * ch) = R.b; *(LAS v4u*)(buf + HG_VI + row * HG_P + 16 * ch) = R.c;
    if (tid < 32) *(LAS v4u*)(buf + HG_GI + 16 * tid) = R.d;
}
template <bool FULL> __device__ __forceinline__ void hg_step(const LAS unsigned char* buf, int r0, int w, f32x4 (&S)[8], f32x4& GA, _Float16* Op, int lane, int dir) {
    const int idx = lane & 15, rq = lane >> 4;
    v2u q[2][8], k[2][8];
    f32x4 P[2][2];
    if (FULL) {
#pragma unroll
        for (int tb = 0; tb < 2; ++tb)
#pragma unroll
            for (int j = 0; j < 8; ++j) { q[tb][j] = *(const LAS v2u*)(buf + HG_QI + (16 * tb + idx) * HG_P + (16 * j + 4 * rq) * 2); k[tb][j] = *(const LAS v2u*)(buf + HG_KI + (16 * tb + idx) * HG_P + (16 * j + 4 * rq) * 2); }
#pragma unroll
        for (int sb = 0; sb < 2; ++sb)
#pragma unroll
            for (int tb = 0; tb < 2; ++tb) { f32x4 p = (f32x4){0.f, 0.f, 0.f, 0.f};
#pragma unroll
                for (int ks = 0; ks < 4; ++ks) { v4u a, b; a.x = k[sb][2 * ks].x; a.y = k[sb][2 * ks].y; a.z = k[sb][2 * ks + 1].x; a.w = k[sb][2 * ks + 1].y; b.x = q[tb][2 * ks].x; b.y = q[tb][2 * ks].y; b.z = q[tb][2 * ks + 1].x; b.w = q[tb][2 * ks + 1].y;
                    p = __builtin_amdgcn_mfma_f32_16x16x32_bf16(__builtin_bit_cast(hb16x8, a), __builtin_bit_cast(hb16x8, b), p, 0, 0, 0); }
                P[sb][tb] = p; } }
#pragma unroll
    for (int kb = 0; kb < 8; ++kb) { const f32x4 gv = *(const LAS f32x4*)(buf + HG_GI + (16 * kb + 4 * rq) * 4); S[kb] = S[kb] * gv; if (kb == w) GA = GA * gv; }
    f32x4 o[2];
    o[0] = (f32x4){0.f, 0.f, 0.f, 0.f}; o[1] = (f32x4){0.f, 0.f, 0.f, 0.f};
    if (FULL) {
#pragma unroll
    for (int ks = 0; ks < 4; ++ks) { v4u a; a.x = pg8::cvt_pk_bf16(S[2 * ks][0], S[2 * ks][1]); a.y = pg8::cvt_pk_bf16(S[2 * ks][2], S[2 * ks][3]); a.z = pg8::cvt_pk_bf16(S[2 * ks + 1][0], S[2 * ks + 1][1]); a.w = pg8::cvt_pk_bf16(S[2 * ks + 1][2], S[2 * ks + 1][3]);
#pragma unroll
        for (int tb = 0; tb < 2; ++tb) { v4u b; b.x = q[tb][2 * ks].x; b.y = q[tb][2 * ks].y; b.z = q[tb][2 * ks + 1].x; b.w = q[tb][2 * ks + 1].y;
            o[tb] = __builtin_amdgcn_mfma_f32_16x16x32_bf16(__builtin_bit_cast(hb16x8, a), __builtin_bit_cast(hb16x8, b), o[tb], 0, 0, 0); } } }
    s16x4 vt0, vt1, k0[8], k1[8];
    { const unsigned q_ = (unsigned)(idx >> 2), p_ = (unsigned)(idx & 3);
      const unsigned va = (unsigned)(size_t)(buf + HG_VI) + (4u * rq + q_) * HG_P + 32u * (unsigned)w + 8u * p_, ka = (unsigned)(size_t)(buf + HG_KI) + (4u * rq + q_) * HG_P + 8u * p_;
      asm volatile("s_waitcnt lgkmcnt(0)\n\t"
                   "ds_read_b64_tr_b16 %0, %18\n\t"
                   "ds_read_b64_tr_b16 %1, %18 offset:4352\n\t"
                   "ds_read_b64_tr_b16 %2, %19\n\t"
                   "ds_read_b64_tr_b16 %3, %19 offset:32\n\t"
                   "ds_read_b64_tr_b16 %4, %19 offset:64\n\t"
                   "ds_read_b64_tr_b16 %5, %19 offset:96\n\t"
                   "ds_read_b64_tr_b16 %6, %19 offset:128\n\t"
                   "ds_read_b64_tr_b16 %7, %19 offset:160\n\t"
                   "ds_read_b64_tr_b16 %8, %19 offset:192\n\t"
                   "ds_read_b64_tr_b16 %9, %19 offset:224\n\t"
                   "ds_read_b64_tr_b16 %10, %19 offset:4352\n\t"
                   "ds_read_b64_tr_b16 %11, %19 offset:4384\n\t"
                   "ds_read_b64_tr_b16 %12, %19 offset:4416\n\t"
                   "ds_read_b64_tr_b16 %13, %19 offset:4448\n\t"
                   "ds_read_b64_tr_b16 %14, %19 offset:4480\n\t"
                   "ds_read_b64_tr_b16 %15, %19 offset:4512\n\t"
                   "ds_read_b64_tr_b16 %16, %19 offset:4544\n\t"
                   "ds_read_b64_tr_b16 %17, %19 offset:4576\n\t"
                   "s_waitcnt lgkmcnt(0)"
                   : "=&v"(vt0), "=&v"(vt1), "=&v"(k0[0]), "=&v"(k0[1]), "=&v"(k0[2]), "=&v"(k0[3]), "=&v"(k0[4]), "=&v"(k0[5]), "=&v"(k0[6]), "=&v"(k0[7]),
                     "=&v"(k1[0]), "=&v"(k1[1]), "=&v"(k1[2]), "=&v"(k1[3]), "=&v"(k1[4]), "=&v"(k1[5]), "=&v"(k1[6]), "=&v"(k1[7])
                   : "v"(va), "v"(ka) : "memory"); }
    static_assert(16 * HG_P == 4352, "tr-read row offsets above");
    const hb16x8 vfrag = __builtin_shufflevector(vt0, vt1, 0, 1, 2, 3, 4, 5, 6, 7);
    if (FULL) {
#pragma unroll
      for (int tb = 0; tb < 2; ++tb) { v4u pb; float pm[2][4];
#pragma unroll
        for (int sb = 0; sb < 2; ++sb)
#pragma unroll
            for (int i = 0; i < 4; ++i) { const int s_ = 16 * sb + 4 * rq + i, t_ = 16 * tb + idx; const bool keep = dir ? (s_ >= t_) : (s_ <= t_); pm[sb][i] = keep ? P[sb][tb][i] : 0.f; }
        pb.x = pg8::cvt_pk_bf16(pm[0][0], pm[0][1]); pb.y = pg8::cvt_pk_bf16(pm[0][2], pm[0][3]); pb.z = pg8::cvt_pk_bf16(pm[1][0], pm[1][1]); pb.w = pg8::cvt_pk_bf16(pm[1][2], pm[1][3]);
        o[tb] = __builtin_amdgcn_mfma_f32_16x16x32_bf16(vfrag, __builtin_bit_cast(hb16x8, pb), o[tb], 0, 0, 0); } }
#pragma unroll
    for (int kb = 0; kb < 8; ++kb) { const hb16x8 kfrag = __builtin_shufflevector(k0[kb], k1[kb], 0, 1, 2, 3, 4, 5, 6, 7);
        S[kb] = __builtin_amdgcn_mfma_f32_16x16x32_bf16(kfrag, vfrag, S[kb], 0, 0, 0); }
    if (FULL) {
#pragma unroll
        for (int tb = 0; tb < 2; ++tb) *(GAS h16x4*)(Op + (size_t)(r0 + 16 * tb + idx) * WK + 4 * rq) = __builtin_convertvector(o[tb], h16x4); }
}
#define HG_BARRIER() do { asm volatile("s_waitcnt lgkmcnt(0)" ::: "memory"); __builtin_amdgcn_s_barrier(); asm volatile("" ::: "memory"); } while (0)
template <int PASS> __device__ __forceinline__ void phase_hgrn() {
    const Frame F = mkframe(); unsigned char* ws = F.ws;
    const int lane = F.lane, tid = F.tid, w = F.wave;
    constexpr bool FULL = PASS == 1;
    for (int task = F.vcu; task < 64 * HG_NSEG; task += F.G) {
        const int chain = task >> 2, seg = task & 3, b = chain >> 4, h = (chain >> 1) & 7, dir = chain & 1;
        if (PASS == 0 && seg == HG_NSEG - 1) continue;
        const bf16* Qp = (const bf16*)(ws + (dir ? WS_QB : WS_QF)) + h * DK; const bf16* Kp = (const bf16*)(ws + (dir ? WS_KB : WS_KF)) + h * DK;
        const bf16* Vp = (const bf16*)(ws + WS_VV) + h * DV; const float* Gp = (const float*)(ws + (dir ? WS_GB : WS_GF)) + h * DK;
        _Float16* Op = (_Float16*)(ws + (dir ? WS_OB : WS_OF)) + h * DV + 16 * w;
        f32x4* SL = (f32x4*)(ws + WS_SLOC);
        LAS unsigned char* buf0 = F.lds; LAS unsigned char* buf1 = F.lds + HG_BUF;
        const int cstep = dir ? -32 : 32, cbase = M_LAT + b * CTXL + (dir ? CTXL - 32 : 0), lbase2 = b * SEQ + (dir ? SEQ - 32 : 0) - HG_NCTX * cstep;
        f32x4 S[8], GA = (f32x4){1.f, 1.f, 1.f, 1.f};
#pragma unroll
        for (int kb = 0; kb < 8; ++kb) S[kb] = (f32x4){0.f, 0.f, 0.f, 0.f};
        if (PASS == 1) {
#pragma unroll 1
            for (int k = 0; k < seg; ++k) { const f32x4* p = SL + (size_t)(task - seg + k) * 4608 + lane;
#pragma unroll
                for (int kb = 0; kb < 8; ++kb) S[kb] = S[kb] * p[4096 + kb * 64] + p[(w * 8 + kb) * 64]; } }
        const int s0 = seg * HG_SEGLEN, slast = s0 + HG_SEGLEN - 1;
#define HG_ROW(s_) hg_row0((s_) < slast ? (s_) : slast, cstep, cbase, lbase2)
        HgReg R0, R1;
        __syncthreads();
        hg_gload<FULL>(R0, HG_ROW(s0), Qp, Kp, Vp, Gp, tid); hg_lwrite<FULL>(R0, buf0, tid);
        hg_gload<FULL>(R1, HG_ROW(s0 + 1), Qp, Kp, Vp, Gp, tid);
        HG_BARRIER();
#pragma unroll 1
        for (int s = s0; s < s0 + HG_SEGLEN; s += 2) {
            hg_gload<FULL>(R0, HG_ROW(s + 2), Qp, Kp, Vp, Gp, tid);
            hg_step<FULL>(buf0, hg_row0(s, cstep, cbase, lbase2), w, S, GA, Op, lane, dir);
            hg_lwrite<FULL>(R1, buf1, tid); HG_BARRIER();
            hg_gload<FULL>(R1, HG_ROW(s + 3), Qp, Kp, Vp, Gp, tid);
            hg_step<FULL>(buf1, hg_row0(s + 1, cstep, cbase, lbase2), w, S, GA, Op, lane, dir);
            hg_lwrite<FULL>(R0, buf0, tid); HG_BARRIER();
        }
#undef HG_ROW
        if (PASS == 0) { f32x4* p = SL + (size_t)task * 4608 + lane;
#pragma unroll
            for (int kb = 0; kb < 8; ++kb) p[(w * 8 + kb) * 64] = S[kb];
            p[4096 + w * 64] = GA; }
    }
}

constexpr int GM_P = 272, GM_WI = 0, GM_VI = 128 * GM_P;
__device__ __forceinline__ void phase_gmlp(int l) {
    const Frame F = mkframe(); unsigned char* ws = F.ws;
    const bf16* Z2 = (const bf16*)(ws + WS_Z2); const bf16* VN = (const bf16*)(ws + WS_VN); bf16* YABC = (bf16*)(ws + WS_YABC);
    const int tid = F.tid, lane = F.lane, w = F.wave, idx = lane & 15, rq = lane >> 4;
    if ((F.vcu & 3) != HG_NSEG - 1) return;
    const int jw = F.vcu >> 2, g = jw & 3, nper = F.G >> 4;
    if ((jw >> 2) >= M / 128) return;
    __syncthreads();
    { const float* wsrc = INP(IWS) + ((size_t)l * 4 + g) * 128 * 128;
#pragma unroll
      for (int i = 0; i < 8; ++i) { const int e = (i * 512 + tid) * 4, t = e >> 7, s0 = e & 127; const f32x4 v = *(const GAS f32x4*)(wsrc + e);
          *(LAS v2u*)(F.lds + GM_WI + t * GM_P + 2 * s0) = (v2u){pk2(v[0], v[1]), pk2(v[2], v[3])}; } }
    for (int chunk = jw >> 2; chunk < M / 128; chunk += nper) { const size_t r0 = (size_t)chunk * 128;
        __syncthreads();
#pragma unroll
        for (int i = 0; i < 4; ++i) { const int e = i * 512 + tid, srow = e >> 4, c8 = e & 15;
            *(LAS v4u*)(F.lds + GM_VI + srow * GM_P + 16 * c8) = *(const GAS v4u*)(VN + (r0 + srow) * BW + g * 128 + 8 * c8); }
        __syncthreads();
        v4u bfr[4];
#pragma unroll
        for (int ks = 0; ks < 4; ++ks) bfr[ks] = *(const LAS v4u*)(F.lds + GM_WI + (16 * w + idx) * GM_P + (32 * ks + 8 * rq) * 2);
        const float bs = INP(IBS)[((size_t)l * 4 + g) * 128 + 16 * w + idx];
        v2u urv[8];
#pragma unroll
        for (int cb = 0; cb < 8; ++cb) urv[cb] = *(const GAS v2u*)(Z2 + (r0 + 16 * w + idx) * Z2W + Z2_U + g * 128 + 16 * cb + 4 * rq);
        const unsigned q_ = (unsigned)(idx >> 2), p_ = (unsigned)(idx & 3);
        const unsigned va = (unsigned)(size_t)(F.lds + GM_VI) + (8u * rq + q_) * GM_P + 8u * p_;
#pragma unroll
        for (int cb = 0; cb < 8; ++cb) {
            s16x4 t0[4], t1[4];
            asm volatile("ds_read_b64_tr_b16 %0, %8\n\t"
                         "ds_read_b64_tr_b16 %1, %8 offset:1088\n\t"
                         "ds_read_b64_tr_b16 %2, %9\n\t"
                         "ds_read_b64_tr_b16 %3, %9 offset:1088\n\t"
                         "ds_read_b64_tr_b16 %4, %10\n\t"
                         "ds_read_b64_tr_b16 %5, %10 offset:1088\n\t"
                         "ds_read_b64_tr_b16 %6, %11\n\t"
                         "ds_read_b64_tr_b16 %7, %11 offset:1088\n\t"
                         "s_waitcnt lgkmcnt(0)"
                         : "=&v"(t0[0]), "=&v"(t1[0]), "=&v"(t0[1]), "=&v"(t1[1]), "=&v"(t0[2]), "=&v"(t1[2]), "=&v"(t0[3]), "=&v"(t1[3])
                         : "v"(va + 32u * cb), "v"(va + 32u * cb + 32u * GM_P), "v"(va + 32u * cb + 64u * GM_P), "v"(va + 32u * cb + 96u * GM_P) : "memory");
            f32x4 acc = (f32x4){0.f, 0.f, 0.f, 0.f};
#pragma unroll
            for (int ks = 0; ks < 4; ++ks) { const hb16x8 afr = __builtin_shufflevector(t0[ks], t1[ks], 0, 1, 2, 3, 4, 5, 6, 7);
                acc = __builtin_amdgcn_mfma_f32_16x16x32_bf16(afr, __builtin_bit_cast(hb16x8, bfr[ks]), acc, 0, 0, 0); }
            const size_t row = r0 + 16 * w + idx; const int ch = g * 128 + 16 * cb + 4 * rq;
            const v2u ur = urv[cb];
            const float y0 = gelu_tanh(bflo(ur.x)) * (acc[0] + bs), y1 = gelu_tanh(bfhi(ur.x)) * (acc[1] + bs), y2 = gelu_tanh(bflo(ur.y)) * (acc[2] + bs), y3 = gelu_tanh(bfhi(ur.y)) * (acc[3] + bs);
            *(GAS v2u*)(YABC + row * 2048 + 1024 + ch) = (v2u){pk2(y0, y1), pk2(y2, y3)};
        }
    }
    __syncthreads();
}

struct RoRow { pg8::eh16x8 f0, f1, b0, b1; v4u g0, g1; };
__device__ __forceinline__ void ro_load(RoRow& R, const _Float16* OFp, const _Float16* OBp, const bf16* Z2, int m, int lane) {
    R.f0 = *(const GAS pg8::eh16x8*)(OFp + (size_t)m * WK + 16 * lane); R.f1 = *(const GAS pg8::eh16x8*)(OFp + (size_t)m * WK + 16 * lane + 8);
    R.b0 = *(const GAS pg8::eh16x8*)(OBp + (size_t)m * WK + 16 * lane); R.b1 = *(const GAS pg8::eh16x8*)(OBp + (size_t)m * WK + 16 * lane + 8);
    R.g0 = *(const GAS v4u*)(Z2 + (size_t)m * Z2W + Z2_GA + 16 * lane); R.g1 = *(const GAS v4u*)(Z2 + (size_t)m * Z2W + Z2_GA + 16 * lane + 8);
}
__device__ __forceinline__ void ro_finish(const RoRow& R, const float (&ag)[16], bf16* YABC, int m, int lane) {
    const pg8::ef32x8 a0 = __builtin_convertvector(R.f0, pg8::ef32x8), a1 = __builtin_convertvector(R.f1, pg8::ef32x8), c0 = __builtin_convertvector(R.b0, pg8::ef32x8), c1 = __builtin_convertvector(R.b1, pg8::ef32x8);
    float o[16]; float ss = 0.f;
#pragma unroll
    for (int e = 0; e < 8; ++e) { o[e] = a0[e] + c0[e]; o[8 + e] = a1[e] + c1[e]; ss += o[e] * o[e] + o[8 + e] * o[8 + e]; }
    ss += dppf<0xB1>(ss); ss += dppf<0x4E>(ss); ss += dppf<0x141>(ss);
    const float rstd = 1.0f / sqrtf(ss * (1.0f / DV) + EPS);
    const v4u g0 = R.g0, g1 = R.g1; float ga[16];
    ga[0] = bflo(g0.x); ga[1] = bfhi(g0.x); ga[2] = bflo(g0.y); ga[3] = bfhi(g0.y); ga[4] = bflo(g0.z); ga[5] = bfhi(g0.z); ga[6] = bflo(g0.w); ga[7] = bfhi(g0.w);
    ga[8] = bflo(g1.x); ga[9] = bfhi(g1.x); ga[10] = bflo(g1.y); ga[11] = bfhi(g1.y); ga[12] = bflo(g1.z); ga[13] = bfhi(g1.z); ga[14] = bflo(g1.w); ga[15] = bfhi(g1.w);
    float y[16];
#pragma unroll
    for (int e = 0; e < 16; ++e) y[e] = o[e] * rstd * ag[e] * siluf_(ga[e]);
    v4u w0, w1; w0.x = pk2(y[0], y[1]); w0.y = pk2(y[2], y[3]); w0.z = pk2(y[4], y[5]); w0.w = pk2(y[6], y[7]); w1.x = pk2(y[8], y[9]); w1.y = pk2(y[10], y[11]); w1.z = pk2(y[12], y[13]); w1.w = pk2(y[14], y[15]);
    *(GAS v4u*)(YABC + (size_t)m * 2048 + 16 * lane) = w0; *(GAS v4u*)(YABC + (size_t)m * 2048 + 16 * lane + 8) = w1;
}
__device__ __forceinline__ void phase_readout(int l) {
    const Frame F = mkframe(); unsigned char* ws = F.ws;
    const _Float16* OFp = (const _Float16*)(ws + WS_OF); const _Float16* OBp = (const _Float16*)(ws + WS_OB); const bf16* Z2 = (const bf16*)(ws + WS_Z2); bf16* YABC = (bf16*)(ws + WS_YABC);
    const int gw = F.vcu * 8 + F.wave, NGW = F.G * 8, lane = F.lane;
    float ag[16];
    { const float* agp = INP(IANORM) + l * DV + (16 * lane & 127);
#pragma unroll
      for (int e = 0; e < 16; ++e) ag[e] = agp[e]; }
    const int per = (M_LAT + NGW - 1) / NGW, m0 = gw * per, m1 = (m0 + per < M_LAT) ? m0 + per : M_LAT;
    if (m0 < m1) { RoRow cur, nxt; ro_load(cur, OFp, OBp, Z2, m0, lane);
#pragma unroll 1
        for (int m = m0; m < m1; ++m) { ro_load(nxt, OFp, OBp, Z2, m + 1 < m1 ? m + 1 : m, lane); ro_finish(cur, ag, YABC, m, lane); cur = nxt; } }
    for (int m = M_LAT + (gw >> 1) + ((gw & 1) ? (NGW >> 1) : 0); m < M; m += NGW) { RoRow cur; ro_load(cur, OFp, OBp, Z2, m, lane); ro_finish(cur, ag, YABC, m, lane); }
}

constexpr int PH_PER_LAYER = 13, N_PHASES = 1 + DEPTH * PH_PER_LAYER + 1;
__device__ __forceinline__ void grid_seam() {
    extern __shared__ __attribute__((aligned(16))) unsigned char lds_dyn[];
    XcdBarrier bar; bar.bar = (unsigned*)(kargs()->ws + WS_CTL) + CW_BAR; bar.x = xb_xcc_id(); bar.st = (volatile LAS unsigned*)((LAS unsigned char*)lds_dyn + MISC_OFF) + 8;
    xcd_barrier(bar);
}
__global__ void __launch_bounds__(512, 2) fwd_kernel(Args args_unused) {
    extern __shared__ __attribute__((aligned(16))) unsigned char lds_dyn[];
    { LAS unsigned char* lds = (LAS unsigned char*)lds_dyn;
      for (int u = threadIdx.x; u < (LDS_BYTES - LDSCTL_OFF) / 4; u += 512) ((LAS unsigned*)(lds + LDSCTL_OFF))[u] = 0u;
      __syncthreads();
      if (kargs()->ph_hi - kargs()->ph_lo > 1) (void)xcd_barrier_post((unsigned*)(kargs()->ws + WS_CTL) + CW_BAR, (volatile LAS unsigned*)(lds + MISC_OFF) + 8); }
    const int lo = kargs()->ph_lo, hi = kargs()->ph_hi;
#define IN(k) (lo <= (k) && (k) < hi)
#define SEAM(k) do { if (IN((k) + 1)) grid_seam(); } while (0)
#define LDSP ((LAS unsigned char*)lds_dyn)
#define WSP(off) (kargs()->ws + (off))

    if (IN(0)) { phase_prologue(); __syncthreads(); SEAM(0); }

#pragma unroll 1
    for (int l = 0; l < DEPTH; ++l) {
        const int pb = 1 + l * PH_PER_LAYER;
        if (hi <= pb || lo >= pb + PH_PER_LAYER) continue;
#pragma unroll 1
        for (int j = 0; j < 2; ++j) {
            const int p0 = pb + (j ? 10 : 0);
            const bool noctx = (l == DEPTH - 1) && j == 1;
            if (IN(p0)) { if (j) phase_norm(l, 2, noctx ? M_LAT : M, noctx ? 0 : 1, l, 5, 1.0f); else { if (l > 0) convert_rest(l); phase_norm(l, 0, M, l > 0 ? 1 : 0, l - 1, 8, 0.5f); } SEAM(p0); }
            if (IN(p0 + 1)) { pg8::Gemm g{(const bf16*)WSP(WS_H), (const bf16*)WSP(WS_WGU) + (size_t)(l * 2 + j) * (2 * DFF) * D, M, 2 * DFF, D, D, D};
                pg8::StaticOrder S; S.init(noctx ? M_LAT : M, 2 * DFF, (int)gridDim.x, (int)blockIdx.x, D); pg8::EpiSwiGLU E{(bf16*)WSP(WS_ACT)};
                pg8::gemm_phase<pg8::EpiSwiGLU, pg8::StaticOrder, true, true>(LDSP, g, S, E);
                if (l < DEPTH - 1) convert_slot(l + 1, j ? 3 : 0, (M / 256) * (2 * DFF / 256), CV_Q_GU);
                SEAM(p0 + 1); }
            if (IN(p0 + 2)) { pg8::Gemm g{(const bf16*)WSP(WS_ACT), (const bf16*)WSP(WS_WD) + (size_t)(l * 2 + j) * D * DFF, M, D, DFF, DFF, DFF};
                pg8::SplitOrder S; S.init((int)gridDim.x, (int)blockIdx.x, DFF, !noctx); pg8::EpiResid E{(ytype*)WSP(WS_Y), (const float*)WSP(WS_MOD) + (size_t)l * NGRP * MODW + (j ? 8 : 2) * D, 0.5f, (float*)WSP(WS_MF32)};
                pg8::gemm_phase<pg8::EpiResid, pg8::SplitOrder, true, true>(LDSP, g, S, E); SEAM(p0 + 2); }
            if (j == 0) {
                const bool lastl = (l == DEPTH - 1);
                if (IN(pb + 3)) { phase_norm(l, 1, M, 1, l, 2, 0.5f); SEAM(pb + 3); }
                if (IN(pb + 4)) { pg8::Gemm g{(const bf16*)WSP(WS_H), (const bf16*)WSP(WS_WIN) + (size_t)l * INW * D, M, INW, D, D, D};
                    pg8::InprojOrder S; S.init((int)gridDim.x, (int)blockIdx.x, D, lastl ? 16 : 54); pg8::EpiInproj E{(bf16*)WSP(WS_QS), (bf16*)WSP(WS_VV), (_Float16*)WSP(WS_ZF), (bf16*)WSP(WS_Z2)};
                    pg8::gemm_phase<pg8::EpiInproj, pg8::InprojOrder, true, true>(LDSP, g, S, E);
                    if (!lastl) convert_slot(l + 1, 1, 64 * 54 + 4 * 54, CV_Q_IN);
                    SEAM(pb + 4); }
                if (IN(pb + 5)) { phase_hgrn_prep(l); phase_mix_elem(l); SEAM(pb + 5); }
                if (IN(pb + 6)) { phase_hgrn<0>(); phase_gmlp(l); grid_seam(); phase_hgrn<1>(); SEAM(pb + 6); }
                if (IN(pb + 7)) { phase_readout(l); SEAM(pb + 7); }
                if (IN(pb + 8)) { pg8::Gemm g{(const bf16*)WSP(WS_YABC), (const bf16*)WSP(WS_WP) + (size_t)l * D * 2048, M, D, 2048, 2048, 2048};
                    pg8::StaticOrder S; S.init(lastl ? M_LAT : M, D, (int)gridDim.x, (int)blockIdx.x, 2048); pg8::EpiProjF E{(bf16*)WSP(WS_MRG), (const bf16*)WSP(WS_Z2)};
                    pg8::gemm_phase<pg8::EpiProjF, pg8::StaticOrder, true, true>(LDSP, g, S, E);
                    if (!lastl) convert_slot(l + 1, 2, (M / 256) * (D / 256), CV_Q_PJ);
                    SEAM(pb + 8); }
                if (IN(pb + 9)) { pg8::Gemm g{(const bf16*)WSP(WS_MRG), (const bf16*)WSP(WS_WO) + (size_t)l * D * D, M, D, D, D, D};
                    pg8::SplitOrder S; S.init((int)gridDim.x, (int)blockIdx.x, D, !lastl); pg8::EpiResid E{(ytype*)WSP(WS_Y), (const float*)WSP(WS_MOD) + (size_t)l * NGRP * MODW + 5 * D, 1.0f, (float*)WSP(WS_MF32)};
                    pg8::gemm_phase<pg8::EpiResid, pg8::SplitOrder, true, true>(LDSP, g, S, E); SEAM(pb + 9); }
            }
        }
    }
    if (IN(N_PHASES - 1)) phase_final();
#undef IN
#undef SEAM
}

#ifndef MK_PER_PHASE
#define MK_PER_PHASE 0
#endif
extern "C" void kernel_launch(void* const* d_in, const int* in_sizes, int n_in, void* d_out, int out_size, void* d_ws, size_t ws_size, hipStream_t stream) {
    static int grid = 0;
    if (grid == 0) {
        if (n_in != 23 || out_size != M_LAT * D || ws_size < WS_END) { fprintf(stderr, "kernel_launch: unexpected sizes n_in %d out %d ws %zu (need %zu)\n", n_in, out_size, ws_size, (size_t)WS_END); grid = -1; return; }
        int dev = 0, cus = 0, per_cu = 0;
        if (hipGetDevice(&dev) != hipSuccess || hipDeviceGetAttribute(&cus, hipDeviceAttributeMultiprocessorCount, dev) != hipSuccess) { grid = -1; return; }
        if (hipFuncSetAttribute((const void*)fwd_kernel, hipFuncAttributeMaxDynamicSharedMemorySize, LDS_BYTES) != hipSuccess) { fprintf(stderr, "kernel_launch: hipFuncSetAttribute failed\n"); grid = -1; return; }
        if (hipOccupancyMaxActiveBlocksPerMultiprocessor(&per_cu, (const void*)fwd_kernel, 512, LDS_BYTES) != hipSuccess || per_cu < 1) { fprintf(stderr, "kernel_launch: occupancy query says %d\n", per_cu); }
        (void)hipGetLastError();
        grid = cus;
    }
    if (grid < 0) return;
    (void)hipMemsetAsync((char*)d_ws + WS_CTL, 0, CTL_ZERO_BYTES, stream);
    Args a{};
    for (int i = 0; i < 23; ++i) a.in[i] = (const float*)d_in[i];
    a.out = (float*)d_out; a.ws = (unsigned char*)d_ws;
#if MK_PER_PHASE
    for (int p = 0; p < N_PHASES; ++p) { a.ph_lo = p; a.ph_hi = p + 1; hipLaunchKernelGGL(fwd_kernel, dim3(grid), dim3(512), LDS_BYTES, stream, a); }
#else
    a.ph_lo = 0; a.ph_hi = N_PHASES; hipLaunchKernelGGL(fwd_kernel, dim3(grid), dim3(512), LDS_BYTES, stream, a);
#endif
}
```

```cpp
#include <hip/hip_runtime.h>
#include <cstdio>
#include <cstdint>
namespace pg8 {
#define PG8_LAS __attribute__((address_space(3)))
typedef unsigned short bf16_t;
typedef short bf16x8 __attribute__((ext_vector_type(8)));
typedef float f32x4 __attribute__((ext_vector_type(4)));
typedef float f32x2 __attribute__((ext_vector_type(2)));
typedef unsigned u32x4 __attribute__((ext_vector_type(4)));
typedef unsigned u32x2 __attribute__((ext_vector_type(2)));
constexpr int BM = 256, BK = 64, HALF = 128, HTB = HALF * BK * 2  , STAGE_BYTES = 8 * HTB, NXCD = 8, WGM = 8;

__host__ __device__ __forceinline__ int lds_byte(int r, int c) { const int st = (r >> 4) * 2 + (c >> 5), rr = r & 15, cc = c & 31, ob = rr * 64 + cc * 2; return st * 1024 + (ob ^ (((ob >> 9) & 1) << 5)); }
__host__ __device__ __forceinline__ void stage_rc(int b, int& R, int& C) { const int st = b / 1024, sb = b % 1024, swz = sb ^ (((sb >> 9) & 1) << 5); R = (st >> 1) * 16 + swz / 64; C = (st & 1) * 32 + (swz % 64) / 2; }
__host__ __device__ __forceinline__ int perm32(int rho) { const int n = rho >> 4, i = rho & 15; return 8 * (i >> 2) + 4 * n + (i & 3); }

struct Unit { int pm, pn, meta;
    __host__ __device__ __forceinline__ int kt0() const { return meta & 255; } __host__ __device__ __forceinline__ int nt() const { return (meta >> 8) & 255; } __host__ __device__ __forceinline__ int part() const { return meta >> 16; }
    __host__ __device__ __forceinline__ void set(int kt0_, int nt_, int part_) { meta = kt0_ | (nt_ << 8) | (part_ << 16); } };
struct Gemm { const bf16_t* A; const bf16_t* Bt; int M, N, K, lda, ldb; };

__host__ __device__ __forceinline__ int xcd_block_pos(int L, int nwg, int G) {
    if (G != 256) return L;
    const int i = L >> 8, c = L & 255;
    if (((i + 1) << 8) <= nwg) return (i << 8) + ((c & 7) << 5) + (c >> 3);
    const int rem = nwg - (i << 8);
    return (rem & 7) ? L : (i << 8) + (c & 7) * (rem >> 3) + (c >> 3);
}
__host__ __device__ __forceinline__ void tile_of(int wgid, int nM, int nN, int& pm, int& pn) {
    const int nig = WGM * nN, gid = wgid / nig, fm = gid * WGM, gsz = (nM - fm) < WGM ? (nM - fm) : WGM;
    pm = fm + ((wgid % nig) % gsz); pn = (wgid % nig) / gsz;
}
struct StaticOrder {
    int nM, nN, nwg, G, c, ntK;
    __host__ __device__ void init(int M, int N, int G_, int c_, int K) { nM = M / BM; nN = N / BM; nwg = nM * nN; G = G_; c = c_; ntK = K / BK; }
    __host__ __device__ bool next(int i, Unit& u) const {
        const long L = (long)i * G + c; if (L >= nwg) return false;
        u.set(0, ntK, 0);
        const int wgid = xcd_block_pos((int)L, nwg, G);
        const int nig = WGM * nN, gid = wgid / nig, fm = gid * WGM, gsz = (nM - fm) < WGM ? (nM - fm) : WGM;
        u.pm = fm + ((wgid % nig) % gsz); u.pn = (wgid % nig) / gsz; return true;
    }
    __device__ __forceinline__ void a_ready(const Unit&) const {}
    __device__ __forceinline__ void done(const Unit&) const {}
};

struct SplitOrder {
    int G, c, ntK, nctx;
    __host__ __device__ void init(int G_, int c_, int K, bool with_ctx) { G = G_; c = c_; ntK = K / BK; nctx = with_ctx ? 256 : 0; }
    __host__ __device__ bool next(int i, Unit& u) const {
        const long L = (long)i * G + c; if (L >= 512 + nctx) return false;
        if (L < 512) { tile_of(xcd_block_pos((int)L, 512, G), 64, 8, u.pm, u.pn); u.set(0, ntK, 0); return true; }
        const int q = (int)L - 512, tile = q >> 3, p = q & 7; u.pm = 64 + (tile >> 3); u.pn = tile & 7;
        if (ntK == 88) u.set((p >> 1) * 22 + (p & 1) * 12, (p & 1) ? 10 : 12, 1 + p); else u.set(p * (ntK >> 3), ntK >> 3, 1 + p);
        return true;
    }
    __device__ __forceinline__ void a_ready(const Unit&) const {}
    __device__ __forceinline__ void done(const Unit&) const {}
};

struct InprojOrder {
    int G, c, ntK, nctx;
    __host__ __device__ void init(int G_, int c_, int K, int nctx_pn) { G = G_; c = c_; ntK = K / BK; nctx = 4 * nctx_pn; }
    __host__ __device__ bool next(int i, Unit& u) const {
        const long L = (long)i * G + c; if (L >= 64 * 54 + nctx) return false;
        u.set(0, ntK, 0);
        if (L < 64 * 54) { tile_of(xcd_block_pos((int)L, 64 * 54, G), 64, 54, u.pm, u.pn); return true; }
        const int q = (int)L - 64 * 54; u.pm = 64 + (q & 3); u.pn = q >> 2; return true;
    }
    __device__ __forceinline__ void a_ready(const Unit&) const {}
    __device__ __forceinline__ void done(const Unit&) const {}
};

__device__ __forceinline__ unsigned cvt_pk_bf16(float lo, float hi) { unsigned r; asm volatile("v_cvt_pk_bf16_f32 %0, %1, %2" : "=v"(r) : "v"(lo), "v"(hi)); return r; }

template <class Epi, class Sched, bool ALIGN_EPI = false, bool SP2 = false>
__device__ __forceinline__ void gemm_phase(PG8_LAS unsigned char* lds, const Gemm g, const Sched& S, const Epi& E) {
    int tid_ = threadIdx.x; asm volatile("" : "+v"(tid_));
    const int tid = tid_, wid = __builtin_amdgcn_readfirstlane(tid >> 6), lane = tid & 63, wr = wid >> 2, wc = wid & 3, fr = lane & 15, fq = lane >> 4;
    unsigned voffA[2], voffB[2];
#pragma unroll
    for (int i = 0; i < 2; ++i) { int R, C; stage_rc(tid * 16 + i * 8192, R, C); const int Rb = Epi::PERM ? ((R & ~31) + perm32(R & 31)) : R;
        voffA[i] = (unsigned)(R * g.lda + C) * 2u; voffB[i] = (unsigned)(Rb * g.ldb + C) * 2u; }
    const unsigned kstep = (unsigned)(BK * 2);
    const unsigned hstepA = (unsigned)HALF * g.lda * 2u, hstepB = (unsigned)HALF * g.ldb * 2u;
    const unsigned tstepA = 2u * hstepA, tstepB = 2u * hstepB;
    const unsigned ldsw = (unsigned)wid * 1024u;
    const int aoff = lds_byte(wr * 64 + fr, fq * 8), boff = lds_byte(wc * 32 + fr, fq * 8);
#define PG8_SA(b, h) (((b) * 2 + (h)) * HTB)
#define PG8_SB(b, h) ((4 + (b) * 2 + (h)) * HTB)
#define PG8_STAGE(bufoff, gbase, voff) do { _Pragma("unroll") for (int _i = 0; _i < 2; ++_i) \
        __builtin_amdgcn_global_load_lds((const unsigned*)((const char*)(gbase) + (voff)[_i]), (PG8_LAS unsigned*)(lds + (bufoff) + ldsw + _i * 8192), 16, 0, 0); } while (0)
#define PG8_LDA(dst, b, h) do { _Pragma("unroll") for (int m = 0; m < 4; ++m) _Pragma("unroll") for (int k = 0; k < 2; ++k) dst[m][k] = *(const PG8_LAS bf16x8*)(lds + PG8_SA(b, h) + aoff + m * 2048 + k * 1024); } while (0)
#define PG8_LDB(dst, b, h) do { _Pragma("unroll") for (int n = 0; n < 2; ++n) _Pragma("unroll") for (int k = 0; k < 2; ++k) dst[n][k] = *(const PG8_LAS bf16x8*)(lds + PG8_SB(b, h) + boff + n * 2048 + k * 1024); } while (0)
#define PG8_MMA(ai, bj, At, Bt) do { __builtin_amdgcn_s_setprio(1); _Pragma("unroll") for (int m = 0; m < 4; ++m) _Pragma("unroll") for (int n = 0; n < 2; ++n) _Pragma("unroll") for (int k = 0; k < 2; ++k) \
        acc[ai][bj][m][n] = __builtin_amdgcn_mfma_f32_16x16x32_bf16(Bt[n][k], At[m][k], acc[ai][bj][m][n], 0, 0, 0); __builtin_amdgcn_s_setprio(0); } while (0)
#define PG8_WAIT_V(n) asm volatile("s_waitcnt vmcnt(" #n ")" ::: "memory")
#define PG8_WAIT_L(n) asm volatile("s_waitcnt lgkmcnt(" #n ")" ::: "memory")
#define PG8_BAR __builtin_amdgcn_s_barrier()
#define PG8_SCHED __builtin_amdgcn_sched_barrier(0)
    Unit cur, nxt; int ui = 0;
    if (!S.next(0, cur)) return;
    f32x4 acc[2][2][4][2];
#pragma unroll
    for (int a = 0; a < 2; ++a)
#pragma unroll
        for (int b = 0; b < 2; ++b)
#pragma unroll
            for (int m = 0; m < 4; ++m)
#pragma unroll
                for (int n = 0; n < 2; ++n) acc[a][b][m][n] = (f32x4){0.f, 0.f, 0.f, 0.f};
    bf16x8 At[4][2], B0[2][2], B1[2][2];
    const char* cA = (const char*)g.A + (size_t)((unsigned)cur.pm * tstepA) + (size_t)((unsigned)cur.kt0() * kstep); const char* cB = (const char*)g.Bt + (size_t)((unsigned)cur.pn * tstepB) + (size_t)((unsigned)cur.kt0() * kstep);
    S.a_ready(cur);
    if constexpr (SP2) {
        PG8_STAGE(PG8_SB(0, 0), cB, voffB); PG8_STAGE(PG8_SB(0, 1), cB + hstepB, voffB); PG8_STAGE(PG8_SA(0, 0), cA, voffA); PG8_STAGE(PG8_SA(0, 1), cA + hstepA, voffA);
        if (wr == 1) PG8_BAR;
        PG8_WAIT_V(2); PG8_BAR;
        PG8_STAGE(PG8_SB(1, 0), cB + kstep, voffB); PG8_STAGE(PG8_SA(1, 0), cA + kstep, voffA); PG8_STAGE(PG8_SB(1, 1), cB + hstepB + kstep, voffB);
        PG8_WAIT_V(6); PG8_BAR;
    } else {
        PG8_STAGE(PG8_SB(0, 0), cB, voffB); PG8_STAGE(PG8_SA(0, 0), cA, voffA); PG8_STAGE(PG8_SB(0, 1), cB + hstepB, voffB); PG8_STAGE(PG8_SA(0, 1), cA + hstepA, voffA);
        if (wr == 1) PG8_BAR;
        PG8_WAIT_V(4); PG8_BAR;
        PG8_STAGE(PG8_SB(1, 0), cB + kstep, voffB); PG8_STAGE(PG8_SA(1, 0), cA + kstep, voffA); PG8_STAGE(PG8_SB(1, 1), cB + hstepB + kstep, voffB);
        PG8_WAIT_V(6); PG8_BAR;
    }
    for (;;) {
        const bool has_next = S.next(ui + 1, nxt);
        const char* nA = has_next ? (const char*)g.A + (size_t)((unsigned)nxt.pm * tstepA) + (size_t)((unsigned)nxt.kt0() * kstep) : cA; const char* nB = has_next ? (const char*)g.Bt + (size_t)((unsigned)nxt.pn * tstepB) + (size_t)((unsigned)nxt.kt0() * kstep) : cB;
        const int nt = cur.nt();
        for (int t = 0; t < nt; t += 2) {
            if constexpr (Epi::HOOK) { if (t == Epi::H1 || t == Epi::H2) E.khook(acc, cur, t, wr, wc, fr, fq); }
            const bool last = (t == nt - 2);
            const char* a1 = cA + (size_t)((unsigned)(t + 1) * kstep);
            const char* a2 = last ? nA : cA + (size_t)((unsigned)(t + 2) * kstep); const char* b2 = last ? nB : cB + (size_t)((unsigned)(t + 2) * kstep);
            const char* a3 = a2 + kstep; const char* b3 = b2 + kstep;
            if (last && has_next) S.a_ready(nxt);
            if constexpr (SP2) {
            PG8_LDB(B0, 0, 0); PG8_LDB(B1, 0, 1); PG8_SCHED; PG8_LDA(At, 0, 0); PG8_STAGE(PG8_SA(1, 1), a1 + hstepA, voffA);
            PG8_WAIT_V(8); PG8_WAIT_L(0); PG8_BAR; PG8_MMA(0, 0, At, B0); PG8_MMA(0, 1, At, B1); PG8_BAR; PG8_SCHED;
            PG8_LDA(At, 0, 1); PG8_STAGE(PG8_SB(0, 0), b2, voffB); PG8_STAGE(PG8_SB(0, 1), b2 + hstepB, voffB); PG8_STAGE(PG8_SA(0, 0), a2, voffA);
            PG8_WAIT_V(8); PG8_WAIT_L(0); PG8_BAR; PG8_MMA(1, 0, At, B0); PG8_MMA(1, 1, At, B1); PG8_BAR; PG8_SCHED;
            PG8_LDB(B0, 1, 0); PG8_LDB(B1, 1, 1); PG8_SCHED; PG8_LDA(At, 1, 0); PG8_STAGE(PG8_SA(0, 1), a2 + hstepA, voffA);
            PG8_WAIT_V(8); PG8_WAIT_L(0); PG8_BAR; PG8_MMA(0, 0, At, B0); PG8_MMA(0, 1, At, B1); PG8_BAR; PG8_SCHED;
            PG8_LDA(At, 1, 1); PG8_STAGE(PG8_SB(1, 0), b3, voffB); PG8_STAGE(PG8_SB(1, 1), b3 + hstepB, voffB); PG8_STAGE(PG8_SA(1, 0), a3, voffA);
            PG8_WAIT_V(8); PG8_WAIT_L(0); PG8_BAR; PG8_MMA(1, 0, At, B0); PG8_MMA(1, 1, At, B1); PG8_BAR; PG8_SCHED;
            } else {
            PG8_LDB(B0, 0, 0); PG8_SCHED; PG8_LDA(At, 0, 0); PG8_STAGE(PG8_SA(1, 1), a1 + hstepA, voffA);
            PG8_WAIT_L(8); PG8_BAR; PG8_WAIT_L(0); PG8_MMA(0, 0, At, B0); PG8_BAR; PG8_SCHED;
            PG8_LDB(B1, 0, 1); PG8_STAGE(PG8_SB(0, 0), b2, voffB);
            PG8_BAR; PG8_WAIT_L(0); PG8_MMA(0, 1, At, B1); PG8_BAR;
            PG8_LDA(At, 0, 1); PG8_STAGE(PG8_SA(0, 0), a2, voffA);
            PG8_BAR; PG8_WAIT_L(0); PG8_MMA(1, 0, At, B0); PG8_BAR; PG8_SCHED;
            PG8_STAGE(PG8_SB(0, 1), b2 + hstepB, voffB);
            PG8_WAIT_V(6); PG8_BAR; PG8_MMA(1, 1, At, B1); PG8_BAR;
            PG8_LDB(B0, 1, 0); PG8_SCHED; PG8_LDA(At, 1, 0); PG8_STAGE(PG8_SA(0, 1), a2 + hstepA, voffA);
            PG8_WAIT_L(8); PG8_BAR; PG8_WAIT_L(0); PG8_MMA(0, 0, At, B0); PG8_BAR; PG8_SCHED;
            PG8_LDB(B1, 1, 1); PG8_STAGE(PG8_SB(1, 0), b3, voffB);
            PG8_BAR; PG8_WAIT_L(0); PG8_MMA(0, 1, At, B1); PG8_BAR;
            PG8_LDA(At, 1, 1); PG8_STAGE(PG8_SA(1, 0), a3, voffA);
            PG8_BAR; PG8_WAIT_L(0); PG8_MMA(1, 0, At, B0); PG8_BAR; PG8_SCHED;
            PG8_STAGE(PG8_SB(1, 1), b3 + hstepB, voffB);
            PG8_WAIT_V(6); PG8_BAR; PG8_MMA(1, 1, At, B1); PG8_BAR;
            }
        }
        if constexpr (ALIGN_EPI) { if (wr == 0) PG8_BAR; }
        E(acc, cur, wr, wc, fr, fq); S.done(cur);
        if (!has_next) break;
#pragma unroll
        for (int a = 0; a < 2; ++a)
#pragma unroll
            for (int b = 0; b < 2; ++b)
#pragma unroll
                for (int m = 0; m < 4; ++m)
#pragma unroll
                    for (int n = 0; n < 2; ++n) acc[a][b][m][n] = (f32x4){0.f, 0.f, 0.f, 0.f};
        cur = nxt; cA = nA; cB = nB; ++ui;
        if constexpr (ALIGN_EPI) { if (wr == 1) PG8_BAR; }
    }
    PG8_WAIT_V(0);
    if constexpr (!ALIGN_EPI) { if (wr == 0) PG8_BAR; }
    PG8_BAR;
#undef PG8_SA
#undef PG8_SB
#undef PG8_STAGE
#undef PG8_LDA
#undef PG8_LDB
#undef PG8_MMA
#undef PG8_WAIT_V
#undef PG8_WAIT_L
#undef PG8_BAR
#undef PG8_SCHED
}
}
#define XB_TMO      128
#define XB_XCNT(j)  (256  + 64 * (j))
#define XB_XSUB(j)  (1280 + 64 * (j))
#define XB_XGEN(j)  (2304 + 64 * (j))
#define XB_TOP      3328
#define XB_TOPGEN   3392
#define XCD_BAR_WORDS 3456
#define XB_SPIN_CAP (1u << 18)
#define LAS __attribute__((address_space(3)))

__device__ __forceinline__ unsigned xb_ld(unsigned* p)              { return __hip_atomic_load(p, __ATOMIC_RELAXED, __HIP_MEMORY_SCOPE_AGENT); }
__device__ __forceinline__ unsigned xb_add(unsigned* p, unsigned v) { return __hip_atomic_fetch_add(p, v, __ATOMIC_RELAXED, __HIP_MEMORY_SCOPE_AGENT); }
__device__ __forceinline__ unsigned xb_xcc_id() { return (unsigned)__builtin_amdgcn_s_getreg((3 << 11) | 20) & 0xFu; }
#define XB_SPIN(cond, bar) do { unsigned _sp = 0; while (cond) { __builtin_amdgcn_s_sleep(1); \
    if ((++_sp & 255u) == 0u) { if (xb_ld(&(bar)[XB_TMO])) break; if (_sp > XB_SPIN_CAP) { atomicAdd(&(bar)[XB_TMO], 1u); break; } } } } while (0)

struct XcdBarrier {
    unsigned* bar; unsigned x;
    volatile LAS unsigned* st;
};

__device__ __forceinline__ XcdBarrier xcd_barrier_post(unsigned* bar, volatile LAS unsigned* st) {
    XcdBarrier b; b.bar = bar; b.x = xb_xcc_id(); b.st = st;
    if (threadIdx.x == 0) (void)xb_add(&bar[XB_XCNT(b.x)], 1u);
    return b;
}
__device__ __forceinline__ void xcd_barrier_complete(unsigned* bar, unsigned x, unsigned& nloc, unsigned& nx) {
    const unsigned G = gridDim.x * gridDim.y * gridDim.z;
    unsigned sum, cnt, mine, sp = 0u;
    for (;;) {
        sum = 0u; cnt = 0u; mine = 0u;
#pragma unroll
        for (unsigned j = 0; j < 16; ++j) { const unsigned c = xb_ld(&bar[XB_XCNT(j)]); sum += c; cnt += (c > 0u) ? 1u : 0u; mine = (j == x) ? c : mine; }
        if (sum == G) break;
        __builtin_amdgcn_s_sleep(1);
        if ((++sp & 255u) == 0u) { if (xb_ld(&bar[XB_TMO])) break; if (sp > XB_SPIN_CAP) { atomicAdd(&bar[XB_TMO], 1u); break; } }
    }
    nloc = mine > 0u ? mine : 1u; nx = cnt > 0u ? cnt : 1u;
}

__device__ __forceinline__ void xcd_barrier(const XcdBarrier& b) {
    asm volatile("s_waitcnt vmcnt(0)" ::: "memory");
    __syncthreads();
    if (threadIdx.x == 0) {
        unsigned* bar = b.bar;
        __builtin_amdgcn_s_waitcnt(0);
        unsigned nloc = b.st[0], nx = b.st[1];
        if (nloc == 0u) { xcd_barrier_complete(bar, b.x, nloc, nx); b.st[0] = nloc; b.st[1] = nx; }
        const unsigned old = xb_add(&bar[XB_XSUB(b.x)], 1u);
        const unsigned gen = old / nloc;
        if (old + 1u == (gen + 1u) * nloc) {
            __builtin_amdgcn_fence(__ATOMIC_RELEASE, "agent");
            asm volatile("s_waitcnt vmcnt(0)" ::: "memory");
            const unsigned og = xb_add(&bar[XB_TOP], 1u);
            const unsigned tg = og / nx;
            if (og + 1u == (tg + 1u) * nx) xb_add(&bar[XB_TOPGEN], 1u);
            else XB_SPIN(xb_ld(&bar[XB_TOPGEN]) == tg, bar);
            __builtin_amdgcn_fence(__ATOMIC_ACQUIRE, "agent");
            xb_add(&bar[XB_XGEN(b.x)], 1u);
            asm volatile("s_waitcnt vmcnt(0)" ::: "memory");
        } else {
            XB_SPIN(xb_ld(&bar[XB_XGEN(b.x)]) == gen, bar);
            __builtin_amdgcn_fence(__ATOMIC_ACQUIRE, "agent");
            asm volatile("s_waitcnt vmcnt(0)" ::: "memory");
        }
    }
    __syncthreads();
}

constexpr int D = 2048, NB = 4, SEQ = 4096, DEPTH = 4, CTXL = 256, NMOD = 9, DFF = 5632, NH = 8, DK = 128, DV = 128, WK = 1024;
constexpr int BW = 512, CWD = 512, INW = 13824;
constexpr int M_LAT = NB * SEQ, M_CTX = NB * CTXL, M = M_LAT + M_CTX;
constexpr int MODW = NMOD * D;
constexpr int NGRP = 5;
constexpr float EPS = 1e-6f;
constexpr int Z1W = 4096, Z2W = INW - Z1W;
constexpr int Z2_GA = 0, Z2_U = 1024, Z2_V = 1536, Z2_HC = 2048, Z2_GB = 2560, Z2_GC = 3072, Z2_MA = 3584, Z2_MB = 5632, Z2_MC = 7680;

constexpr size_t MiB = 1u << 20;
constexpr size_t WS_CTL = 0ull * MiB, CTL_ZERO_BYTES = 32 * 1024;
constexpr size_t WS_MOD = 1ull * MiB;
constexpr size_t WS_LB = 3ull * MiB;
constexpr size_t WS_WGU = 4ull * MiB;
constexpr size_t WS_WD = 356ull * MiB;
constexpr size_t WS_WIN = 532ull * MiB;
constexpr size_t WS_WP = 748ull * MiB;
constexpr size_t WS_WO = 780ull * MiB;
constexpr size_t WS_Y = 812ull * MiB;
constexpr size_t WS_H = 948ull * MiB;
constexpr size_t WS_MRG = 1016ull * MiB;
constexpr size_t WS_YABC = 1084ull * MiB;
constexpr size_t WS_MF32 = 1152ull * MiB;
constexpr size_t WS_OF = 1288ull * MiB;
constexpr size_t WS_OB = 1356ull * MiB;
constexpr size_t WS_FF = 1424ull * MiB;
constexpr size_t WS_FB = 1492ull * MiB;
constexpr size_t WS_VN = 1560ull * MiB;
constexpr size_t WS_Z1 = 1577ull * MiB;
constexpr size_t WS_ZF = WS_Z1, WS_QS = WS_Z1 + 68ull * MiB;
constexpr size_t WS_Z2 = 1849ull * MiB;
constexpr size_t WS_ACT = WS_Z1;
constexpr size_t WS_QF = WS_FF, WS_KF = WS_FF + 34ull * MiB, WS_QB = WS_FB, WS_KB = WS_FB + 34ull * MiB;
constexpr size_t WS_VV = 2172ull * MiB;
constexpr size_t WS_GF = 2206ull * MiB;
constexpr size_t WS_GB = 2211ull * MiB;
constexpr size_t WS_SLOC = 2216ull * MiB;
constexpr size_t WS_END = 2248ull * MiB;
constexpr int CW_BAR = 4096;
static_assert((CW_BAR + 3456) * 4 <= (int)CTL_ZERO_BYTES, "barrier words inside the per-call memset");

constexpr int RING_BYTES = 131072;
constexpr int LDSCTL_OFF = RING_BYTES, MISC_OFF = LDSCTL_OFF + 320;
constexpr int LDS_BYTES = 147456;

#define GAS __attribute__((address_space(1)))
typedef unsigned short bf16;
typedef unsigned v4u __attribute__((ext_vector_type(4)));
typedef unsigned v2u __attribute__((ext_vector_type(2)));
typedef float f32x4 __attribute__((ext_vector_type(4)));
#define LDS_WAIT() asm volatile("s_waitcnt lgkmcnt(0)" ::: "memory")
#define VM_WAIT() asm volatile("s_waitcnt vmcnt(0)" ::: "memory")
__device__ __forceinline__ unsigned f2bf(float f) { unsigned u = __builtin_bit_cast(unsigned, f); return (u + 0x7fffu + ((u >> 16) & 1u)) >> 16; }
__device__ __forceinline__ unsigned pk2(float lo, float hi) { unsigned r; asm("v_cvt_pk_bf16_f32 %0, %1, %2" : "=v"(r) : "v"(lo), "v"(hi)); return r; }
__device__ __forceinline__ float bflo(unsigned w) { return __builtin_bit_cast(float, w << 16); }
__device__ __forceinline__ float bfhi(unsigned w) { return __builtin_bit_cast(float, w & 0xffff0000u); }
__device__ __forceinline__ float sigmoidf_(float x) { return __builtin_amdgcn_rcpf(1.0f + __expf(-x)); }
__device__ __forceinline__ float siluf_(float x) { return x * sigmoidf_(x); }
__device__ __forceinline__ float gelu_tanh(float x) { const float u = 0.7978845608028654f * (x + 0.044715f * x * x * x); return x * sigmoidf_(2.0f * u); }
template <int CTRL> __device__ __forceinline__ float dppf(float x) { return __builtin_bit_cast(float, __builtin_amdgcn_mov_dpp(__builtin_bit_cast(int, x), CTRL, 0xf, 0xf, true)); }
__device__ __forceinline__ float row16_sum(float x) { x += dppf<0xB1>(x); x += dppf<0x4E>(x); x += dppf<0x124>(x); x += dppf<0x128>(x); return x; }
__device__ __forceinline__ float wave_sum(float v) {
#pragma unroll
    for (int o = 1; o < 64; o <<= 1) v += __shfl_xor(v, o);
    return v;
}
__device__ __forceinline__ int grp_of_row(int m) { return m < M_LAT ? (m >> 12) : 4; }
#ifndef YBF16
#define YBF16 1
#endif
#if YBF16
typedef _Float16 ytype;
typedef _Float16 h16x4 __attribute__((ext_vector_type(4)));
__device__ __forceinline__ f32x4 y_ld4(const ytype* p) { const h16x4 w = *(const GAS h16x4*)p; return __builtin_convertvector(w, f32x4); }
__device__ __forceinline__ void y_st4(ytype* p, f32x4 v) { *(GAS h16x4*)p = __builtin_convertvector(v, h16x4); }
#else
typedef float ytype;
__device__ __forceinline__ f32x4 y_ld4(const ytype* p) { return *(const GAS f32x4*)p; }
__device__ __forceinline__ void y_st4(ytype* p, f32x4 v) { *(GAS f32x4*)p = v; }
#endif

struct Frame {
    LAS unsigned char* lds;
    int tid, lane, wave, vcu, G;
    unsigned char* ws;
};
struct Args { const float* in[23]; float* out; unsigned char* ws; int ph_lo, ph_hi; };
typedef const __attribute__((address_space(4))) Args* KArgs;
__device__ __forceinline__ KArgs kargs() { auto p = __builtin_amdgcn_kernarg_segment_ptr(); asm volatile("" : "+s"(p)); return (KArgs)p; }
__device__ __forceinline__ Frame mkframe() {
    extern __shared__ __attribute__((aligned(16))) unsigned char lds_dyn[];
    Frame F; F.lds = (LAS unsigned char*)lds_dyn; { int t = threadIdx.x; asm volatile("" : "+v"(t)); F.tid = t; } F.lane = F.tid & 63; F.wave = __builtin_amdgcn_readfirstlane(F.tid >> 6);
    { int gg = gridDim.x; asm volatile("" : "+s"(gg)); F.G = gg; } { int bx = blockIdx.x; asm volatile("" : "+s"(bx)); F.vcu = (F.G % 8 == 0) ? (bx % 8) * (F.G / 8) + bx / 8 : bx; }
    F.ws = kargs()->ws; return F;
}

namespace pg8 {
#define TRANS8N(op, a) asm(op " %0, -%0\n\t" op " %1, -%1\n\t" op " %2, -%2\n\t" op " %3, -%3\n\t" op " %4, -%4\n\t" op " %5, -%5\n\t" op " %6, -%6\n\t" op " %7, -%7\n\ts_nop 0" \
    : "+v"(a##0), "+v"(a##1), "+v"(a##2), "+v"(a##3), "+v"(a##4), "+v"(a##5), "+v"(a##6), "+v"(a##7))
#define TRANS8(op, a) asm(op " %0, %0\n\t" op " %1, %1\n\t" op " %2, %2\n\t" op " %3, %3\n\t" op " %4, %4\n\t" op " %5, %5\n\t" op " %6, %6\n\t" op " %7, %7\n\ts_nop 0" \
    : "+v"(a##0), "+v"(a##1), "+v"(a##2), "+v"(a##3), "+v"(a##4), "+v"(a##5), "+v"(a##6), "+v"(a##7))
struct EpiSwiGLU { static constexpr bool PERM = true, HOOK = false; static constexpr int H1 = -1, H2 = -1;
    bf16_t* O;
    __device__ __forceinline__ void operator()(const f32x4 (&acc)[2][2][4][2], const Unit& u, int wr, int wc, int fr, int fq) const {
        const int row0 = u.pm * BM + wr * 64 + fr, col0 = u.pn * HALF + wc * 32 + 8 * fq;
#pragma unroll
        for (int ai = 0; ai < 2; ++ai)
#pragma unroll
            for (int m = 0; m < 4; ++m) { bf16_t* rowp = O + (size_t)(row0 + ai * HALF + m * 16) * DFF + col0;
                const f32x4 g0 = acc[ai][0][m][0], g1 = acc[ai][0][m][1], u0 = acc[ai][1][m][0], u1 = acc[ai][1][m][1];
                float t0 = g0[0], t1 = g0[1], t2 = g0[2], t3 = g0[3], t4 = g1[0], t5 = g1[1], t6 = g1[2], t7 = g1[3];
                TRANS8N("v_exp_f32_e64", t);
                t0 += 1.0f; t1 += 1.0f; t2 += 1.0f; t3 += 1.0f; t4 += 1.0f; t5 += 1.0f; t6 += 1.0f; t7 += 1.0f;
                TRANS8("v_rcp_f32", t);
                u32x4 w; w.x = cvt_pk_bf16(g0[0] * u0[0] * t0, g0[1] * u0[1] * t1); w.y = cvt_pk_bf16(g0[2] * u0[2] * t2, g0[3] * u0[3] * t3);
                w.z = cvt_pk_bf16(g1[0] * u1[0] * t4, g1[1] * u1[1] * t5); w.w = cvt_pk_bf16(g1[2] * u1[2] * t6, g1[3] * u1[3] * t7);
                *(u32x4*)rowp = w; }
    }
};
#if YBF16
typedef _Float16 yh16x8 __attribute__((ext_vector_type(8)));
typedef float yf32x8 __attribute__((ext_vector_type(8)));
#endif
struct EpiResid { static constexpr bool PERM = true, HOOK = false; static constexpr int H1 = -1, H2 = -1;
    ytype* Y; const float* gate; float coef; float* slab;
    __device__ __forceinline__ void operator()(const f32x4 (&acc)[2][2][4][2], const Unit& u, int wr, int wc, int fr, int fq) const {
        const int row0 = u.pm * BM + wr * 64 + fr, col0 = u.pn * BM + wc * 32 + 8 * fq; const int grp = u.pm < 64 ? (u.pm >> 4) : 4;
        if (u.part() == 0) {
        const float* gp = gate + (size_t)grp * MODW + col0; f32x4 gv[2][2];
#pragma unroll
        for (int bj = 0; bj < 2; ++bj)
#pragma unroll
            for (int n = 0; n < 2; ++n) gv[bj][n] = *(const f32x4*)(gp + bj * HALF + 4 * n) * coef;
#if YBF16
#pragma unroll
        for (int ai = 0; ai < 2; ++ai) { yh16x8 old[4][2];
#pragma unroll
            for (int m = 0; m < 4; ++m)
#pragma unroll
                for (int bj = 0; bj < 2; ++bj) old[m][bj] = *(const yh16x8*)(Y + (size_t)(row0 + ai * HALF + m * 16) * D + col0 + bj * HALF);
#pragma unroll
            for (int m = 0; m < 4; ++m)
#pragma unroll
                for (int bj = 0; bj < 2; ++bj) { const yf32x8 o = __builtin_convertvector(old[m][bj], yf32x8); const f32x4 a0 = gv[bj][0] * acc[ai][bj][m][0], a1 = gv[bj][1] * acc[ai][bj][m][1];
                    const yf32x8 r = {o[0] + a0[0], o[1] + a0[1], o[2] + a0[2], o[3] + a0[3], o[4] + a1[0], o[5] + a1[1], o[6] + a1[2], o[7] + a1[3]};
                    *(yh16x8*)(Y + (size_t)(row0 + ai * HALF + m * 16) * D + col0 + bj * HALF) = __builtin_convertvector(r, yh16x8); }
            asm volatile("" ::: "memory"); }
#else
#pragma unroll
        for (int ai = 0; ai < 2; ++ai)
#pragma unroll
            for (int m = 0; m < 4; ++m) { float* rowp = Y + (size_t)(row0 + ai * HALF + m * 16) * D + col0;
#pragma unroll
                for (int bj = 0; bj < 2; ++bj)
#pragma unroll
                    for (int n = 0; n < 2; ++n) { float* p = rowp + bj * HALF + 4 * n; const f32x4 o = *(const f32x4*)p; *(f32x4*)p = o + gv[bj][n] * acc[ai][bj][m][n]; }
                asm volatile("" ::: "memory"); }
#endif
        } else {
#pragma unroll
        for (int ai = 0; ai < 2; ++ai)
#pragma unroll
            for (int m = 0; m < 4; ++m) { _Float16* rowp = (_Float16*)slab + ((size_t)(u.part() - 1) * M_CTX + (size_t)(row0 + ai * HALF + m * 16 - M_LAT)) * D + col0;
#pragma unroll
                for (int bj = 0; bj < 2; ++bj) { const f32x4 v0 = acc[ai][bj][m][0], v1 = acc[ai][bj][m][1]; const yf32x8 v = {v0[0], v0[1], v0[2], v0[3], v1[0], v1[1], v1[2], v1[3]};
                    *(yh16x8*)(rowp + bj * HALF) = __builtin_convertvector(v, yh16x8); } }
        }
    }
};
typedef _Float16 eh16x8 __attribute__((ext_vector_type(8)));
typedef float ef32x8 __attribute__((ext_vector_type(8)));
struct EpiInproj { static constexpr bool PERM = true, HOOK = false; static constexpr int H1 = -1, H2 = -1;
    bf16_t* QS; bf16_t* VV; _Float16* ZF; bf16_t* Z2;
    __device__ __forceinline__ void operator()(const f32x4 (&acc)[2][2][4][2], const Unit& u, int wr, int wc, int fr, int fq) const {
        const int row0 = u.pm * BM + wr * 64 + fr;
        if (u.pn < 8) { bf16_t* base = u.pn < 4 ? QS : VV; const float sc = 1.0f;        const int col0 = (u.pn & 3) * BM + wc * 32 + 8 * fq;
#pragma unroll
            for (int ai = 0; ai < 2; ++ai)
#pragma unroll
                for (int m = 0; m < 4; ++m) { bf16_t* rowp = base + (size_t)(row0 + ai * HALF + m * 16) * WK + col0;
#pragma unroll
                    for (int bj = 0; bj < 2; ++bj) { const f32x4 v0 = acc[ai][bj][m][0] * sc, v1 = acc[ai][bj][m][1] * sc;
                        u32x4 w; w.x = cvt_pk_bf16(v0[0], v0[1]); w.y = cvt_pk_bf16(v0[2], v0[3]); w.z = cvt_pk_bf16(v1[0], v1[1]); w.w = cvt_pk_bf16(v1[2], v1[3]);
                        *(u32x4*)(rowp + bj * HALF) = w; } }
        } else if (u.pn < 16) { const int col0 = (u.pn - 8) * BM + wc * 32 + 8 * fq;
#pragma unroll
            for (int ai = 0; ai < 2; ++ai)
#pragma unroll
                for (int m = 0; m < 4; ++m) { _Float16* rowp = ZF + (size_t)(row0 + ai * HALF + m * 16) * 2048 + col0;
#pragma unroll
                    for (int bj = 0; bj < 2; ++bj) { const f32x4 v0 = acc[ai][bj][m][0], v1 = acc[ai][bj][m][1];
                        const ef32x8 v = {v0[0], v0[1], v0[2], v0[3], v1[0], v1[1], v1[2], v1[3]}; *(eh16x8*)(rowp + bj * HALF) = __builtin_convertvector(v, eh16x8); } }
        } else if (u.pn < 30) { const int col0 = (u.pn - 16) * BM + wc * 32 + 8 * fq;
#pragma unroll
            for (int ai = 0; ai < 2; ++ai)
#pragma unroll
                for (int m = 0; m < 4; ++m) { bf16_t* rowp = Z2 + (size_t)(row0 + ai * HALF + m * 16) * Z2W + col0;
#pragma unroll
                    for (int bj = 0; bj < 2; ++bj) { const f32x4 v0 = acc[ai][bj][m][0], v1 = acc[ai][bj][m][1];
                        u32x4 w; w.x = cvt_pk_bf16(v0[0], v0[1]); w.y = cvt_pk_bf16(v0[2], v0[3]); w.z = cvt_pk_bf16(v1[0], v1[1]); w.w = cvt_pk_bf16(v1[2], v1[3]);
                        *(u32x4*)(rowp + bj * HALF) = w; } }
        } else { const int col0 = (u.pn - 16) * BM + wc * 32 + 8 * fq;
            constexpr float CL = 30.0f * 1.4426950408889634f;
#pragma unroll
            for (int ai = 0; ai < 2; ++ai)
#pragma unroll
                for (int m = 0; m < 4; ++m) { bf16_t* rowp = Z2 + (size_t)(row0 + ai * HALF + m * 16) * Z2W + col0;
#pragma unroll
                    for (int bj = 0; bj < 2; ++bj) { const f32x4 v0 = acc[ai][bj][m][0], v1 = acc[ai][bj][m][1];
                        float t0 = __builtin_amdgcn_fmed3f(v0[0], -CL, CL), t1 = __builtin_amdgcn_fmed3f(v0[1], -CL, CL), t2 = __builtin_amdgcn_fmed3f(v0[2], -CL, CL), t3 = __builtin_amdgcn_fmed3f(v0[3], -CL, CL);
                        float t4 = __builtin_amdgcn_fmed3f(v1[0], -CL, CL), t5 = __builtin_amdgcn_fmed3f(v1[1], -CL, CL), t6 = __builtin_amdgcn_fmed3f(v1[2], -CL, CL), t7 = __builtin_amdgcn_fmed3f(v1[3], -CL, CL);
                        TRANS8("v_exp_f32", t);
                        u32x4 w; w.x = cvt_pk_bf16(t0 + 1.0f, t1 + 1.0f); w.y = cvt_pk_bf16(t2 + 1.0f, t3 + 1.0f); w.z = cvt_pk_bf16(t4 + 1.0f, t5 + 1.0f); w.w = cvt_pk_bf16(t6 + 1.0f, t7 + 1.0f);
                        *(u32x4*)(rowp + bj * HALF) = w; } }
        }
    }
};
struct EpiProjF { static constexpr bool PERM = true, HOOK = true; static constexpr int H1 = 16, H2 = 24;
    bf16_t* MRG; const bf16_t* Z2;
    __device__ __forceinline__ void khook(f32x4 (&acc)[2][2][4][2], const Unit& u, int t, int wr, int wc, int fr_, int fq_) const {
        int fr = fr_, fq = fq_; asm volatile("" : "+v"(fr), "+v"(fq));
        const int row0 = u.pm * BM + wr * 64 + fr, col0 = u.pn * BM + wc * 32 + 8 * fq; const int onum = (t == H1) ? Z2_MB : Z2_MC, oden = (t == H1) ? Z2_MA : Z2_MB;
#pragma unroll
        for (int ai = 0; ai < 2; ++ai) { u32x4 wn[4][2], wd[4][2];
#pragma unroll
            for (int m = 0; m < 4; ++m) { const bf16_t* rp = Z2 + (size_t)(row0 + ai * HALF + m * 16) * Z2W + col0;
#pragma unroll
                for (int bj = 0; bj < 2; ++bj) { wn[m][bj] = *(const u32x4*)(rp + onum + bj * HALF); wd[m][bj] = *(const u32x4*)(rp + oden + bj * HALF); } }
#pragma unroll
            for (int m = 0; m < 4; ++m)
#pragma unroll
                for (int bj = 0; bj < 2; ++bj) { const u32x4 a = wn[m][bj], b = wd[m][bj]; f32x4 r0, r1;
                    r0[0] = bflo(a.x) * __builtin_amdgcn_rcpf(bflo(b.x)); r0[1] = bfhi(a.x) * __builtin_amdgcn_rcpf(bfhi(b.x)); r0[2] = bflo(a.y) * __builtin_amdgcn_rcpf(bflo(b.y)); r0[3] = bfhi(a.y) * __builtin_amdgcn_rcpf(bfhi(b.y));
                    r1[0] = bflo(a.z) * __builtin_amdgcn_rcpf(bflo(b.z)); r1[1] = bfhi(a.z) * __builtin_amdgcn_rcpf(bfhi(b.z)); r1[2] = bflo(a.w) * __builtin_amdgcn_rcpf(bflo(b.w)); r1[3] = bfhi(a.w) * __builtin_amdgcn_rcpf(bfhi(b.w));
                    acc[ai][bj][m][0] = acc[ai][bj][m][0] * r0; acc[ai][bj][m][1] = acc[ai][bj][m][1] * r1; }
            asm volatile("" ::: "memory"); }
    }
    __device__ __forceinline__ void operator()(const f32x4 (&acc)[2][2][4][2], const Unit& u, int wr, int wc, int fr, int fq) const {
        const int row0 = u.pm * BM + wr * 64 + fr, col0 = u.pn * BM + wc * 32 + 8 * fq;
#pragma unroll
        for (int ai = 0; ai < 2; ++ai) { u32x4 wc_[4][2];
#pragma unroll
            for (int m = 0; m < 4; ++m)
#pragma unroll
                for (int bj = 0; bj < 2; ++bj) wc_[m][bj] = *(const u32x4*)(Z2 + (size_t)(row0 + ai * HALF + m * 16) * Z2W + Z2_MC + col0 + bj * HALF);
#pragma unroll
            for (int m = 0; m < 4; ++m)
#pragma unroll
                for (int bj = 0; bj < 2; ++bj) { const u32x4 c = wc_[m][bj]; const f32x4 v0 = acc[ai][bj][m][0], v1 = acc[ai][bj][m][1]; u32x4 w;
                    w.x = cvt_pk_bf16(v0[0] * __builtin_amdgcn_rcpf(bflo(c.x)), v0[1] * __builtin_amdgcn_rcpf(bfhi(c.x))); w.y = cvt_pk_bf16(v0[2] * __builtin_amdgcn_rcpf(bflo(c.y)), v0[3] * __builtin_amdgcn_rcpf(bfhi(c.y)));
                    w.z = cvt_pk_bf16(v1[0] * __builtin_amdgcn_rcpf(bflo(c.z)), v1[1] * __builtin_amdgcn_rcpf(bfhi(c.z))); w.w = cvt_pk_bf16(v1[2] * __builtin_amdgcn_rcpf(bflo(c.w)), v1[3] * __builtin_amdgcn_rcpf(bfhi(c.w)));
                    *(u32x4*)(MRG + (size_t)(row0 + ai * HALF + m * 16) * D + col0 + bj * HALF) = w; }
            asm volatile("" ::: "memory"); }
    }
};
}

struct CvItem { const float* W; bf16* dst; int ldw, k0, n0, ldk, drow0, dk0; float sc; };
__device__ __forceinline__ void transpose_load(const CvItem& I, float (&wv)[32], int lane) {
#pragma unroll
    for (int i = 0; i < 32; ++i) wv[i] = __builtin_nontemporal_load(I.W + (size_t)(I.k0 + 2 * i + (lane >> 5)) * I.ldw + I.n0 + (lane & 31));
}
__device__ __forceinline__ void transpose_store(const CvItem& I, const float (&wv)[32], LAS float* scr, int lane) {
#pragma unroll
    for (int i = 0; i < 32; ++i) scr[(2 * i + (lane >> 5)) * 33 + (lane & 31)] = wv[i];
    LDS_WAIT(); asm volatile("" ::: "memory");
    const int c = lane & 7;
#pragma unroll
    for (int j = 0; j < 4; ++j) { const int n = (lane >> 3) + 8 * j; const LAS float* s = scr + (8 * c) * 33 + n;
        const float sc = I.sc; v4u o; o.x = pk2(s[0 * 33] * sc, s[1 * 33] * sc); o.y = pk2(s[2 * 33] * sc, s[3 * 33] * sc); o.z = pk2(s[4 * 33] * sc, s[5 * 33] * sc); o.w = pk2(s[6 * 33] * sc, s[7 * 33] * sc);
        __builtin_nontemporal_store(o, (GAS v4u*)(I.dst + (size_t)(I.drow0 + n) * I.ldk + I.dk0 + I.k0 + 8 * c)); }
    LDS_WAIT(); asm volatile("" ::: "memory");
}

enum { IX = 0, IC, ICTX, ICCTX, IWMOD, IBMOD, INORMG, IFINALG, IWGATE, IWUP, IWDOWN, IWIN, ILB, IANORM, ILNG, ILNB, IWS, IBS, ICONV, IWPA, IWPB, IWPC, IWOUT };
#define INP(k) (kargs()->in[(k)])

constexpr int CV_I_FF = (D / 64) * (DFF / 32);
constexpr int CV_I_IN = (D / 64) * (INW / 32);
constexpr int CV_I_PA = (1024 / 64) * (D / 32), CV_I_PB = (512 / 64) * (D / 32);
constexpr int CV_I_WO = (D / 64) * (D / 32);
constexpr int CV_PER_L = 6 * CV_I_FF + CV_I_IN + CV_I_PA + 2 * CV_I_PB + CV_I_WO;
__device__ __forceinline__ CvItem cv_decode(int l, int r) {
    unsigned char* ws = kargs()->ws; CvItem I;
    if (r < 6 * CV_I_FF) { const int j = r / (3 * CV_I_FF); r %= 3 * CV_I_FF; const int which = r / CV_I_FF; r %= CV_I_FF; const size_t lj = (size_t)(l * 2 + j);
        if (which < 2) { const int nblk = DFF / 32, kb = r / nblk, nb = r % nblk, n0 = 32 * nb;
            I.W = (which == 0 ? INP(IWGATE) : INP(IWUP)) + lj * D * DFF; I.ldw = DFF; I.k0 = 64 * kb; I.n0 = n0; I.dst = (bf16*)(ws + WS_WGU) + lj * (size_t)(2 * DFF) * D; I.ldk = D; I.drow0 = 256 * (n0 >> 7) + (n0 & 127) + 128 * which; I.dk0 = 0; I.sc = which == 0 ? 1.4426950408889634f : 0.6931471805599453f;
        } else { const int nblk = D / 32, kb = r / nblk, nb = r % nblk;
            I.W = INP(IWDOWN) + lj * DFF * D; I.ldw = D; I.k0 = 64 * kb; I.n0 = 32 * nb; I.dst = (bf16*)(ws + WS_WD) + lj * (size_t)D * DFF; I.ldk = DFF; I.drow0 = 32 * nb; I.dk0 = 0; I.sc = 1.0f; }
        return I; }
    r -= 6 * CV_I_FF;
    if (r < CV_I_IN) { const int nblk = INW / 32, kb = r / nblk, nb = r % nblk; I.W = INP(IWIN) + (size_t)l * D * INW; I.ldw = INW; I.k0 = 64 * kb; I.n0 = 32 * nb; I.dst = (bf16*)(ws + WS_WIN) + (size_t)l * INW * D; I.ldk = D; I.drow0 = 32 * nb; I.dk0 = 0;
        { const int n0 = 32 * nb; I.sc = n0 < 1024 ? 0.08838834764831845f : n0 < 2048 ? 1.0f : n0 < 4096 ? -1.4426950408889634f : n0 < 4096 + Z2_MA ? 1.0f : -1.4426950408889634f; }
        return I; }
    r -= CV_I_IN;
    bf16* WP = (bf16*)(ws + WS_WP) + (size_t)l * D * 2048; const int nblk = D / 32;
    if (r < CV_I_PA) { const int kb = r / nblk, nb = r % nblk; I.W = INP(IWPA) + (size_t)l * 1024 * D; I.ldw = D; I.k0 = 64 * kb; I.n0 = 32 * nb; I.dst = WP; I.ldk = 2048; I.drow0 = 32 * nb; I.dk0 = 0; I.sc = 1.0f; return I; }
    r -= CV_I_PA;
    if (r < CV_I_PB) { const int kb = r / nblk, nb = r % nblk; I.W = INP(IWPB) + (size_t)l * 512 * D; I.ldw = D; I.k0 = 64 * kb; I.n0 = 32 * nb; I.dst = WP; I.ldk = 2048; I.drow0 = 32 * nb; I.dk0 = 1024; I.sc = 1.0f; return I; }
    r -= CV_I_PB;
    if (r < CV_I_PB) { const int kb = r / nblk, nb = r % nblk; I.W = INP(IWPC) + (size_t)l * 512 * D; I.ldw = D; I.k0 = 64 * kb; I.n0 = 32 * nb; I.dst = WP; I.ldk = 2048; I.drow0 = 32 * nb; I.dk0 = 1536; I.sc = 1.0f; return I; }
    r -= CV_I_PB;
    { const int kb = r / nblk, nb = r % nblk; I.W = INP(IWOUT) + (size_t)l * D * D; I.ldw = D; I.k0 = 64 * kb; I.n0 = 32 * nb; I.dst = (bf16*)(ws + WS_WO) + (size_t)l * D * D; I.ldk = D; I.drow0 = 32 * nb; I.dk0 = 0; I.sc = 1.0f; }
    return I;
}
__device__ __forceinline__ void convert_run(int l, int first, int end, int stride, LAS float* scr, int lane) {
#pragma unroll 1
    for (int it = first; it < end; it += 2 * stride) { const bool two = it + stride < end;
        const CvItem A = cv_decode(l, it), B = cv_decode(l, two ? it + stride : it);
        float wa[32], wb[32];
        transpose_load(A, wa, lane); if (two) transpose_load(B, wb, lane);
        transpose_store(A, wa, scr, lane); if (two) transpose_store(B, wb, scr, lane); }
}
constexpr int CV_Q_GU = 64, CV_Q_IN = 64, CV_Q_PJ = 96;
__device__ __forceinline__ int cv_nidle(int nwg, int G) { const int rem = nwg % G; return rem ? G - rem : 0; }
__device__ __forceinline__ int cv_base(int slot, int G) {
    const int n_gu = cv_nidle((M / 256) * (2 * DFF / 256), G), n_in = cv_nidle(64 * 54 + 4 * 54, G), n_pj = cv_nidle((M / 256) * (D / 256), G);
    int b = 0; if (slot > 0) b += n_gu * CV_Q_GU; if (slot > 1) b += n_in * CV_Q_IN; if (slot > 2) b += n_pj * CV_Q_PJ; if (slot > 3) b += n_gu * CV_Q_GU; return b < CV_PER_L ? b : CV_PER_L;
}
__device__ __forceinline__ void convert_slot(int l, int slot, int nwg, int q) {
    int G = gridDim.x, c = blockIdx.x; asm volatile("" : "+s"(G), "+s"(c));
    const int rem = nwg % G; if (rem == 0 || c < rem) return;
    const Frame F = mkframe(); LAS float* scr = (LAS float*)(F.lds + F.wave * 16384);
    const int first = cv_base(slot, G) + (c - rem) * q; int end = first + q; if (end > CV_PER_L) end = CV_PER_L;
    convert_run(l, first + F.wave, end, 8, scr, F.lane);
}
__device__ __forceinline__ void convert_rest(int l) {
    const Frame F = mkframe(); LAS float* scr = (LAS float*)(F.lds + F.wave * 16384);
    const int gw = F.vcu * 8 + F.wave, NGW = F.G * 8;
    convert_run(l, cv_base(4, F.G) + gw, CV_PER_L, NGW, scr, F.lane);
}

__device__ __forceinline__ void phase_prologue() {
    const Frame F = mkframe(); unsigned char* ws = F.ws;
    const int gw = F.vcu * 8 + F.wave, NGW = F.G * 8;
    { ytype* Y = (ytype*)(ws + WS_Y);
      for (int m = gw; m < M; m += NGW) { const float* src = m < M_LAT ? INP(IX) + (size_t)m * D : INP(ICTX) + (size_t)(m - M_LAT) * D; const GAS f32x4* s = (const GAS f32x4*)src + F.lane;
#pragma unroll
          for (int j = 0; j < 8; ++j) y_st4(Y + (size_t)m * D + 4 * (64 * j + F.lane), s[64 * j]); } }
    if (blockIdx.x == 0) { float* LB = (float*)(ws + WS_LB);
        for (int i = F.tid; i < 2 * WK; i += 512) { float lg[DEPTH], mx = -1e30f;
#pragma unroll
            for (int l = 0; l < DEPTH; ++l) { lg[l] = INP(ILB)[l * 2 * WK + i]; mx = fmaxf(mx, lg[l]); }
            float s = 0.f;
#pragma unroll
            for (int l = 0; l < DEPTH; ++l) { lg[l] = __expf(lg[l] - mx); s += lg[l]; }
            float cum = 0.f; const float inv = 1.0f / s;
#pragma unroll
            for (int l = 0; l < DEPTH; ++l) { LB[l * 2 * WK + i] = cum; if (l + 1 < DEPTH) cum += lg[l + 1] * inv; } } }
    { LAS float* sc = (LAS float*)F.lds;
      LAS float* red = (LAS float*)(F.lds + 5 * D * 4);
      for (int i = F.tid; i < NGRP * D; i += 512) { const int g = i / D, k = i % D; const float v = g < 4 ? INP(IC)[g * D + k] : INP(ICCTX)[k]; sc[i] = siluf_(v); }
      __syncthreads();
      float* MOD = (float*)(ws + WS_MOD);
      constexpr int NU = DEPTH * (MODW / 128);
      for (int u = F.vcu; u < NU; u += F.G) { const int l = u / (MODW / 128), n0 = (u % (MODW / 128)) * 128;
          const float* Wp = INP(IWMOD) + (size_t)l * D * MODW + n0 + 2 * F.lane;
          float a0[NGRP], a1[NGRP];
#pragma unroll
          for (int g = 0; g < NGRP; ++g) { a0[g] = 0.f; a1[g] = 0.f; }
          const int kb = F.wave * 256;
#pragma unroll 16
          for (int k = kb; k < kb + 256; ++k) { typedef float f32x2v __attribute__((ext_vector_type(2))); const f32x2v w = __builtin_nontemporal_load((const GAS f32x2v*)(Wp + (size_t)k * MODW));
#pragma unroll
              for (int g = 0; g < NGRP; ++g) { const float s = sc[g * D + k]; a0[g] += s * w.x; a1[g] += s * w.y; } }
#pragma unroll
          for (int g = 0; g < NGRP; ++g) { red[(F.wave * NGRP + g) * 128 + 2 * F.lane] = a0[g]; red[(F.wave * NGRP + g) * 128 + 2 * F.lane + 1] = a1[g]; }
          __syncthreads();
          for (int i = F.tid; i < NGRP * 128; i += 512) { const int g = i / 128, n = i % 128; float s = 0.f;
#pragma unroll
              for (int w = 0; w < 8; ++w) s += red[(w * NGRP + g) * 128 + n];
              MOD[((size_t)l * NGRP + g) * MODW + n0 + n] = s + INP(IBMOD)[l * MODW + n0 + n]; }
          __syncthreads(); }
    }
    __syncthreads();
    { LAS float* scr = (LAS float*)(F.lds + F.wave * 16384);
      convert_run(0, gw, CV_PER_L, NGW, scr, F.lane); }
}

__device__ __forceinline__ float wave_sum_fast(float x) {
    x = row16_sum(x);
    const float a = __builtin_bit_cast(float, __builtin_amdgcn_readlane(__builtin_bit_cast(int, x), 0)), b = __builtin_bit_cast(float, __builtin_amdgcn_readlane(__builtin_bit_cast(int, x), 16));
    const float c = __builtin_bit_cast(float, __builtin_amdgcn_readlane(__builtin_bit_cast(int, x), 32)), d = __builtin_bit_cast(float, __builtin_amdgcn_readlane(__builtin_bit_cast(int, x), 48));
    return (a + b) + (c + d);
}
__device__ __forceinline__ void phase_norm(int l, int which, int mlim, int red, int rgate_l, int rgate_idx, float rcoef) {
    const Frame F = mkframe(); ytype* Y = (ytype*)(F.ws + WS_Y); bf16* H = (bf16*)(F.ws + WS_H);
    const float* g = INP(INORMG) + (size_t)(l * 3 + which) * D; const float* mod_l = (const float*)(F.ws + WS_MOD) + (size_t)l * NGRP * MODW; const int shift_idx = 3 * which;
    const int gw = F.vcu * 8 + F.wave, NGW = F.G * 8, lane = F.lane;
    typedef pg8::eh16x8 h8; typedef pg8::ef32x8 f8;
    f32x4 gs[4][2], sh[4][2];
    auto load_vecs = [&](int grp) { const float* mp = mod_l + (size_t)grp * MODW + shift_idx * D;
#pragma unroll
        for (int j = 0; j < 4; ++j)
#pragma unroll
            for (int e = 0; e < 2; ++e) { const int c = 8 * lane + 512 * j + 4 * e; gs[j][e] = *(const GAS f32x4*)(g + c) * (1.0f + *(const GAS f32x4*)(mp + D + c)); sh[j][e] = *(const GAS f32x4*)(mp + c); } };
    auto finish_row = [&](int m, f8 (&v)[4]) { float ss = 0.f;
#pragma unroll
        for (int j = 0; j < 4; ++j)
#pragma unroll
            for (int e = 0; e < 8; ++e) ss += v[j][e] * v[j][e];
        const float rstd = 1.0f / sqrtf(wave_sum_fast(ss) * (1.0f / D) + EPS);
#pragma unroll
        for (int j = 0; j < 4; ++j) { v4u o; const f32x4 a = (f32x4){v[j][0], v[j][1], v[j][2], v[j][3]} * rstd * gs[j][0] + sh[j][0], b = (f32x4){v[j][4], v[j][5], v[j][6], v[j][7]} * rstd * gs[j][1] + sh[j][1];
            o.x = pk2(a[0], a[1]); o.y = pk2(a[2], a[3]); o.z = pk2(b[0], b[1]); o.w = pk2(b[2], b[3]); *(GAS v4u*)(H + (size_t)m * D + 8 * lane + 512 * j) = o; } };
    if (NGW * 8 == M_LAT) {
        load_vecs(gw >> 9);
        h8 cur[4], nxt[4];
#pragma unroll
        for (int j = 0; j < 4; ++j) cur[j] = *(const GAS h8*)(Y + (size_t)(8 * gw) * D + 8 * lane + 512 * j);
#pragma unroll 1
        for (int r = 0; r < 8; ++r) { const int m = 8 * gw + r, mn = r < 7 ? m + 1 : m;
#pragma unroll
            for (int j = 0; j < 4; ++j) nxt[j] = *(const GAS h8*)(Y + (size_t)mn * D + 8 * lane + 512 * j);
            f8 v[4];
#pragma unroll
            for (int j = 0; j < 4; ++j) v[j] = __builtin_convertvector(cur[j], f8);
            finish_row(m, v);
#pragma unroll
            for (int j = 0; j < 4; ++j) cur[j] = nxt[j]; }
    } else {
        for (int m = gw; m < M_LAT; m += NGW) { load_vecs(m >> 12); f8 v[4];
#pragma unroll
            for (int j = 0; j < 4; ++j) v[j] = __builtin_convertvector(*(const GAS h8*)(Y + (size_t)m * D + 8 * lane + 512 * j), f8);
            finish_row(m, v); } }
    if (mlim > M_LAT) {
        load_vecs(4);
        for (int m = M_LAT + (gw >> 1) + ((gw & 1) ? (NGW >> 1) : 0); m < mlim; m += NGW) { f8 v[4];
#pragma unroll
            for (int j = 0; j < 4; ++j) v[j] = __builtin_convertvector(*(const GAS h8*)(Y + (size_t)m * D + 8 * lane + 512 * j), f8);
            if (red) { const _Float16* sl = (const _Float16*)(F.ws + WS_MF32) + (size_t)(m - M_LAT) * D; const float* rg = (const float*)(F.ws + WS_MOD) + ((size_t)rgate_l * NGRP + 4) * MODW + rgate_idx * D;
#pragma unroll
                for (int jh = 0; jh < 2; ++jh) { h8 part[2][8];
#pragma unroll
                    for (int jj = 0; jj < 2; ++jj)
#pragma unroll
                        for (int p = 0; p < 8; ++p) part[jj][p] = *(const GAS h8*)(sl + (size_t)p * M_CTX * D + 8 * lane + 512 * (2 * jh + jj));
#pragma unroll
                    for (int jj = 0; jj < 2; ++jj) { const int j = 2 * jh + jj, c = 8 * lane + 512 * j; f8 a = __builtin_convertvector(part[jj][0], f8);
#pragma unroll
                        for (int p = 1; p < 8; ++p) a = a + __builtin_convertvector(part[jj][p], f8);
                        const f32x4 g0 = *(const GAS f32x4*)(rg + c) * rcoef, g1 = *(const GAS f32x4*)(rg + c + 4) * rcoef;
#pragma unroll
                        for (int e = 0; e < 4; ++e) { v[j][e] += g0[e] * a[e]; v[j][4 + e] += g1[e] * a[4 + e]; }
                        *(GAS h8*)(Y + (size_t)m * D + c) = __builtin_convertvector(v[j], h8); }
                    asm volatile("" ::: "memory"); } }
            finish_row(m, v); } }
}

__device__ __forceinline__ void phase_final() {
    const Frame F = mkframe(); const ytype* Y = (const ytype*)(F.ws + WS_Y); float* out = kargs()->out; const float* g = INP(IFINALG);
    const int gw = F.vcu * 8 + F.wave, NGW = F.G * 8, lane = F.lane;
    typedef pg8::eh16x8 h8; typedef pg8::ef32x8 f8;
    f32x4 gs[4][2];
#pragma unroll
    for (int j = 0; j < 4; ++j)
#pragma unroll
        for (int e = 0; e < 2; ++e) gs[j][e] = *(const GAS f32x4*)(g + 8 * lane + 512 * j + 4 * e);
    const int per = (M_LAT + NGW - 1) / NGW, m0 = gw * per, m1 = (m0 + per < M_LAT) ? m0 + per : M_LAT;
    if (m0 >= m1) return;
    h8 cur[4], nxt[4];
#pragma unroll
    for (int j = 0; j < 4; ++j) cur[j] = *(const GAS h8*)(Y + (size_t)m0 * D + 8 * lane + 512 * j);
#pragma unroll 1
    for (int m = m0; m < m1; ++m) { const int mn = m + 1 < m1 ? m + 1 : m;
#pragma unroll
        for (int j = 0; j < 4; ++j) nxt[j] = *(const GAS h8*)(Y + (size_t)mn * D + 8 * lane + 512 * j);
        f8 v[4]; float ss = 0.f;
#pragma unroll
        for (int j = 0; j < 4; ++j) { v[j] = __builtin_convertvector(cur[j], f8);
#pragma unroll
            for (int e = 0; e < 8; ++e) ss += v[j][e] * v[j][e]; }
        const float rstd = 1.0f / sqrtf(wave_sum_fast(ss) * (1.0f / D) + EPS);
#pragma unroll
        for (int j = 0; j < 4; ++j) { float* o = out + (size_t)m * D + 8 * lane + 512 * j;
            *(GAS f32x4*)o = (f32x4){v[j][0], v[j][1], v[j][2], v[j][3]} * rstd * gs[j][0]; *(GAS f32x4*)(o + 4) = (f32x4){v[j][4], v[j][5], v[j][6], v[j][7]} * rstd * gs[j][1]; }
#pragma unroll
        for (int j = 0; j < 4; ++j) cur[j] = nxt[j]; }
}

struct ElemC { float lg[8], lbv[8], cw0[8], cw1[8], cw2[8]; };
__device__ __forceinline__ void elem_vn(const v4u raw, const ElemC& C, bf16* VN, int m, int lane) {
    float x[8];
    x[0] = gelu_tanh(bflo(raw.x)); x[1] = gelu_tanh(bfhi(raw.x)); x[2] = gelu_tanh(bflo(raw.y)); x[3] = gelu_tanh(bfhi(raw.y));
    x[4] = gelu_tanh(bflo(raw.z)); x[5] = gelu_tanh(bfhi(raw.z)); x[6] = gelu_tanh(bflo(raw.w)); x[7] = gelu_tanh(bfhi(raw.w));
    float s = 0.f;
#pragma unroll
    for (int e = 0; e < 8; ++e) s += x[e];
    const float mean = wave_sum_fast(s) * (1.0f / BW); float q = 0.f;
#pragma unroll
    for (int e = 0; e < 8; ++e) { x[e] -= mean; q += x[e] * x[e]; }
    const float rstd = 1.0f / sqrtf(wave_sum_fast(q) * (1.0f / BW) + EPS); float y[8];
#pragma unroll
    for (int e = 0; e < 8; ++e) y[e] = x[e] * rstd * C.lg[e] + C.lbv[e];
    v4u o; o.x = pk2(y[0], y[1]); o.y = pk2(y[2], y[3]); o.z = pk2(y[4], y[5]); o.w = pk2(y[6], y[7]);
    *(GAS v4u*)(VN + (size_t)m * BW + 8 * lane) = o;
}
__device__ __forceinline__ void elem_t(const v4u hc, const v4u gc, float zz, float (&t)[8]) {
    t[0] = zz * bflo(hc.x) * bflo(gc.x); t[1] = zz * bfhi(hc.x) * bfhi(gc.x); t[2] = zz * bflo(hc.y) * bflo(gc.y); t[3] = zz * bfhi(hc.y) * bfhi(gc.y);
    t[4] = zz * bflo(hc.z) * bflo(gc.z); t[5] = zz * bfhi(hc.z) * bfhi(gc.z); t[6] = zz * bflo(hc.w) * bflo(gc.w); t[7] = zz * bfhi(hc.w) * bfhi(gc.w);
}
__device__ __forceinline__ void elem_conv(const float (&t0)[8], const float (&t1)[8], const float (&t2)[8], const v4u gbr, const ElemC& C, bf16* YABC, int m, int lane) {
    float gb[8], y[8];
    gb[0] = bflo(gbr.x); gb[1] = bfhi(gbr.x); gb[2] = bflo(gbr.y); gb[3] = bfhi(gbr.y); gb[4] = bflo(gbr.z); gb[5] = bfhi(gbr.z); gb[6] = bflo(gbr.w); gb[7] = bfhi(gbr.w);
#pragma unroll
    for (int e = 0; e < 8; ++e) y[e] = gb[e] * (C.cw0[e] * t0[e] + C.cw1[e] * t1[e] + C.cw2[e] * t2[e]);
    v4u o; o.x = pk2(y[0], y[1]); o.y = pk2(y[2], y[3]); o.z = pk2(y[4], y[5]); o.w = pk2(y[6], y[7]);
    *(GAS v4u*)(YABC + (size_t)m * 2048 + 1536 + 8 * lane) = o;
}
__device__ __forceinline__ void elem_row(const bf16* Z2, const ElemC& C, bf16* VN, bf16* YABC, int m, int lane) {
    bool hp, hn; if (m < M_LAT) { const int p = m & 63; hp = p != 0; hn = p != 63; } else { const int p = (m - M_LAT) & 255; hp = p != 0; hn = p != 255; }
    const size_t mp = (size_t)(hp ? m - 1 : m), mn = (size_t)(hn ? m + 1 : m);
    const v4u raw = *(const GAS v4u*)(Z2 + (size_t)m * Z2W + Z2_V + 8 * lane);
    const v4u hc0 = *(const GAS v4u*)(Z2 + mp * Z2W + Z2_HC + 8 * lane), gc0 = *(const GAS v4u*)(Z2 + mp * Z2W + Z2_GC + 8 * lane);
    const v4u hc1 = *(const GAS v4u*)(Z2 + (size_t)m * Z2W + Z2_HC + 8 * lane), gc1 = *(const GAS v4u*)(Z2 + (size_t)m * Z2W + Z2_GC + 8 * lane);
    const v4u hc2 = *(const GAS v4u*)(Z2 + mn * Z2W + Z2_HC + 8 * lane), gc2 = *(const GAS v4u*)(Z2 + mn * Z2W + Z2_GC + 8 * lane);
    const v4u gbr = *(const GAS v4u*)(Z2 + (size_t)m * Z2W + Z2_GB + 8 * lane);
    elem_vn(raw, C, VN, m, lane);
    float t0[8], t1[8], t2[8]; elem_t(hc0, gc0, hp ? 1.0f : 0.0f, t0); elem_t(hc1, gc1, 1.0f, t1); elem_t(hc2, gc2, hn ? 1.0f : 0.0f, t2);
    elem_conv(t0, t1, t2, gbr, C, YABC, m, lane);
}
__device__ __forceinline__ void phase_mix_elem(int l) {
    const Frame F = mkframe(); unsigned char* ws = F.ws;
    const bf16* Z2 = (const bf16*)(ws + WS_Z2);
    bf16* VN = (bf16*)(ws + WS_VN); bf16* YABC = (bf16*)(ws + WS_YABC);
    const int gw = F.vcu * 8 + F.wave, NGW = F.G * 8, lane = F.lane;
    ElemC C;
    { const float* gp = INP(ILNG) + l * BW + 8 * lane; const float* bp = INP(ILNB) + l * BW + 8 * lane; const float* cw = INP(ICONV) + (size_t)l * 3 * CWD + 8 * lane;
#pragma unroll
      for (int e = 0; e < 8; ++e) { C.lg[e] = gp[e]; C.lbv[e] = bp[e]; C.cw0[e] = cw[e]; C.cw1[e] = cw[CWD + e]; C.cw2[e] = cw[2 * CWD + e]; } }
    if (NGW * 8 == M_LAT) {
#pragma unroll 1
        for (int h = 0; h < 4; ++h) { const int r0 = 8 * gw + 2 * h; const bool vp = (r0 & 63) != 0, vn = ((r0 + 1) & 63) != 63;
            v4u hc[4], gc[4], vv[2], gb[2];
#pragma unroll
            for (int i = 0; i < 4; ++i) { const int row = (i == 0 && !vp) ? r0 : (i == 3 && !vn) ? r0 + 1 : r0 - 1 + i;
                hc[i] = *(const GAS v4u*)(Z2 + (size_t)row * Z2W + Z2_HC + 8 * lane); gc[i] = *(const GAS v4u*)(Z2 + (size_t)row * Z2W + Z2_GC + 8 * lane); }
#pragma unroll
            for (int i = 0; i < 2; ++i) { vv[i] = *(const GAS v4u*)(Z2 + (size_t)(r0 + i) * Z2W + Z2_V + 8 * lane); gb[i] = *(const GAS v4u*)(Z2 + (size_t)(r0 + i) * Z2W + Z2_GB + 8 * lane); }
            float t[4][8];
#pragma unroll
            for (int i = 0; i < 4; ++i) elem_t(hc[i], gc[i], (i == 0 && !vp) || (i == 3 && !vn) ? 0.0f : 1.0f, t[i]);
#pragma unroll
            for (int i = 0; i < 2; ++i) { elem_vn(vv[i], C, VN, r0 + i, lane); elem_conv(t[i], t[i + 1], t[i + 2], gb[i], C, YABC, r0 + i, lane); } }
    } else {
        for (int m = gw; m < M_LAT; m += NGW) elem_row(Z2, C, VN, YABC, m, lane); }
    for (int m = M_LAT + (gw >> 1) + ((gw & 1) ? (NGW >> 1) : 0); m < M; m += NGW) elem_row(Z2, C, VN, YABC, m, lane);
}

template <int N> __device__ __forceinline__ float row_shl1(float v) { return __builtin_bit_cast(float, __builtin_amdgcn_update_dpp(0x3f800000, __builtin_bit_cast(int, v), 0x100 + N, 0xf, 0xf, false)); }
template <int N> __device__ __forceinline__ float row_shr1(float v) { return __builtin_bit_cast(float, __builtin_amdgcn_update_dpp(0x3f800000, __builtin_bit_cast(int, v), 0x110 + N, 0xf, 0xf, false)); }
template <int N> __device__ __forceinline__ float row_shr(float v) { return __builtin_bit_cast(float, __builtin_amdgcn_update_dpp(0, __builtin_bit_cast(int, v), 0x110 + N, 0xf, 0xf, true)); }
__device__ __forceinline__ float row16_prod(float x) { x *= dppf<0xB1>(x); x *= dppf<0x4E>(x); x *= dppf<0x124>(x); x *= dppf<0x128>(x); return x; }
__device__ __forceinline__ void phase_hgrn_prep(int l) {
    const Frame F = mkframe(); unsigned char* ws = F.ws;
    const _Float16* ZF = (const _Float16*)(ws + WS_ZF); const bf16* QS = (const bf16*)(ws + WS_QS); const float* LB = (const float*)(ws + WS_LB) + (size_t)l * 2 * WK;
    const int gw = F.vcu * 8 + F.wave, NGW = F.G * 8, lane = F.lane, fr = lane & 15, cq = lane >> 4;
    constexpr int NIT = (M / 32) * 32;
    const int per = (NIT + NGW - 1) / NGW, it0 = gw * per, it1 = (it0 + per < NIT) ? it0 + per : NIT;
#pragma unroll 2
    for (int it = it0; it < it1; ++it) { const int sc = it >> 5, jj = it & 31; const size_t rlo = (size_t)sc * 32 + fr, rhi = rlo + 16; const int c0 = 32 * jj + 8 * cq;
        const v4u qlo_r = *(const GAS v4u*)(QS + rlo * WK + c0), qhi_r = *(const GAS v4u*)(QS + rhi * WK + c0);
        const float qlo[8] = {bflo(qlo_r.x), bfhi(qlo_r.x), bflo(qlo_r.y), bfhi(qlo_r.y), bflo(qlo_r.z), bfhi(qlo_r.z), bflo(qlo_r.w), bfhi(qlo_r.w)};
        const float qhi[8] = {bflo(qhi_r.x), bfhi(qhi_r.x), bflo(qhi_r.y), bfhi(qhi_r.y), bflo(qhi_r.z), bfhi(qhi_r.z), bflo(qhi_r.w), bfhi(qhi_r.w)};
#pragma unroll
        for (int dir = 0; dir < 2; ++dir) {
            const pg8::ef32x8 zlo = __builtin_convertvector(*(const GAS pg8::eh16x8*)(ZF + rlo * 2048 + dir * WK + c0), pg8::ef32x8), zhi = __builtin_convertvector(*(const GAS pg8::eh16x8*)(ZF + rhi * 2048 + dir * WK + c0), pg8::ef32x8);
            const f32x4 b0 = *(const GAS f32x4*)(LB + dir * WK + c0), b1 = *(const GAS f32x4*)(LB + dir * WK + c0 + 4);
            float qtl[8], qth[8], ktl[8], kth[8], gt[8];
            float fl0, fl1, fl2, fl3, fl4, fl5, fl6, fl7, fh0, fh1, fh2, fh3, fh4, fh5, fh6, fh7;
#define HP_F(e_, dl, dh) { const float lb = (e_) < 4 ? b0[(e_) & 3] : b1[(e_) & 3]; const float oml = 1.0f - lb; dl = fmaxf(__builtin_fmaf(oml, __builtin_amdgcn_rcpf(1.0f + __builtin_amdgcn_exp2f(zlo[e_])), lb), 1e-30f); dh = fmaxf(__builtin_fmaf(oml, __builtin_amdgcn_rcpf(1.0f + __builtin_amdgcn_exp2f(zhi[e_])), lb), 1e-30f); }
            HP_F(0, fl0, fh0) HP_F(1, fl1, fh1) HP_F(2, fl2, fh2) HP_F(3, fl3, fh3) HP_F(4, fl4, fh4) HP_F(5, fl5, fh5) HP_F(6, fl6, fh6) HP_F(7, fl7, fh7)
#undef HP_F
#define HP_STEP(ctrl) "v_mul_f32_dpp %0, %0, %0 " ctrl " row_mask:0xf bank_mask:0xf\n\tv_mul_f32_dpp %1, %1, %1 " ctrl " row_mask:0xf bank_mask:0xf\n\tv_mul_f32_dpp %2, %2, %2 " ctrl " row_mask:0xf bank_mask:0xf\n\t" \
                      "v_mul_f32_dpp %3, %3, %3 " ctrl " row_mask:0xf bank_mask:0xf\n\tv_mul_f32_dpp %4, %4, %4 " ctrl " row_mask:0xf bank_mask:0xf\n\tv_mul_f32_dpp %5, %5, %5 " ctrl " row_mask:0xf bank_mask:0xf\n\t" \
                      "v_mul_f32_dpp %6, %6, %6 " ctrl " row_mask:0xf bank_mask:0xf\n\tv_mul_f32_dpp %7, %7, %7 " ctrl " row_mask:0xf bank_mask:0xf\n\t"
#define HP_OPS8(a) "+v"(a##0), "+v"(a##1), "+v"(a##2), "+v"(a##3), "+v"(a##4), "+v"(a##5), "+v"(a##6), "+v"(a##7)
#define HP_PROD8(a) asm("s_nop 1\n\t" HP_STEP("quad_perm:[1,0,3,2]") HP_STEP("quad_perm:[2,3,0,1]") HP_STEP("row_ror:4") HP_STEP("row_ror:8") "s_nop 1" : HP_OPS8(a))
#define HP_SCANL8(a) asm("s_nop 1\n\t" HP_STEP("row_shl:1") HP_STEP("row_shl:2") HP_STEP("row_shl:4") HP_STEP("row_shl:8") "s_nop 1" : HP_OPS8(a))
#define HP_SCANR8(a) asm("s_nop 1\n\t" HP_STEP("row_shr:1") HP_STEP("row_shr:2") HP_STEP("row_shr:4") HP_STEP("row_shr:8") "s_nop 1" : HP_OPS8(a))
#define HP_FIN8(ctrl, X, p, m) asm("s_nop 1\n\t" \
                "v_mul_f32_dpp %0, %8, %16 " ctrl " row_mask:0xf bank_mask:0xf\n\tv_mul_f32_dpp %1, %9, %17 " ctrl " row_mask:0xf bank_mask:0xf\n\tv_mul_f32_dpp %2, %10, %18 " ctrl " row_mask:0xf bank_mask:0xf\n\t" \
                "v_mul_f32_dpp %3, %11, %19 " ctrl " row_mask:0xf bank_mask:0xf\n\tv_mul_f32_dpp %4, %12, %20 " ctrl " row_mask:0xf bank_mask:0xf\n\tv_mul_f32_dpp %5, %13, %21 " ctrl " row_mask:0xf bank_mask:0xf\n\t" \
                "v_mul_f32_dpp %6, %14, %22 " ctrl " row_mask:0xf bank_mask:0xf\n\tv_mul_f32_dpp %7, %15, %23 " ctrl " row_mask:0xf bank_mask:0xf\n\ts_nop 1" \
                : "+&v"(X##0), "+&v"(X##1), "+&v"(X##2), "+&v"(X##3), "+&v"(X##4), "+&v"(X##5), "+&v"(X##6), "+&v"(X##7) : "v"(p##0), "v"(p##1), "v"(p##2), "v"(p##3), "v"(p##4), "v"(p##5), "v"(p##6), "v"(p##7), "v"(m##0), "v"(m##1), "v"(m##2), "v"(m##3), "v"(m##4), "v"(m##5), "v"(m##6), "v"(m##7))
            float tl0 = fl0, tl1 = fl1, tl2 = fl2, tl3 = fl3, tl4 = fl4, tl5 = fl5, tl6 = fl6, tl7 = fl7, th0 = fh0, th1 = fh1, th2 = fh2, th3 = fh3, th4 = fh4, th5 = fh5, th6 = fh6, th7 = fh7;
            HP_PROD8(tl); HP_PROD8(th);
            float pl0 = fl0, pl1 = fl1, pl2 = fl2, pl3 = fl3, pl4 = fl4, pl5 = fl5, pl6 = fl6, pl7 = fl7, ph0 = fh0, ph1 = fh1, ph2 = fh2, ph3 = fh3, ph4 = fh4, ph5 = fh5, ph6 = fh6, ph7 = fh7;
            const float one0 = 1.0f, one1 = 1.0f, one2 = 1.0f, one3 = 1.0f, one4 = 1.0f, one5 = 1.0f, one6 = 1.0f, one7 = 1.0f;
            float Xl0, Xl1, Xl2, Xl3, Xl4, Xl5, Xl6, Xl7, Xh0, Xh1, Xh2, Xh3, Xh4, Xh5, Xh6, Xh7;
            if (dir == 0) { HP_SCANL8(pl); HP_SCANL8(ph);
                Xl0 = th0; Xl1 = th1; Xl2 = th2; Xl3 = th3; Xl4 = th4; Xl5 = th5; Xl6 = th6; Xl7 = th7; HP_FIN8("row_shl:1", Xl, pl, th);
                Xh0 = 1.0f; Xh1 = 1.0f; Xh2 = 1.0f; Xh3 = 1.0f; Xh4 = 1.0f; Xh5 = 1.0f; Xh6 = 1.0f; Xh7 = 1.0f; HP_FIN8("row_shl:1", Xh, ph, one); }
            else { HP_SCANR8(pl); HP_SCANR8(ph);
                Xl0 = 1.0f; Xl1 = 1.0f; Xl2 = 1.0f; Xl3 = 1.0f; Xl4 = 1.0f; Xl5 = 1.0f; Xl6 = 1.0f; Xl7 = 1.0f; HP_FIN8("row_shr:1", Xl, pl, one);
                Xh0 = tl0; Xh1 = tl1; Xh2 = tl2; Xh3 = tl3; Xh4 = tl4; Xh5 = tl5; Xh6 = tl6; Xh7 = tl7; HP_FIN8("row_shr:1", Xh, ph, tl); }
#define HP_OUT(e_) ktl[e_] = __builtin_fmaf(-fl##e_, Xl##e_, Xl##e_); kth[e_] = __builtin_fmaf(-fh##e_, Xh##e_, Xh##e_); qtl[e_] = qlo[e_] * __builtin_amdgcn_rcpf(fmaxf(Xl##e_, 1e-35f)); qth[e_] = qhi[e_] * __builtin_amdgcn_rcpf(fmaxf(Xh##e_, 1e-35f)); gt[e_] = tl##e_ * th##e_;
            HP_OUT(0) HP_OUT(1) HP_OUT(2) HP_OUT(3) HP_OUT(4) HP_OUT(5) HP_OUT(6) HP_OUT(7)
#undef HP_OUT
#undef HP_FIN8
#undef HP_SCANR8
#undef HP_SCANL8
#undef HP_PROD8
#undef HP_OPS8
#undef HP_STEP
            bf16* Qd = (bf16*)(ws + (dir ? WS_QB : WS_QF)); bf16* Kd = (bf16*)(ws + (dir ? WS_KB : WS_KF)); float* Gd = (float*)(ws + (dir ? WS_GB : WS_GF));
            v4u o; o.x = pk2(qtl[0], qtl[1]); o.y = pk2(qtl[2], qtl[3]); o.z = pk2(qtl[4], qtl[5]); o.w = pk2(qtl[6], qtl[7]); *(GAS v4u*)(Qd + rlo * WK + c0) = o;
            o.x = pk2(qth[0], qth[1]); o.y = pk2(qth[2], qth[3]); o.z = pk2(qth[4], qth[5]); o.w = pk2(qth[6], qth[7]); *(GAS v4u*)(Qd + rhi * WK + c0) = o;
            o.x = pk2(ktl[0], ktl[1]); o.y = pk2(ktl[2], ktl[3]); o.z = pk2(ktl[4], ktl[5]); o.w = pk2(ktl[6], ktl[7]); *(GAS v4u*)(Kd + rlo * WK + c0) = o;
            o.x = pk2(kth[0], kth[1]); o.y = pk2(kth[2], kth[3]); o.z = pk2(kth[4], kth[5]); o.w = pk2(kth[6], kth[7]); *(GAS v4u*)(Kd + rhi * WK + c0) = o;
            if (fr == 0) { *(GAS f32x4*)(Gd + (size_t)sc * WK + c0) = (f32x4){gt[0], gt[1], gt[2], gt[3]}; *(GAS f32x4*)(Gd + (size_t)sc * WK + c0 + 4) = (f32x4){gt[4], gt[5], gt[6], gt[7]}; }
        } }
}

typedef short s16x4 __attribute__((ext_vector_type(4)));
typedef short hb16x8 __attribute__((ext_vector_type(8)));
constexpr int HG_P = 272;
constexpr int HG_QI = 0, HG_KI = 32 * HG_P, HG_VI = 64 * HG_P, HG_GI = 96 * HG_P, HG_BUF = 96 * HG_P + 512 + 256;
constexpr int HG_NSTEP = (CTXL + SEQ) / 32, HG_NSEG = 4, HG_SEGLEN = HG_NSTEP / HG_NSEG, HG_NCTX = CTXL / 32;
static_assert(HG_SEGLEN * HG_NSEG == HG_NSTEP && HG_SEGLEN % 2 == 0, "segment loop below is unrolled by 2");
__device__ __forceinline__ int hg_row0(int s, int cstep, int cbase, int lbase2) { return cstep * s + (s < HG_NCTX ? cbase : lbase2); }
struct HgReg { v4u a, b, c, d; };
template <bool FULL> __device__ __forceinline__ void hg_gload(HgReg& R, int r0, const bf16* Qp, const bf16* Kp, const bf16* Vp, const float* Gp, int tid) {
    const int row = tid >> 4, ch = tid & 15; const size_t o = (size_t)(r0 + row) * WK + 8 * ch;
    if (FULL) R.a = *(const GAS v4u*)(Qp + o);
    R.b = *(const GAS v4u*)(Kp + o); R.c = *(const GAS v4u*)(Vp + o);
    R.d = *(const GAS v4u*)(Gp + (size_t)(r0 >> 5) * WK + 4 * (tid & 31));
}
template <bool FULL> __device__ __forceinline__ void hg_lwrite(const HgReg& R, LAS unsigned char* buf, int tid) {
    const int row = tid >> 4, ch = tid & 15;
    if (FULL) *(LAS v4u*)(buf + HG_QI + row * HG_P + 16 * ch) = R.a;
    *(LAS v4u*)(buf + HG_KI + row * HG_P + 16 * ch) = R.b; *(LAS v4u*)(buf + HG_VI + row * HG_P + 16 * ch) = R.c;
    if (tid < 32) *(LAS v4u*)(buf + HG_GI + 16 * tid) = R.d;
}
template <bool FULL> __device__ __forceinline__ void hg_step(const LAS unsigned char* buf, int r0, int w, f32x4 (&S)[8], f32x4& GA, _Float16* Op, int lane, int dir) {
    const int idx = lane & 15, rq = lane >> 4;
    v2u q[2][8], k[2][8];
    f32x4 P[2][2];
    if (FULL) {
#pragma unroll
        for (int tb = 0; tb < 2; ++tb)
#pragma unroll
            for (int j = 0; j < 8; ++j) { q[tb][j] = *(const LAS v2u*)(buf + HG_QI + (16 * tb + idx) * HG_P + (16 * j + 4 * rq) * 2); k[tb][j] = *(const LAS v2u*)(buf + HG_KI + (16 * tb + idx) * HG_P + (16 * j + 4 * rq) * 2); }
#pragma unroll
        for (int sb = 0; sb < 2; ++sb)
#pragma unroll
            for (int tb = 0; tb < 2; ++tb) { f32x4 p = (f32x4){0.f, 0.f, 0.f, 0.f};
#pragma unroll
                for (int ks = 0; ks < 4; ++ks) { v4u a, b; a.x = k[sb][2 * ks].x; a.y = k[sb][2 * ks].y; a.z = k[sb][2 * ks + 1].x; a.w = k[sb][2 * ks + 1].y; b.x = q[tb][2 * ks].x; b.y = q[tb][2 * ks].y; b.z = q[tb][2 * ks + 1].x; b.w = q[tb][2 * ks + 1].y;
                    p = __builtin_amdgcn_mfma_f32_16x16x32_bf16(__builtin_bit_cast(hb16x8, a), __builtin_bit_cast(hb16x8, b), p, 0, 0, 0); }
                P[sb][tb] = p; } }
#pragma unroll
    for (int kb = 0; kb < 8; ++kb) { const f32x4 gv = *(const LAS f32x4*)(buf + HG_GI + (16 * kb + 4 * rq) * 4); S[kb] = S[kb] * gv; if (kb == w) GA = GA * gv; }
    f32x4 o[2];
    o[0] = (f32x4){0.f, 0.f, 0.f, 0.f}; o[1] = (f32x4){0.f, 0.f, 0.f, 0.f};
    if (FULL) {
#pragma unroll
    for (int ks = 0; ks < 4; ++ks) { v4u a; a.x = pg8::cvt_pk_bf16(S[2 * ks][0], S[2 * ks][1]); a.y = pg8::cvt_pk_bf16(S[2 * ks][2], S[2 * ks][3]); a.z = pg8::cvt_pk_bf16(S[2 * ks + 1][0], S[2 * ks + 1][1]); a.w = pg8::cvt_pk_bf16(S[2 * ks + 1][2], S[2 * ks + 1][3]);
#pragma unroll
        for (int tb = 0; tb < 2; ++tb) { v4u b; b.x = q[tb][2 * ks].x; b.y = q[tb][2 * ks].y; b.z = q[tb][2 * ks + 1].x; b.w = q[tb][2 * ks + 1].y;
            o[tb] = __builtin_amdgcn_mfma_f32_16x16x32_bf16(__builtin_bit_cast(hb16x8, a), __builtin_bit_cast(hb16x8, b), o[tb], 0, 0, 0); } } }
    s16x4 vt0, vt1, k0[8], k1[8];
    { const unsigned q_ = (unsigned)(idx >> 2), p_ = (unsigned)(idx & 3);
      const unsigned va = (unsigned)(size_t)(buf + HG_VI) + (4u * rq + q_) * HG_P + 32u * (unsigned)w + 8u * p_, ka = (unsigned)(size_t)(buf + HG_KI) + (4u * rq + q_) * HG_P + 8u * p_;
      asm volatile("s_waitcnt lgkmcnt(0)\n\t"
                   "ds_read_b64_tr_b16 %0, %18\n\t"
                   "ds_read_b64_tr_b16 %1, %18 offset:4352\n\t"
                   "ds_read_b64_tr_b16 %2, %19\n\t"
                   "ds_read_b64_tr_b16 %3, %19 offset:32\n\t"
                   "ds_read_b64_tr_b16 %4, %19 offset:64\n\t"
                   "ds_read_b64_tr_b16 %5, %19 offset:96\n\t"
                   "ds_read_b64_tr_b16 %6, %19 offset:128\n\t"
                   "ds_read_b64_tr_b16 %7, %19 offset:160\n\t"
                   "ds_read_b64_tr_b16 %8, %19 offset:192\n\t"
                   "ds_read_b64_tr_b16 %9, %19 offset:224\n\t"
                   "ds_read_b64_tr_b16 %10, %19 offset:4352\n\t"
                   "ds_read_b64_tr_b16 %11, %19 offset:4384\n\t"
                   "ds_read_b64_tr_b16 %12, %19 offset:4416\n\t"
                   "ds_read_b64_tr_b16 %13, %19 offset:4448\n\t"
                   "ds_read_b64_tr_b16 %14, %19 offset:4480\n\t"
                   "ds_read_b64_tr_b16 %15, %19 offset:4512\n\t"
                   "ds_read_b64_tr_b16 %16, %19 offset:4544\n\t"
                   "ds_read_b64_tr_b16 %17, %19 offset:4576\n\t"
                   "s_waitcnt lgkmcnt(0)"
                   : "=&v"(vt0), "=&v"(vt1), "=&v"(k0[0]), "=&v"(k0[1]), "=&v"(k0[2]), "=&v"(k0[3]), "=&v"(k0[4]), "=&v"(k0[5]), "=&v"(k0[6]), "=&v"(k0[7]),
                     "=&v"(k1[0]), "=&v"(k1[1]), "=&v"(k1[2]), "=&v"(k1[3]), "=&v"(k1[4]), "=&v"(k1[5]), "=&v"(k1[6]), "=&v"(k1[7])
                   : "v"(va), "v"(ka) : "memory"); }
    static_assert(16 * HG_P == 4352, "tr-read row offsets above");
    const hb16x8 vfrag = __builtin_shufflevector(vt0, vt1, 0, 1, 2, 3, 4, 5, 6, 7);
    if (FULL) {
#pragma unroll
      for (int tb = 0; tb < 2; ++tb) { v4u pb; float pm[2][4];
#pragma unroll
        for (int sb = 0; sb < 2; ++sb)
#pragma unroll
            for (int i = 0; i < 4; ++i) { const int s_ = 16 * sb + 4 * rq + i, t_ = 16 * tb + idx; const bool keep = dir ? (s_ >= t_) : (s_ <= t_); pm[sb][i] = keep ? P[sb][tb][i] : 0.f; }
        pb.x = pg8::cvt_pk_bf16(pm[0][0], pm[0][1]); pb.y = pg8::cvt_pk_bf16(pm[0][2], pm[0][3]); pb.z = pg8::cvt_pk_bf16(pm[1][0], pm[1][1]); pb.w = pg8::cvt_pk_bf16(pm[1][2], pm[1][3]);
        o[tb] = __builtin_amdgcn_mfma_f32_16x16x32_bf16(vfrag, __builtin_bit_cast(hb16x8, pb), o[tb], 0, 0, 0); } }
#pragma unroll
    for (int kb = 0; kb < 8; ++kb) { const hb16x8 kfrag = __builtin_shufflevector(k0[kb], k1[kb], 0, 1, 2, 3, 4, 5, 6, 7);
        S[kb] = __builtin_amdgcn_mfma_f32_16x16x32_bf16(kfrag, vfrag, S[kb], 0, 0, 0); }
    if (FULL) {
#pragma unroll
        for (int tb = 0; tb < 2; ++tb) *(GAS h16x4*)(Op + (size_t)(r0 + 16 * tb + idx) * WK + 4 * rq) = __builtin_convertvector(o[tb], h16x4); }
}
#define HG_BARRIER() do { asm volatile("s_waitcnt lgkmcnt(0)" ::: "memory"); __builtin_amdgcn_s_barrier(); asm volatile("" ::: "memory"); } while (0)
template <int PASS> __device__ __forceinline__ void phase_hgrn() {
    const Frame F = mkframe(); unsigned char* ws = F.ws;
    const int lane = F.lane, tid = F.tid, w = F.wave;
    constexpr bool FULL = PASS == 1;
    for (int task = F.vcu; task < 64 * HG_NSEG; task += F.G) {
        const int chain = task >> 2, seg = task & 3, b = chain >> 4, h = (chain >> 1) & 7, dir = chain & 1;
        if (PASS == 0 && seg == HG_NSEG - 1) continue;
        const bf16* Qp = (const bf16*)(ws + (dir ? WS_QB : WS_QF)) + h * DK; const bf16* Kp = (const bf16*)(ws + (dir ? WS_KB : WS_KF)) + h * DK;
        const bf16* Vp = (const bf16*)(ws + WS_VV) + h * DV; const float* Gp = (const float*)(ws + (dir ? WS_GB : WS_GF)) + h * DK;
        _Float16* Op = (_Float16*)(ws + (dir ? WS_OB : WS_OF)) + h * DV + 16 * w;
        f32x4* SL = (f32x4*)(ws + WS_SLOC);
        LAS unsigned char* buf0 = F.lds; LAS unsigned char* buf1 = F.lds + HG_BUF;
        const int cstep = dir ? -32 : 32, cbase = M_LAT + b * CTXL + (dir ? CTXL - 32 : 0), lbase2 = b * SEQ + (dir ? SEQ - 32 : 0) - HG_NCTX * cstep;
        f32x4 S[8], GA = (f32x4){1.f, 1.f, 1.f, 1.f};
#pragma unroll
        for (int kb = 0; kb < 8; ++kb) S[kb] = (f32x4){0.f, 0.f, 0.f, 0.f};
        if (PASS == 1) {
#pragma unroll 1
            for (int k = 0; k < seg; ++k) { const f32x4* p = SL + (size_t)(task - seg + k) * 4608 + lane;
#pragma unroll
                for (int kb = 0; kb < 8; ++kb) S[kb] = S[kb] * p[4096 + kb * 64] + p[(w * 8 + kb) * 64]; } }
        const int s0 = seg * HG_SEGLEN, slast = s0 + HG_SEGLEN - 1;
#define HG_ROW(s_) hg_row0((s_) < slast ? (s_) : slast, cstep, cbase, lbase2)
        HgReg R0, R1;
        __syncthreads();
        hg_gload<FULL>(R0, HG_ROW(s0), Qp, Kp, Vp, Gp, tid); hg_lwrite<FULL>(R0, buf0, tid);
        hg_gload<FULL>(R1, HG_ROW(s0 + 1), Qp, Kp, Vp, Gp, tid);
        HG_BARRIER();
#pragma unroll 1
        for (int s = s0; s < s0 + HG_SEGLEN; s += 2) {
            hg_gload<FULL>(R0, HG_ROW(s + 2), Qp, Kp, Vp, Gp, tid);
            hg_step<FULL>(buf0, hg_row0(s, cstep, cbase, lbase2), w, S, GA, Op, lane, dir);
            hg_lwrite<FULL>(R1, buf1, tid); HG_BARRIER();
            hg_gload<FULL>(R1, HG_ROW(s + 3), Qp, Kp, Vp, Gp, tid);
            hg_step<FULL>(buf1, hg_row0(s + 1, cstep, cbase, lbase2), w, S, GA, Op, lane, dir);
            hg_lwrite<FULL>(R0, buf0, tid); HG_BARRIER();
        }
#undef HG_ROW
        if (PASS == 0) { f32x4* p = SL + (size_t)task * 4608 + lane;
#pragma unroll
            for (int kb = 0; kb < 8; ++kb) p[(w * 8 + kb) * 64] = S[kb];
            p[4096 + w * 64] = GA; }
    }
}

constexpr int GM_P = 272, GM_WI = 0, GM_VI = 128 * GM_P;
__device__ __forceinline__ void phase_gmlp(int l) {
    const Frame F = mkframe(); unsigned char* ws = F.ws;
    const bf16* Z2 = (const bf16*)(ws + WS_Z2); const bf16* VN = (const bf16*)(ws + WS_VN); bf16* YABC = (bf16*)(ws + WS_YABC);
    const int tid = F.tid, lane = F.lane, w = F.wave, idx = lane & 15, rq = lane >> 4;
    if ((F.vcu & 3) != HG_NSEG - 1) return;
    const int jw = F.vcu >> 2, g = jw & 3, nper = F.G >> 4;
    if ((jw >> 2) >= M / 128) return;
    __syncthreads();
    { const float* wsrc = INP(IWS) + ((size_t)l * 4 + g) * 128 * 128;
#pragma unroll
      for (int i = 0; i < 8; ++i) { const int e = (i * 512 + tid) * 4, t = e >> 7, s0 = e & 127; const f32x4 v = *(const GAS f32x4*)(wsrc + e);
          *(LAS v2u*)(F.lds + GM_WI + t * GM_P + 2 * s0) = (v2u){pk2(v[0], v[1]), pk2(v[2], v[3])}; } }
    for (int chunk = jw >> 2; chunk < M / 128; chunk += nper) { const size_t r0 = (size_t)chunk * 128;
        __syncthreads();
#pragma unroll
        for (int i = 0; i < 4; ++i) { const int e = i * 512 + tid, srow = e >> 4, c8 = e & 15;
            *(LAS v4u*)(F.lds + GM_VI + srow * GM_P + 16 * c8) = *(const GAS v4u*)(VN + (r0 + srow) * BW + g * 128 + 8 * c8); }
        __syncthreads();
        v4u bfr[4];
#pragma unroll
        for (int ks = 0; ks < 4; ++ks) bfr[ks] = *(const LAS v4u*)(F.lds + GM_WI + (16 * w + idx) * GM_P + (32 * ks + 8 * rq) * 2);
        const float bs = INP(IBS)[((size_t)l * 4 + g) * 128 + 16 * w + idx];
        v2u urv[8];
#pragma unroll
        for (int cb = 0; cb < 8; ++cb) urv[cb] = *(const GAS v2u*)(Z2 + (r0 + 16 * w + idx) * Z2W + Z2_U + g * 128 + 16 * cb + 4 * rq);
        const unsigned q_ = (unsigned)(idx >> 2), p_ = (unsigned)(idx & 3);
        const unsigned va = (unsigned)(size_t)(F.lds + GM_VI) + (8u * rq + q_) * GM_P + 8u * p_;
#pragma unroll
        for (int cb = 0; cb < 8; ++cb) {
            s16x4 t0[4], t1[4];
            asm volatile("ds_read_b64_tr_b16 %0, %8\n\t"
                         "ds_read_b64_tr_b16 %1, %8 offset:1088\n\t"
                         "ds_read_b64_tr_b16 %2, %9\n\t"
                         "ds_read_b64_tr_b16 %3, %9 offset:1088\n\t"
                         "ds_read_b64_tr_b16 %4, %10\n\t"
                         "ds_read_b64_tr_b16 %5, %10 offset:1088\n\t"
                         "ds_read_b64_tr_b16 %6, %11\n\t"
                         "ds_read_b64_tr_b16 %7, %11 offset:1088\n\t"
                         "s_waitcnt lgkmcnt(0)"
                         : "=&v"(t0[0]), "=&v"(t1[0]), "=&v"(t0[1]), "=&v"(t1[1]), "=&v"(t0[2]), "=&v"(t1[2]), "=&v"(t0[3]), "=&v"(t1[3])
                         : "v"(va + 32u * cb), "v"(va + 32u * cb + 32u * GM_P), "v"(va + 32u * cb + 64u * GM_P), "v"(va + 32u * cb + 96u * GM_P) : "memory");
            f32x4 acc = (f32x4){0.f, 0.f, 0.f, 0.f};
#pragma unroll
            for (int ks = 0; ks < 4; ++ks) { const hb16x8 afr = __builtin_shufflevector(t0[ks], t1[ks], 0, 1, 2, 3, 4, 5, 6, 7);
                acc = __builtin_amdgcn_mfma_f32_16x16x32_bf16(afr, __builtin_bit_cast(hb16x8, bfr[ks]), acc, 0, 0, 0); }
            const size_t row = r0 + 16 * w + idx; const int ch = g * 128 + 16 * cb + 4 * rq;
            const v2u ur = urv[cb];
            const float y0 = gelu_tanh(bflo(ur.x)) * (acc[0] + bs), y1 = gelu_tanh(bfhi(ur.x)) * (acc[1] + bs), y2 = gelu_tanh(bflo(ur.y)) * (acc[2] + bs), y3 = gelu_tanh(bfhi(ur.y)) * (acc[3] + bs);
            *(GAS v2u*)(YABC + row * 2048 + 1024 + ch) = (v2u){pk2(y0, y1), pk2(y2, y3)};
        }
    }
    __syncthreads();
}

struct RoRow { pg8::eh16x8 f0, f1, b0, b1; v4u g0, g1; };
__device__ __forceinline__ void ro_load(RoRow& R, const _Float16* OFp, const _Float16* OBp, const bf16* Z2, int m, int lane) {
    R.f0 = *(const GAS pg8::eh16x8*)(OFp + (size_t)m * WK + 16 * lane); R.f1 = *(const GAS pg8::eh16x8*)(OFp + (size_t)m * WK + 16 * lane + 8);
    R.b0 = *(const GAS pg8::eh16x8*)(OBp + (size_t)m * WK + 16 * lane); R.b1 = *(const GAS pg8::eh16x8*)(OBp + (size_t)m * WK + 16 * lane + 8);
    R.g0 = *(const GAS v4u*)(Z2 + (size_t)m * Z2W + Z2_GA + 16 * lane); R.g1 = *(const GAS v4u*)(Z2 + (size_t)m * Z2W + Z2_GA + 16 * lane + 8);
}
__device__ __forceinline__ void ro_finish(const RoRow& R, const float (&ag)[16], bf16* YABC, int m, int lane) {
    const pg8::ef32x8 a0 = __builtin_convertvector(R.f0, pg8::ef32x8), a1 = __builtin_convertvector(R.f1, pg8::ef32x8), c0 = __builtin_convertvector(R.b0, pg8::ef32x8), c1 = __builtin_convertvector(R.b1, pg8::ef32x8);
    float o[16]; float ss = 0.f;
#pragma unroll
    for (int e = 0; e < 8; ++e) { o[e] = a0[e] + c0[e]; o[8 + e] = a1[e] + c1[e]; ss += o[e] * o[e] + o[8 + e] * o[8 + e]; }
    ss += dppf<0xB1>(ss); ss += dppf<0x4E>(ss); ss += dppf<0x141>(ss);
    const float rstd = 1.0f / sqrtf(ss * (1.0f / DV) + EPS);
    const v4u g0 = R.g0, g1 = R.g1; float ga[16];
    ga[0] = bflo(g0.x); ga[1] = bfhi(g0.x); ga[2] = bflo(g0.y); ga[3] = bfhi(g0.y); ga[4] = bflo(g0.z); ga[5] = bfhi(g0.z); ga[6] = bflo(g0.w); ga[7] = bfhi(g0.w);
    ga[8] = bflo(g1.x); ga[9] = bfhi(g1.x); ga[10] = bflo(g1.y); ga[11] = bfhi(g1.y); ga[12] = bflo(g1.z); ga[13] = bfhi(g1.z); ga[14] = bflo(g1.w); ga[15] = bfhi(g1.w);
    float y[16];
#pragma unroll
    for (int e = 0; e < 16; ++e) y[e] = o[e] * rstd * ag[e] * siluf_(ga[e]);
    v4u w0, w1; w0.x = pk2(y[0], y[1]); w0.y = pk2(y[2], y[3]); w0.z = pk2(y[4], y[5]); w0.w = pk2(y[6], y[7]); w1.x = pk2(y[8], y[9]); w1.y = pk2(y[10], y[11]); w1.z = pk2(y[12], y[13]); w1.w = pk2(y[14], y[15]);
    *(GAS v4u*)(YABC + (size_t)m * 2048 + 16 * lane) = w0; *(GAS v4u*)(YABC + (size_t)m * 2048 + 16 * lane + 8) = w1;
}
__device__ __forceinline__ void phase_readout(int l) {
    const Frame F = mkframe(); unsigned char* ws = F.ws;
    const _Float16* OFp = (const _Float16*)(ws + WS_OF); const _Float16* OBp = (const _Float16*)(ws + WS_OB); const bf16* Z2 = (const bf16*)(ws + WS_Z2); bf16* YABC = (bf16*)(ws + WS_YABC);
    const int gw = F.vcu * 8 + F.wave, NGW = F.G * 8, lane = F.lane;
    float ag[16];
    { const float* agp = INP(IANORM) + l * DV + (16 * lane & 127);
#pragma unroll
      for (int e = 0; e < 16; ++e) ag[e] = agp[e]; }
    const int per = (M_LAT + NGW - 1) / NGW, m0 = gw * per, m1 = (m0 + per < M_LAT) ? m0 + per : M_LAT;
    if (m0 < m1) { RoRow cur, nxt; ro_load(cur, OFp, OBp, Z2, m0, lane);
#pragma unroll 1
        for (int m = m0; m < m1; ++m) { ro_load(nxt, OFp, OBp, Z2, m + 1 < m1 ? m + 1 : m, lane); ro_finish(cur, ag, YABC, m, lane); cur = nxt; } }
    for (int m = M_LAT + (gw >> 1) + ((gw & 1) ? (NGW >> 1) : 0); m < M; m += NGW) { RoRow cur; ro_load(cur, OFp, OBp, Z2, m, lane); ro_finish(cur, ag, YABC, m, lane); }
}

constexpr int PH_PER_LAYER = 13, N_PHASES = 1 + DEPTH * PH_PER_LAYER + 1;
__device__ __forceinline__ void grid_seam() {
    extern __shared__ __attribute__((aligned(16))) unsigned char lds_dyn[];
    XcdBarrier bar; bar.bar = (unsigned*)(kargs()->ws + WS_CTL) + CW_BAR; bar.x = xb_xcc_id(); bar.st = (volatile LAS unsigned*)((LAS unsigned char*)lds_dyn + MISC_OFF) + 8;
    xcd_barrier(bar);
}
__global__ void __launch_bounds__(512, 2) fwd_kernel(Args args_unused) {
    extern __shared__ __attribute__((aligned(16))) unsigned char lds_dyn[];
    { LAS unsigned char* lds = (LAS unsigned char*)lds_dyn;
      for (int u = threadIdx.x; u < (LDS_BYTES - LDSCTL_OFF) / 4; u += 512) ((LAS unsigned*)(lds + LDSCTL_OFF))[u] = 0u;
      __syncthreads();
      if (kargs()->ph_hi - kargs()->ph_lo > 1) (void)xcd_barrier_post((unsigned*)(kargs()->ws + WS_CTL) + CW_BAR, (volatile LAS unsigned*)(lds + MISC_OFF) + 8); }
    const int lo = kargs()->ph_lo, hi = kargs()->ph_hi;
#define IN(k) (lo <= (k) && (k) < hi)
#define SEAM(k) do { if (IN((k) + 1)) grid_seam(); } while (0)
#define LDSP ((LAS unsigned char*)lds_dyn)
#define WSP(off) (kargs()->ws + (off))

    if (IN(0)) { phase_prologue(); __syncthreads(); SEAM(0); }

#pragma unroll 1
    for (int l = 0; l < DEPTH; ++l) {
        const int pb = 1 + l * PH_PER_LAYER;
        if (hi <= pb || lo >= pb + PH_PER_LAYER) continue;
#pragma unroll 1
        for (int j = 0; j < 2; ++j) {
            const int p0 = pb + (j ? 10 : 0);
            const bool noctx = (l == DEPTH - 1) && j == 1;
            if (IN(p0)) { if (j) phase_norm(l, 2, noctx ? M_LAT : M, noctx ? 0 : 1, l, 5, 1.0f); else { if (l > 0) convert_rest(l); phase_norm(l, 0, M, l > 0 ? 1 : 0, l - 1, 8, 0.5f); } SEAM(p0); }
            if (IN(p0 + 1)) { pg8::Gemm g{(const bf16*)WSP(WS_H), (const bf16*)WSP(WS_WGU) + (size_t)(l * 2 + j) * (2 * DFF) * D, M, 2 * DFF, D, D, D};
                pg8::StaticOrder S; S.init(noctx ? M_LAT : M, 2 * DFF, (int)gridDim.x, (int)blockIdx.x, D); pg8::EpiSwiGLU E{(bf16*)WSP(WS_ACT)};
                pg8::gemm_phase<pg8::EpiSwiGLU, pg8::StaticOrder, true, true>(LDSP, g, S, E);
                if (l < DEPTH - 1) convert_slot(l + 1, j ? 3 : 0, (M / 256) * (2 * DFF / 256), CV_Q_GU);
                SEAM(p0 + 1); }
            if (IN(p0 + 2)) { pg8::Gemm g{(const bf16*)WSP(WS_ACT), (const bf16*)WSP(WS_WD) + (size_t)(l * 2 + j) * D * DFF, M, D, DFF, DFF, DFF};
                pg8::SplitOrder S; S.init((int)gridDim.x, (int)blockIdx.x, DFF, !noctx); pg8::EpiResid E{(ytype*)WSP(WS_Y), (const float*)WSP(WS_MOD) + (size_t)l * NGRP * MODW + (j ? 8 : 2) * D, 0.5f, (float*)WSP(WS_MF32)};
                pg8::gemm_phase<pg8::EpiResid, pg8::SplitOrder, true, true>(LDSP, g, S, E); SEAM(p0 + 2); }
            if (j == 0) {
                const bool lastl = (l == DEPTH - 1);
                if (IN(pb + 3)) { phase_norm(l, 1, M, 1, l, 2, 0.5f); SEAM(pb + 3); }
                if (IN(pb + 4)) { pg8::Gemm g{(const bf16*)WSP(WS_H), (const bf16*)WSP(WS_WIN) + (size_t)l * INW * D, M, INW, D, D, D};
                    pg8::InprojOrder S; S.init((int)gridDim.x, (int)blockIdx.x, D, lastl ? 16 : 54); pg8::EpiInproj E{(bf16*)WSP(WS_QS), (bf16*)WSP(WS_VV), (_Float16*)WSP(WS_ZF), (bf16*)WSP(WS_Z2)};
                    pg8::gemm_phase<pg8::EpiInproj, pg8::InprojOrder, true, true>(LDSP, g, S, E);
                    if (!lastl) convert_slot(l + 1, 1, 64 * 54 + 4 * 54, CV_Q_IN);
                    SEAM(pb + 4); }
                if (IN(pb + 5)) { phase_hgrn_prep(l); phase_mix_elem(l); SEAM(pb + 5); }
                if (IN(pb + 6)) { phase_hgrn<0>(); phase_gmlp(l); grid_seam(); phase_hgrn<1>(); SEAM(pb + 6); }
                if (IN(pb + 7)) { phase_readout(l); SEAM(pb + 7); }
                if (IN(pb + 8)) { pg8::Gemm g{(const bf16*)WSP(WS_YABC), (const bf16*)WSP(WS_WP) + (size_t)l * D * 2048, M, D, 2048, 2048, 2048};
                    pg8::StaticOrder S; S.init(lastl ? M_LAT : M, D, (int)gridDim.x, (int)blockIdx.x, 2048); pg8::EpiProjF E{(bf16*)WSP(WS_MRG), (const bf16*)WSP(WS_Z2)};
                    pg8::gemm_phase<pg8::EpiProjF, pg8::StaticOrder, true, true>(LDSP, g, S, E);
                    if (!lastl) convert_slot(l + 1, 2, (M / 256) * (D / 256), CV_Q_PJ);
                    SEAM(pb + 8); }
                if (IN(pb + 9)) { pg8::Gemm g{(const bf16*)WSP(WS_MRG), (const bf16*)WSP(WS_WO) + (size_t)l * D * D, M, D, D, D, D};
                    pg8::SplitOrder S; S.init((int)gridDim.x, (int)blockIdx.x, D, !lastl); pg8::EpiResid E{(ytype*)WSP(WS_Y), (const float*)WSP(WS_MOD) + (size_t)l * NGRP * MODW + 5 * D, 1.0f, (float*)WSP(WS_MF32)};
                    pg8::gemm_phase<pg8::EpiResid, pg8::SplitOrder, true, true>(LDSP, g, S, E); SEAM(pb + 9); }
            }
        }
    }
    if (IN(N_PHASES - 1)) phase_final();
#undef IN
#undef SEAM
}

#ifndef MK_PER_PHASE
#define MK_PER_PHASE 0
#endif
extern "C" void kernel_launch(void* const* d_in, const int* in_sizes, int n_in, void* d_out, int out_size, void* d_ws, size_t ws_size, hipStream_t stream) {
    static int grid = 0;
    if (grid == 0) {
        if (n_in != 23 || out_size != M_LAT * D || ws_size < WS_END) { fprintf(stderr, "kernel_launch: unexpected sizes n_in %d out %d ws %zu (need %zu)\n", n_in, out_size, ws_size, (size_t)WS_END); grid = -1; return; }
        int dev = 0, cus = 0, per_cu = 0;
        if (hipGetDevice(&dev) != hipSuccess || hipDeviceGetAttribute(&cus, hipDeviceAttributeMultiprocessorCount, dev) != hipSuccess) { grid = -1; return; }
        if (hipFuncSetAttribute((const void*)fwd_kernel, hipFuncAttributeMaxDynamicSharedMemorySize, LDS_BYTES) != hipSuccess) { fprintf(stderr, "kernel_launch: hipFuncSetAttribute failed\n"); grid = -1; return; }
        if (hipOccupancyMaxActiveBlocksPerMultiprocessor(&per_cu, (const void*)fwd_kernel, 512, LDS_BYTES) != hipSuccess || per_cu < 1) { fprintf(stderr, "kernel_launch: occupancy query says %d\n", per_cu); }
        (void)hipGetLastError();
        grid = cus;
    }
    if (grid < 0) return;
    (void)hipMemsetAsync((char*)d_ws + WS_CTL, 0, CTL_ZERO_BYTES, stream);
    Args a{};
    for (int i = 0; i < 23; ++i) a.in[i] = (const float*)d_in[i];
    a.out = (float*)d_out; a.ws = (unsigned char*)d_ws;
#if MK_PER_PHASE
    for (int p = 0; p < N_PHASES; ++p) { a.ph_lo = p; a.ph_hi = p + 1; hipLaunchKernelGGL(fwd_kernel, dim3(grid), dim3(512), LDS_BYTES, stream, a); }
#else
    a.ph_lo = 0; a.ph_hi = N_PHASES; hipLaunchKernelGGL(fwd_kernel, dim3(grid), dim3(512), LDS_BYTES, stream, a);
#endif
}
```

```cpp
#include <hip/hip_runtime.h>
#include <cstdio>
#include <cstdint>
namespace pg8 {
#define PG8_LAS __attribute__((address_space(3)))
typedef unsigned short bf16_t;
typedef short bf16x8 __attribute__((ext_vector_type(8)));
typedef float f32x4 __attribute__((ext_vector_type(4)));
typedef float f32x2 __attribute__((ext_vector_type(2)));
typedef unsigned u32x4 __attribute__((ext_vector_type(4)));
typedef unsigned u32x2 __attribute__((ext_vector_type(2)));
constexpr int BM = 256, BK = 64, HALF = 128, HTB = HALF * BK * 2  , STAGE_BYTES = 8 * HTB, NXCD = 8, WGM = 8;

__host__ __device__ __forceinline__ int lds_byte(int r, int c) { const int st = (r >> 4) * 2 + (c >> 5), rr = r & 15, cc = c & 31, ob = rr * 64 + cc * 2; return st * 1024 + (ob ^ (((ob >> 9) & 1) << 5)); }
__host__ __device__ __forceinline__ void stage_rc(int b, int& R, int& C) { const int st = b / 1024, sb = b % 1024, swz = sb ^ (((sb >> 9) & 1) << 5); R = (st >> 1) * 16 + swz / 64; C = (st & 1) * 32 + (swz % 64) / 2; }
__host__ __device__ __forceinline__ int perm32(int rho) { const int n = rho >> 4, i = rho & 15; return 8 * (i >> 2) + 4 * n + (i & 3); }

struct Unit { int pm, pn, meta;
    __host__ __device__ __forceinline__ int kt0() const { return meta & 255; } __host__ __device__ __forceinline__ int nt() const { return (meta >> 8) & 255; } __host__ __device__ __forceinline__ int part() const { return meta >> 16; }
    __host__ __device__ __forceinline__ void set(int kt0_, int nt_, int part_) { meta = kt0_ | (nt_ << 8) | (part_ << 16); } };
struct Gemm { const bf16_t* A; const bf16_t* Bt; int M, N, K, lda, ldb; };

__host__ __device__ __forceinline__ int xcd_block_pos(int L, int nwg, int G) {
    if (G != 256) return L;
    const int i = L >> 8, c = L & 255;
    if (((i + 1) << 8) <= nwg) return (i << 8) + ((c & 7) << 5) + (c >> 3);
    const int rem = nwg - (i << 8);
    return (rem & 7) ? L : (i << 8) + (c & 7) * (rem >> 3) + (c >> 3);
}
__host__ __device__ __forceinline__ void tile_of(int wgid, int nM, int nN, int& pm, int& pn) {
    const int nig = WGM * nN, gid = wgid / nig, fm = gid * WGM, gsz = (nM - fm) < WGM ? (nM - fm) : WGM;
    pm = fm + ((wgid % nig) % gsz); pn = (wgid % nig) / gsz;
}
struct StaticOrder {
    int nM, nN, nwg, G, c, ntK;
    __host__ __device__ void init(int M, int N, int G_, int c_, int K) { nM = M / BM; nN = N / BM; nwg = nM * nN; G = G_; c = c_; ntK = K / BK; }
    __host__ __device__ bool next(int i, Unit& u) const {
        const long L = (long)i * G + c; if (L >= nwg) return false;
        u.set(0, ntK, 0);
        const int wgid = xcd_block_pos((int)L, nwg, G);
        const int nig = WGM * nN, gid = wgid / nig, fm = gid * WGM, gsz = (nM - fm) < WGM ? (nM - fm) : WGM;
        u.pm = fm + ((wgid % nig) % gsz); u.pn = (wgid % nig) / gsz; return true;
    }
    __device__ __forceinline__ void a_ready(const Unit&) const {}
    __device__ __forceinline__ void done(const Unit&) const {}
};

struct SplitOrder {
    int G, c, ntK, nctx;
    __host__ __device__ void init(int G_, int c_, int K, bool with_ctx) { G = G_; c = c_; ntK = K / BK; nctx = with_ctx ? 256 : 0; }
    __host__ __device__ bool next(int i, Unit& u) const {
        const long L = (long)i * G + c; if (L >= 512 + nctx) return false;
        if (L < 512) { tile_of(xcd_block_pos((int)(L < 256 ? L + 256 : L - 256), 512, G), 64, 8, u.pm, u.pn); u.set(0, ntK, 0); return true; }
        const int q = (int)L - 512, tile = q >> 3, p = q & 7; u.pm = 64 + (tile >> 3); u.pn = tile & 7;
        if (ntK == 88) u.set((p >> 1) * 22 + (p & 1) * 12, (p & 1) ? 10 : 12, 1 + p); else u.set(p * (ntK >> 3), ntK >> 3, 1 + p);
        return true;
    }
    __device__ __forceinline__ void a_ready(const Unit&) const {}
    __device__ __forceinline__ void done(const Unit&) const {}
};

struct InprojOrder {
    int G, c, ntK, nctx;
    __host__ __device__ void init(int G_, int c_, int K, int nctx_pn) { G = G_; c = c_; ntK = K / BK; nctx = 4 * nctx_pn; }
    __host__ __device__ bool next(int i, Unit& u) const {
        const long L = (long)i * G + c; if (L >= 64 * 54 + nctx) return false;
        u.set(0, ntK, 0);
        if (L < 64 * 54) { tile_of(xcd_block_pos((int)L, 64 * 54, G), 64, 54, u.pm, u.pn); return true; }
        const int q = (int)L - 64 * 54; u.pm = 64 + (q & 3); u.pn = q >> 2; return true;
    }
    __device__ __forceinline__ void a_ready(const Unit&) const {}
    __device__ __forceinline__ void done(const Unit&) const {}
};

__device__ __forceinline__ unsigned cvt_pk_bf16(float lo, float hi) { unsigned r; asm volatile("v_cvt_pk_bf16_f32 %0, %1, %2" : "=v"(r) : "v"(lo), "v"(hi)); return r; }

template <class Epi, class Sched, bool ALIGN_EPI = false, bool SP2 = false>
__device__ __forceinline__ void gemm_phase(PG8_LAS unsigned char* lds, const Gemm g, const Sched& S, const Epi& E) {
    int tid_ = threadIdx.x; asm volatile("" : "+v"(tid_));
    const int tid = tid_, wid = __builtin_amdgcn_readfirstlane(tid >> 6), lane = tid & 63, wr = wid >> 2, wc = wid & 3, fr = lane & 15, fq = lane >> 4;
    unsigned voffA[2], voffB[2];
#pragma unroll
    for (int i = 0; i < 2; ++i) { int R, C; stage_rc(tid * 16 + i * 8192, R, C); const int Rb = Epi::PERM ? ((R & ~31) + perm32(R & 31)) : R;
        voffA[i] = (unsigned)(R * g.lda + C) * 2u; voffB[i] = (unsigned)(Rb * g.ldb + C) * 2u; }
    const unsigned kstep = (unsigned)(BK * 2);
    const unsigned hstepA = (unsigned)HALF * g.lda * 2u, hstepB = (unsigned)HALF * g.ldb * 2u;
    const unsigned tstepA = 2u * hstepA, tstepB = 2u * hstepB;
    const unsigned ldsw = (unsigned)wid * 1024u;
    const int aoff = lds_byte(wr * 64 + fr, fq * 8), boff = lds_byte(wc * 32 + fr, fq * 8);
#define PG8_SA(b, h) (((b) * 2 + (h)) * HTB)
#define PG8_SB(b, h) ((4 + (b) * 2 + (h)) * HTB)
#define PG8_STAGE(bufoff, gbase, voff) do { _Pragma("unroll") for (int _i = 0; _i < 2; ++_i) \
        __builtin_amdgcn_global_load_lds((const unsigned*)((const char*)(gbase) + (voff)[_i]), (PG8_LAS unsigned*)(lds + (bufoff) + ldsw + _i * 8192), 16, 0, 0); } while (0)
#define PG8_LDA(dst, b, h) do { _Pragma("unroll") for (int m = 0; m < 4; ++m) _Pragma("unroll") for (int k = 0; k < 2; ++k) dst[m][k] = *(const PG8_LAS bf16x8*)(lds + PG8_SA(b, h) + aoff + m * 2048 + k * 1024); } while (0)
#define PG8_LDB(dst, b, h) do { _Pragma("unroll") for (int n = 0; n < 2; ++n) _Pragma("unroll") for (int k = 0; k < 2; ++k) dst[n][k] = *(const PG8_LAS bf16x8*)(lds + PG8_SB(b, h) + boff + n * 2048 + k * 1024); } while (0)
#define PG8_MMA(ai, bj, At, Bt) do { __builtin_amdgcn_s_setprio(1); _Pragma("unroll") for (int m = 0; m < 4; ++m) _Pragma("unroll") for (int n = 0; n < 2; ++n) _Pragma("unroll") for (int k = 0; k < 2; ++k) \
        acc[ai][bj][m][n] = __builtin_amdgcn_mfma_f32_16x16x32_bf16(Bt[n][k], At[m][k], acc[ai][bj][m][n], 0, 0, 0); __builtin_amdgcn_s_setprio(0); } while (0)
#define PG8_WAIT_V(n) asm volatile("s_waitcnt vmcnt(" #n ")" ::: "memory")
#define PG8_WAIT_L(n) asm volatile("s_waitcnt lgkmcnt(" #n ")" ::: "memory")
#define PG8_BAR __builtin_amdgcn_s_barrier()
#define PG8_SCHED __builtin_amdgcn_sched_barrier(0)
    Unit cur, nxt; int ui = 0;
    if (!S.next(0, cur)) return;
    f32x4 acc[2][2][4][2];
#pragma unroll
    for (int a = 0; a < 2; ++a)
#pragma unroll
        for (int b = 0; b < 2; ++b)
#pragma unroll
            for (int m = 0; m < 4; ++m)
#pragma unroll
                for (int n = 0; n < 2; ++n) acc[a][b][m][n] = (f32x4){0.f, 0.f, 0.f, 0.f};
    bf16x8 At[4][2], B0[2][2], B1[2][2];
    const char* cA = (const char*)g.A + (size_t)((unsigned)cur.pm * tstepA) + (size_t)((unsigned)cur.kt0() * kstep); const char* cB = (const char*)g.Bt + (size_t)((unsigned)cur.pn * tstepB) + (size_t)((unsigned)cur.kt0() * kstep);
    S.a_ready(cur);
    if constexpr (SP2) {
        PG8_STAGE(PG8_SB(0, 0), cB, voffB); PG8_STAGE(PG8_SB(0, 1), cB + hstepB, voffB); PG8_STAGE(PG8_SA(0, 0), cA, voffA); PG8_STAGE(PG8_SA(0, 1), cA + hstepA, voffA);
        if (wr == 1) PG8_BAR;
        PG8_WAIT_V(2); PG8_BAR;
        PG8_STAGE(PG8_SB(1, 0), cB + kstep, voffB); PG8_STAGE(PG8_SA(1, 0), cA + kstep, voffA); PG8_STAGE(PG8_SB(1, 1), cB + hstepB + kstep, voffB);
        PG8_WAIT_V(6); PG8_BAR;
    } else {
        PG8_STAGE(PG8_SB(0, 0), cB, voffB); PG8_STAGE(PG8_SA(0, 0), cA, voffA); PG8_STAGE(PG8_SB(0, 1), cB + hstepB, voffB); PG8_STAGE(PG8_SA(0, 1), cA + hstepA, voffA);
        if (wr == 1) PG8_BAR;
        PG8_WAIT_V(4); PG8_BAR;
        PG8_STAGE(PG8_SB(1, 0), cB + kstep, voffB); PG8_STAGE(PG8_SA(1, 0), cA + kstep, voffA); PG8_STAGE(PG8_SB(1, 1), cB + hstepB + kstep, voffB);
        PG8_WAIT_V(6); PG8_BAR;
    }
    for (;;) {
        const bool has_next = S.next(ui + 1, nxt);
        const char* nA = has_next ? (const char*)g.A + (size_t)((unsigned)nxt.pm * tstepA) + (size_t)((unsigned)nxt.kt0() * kstep) : cA; const char* nB = has_next ? (const char*)g.Bt + (size_t)((unsigned)nxt.pn * tstepB) + (size_t)((unsigned)nxt.kt0() * kstep) : cB;
        const int nt = cur.nt();
        for (int t = 0; t < nt; t += 2) {
            if constexpr (Epi::HOOK) { if (t == Epi::H1 || t == Epi::H2) E.khook(acc, cur, t, wr, wc, fr, fq); }
            const bool last = (t == nt - 2);
            const char* a1 = cA + (size_t)((unsigned)(t + 1) * kstep);
            const char* a2 = last ? nA : cA + (size_t)((unsigned)(t + 2) * kstep); const char* b2 = last ? nB : cB + (size_t)((unsigned)(t + 2) * kstep);
            const char* a3 = a2 + kstep; const char* b3 = b2 + kstep;
            if (last && has_next) S.a_ready(nxt);
            if constexpr (SP2) {
            PG8_LDB(B0, 0, 0); PG8_LDB(B1, 0, 1); PG8_SCHED; PG8_LDA(At, 0, 0); PG8_STAGE(PG8_SA(1, 1), a1 + hstepA, voffA);
            PG8_WAIT_V(8); PG8_WAIT_L(0); PG8_BAR; PG8_MMA(0, 0, At, B0); PG8_MMA(0, 1, At, B1); PG8_BAR; PG8_SCHED;
            PG8_LDA(At, 0, 1); PG8_STAGE(PG8_SB(0, 0), b2, voffB); PG8_STAGE(PG8_SB(0, 1), b2 + hstepB, voffB); PG8_STAGE(PG8_SA(0, 0), a2, voffA);
            PG8_WAIT_V(8); PG8_WAIT_L(0); PG8_BAR; PG8_MMA(1, 0, At, B0); PG8_MMA(1, 1, At, B1); PG8_BAR; PG8_SCHED;
            PG8_LDB(B0, 1, 0); PG8_LDB(B1, 1, 1); PG8_SCHED; PG8_LDA(At, 1, 0); PG8_STAGE(PG8_SA(0, 1), a2 + hstepA, voffA);
            PG8_WAIT_V(8); PG8_WAIT_L(0); PG8_BAR; PG8_MMA(0, 0, At, B0); PG8_MMA(0, 1, At, B1); PG8_BAR; PG8_SCHED;
            PG8_LDA(At, 1, 1); PG8_STAGE(PG8_SB(1, 0), b3, voffB); PG8_STAGE(PG8_SB(1, 1), b3 + hstepB, voffB); PG8_STAGE(PG8_SA(1, 0), a3, voffA);
            PG8_WAIT_V(8); PG8_WAIT_L(0); PG8_BAR; PG8_MMA(1, 0, At, B0); PG8_MMA(1, 1, At, B1); PG8_BAR; PG8_SCHED;
            } else {
            PG8_LDB(B0, 0, 0); PG8_SCHED; PG8_LDA(At, 0, 0); PG8_STAGE(PG8_SA(1, 1), a1 + hstepA, voffA);
            PG8_WAIT_L(8); PG8_BAR; PG8_WAIT_L(0); PG8_MMA(0, 0, At, B0); PG8_BAR; PG8_SCHED;
            PG8_LDB(B1, 0, 1); PG8_STAGE(PG8_SB(0, 0), b2, voffB);
            PG8_BAR; PG8_WAIT_L(0); PG8_MMA(0, 1, At, B1); PG8_BAR;
            PG8_LDA(At, 0, 1); PG8_STAGE(PG8_SA(0, 0), a2, voffA);
            PG8_BAR; PG8_WAIT_L(0); PG8_MMA(1, 0, At, B0); PG8_BAR; PG8_SCHED;
            PG8_STAGE(PG8_SB(0, 1), b2 + hstepB, voffB);
            PG8_WAIT_V(6); PG8_BAR; PG8_MMA(1, 1, At, B1); PG8_BAR;
            PG8_LDB(B0, 1, 0); PG8_SCHED; PG8_LDA(At, 1, 0); PG8_STAGE(PG8_SA(0, 1), a2 + hstepA, voffA);
            PG8_WAIT_L(8); PG8_BAR; PG8_WAIT_L(0); PG8_MMA(0, 0, At, B0); PG8_BAR; PG8_SCHED;
            PG8_LDB(B1, 1, 1); PG8_STAGE(PG8_SB(1, 0), b3, voffB);
            PG8_BAR; PG8_WAIT_L(0); PG8_MMA(0, 1, At, B1); PG8_BAR;
            PG8_LDA(At, 1, 1); PG8_STAGE(PG8_SA(1, 0), a3, voffA);
            PG8_BAR; PG8_WAIT_L(0); PG8_MMA(1, 0, At, B0); PG8_BAR; PG8_SCHED;
            PG8_STAGE(PG8_SB(1, 1), b3 + hstepB, voffB);
            PG8_WAIT_V(6); PG8_BAR; PG8_MMA(1, 1, At, B1); PG8_BAR;
            }
        }
        if constexpr (ALIGN_EPI) { if (wr == 0) PG8_BAR; }
        E(acc, cur, wr, wc, fr, fq); S.done(cur);
        if (!has_next) break;
#pragma unroll
        for (int a = 0; a < 2; ++a)
#pragma unroll
            for (int b = 0; b < 2; ++b)
#pragma unroll
                for (int m = 0; m < 4; ++m)
#pragma unroll
                    for (int n = 0; n < 2; ++n) acc[a][b][m][n] = (f32x4){0.f, 0.f, 0.f, 0.f};
        cur = nxt; cA = nA; cB = nB; ++ui;
        if constexpr (ALIGN_EPI) { if (wr == 1) PG8_BAR; }
    }
    PG8_WAIT_V(0);
    if constexpr (!ALIGN_EPI) { if (wr == 0) PG8_BAR; }
    PG8_BAR;
#undef PG8_SA
#undef PG8_SB
#undef PG8_STAGE
#undef PG8_LDA
#undef PG8_LDB
#undef PG8_MMA
#undef PG8_WAIT_V
#undef PG8_WAIT_L
#undef PG8_BAR
#undef PG8_SCHED
}
}
#define XB_TMO      128
#define XB_XCNT(j)  (256  + 64 * (j))
#define XB_XSUB(j)  (1280 + 64 * (j))
#define XB_XGEN(j)  (2304 + 64 * (j))
#define XB_TOP      3328
#define XB_TOPGEN   3392
#define XCD_BAR_WORDS 3456
#define XB_SPIN_CAP (1u << 18)
#define LAS __attribute__((address_space(3)))

__device__ __forceinline__ unsigned xb_ld(unsigned* p)              { return __hip_atomic_load(p, __ATOMIC_RELAXED, __HIP_MEMORY_SCOPE_AGENT); }
__device__ __forceinline__ unsigned xb_add(unsigned* p, unsigned v) { return __hip_atomic_fetch_add(p, v, __ATOMIC_RELAXED, __HIP_MEMORY_SCOPE_AGENT); }
__device__ __forceinline__ unsigned xb_xcc_id() { return (unsigned)__builtin_amdgcn_s_getreg((3 << 11) | 20) & 0xFu; }
#define XB_SPIN(cond, bar) do { unsigned _sp = 0; while (cond) { __builtin_amdgcn_s_sleep(1); \
    if ((++_sp & 255u) == 0u) { if (xb_ld(&(bar)[XB_TMO])) break; if (_sp > XB_SPIN_CAP) { atomicAdd(&(bar)[XB_TMO], 1u); break; } } } } while (0)

struct XcdBarrier {
    unsigned* bar; unsigned x;
    volatile LAS unsigned* st;
};

__device__ __forceinline__ XcdBarrier xcd_barrier_post(unsigned* bar, volatile LAS unsigned* st) {
    XcdBarrier b; b.bar = bar; b.x = xb_xcc_id(); b.st = st;
    if (threadIdx.x == 0) (void)xb_add(&bar[XB_XCNT(b.x)], 1u);
    return b;
}
__device__ __forceinline__ void xcd_barrier_complete(unsigned* bar, unsigned x, unsigned& nloc, unsigned& nx) {
    const unsigned G = gridDim.x * gridDim.y * gridDim.z;
    unsigned sum, cnt, mine, sp = 0u;
    for (;;) {
        sum = 0u; cnt = 0u; mine = 0u;
#pragma unroll
        for (unsigned j = 0; j < 16; ++j) { const unsigned c = xb_ld(&bar[XB_XCNT(j)]); sum += c; cnt += (c > 0u) ? 1u : 0u; mine = (j == x) ? c : mine; }
        if (sum == G) break;
        __builtin_amdgcn_s_sleep(1);
        if ((++sp & 255u) == 0u) { if (xb_ld(&bar[XB_TMO])) break; if (sp > XB_SPIN_CAP) { atomicAdd(&bar[XB_TMO], 1u); break; } }
    }
    nloc = mine > 0u ? mine : 1u; nx = cnt > 0u ? cnt : 1u;
}

__device__ __forceinline__ void xcd_barrier(const XcdBarrier& b) {
    asm volatile("s_waitcnt vmcnt(0)" ::: "memory");
    __syncthreads();
    if (threadIdx.x == 0) {
        unsigned* bar = b.bar;
        __builtin_amdgcn_s_waitcnt(0);
        unsigned nloc = b.st[0], nx = b.st[1];
        if (nloc == 0u) { xcd_barrier_complete(bar, b.x, nloc, nx); b.st[0] = nloc; b.st[1] = nx; }
        const unsigned old = xb_add(&bar[XB_XSUB(b.x)], 1u);
        const unsigned gen = old / nloc;
        if (old + 1u == (gen + 1u) * nloc) {
            __builtin_amdgcn_fence(__ATOMIC_RELEASE, "agent");
            asm volatile("s_waitcnt vmcnt(0)" ::: "memory");
            const unsigned og = xb_add(&bar[XB_TOP], 1u);
            const unsigned tg = og / nx;
            if (og + 1u == (tg + 1u) * nx) xb_add(&bar[XB_TOPGEN], 1u);
            else XB_SPIN(xb_ld(&bar[XB_TOPGEN]) == tg, bar);
            __builtin_amdgcn_fence(__ATOMIC_ACQUIRE, "agent");
            xb_add(&bar[XB_XGEN(b.x)], 1u);
            asm volatile("s_waitcnt vmcnt(0)" ::: "memory");
        } else {
            XB_SPIN(xb_ld(&bar[XB_XGEN(b.x)]) == gen, bar);
            __builtin_amdgcn_fence(__ATOMIC_ACQUIRE, "agent");
            asm volatile("s_waitcnt vmcnt(0)" ::: "memory");
        }
    }
    __syncthreads();
}

constexpr int D = 2048, NB = 4, SEQ = 4096, DEPTH = 4, CTXL = 256, NMOD = 9, DFF = 5632, NH = 8, DK = 128, DV = 128, WK = 1024;
constexpr int BW = 512, CWD = 512, INW = 13824;
constexpr int M_LAT = NB * SEQ, M_CTX = NB * CTXL, M = M_LAT + M_CTX;
constexpr int MODW = NMOD * D;
constexpr int NGRP = 5;
constexpr float EPS = 1e-6f;
constexpr int Z1W = 4096, Z2W = INW - Z1W;
constexpr int Z2_GA = 0, Z2_U = 1024, Z2_V = 1536, Z2_HC = 2048, Z2_GB = 2560, Z2_GC = 3072, Z2_MA = 3584, Z2_MB = 5632, Z2_MC = 7680;

constexpr size_t MiB = 1u << 20;
constexpr size_t WS_CTL = 0ull * MiB, CTL_ZERO_BYTES = 32 * 1024;
constexpr size_t WS_MOD = 1ull * MiB;
constexpr size_t WS_LB = 3ull * MiB;
constexpr size_t WS_WGU = 4ull * MiB;
constexpr size_t WS_WD = 356ull * MiB;
constexpr size_t WS_WIN = 532ull * MiB;
constexpr size_t WS_WP = 748ull * MiB;
constexpr size_t WS_WO = 780ull * MiB;
constexpr size_t WS_Y = 812ull * MiB;
constexpr size_t WS_H = 948ull * MiB;
constexpr size_t WS_MRG = 1016ull * MiB;
constexpr size_t WS_YABC = 1084ull * MiB;
constexpr size_t WS_MF32 = 1152ull * MiB;
constexpr size_t WS_OF = 1288ull * MiB;
constexpr size_t WS_OB = 1356ull * MiB;
constexpr size_t WS_FF = 1424ull * MiB;
constexpr size_t WS_FB = 1492ull * MiB;
constexpr size_t WS_VN = 1560ull * MiB;
constexpr size_t WS_Z1 = 1577ull * MiB;
constexpr size_t WS_ZF = WS_Z1, WS_QS = WS_Z1 + 68ull * MiB;
constexpr size_t WS_Z2 = 1849ull * MiB;
constexpr size_t WS_ACT = WS_Z1;
constexpr size_t WS_QF = WS_FF, WS_KF = WS_FF + 34ull * MiB, WS_QB = WS_FB, WS_KB = WS_FB + 34ull * MiB;
constexpr size_t WS_VV = 2172ull * MiB;
constexpr size_t WS_GF = 2206ull * MiB;
constexpr size_t WS_GB = 2211ull * MiB;
constexpr size_t WS_SLOC = 2216ull * MiB;
constexpr size_t WS_END = 2248ull * MiB;
constexpr int CW_BAR = 4096;
static_assert((CW_BAR + 3456) * 4 <= (int)CTL_ZERO_BYTES, "barrier words inside the per-call memset");

constexpr int RING_BYTES = 131072;
constexpr int LDSCTL_OFF = RING_BYTES, MISC_OFF = LDSCTL_OFF + 320;
constexpr int LDS_BYTES = 147456;

#define GAS __attribute__((address_space(1)))
typedef unsigned short bf16;
typedef unsigned v4u __attribute__((ext_vector_type(4)));
typedef unsigned v2u __attribute__((ext_vector_type(2)));
typedef float f32x4 __attribute__((ext_vector_type(4)));
#define LDS_WAIT() asm volatile("s_waitcnt lgkmcnt(0)" ::: "memory")
#define VM_WAIT() asm volatile("s_waitcnt vmcnt(0)" ::: "memory")
__device__ __forceinline__ unsigned f2bf(float f) { unsigned u = __builtin_bit_cast(unsigned, f); return (u + 0x7fffu + ((u >> 16) & 1u)) >> 16; }
__device__ __forceinline__ unsigned pk2(float lo, float hi) { unsigned r; asm("v_cvt_pk_bf16_f32 %0, %1, %2" : "=v"(r) : "v"(lo), "v"(hi)); return r; }
__device__ __forceinline__ float bflo(unsigned w) { return __builtin_bit_cast(float, w << 16); }
__device__ __forceinline__ float bfhi(unsigned w) { return __builtin_bit_cast(float, w & 0xffff0000u); }
__device__ __forceinline__ float sigmoidf_(float x) { return __builtin_amdgcn_rcpf(1.0f + __expf(-x)); }
__device__ __forceinline__ float siluf_(float x) { return x * sigmoidf_(x); }
__device__ __forceinline__ float gelu_tanh(float x) { const float u = 0.7978845608028654f * (x + 0.044715f * x * x * x); return x * sigmoidf_(2.0f * u); }
template <int CTRL> __device__ __forceinline__ float dppf(float x) { return __builtin_bit_cast(float, __builtin_amdgcn_mov_dpp(__builtin_bit_cast(int, x), CTRL, 0xf, 0xf, true)); }
__device__ __forceinline__ float row16_sum(float x) { x += dppf<0xB1>(x); x += dppf<0x4E>(x); x += dppf<0x124>(x); x += dppf<0x128>(x); return x; }
__device__ __forceinline__ float wave_sum(float v) {
#pragma unroll
    for (int o = 1; o < 64; o <<= 1) v += __shfl_xor(v, o);
    return v;
}
__device__ __forceinline__ int grp_of_row(int m) { return m < M_LAT ? (m >> 12) : 4; }
#ifndef YBF16
#define YBF16 1
#endif
#if YBF16
typedef _Float16 ytype;
typedef _Float16 h16x4 __attribute__((ext_vector_type(4)));
__device__ __forceinline__ f32x4 y_ld4(const ytype* p) { const h16x4 w = *(const GAS h16x4*)p; return __builtin_convertvector(w, f32x4); }
__device__ __forceinline__ void y_st4(ytype* p, f32x4 v) { *(GAS h16x4*)p = __builtin_convertvector(v, h16x4); }
#else
typedef float ytype;
__device__ __forceinline__ f32x4 y_ld4(const ytype* p) { return *(const GAS f32x4*)p; }
__device__ __forceinline__ void y_st4(ytype* p, f32x4 v) { *(GAS f32x4*)p = v; }
#endif

struct Frame {
    LAS unsigned char* lds;
    int tid, lane, wave, vcu, G;
    unsigned char* ws;
};
struct Args { const float* in[23]; float* out; unsigned char* ws; int ph_lo, ph_hi; };
typedef const __attribute__((address_space(4))) Args* KArgs;
__device__ __forceinline__ KArgs kargs() { auto p = __builtin_amdgcn_kernarg_segment_ptr(); asm volatile("" : "+s"(p)); return (KArgs)p; }
__device__ __forceinline__ Frame mkframe() {
    extern __shared__ __attribute__((aligned(16))) unsigned char lds_dyn[];
    Frame F; F.lds = (LAS unsigned char*)lds_dyn; { int t = threadIdx.x; asm volatile("" : "+v"(t)); F.tid = t; } F.lane = F.tid & 63; F.wave = __builtin_amdgcn_readfirstlane(F.tid >> 6);
    { int gg = gridDim.x; asm volatile("" : "+s"(gg)); F.G = gg; } { int bx = blockIdx.x; asm volatile("" : "+s"(bx)); F.vcu = (F.G % 8 == 0) ? (bx % 8) * (F.G / 8) + bx / 8 : bx; }
    F.ws = kargs()->ws; return F;
}

namespace pg8 {
#define TRANS8(op, a) asm(op " %0, %0\n\t" op " %1, %1\n\t" op " %2, %2\n\t" op " %3, %3\n\t" op " %4, %4\n\t" op " %5, %5\n\t" op " %6, %6\n\t" op " %7, %7\n\ts_nop 0" \
    : "+v"(a##0), "+v"(a##1), "+v"(a##2), "+v"(a##3), "+v"(a##4), "+v"(a##5), "+v"(a##6), "+v"(a##7))
struct EpiSwiGLU { static constexpr bool PERM = true, HOOK = false; static constexpr int H1 = -1, H2 = -1;
    bf16_t* O;
    __device__ __forceinline__ void operator()(const f32x4 (&acc)[2][2][4][2], const Unit& u, int wr, int wc, int fr, int fq) const {
        const int row0 = u.pm * BM + wr * 64 + fr, col0 = u.pn * HALF + wc * 32 + 8 * fq;
#pragma unroll
        for (int ai = 0; ai < 2; ++ai)
#pragma unroll
            for (int m = 0; m < 4; ++m) { bf16_t* rowp = O + (size_t)(row0 + ai * HALF + m * 16) * DFF + col0;
                const f32x4 g0 = acc[ai][0][m][0], g1 = acc[ai][0][m][1], u0 = acc[ai][1][m][0], u1 = acc[ai][1][m][1];
                constexpr float NL2E = -1.4426950408889634f;
                float t0 = g0[0] * NL2E, t1 = g0[1] * NL2E, t2 = g0[2] * NL2E, t3 = g0[3] * NL2E, t4 = g1[0] * NL2E, t5 = g1[1] * NL2E, t6 = g1[2] * NL2E, t7 = g1[3] * NL2E;
                TRANS8("v_exp_f32", t);
                t0 += 1.0f; t1 += 1.0f; t2 += 1.0f; t3 += 1.0f; t4 += 1.0f; t5 += 1.0f; t6 += 1.0f; t7 += 1.0f;
                TRANS8("v_rcp_f32", t);
                u32x4 w; w.x = cvt_pk_bf16(g0[0] * u0[0] * t0, g0[1] * u0[1] * t1); w.y = cvt_pk_bf16(g0[2] * u0[2] * t2, g0[3] * u0[3] * t3);
                w.z = cvt_pk_bf16(g1[0] * u1[0] * t4, g1[1] * u1[1] * t5); w.w = cvt_pk_bf16(g1[2] * u1[2] * t6, g1[3] * u1[3] * t7);
                *(u32x4*)rowp = w; }
    }
};
#if YBF16
typedef _Float16 yh16x8 __attribute__((ext_vector_type(8)));
typedef float yf32x8 __attribute__((ext_vector_type(8)));
#endif
struct EpiResid { static constexpr bool PERM = true, HOOK = false; static constexpr int H1 = -1, H2 = -1;
    ytype* Y; const float* gate; float coef; float* slab;
    __device__ __forceinline__ void operator()(const f32x4 (&acc)[2][2][4][2], const Unit& u, int wr, int wc, int fr, int fq) const {
        const int row0 = u.pm * BM + wr * 64 + fr, col0 = u.pn * BM + wc * 32 + 8 * fq; const int grp = u.pm < 64 ? (u.pm >> 4) : 4;
        if (u.part() == 0) {
        const float* gp = gate + (size_t)grp * MODW + col0; f32x4 gv[2][2];
#pragma unroll
        for (int bj = 0; bj < 2; ++bj)
#pragma unroll
            for (int n = 0; n < 2; ++n) gv[bj][n] = *(const f32x4*)(gp + bj * HALF + 4 * n) * coef;
#if YBF16
#pragma unroll
        for (int ai = 0; ai < 2; ++ai) { yh16x8 old[4][2];
#pragma unroll
            for (int m = 0; m < 4; ++m)
#pragma unroll
                for (int bj = 0; bj < 2; ++bj) old[m][bj] = *(const yh16x8*)(Y + (size_t)(row0 + ai * HALF + m * 16) * D + col0 + bj * HALF);
#pragma unroll
            for (int m = 0; m < 4; ++m)
#pragma unroll
                for (int bj = 0; bj < 2; ++bj) { const yf32x8 o = __builtin_convertvector(old[m][bj], yf32x8); const f32x4 a0 = gv[bj][0] * acc[ai][bj][m][0], a1 = gv[bj][1] * acc[ai][bj][m][1];
                    const yf32x8 r = {o[0] + a0[0], o[1] + a0[1], o[2] + a0[2], o[3] + a0[3], o[4] + a1[0], o[5] + a1[1], o[6] + a1[2], o[7] + a1[3]};
                    *(yh16x8*)(Y + (size_t)(row0 + ai * HALF + m * 16) * D + col0 + bj * HALF) = __builtin_convertvector(r, yh16x8); }
            asm volatile("" ::: "memory"); }
#else
#pragma unroll
        for (int ai = 0; ai < 2; ++ai)
#pragma unroll
            for (int m = 0; m < 4; ++m) { float* rowp = Y + (size_t)(row0 + ai * HALF + m * 16) * D + col0;
#pragma unroll
                for (int bj = 0; bj < 2; ++bj)
#pragma unroll
                    for (int n = 0; n < 2; ++n) { float* p = rowp + bj * HALF + 4 * n; const f32x4 o = *(const f32x4*)p; *(f32x4*)p = o + gv[bj][n] * acc[ai][bj][m][n]; }
                asm volatile("" ::: "memory"); }
#endif
        } else {
#pragma unroll
        for (int ai = 0; ai < 2; ++ai)
#pragma unroll
            for (int m = 0; m < 4; ++m) { _Float16* rowp = (_Float16*)slab + ((size_t)(u.part() - 1) * M_CTX + (size_t)(row0 + ai * HALF + m * 16 - M_LAT)) * D + col0;
#pragma unroll
                for (int bj = 0; bj < 2; ++bj) { const f32x4 v0 = acc[ai][bj][m][0], v1 = acc[ai][bj][m][1]; const yf32x8 v = {v0[0], v0[1], v0[2], v0[3], v1[0], v1[1], v1[2], v1[3]};
                    *(yh16x8*)(rowp + bj * HALF) = __builtin_convertvector(v, yh16x8); } }
        }
    }
};
typedef _Float16 eh16x8 __attribute__((ext_vector_type(8)));
typedef float ef32x8 __attribute__((ext_vector_type(8)));
struct EpiInproj { static constexpr bool PERM = true, HOOK = false; static constexpr int H1 = -1, H2 = -1;
    bf16_t* QS; bf16_t* VV; _Float16* ZF; bf16_t* Z2;
    __device__ __forceinline__ void operator()(const f32x4 (&acc)[2][2][4][2], const Unit& u, int wr, int wc, int fr, int fq) const {
        const int row0 = u.pm * BM + wr * 64 + fr;
        if (u.pn < 8) { bf16_t* base = u.pn < 4 ? QS : VV; const float sc = u.pn < 4 ? 0.08838834764831845f : 1.0f; const int col0 = (u.pn & 3) * BM + wc * 32 + 8 * fq;
#pragma unroll
            for (int ai = 0; ai < 2; ++ai)
#pragma unroll
                for (int m = 0; m < 4; ++m) { bf16_t* rowp = base + (size_t)(row0 + ai * HALF + m * 16) * WK + col0;
#pragma unroll
                    for (int bj = 0; bj < 2; ++bj) { const f32x4 v0 = acc[ai][bj][m][0] * sc, v1 = acc[ai][bj][m][1] * sc;
                        u32x4 w; w.x = cvt_pk_bf16(v0[0], v0[1]); w.y = cvt_pk_bf16(v0[2], v0[3]); w.z = cvt_pk_bf16(v1[0], v1[1]); w.w = cvt_pk_bf16(v1[2], v1[3]);
                        *(u32x4*)(rowp + bj * HALF) = w; } }
        } else if (u.pn < 16) { const int col0 = (u.pn - 8) * BM + wc * 32 + 8 * fq;
#pragma unroll
            for (int ai = 0; ai < 2; ++ai)
#pragma unroll
                for (int m = 0; m < 4; ++m) { _Float16* rowp = ZF + (size_t)(row0 + ai * HALF + m * 16) * 2048 + col0;
#pragma unroll
                    for (int bj = 0; bj < 2; ++bj) { const f32x4 v0 = acc[ai][bj][m][0], v1 = acc[ai][bj][m][1];
                        const ef32x8 v = {v0[0], v0[1], v0[2], v0[3], v1[0], v1[1], v1[2], v1[3]}; *(eh16x8*)(rowp + bj * HALF) = __builtin_convertvector(v * -1.4426950408889634f, eh16x8); } }
        } else if (u.pn < 30) { const int col0 = (u.pn - 16) * BM + wc * 32 + 8 * fq;
#pragma unroll
            for (int ai = 0; ai < 2; ++ai)
#pragma unroll
                for (int m = 0; m < 4; ++m) { bf16_t* rowp = Z2 + (size_t)(row0 + ai * HALF + m * 16) * Z2W + col0;
#pragma unroll
                    for (int bj = 0; bj < 2; ++bj) { const f32x4 v0 = acc[ai][bj][m][0], v1 = acc[ai][bj][m][1];
                        u32x4 w; w.x = cvt_pk_bf16(v0[0], v0[1]); w.y = cvt_pk_bf16(v0[2], v0[3]); w.z = cvt_pk_bf16(v1[0], v1[1]); w.w = cvt_pk_bf16(v1[2], v1[3]);
                        *(u32x4*)(rowp + bj * HALF) = w; } }
        } else { const int col0 = (u.pn - 16) * BM + wc * 32 + 8 * fq;
            constexpr float NL2E = -1.4426950408889634f;
#pragma unroll
            for (int ai = 0; ai < 2; ++ai)
#pragma unroll
                for (int m = 0; m < 4; ++m) { bf16_t* rowp = Z2 + (size_t)(row0 + ai * HALF + m * 16) * Z2W + col0;
#pragma unroll
                    for (int bj = 0; bj < 2; ++bj) { const f32x4 v0 = acc[ai][bj][m][0], v1 = acc[ai][bj][m][1];
                        float t0 = __builtin_amdgcn_fmed3f(v0[0], -30.f, 30.f) * NL2E, t1 = __builtin_amdgcn_fmed3f(v0[1], -30.f, 30.f) * NL2E, t2 = __builtin_amdgcn_fmed3f(v0[2], -30.f, 30.f) * NL2E, t3 = __builtin_amdgcn_fmed3f(v0[3], -30.f, 30.f) * NL2E;
                        float t4 = __builtin_amdgcn_fmed3f(v1[0], -30.f, 30.f) * NL2E, t5 = __builtin_amdgcn_fmed3f(v1[1], -30.f, 30.f) * NL2E, t6 = __builtin_amdgcn_fmed3f(v1[2], -30.f, 30.f) * NL2E, t7 = __builtin_amdgcn_fmed3f(v1[3], -30.f, 30.f) * NL2E;
                        TRANS8("v_exp_f32", t);
                        u32x4 w; w.x = cvt_pk_bf16(t0 + 1.0f, t1 + 1.0f); w.y = cvt_pk_bf16(t2 + 1.0f, t3 + 1.0f); w.z = cvt_pk_bf16(t4 + 1.0f, t5 + 1.0f); w.w = cvt_pk_bf16(t6 + 1.0f, t7 + 1.0f);
                        *(u32x4*)(rowp + bj * HALF) = w; } }
        }
    }
};
struct EpiProjF { static constexpr bool PERM = true, HOOK = true; static constexpr int H1 = 16, H2 = 24;
    bf16_t* MRG; const bf16_t* Z2;
    __device__ __forceinline__ void khook(f32x4 (&acc)[2][2][4][2], const Unit& u, int t, int wr, int wc, int fr_, int fq_) const {
        int fr = fr_, fq = fq_; asm volatile("" : "+v"(fr), "+v"(fq));
        const int row0 = u.pm * BM + wr * 64 + fr, col0 = u.pn * BM + wc * 32 + 8 * fq; const int onum = (t == H1) ? Z2_MB : Z2_MC, oden = (t == H1) ? Z2_MA : Z2_MB;
#pragma unroll
        for (int ai = 0; ai < 2; ++ai) { u32x4 wn[4][2], wd[4][2];
#pragma unroll
            for (int m = 0; m < 4; ++m) { const bf16_t* rp = Z2 + (size_t)(row0 + ai * HALF + m * 16) * Z2W + col0;
#pragma unroll
                for (int bj = 0; bj < 2; ++bj) { wn[m][bj] = *(const u32x4*)(rp + onum + bj * HALF); wd[m][bj] = *(const u32x4*)(rp + oden + bj * HALF); } }
#pragma unroll
            for (int m = 0; m < 4; ++m)
#pragma unroll
                for (int bj = 0; bj < 2; ++bj) { const u32x4 a = wn[m][bj], b = wd[m][bj]; f32x4 r0, r1;
                    r0[0] = bflo(a.x) * __builtin_amdgcn_rcpf(bflo(b.x)); r0[1] = bfhi(a.x) * __builtin_amdgcn_rcpf(bfhi(b.x)); r0[2] = bflo(a.y) * __builtin_amdgcn_rcpf(bflo(b.y)); r0[3] = bfhi(a.y) * __builtin_amdgcn_rcpf(bfhi(b.y));
                    r1[0] = bflo(a.z) * __builtin_amdgcn_rcpf(bflo(b.z)); r1[1] = bfhi(a.z) * __builtin_amdgcn_rcpf(bfhi(b.z)); r1[2] = bflo(a.w) * __builtin_amdgcn_rcpf(bflo(b.w)); r1[3] = bfhi(a.w) * __builtin_amdgcn_rcpf(bfhi(b.w));
                    acc[ai][bj][m][0] = acc[ai][bj][m][0] * r0; acc[ai][bj][m][1] = acc[ai][bj][m][1] * r1; }
            asm volatile("" ::: "memory"); }
    }
    __device__ __forceinline__ void operator()(const f32x4 (&acc)[2][2][4][2], const Unit& u, int wr, int wc, int fr, int fq) const {
        const int row0 = u.pm * BM + wr * 64 + fr, col0 = u.pn * BM + wc * 32 + 8 * fq;
#pragma unroll
        for (int ai = 0; ai < 2; ++ai) { u32x4 wc_[4][2];
#pragma unroll
            for (int m = 0; m < 4; ++m)
#pragma unroll
                for (int bj = 0; bj < 2; ++bj) wc_[m][bj] = *(const u32x4*)(Z2 + (size_t)(row0 + ai * HALF + m * 16) * Z2W + Z2_MC + col0 + bj * HALF);
#pragma unroll
            for (int m = 0; m < 4; ++m)
#pragma unroll
                for (int bj = 0; bj < 2; ++bj) { const u32x4 c = wc_[m][bj]; const f32x4 v0 = acc[ai][bj][m][0], v1 = acc[ai][bj][m][1]; u32x4 w;
                    w.x = cvt_pk_bf16(v0[0] * __builtin_amdgcn_rcpf(bflo(c.x)), v0[1] * __builtin_amdgcn_rcpf(bfhi(c.x))); w.y = cvt_pk_bf16(v0[2] * __builtin_amdgcn_rcpf(bflo(c.y)), v0[3] * __builtin_amdgcn_rcpf(bfhi(c.y)));
                    w.z = cvt_pk_bf16(v1[0] * __builtin_amdgcn_rcpf(bflo(c.z)), v1[1] * __builtin_amdgcn_rcpf(bfhi(c.z))); w.w = cvt_pk_bf16(v1[2] * __builtin_amdgcn_rcpf(bflo(c.w)), v1[3] * __builtin_amdgcn_rcpf(bfhi(c.w)));
                    *(u32x4*)(MRG + (size_t)(row0 + ai * HALF + m * 16) * D + col0 + bj * HALF) = w; }
            asm volatile("" ::: "memory"); }
    }
};
}

struct CvItem { const float* W; bf16* dst; int ldw, k0, n0, ldk, drow0, dk0; };
__device__ __forceinline__ void transpose_load(const CvItem& I, float (&wv)[32], int lane) {
#pragma unroll
    for (int i = 0; i < 32; ++i) wv[i] = __builtin_nontemporal_load(I.W + (size_t)(I.k0 + 2 * i + (lane >> 5)) * I.ldw + I.n0 + (lane & 31));
}
__device__ __forceinline__ void transpose_store(const CvItem& I, const float (&wv)[32], LAS float* scr, int lane) {
#pragma unroll
    for (int i = 0; i < 32; ++i) scr[(2 * i + (lane >> 5)) * 33 + (lane & 31)] = wv[i];
    LDS_WAIT(); asm volatile("" ::: "memory");
    const int c = lane & 7;
#pragma unroll
    for (int j = 0; j < 4; ++j) { const int n = (lane >> 3) + 8 * j; const LAS float* s = scr + (8 * c) * 33 + n;
        v4u o; o.x = pk2(s[0 * 33], s[1 * 33]); o.y = pk2(s[2 * 33], s[3 * 33]); o.z = pk2(s[4 * 33], s[5 * 33]); o.w = pk2(s[6 * 33], s[7 * 33]);
        __builtin_nontemporal_store(o, (GAS v4u*)(I.dst + (size_t)(I.drow0 + n) * I.ldk + I.dk0 + I.k0 + 8 * c)); }
    LDS_WAIT(); asm volatile("" ::: "memory");
}

enum { IX = 0, IC, ICTX, ICCTX, IWMOD, IBMOD, INORMG, IFINALG, IWGATE, IWUP, IWDOWN, IWIN, ILB, IANORM, ILNG, ILNB, IWS, IBS, ICONV, IWPA, IWPB, IWPC, IWOUT };
#define INP(k) (kargs()->in[(k)])

constexpr int CV_I_FF = (D / 64) * (DFF / 32);
constexpr int CV_I_IN = (D / 64) * (INW / 32);
constexpr int CV_I_PA = (1024 / 64) * (D / 32), CV_I_PB = (512 / 64) * (D / 32);
constexpr int CV_I_WO = (D / 64) * (D / 32);
constexpr int CV_PER_L = 6 * CV_I_FF + CV_I_IN + CV_I_PA + 2 * CV_I_PB + CV_I_WO;
__device__ __forceinline__ CvItem cv_decode(int l, int r) {
    unsigned char* ws = kargs()->ws; CvItem I;
    if (r < 6 * CV_I_FF) { const int j = r / (3 * CV_I_FF); r %= 3 * CV_I_FF; const int which = r / CV_I_FF; r %= CV_I_FF; const size_t lj = (size_t)(l * 2 + j);
        if (which < 2) { const int nblk = DFF / 32, kb = r / nblk, nb = r % nblk, n0 = 32 * nb;
            I.W = (which == 0 ? INP(IWGATE) : INP(IWUP)) + lj * D * DFF; I.ldw = DFF; I.k0 = 64 * kb; I.n0 = n0; I.dst = (bf16*)(ws + WS_WGU) + lj * (size_t)(2 * DFF) * D; I.ldk = D; I.drow0 = 256 * (n0 >> 7) + (n0 & 127) + 128 * which; I.dk0 = 0;
        } else { const int nblk = D / 32, kb = r / nblk, nb = r % nblk;
            I.W = INP(IWDOWN) + lj * DFF * D; I.ldw = D; I.k0 = 64 * kb; I.n0 = 32 * nb; I.dst = (bf16*)(ws + WS_WD) + lj * (size_t)D * DFF; I.ldk = DFF; I.drow0 = 32 * nb; I.dk0 = 0; }
        return I; }
    r -= 6 * CV_I_FF;
    if (r < CV_I_IN) { const int nblk = INW / 32, kb = r / nblk, nb = r % nblk; I.W = INP(IWIN) + (size_t)l * D * INW; I.ldw = INW; I.k0 = 64 * kb; I.n0 = 32 * nb; I.dst = (bf16*)(ws + WS_WIN) + (size_t)l * INW * D; I.ldk = D; I.drow0 = 32 * nb; I.dk0 = 0; return I; }
    r -= CV_I_IN;
    bf16* WP = (bf16*)(ws + WS_WP) + (size_t)l * D * 2048; const int nblk = D / 32;
    if (r < CV_I_PA) { const int kb = r / nblk, nb = r % nblk; I.W = INP(IWPA) + (size_t)l * 1024 * D; I.ldw = D; I.k0 = 64 * kb; I.n0 = 32 * nb; I.dst = WP; I.ldk = 2048; I.drow0 = 32 * nb; I.dk0 = 0; return I; }
    r -= CV_I_PA;
    if (r < CV_I_PB) { const int kb = r / nblk, nb = r % nblk; I.W = INP(IWPB) + (size_t)l * 512 * D; I.ldw = D; I.k0 = 64 * kb; I.n0 = 32 * nb; I.dst = WP; I.ldk = 2048; I.drow0 = 32 * nb; I.dk0 = 1024; return I; }
    r -= CV_I_PB;
    if (r < CV_I_PB) { const int kb = r / nblk, nb = r % nblk; I.W = INP(IWPC) + (size_t)l * 512 * D; I.ldw = D; I.k0 = 64 * kb; I.n0 = 32 * nb; I.dst = WP; I.ldk = 2048; I.drow0 = 32 * nb; I.dk0 = 1536; return I; }
    r -= CV_I_PB;
    { const int kb = r / nblk, nb = r % nblk; I.W = INP(IWOUT) + (size_t)l * D * D; I.ldw = D; I.k0 = 64 * kb; I.n0 = 32 * nb; I.dst = (bf16*)(ws + WS_WO) + (size_t)l * D * D; I.ldk = D; I.drow0 = 32 * nb; I.dk0 = 0; }
    return I;
}
__device__ __forceinline__ void convert_run(int l, int first, int end, int stride, LAS float* scr, int lane) {
#pragma unroll 1
    for (int it = first; it < end; it += 2 * stride) { const bool two = it + stride < end;
        const CvItem A = cv_decode(l, it), B = cv_decode(l, two ? it + stride : it);
        float wa[32], wb[32];
        transpose_load(A, wa, lane); if (two) transpose_load(B, wb, lane);
        transpose_store(A, wa, scr, lane); if (two) transpose_store(B, wb, scr, lane); }
}
constexpr int CV_Q_GU = 64, CV_Q_IN = 64, CV_Q_PJ = 96;
__device__ __forceinline__ int cv_nidle(int nwg, int G) { const int rem = nwg % G; return rem ? G - rem : 0; }
__device__ __forceinline__ int cv_base(int slot, int G) {
    const int n_gu = cv_nidle((M / 256) * (2 * DFF / 256), G), n_in = cv_nidle(64 * 54 + 4 * 54, G), n_pj = cv_nidle((M / 256) * (D / 256), G);
    int b = 0; if (slot > 0) b += n_gu * CV_Q_GU; if (slot > 1) b += n_in * CV_Q_IN; if (slot > 2) b += n_pj * CV_Q_PJ; if (slot > 3) b += n_gu * CV_Q_GU; return b < CV_PER_L ? b : CV_PER_L;
}
__device__ __forceinline__ void convert_slot(int l, int slot, int nwg, int q) {
    int G = gridDim.x, c = blockIdx.x; asm volatile("" : "+s"(G), "+s"(c));
    const int rem = nwg % G; if (rem == 0 || c < rem) return;
    const Frame F = mkframe(); LAS float* scr = (LAS float*)(F.lds + F.wave * 16384);
    const int first = cv_base(slot, G) + (c - rem) * q; int end = first + q; if (end > CV_PER_L) end = CV_PER_L;
    convert_run(l, first + F.wave, end, 8, scr, F.lane);
}
__device__ __forceinline__ void convert_rest(int l) {
    const Frame F = mkframe(); LAS float* scr = (LAS float*)(F.lds + F.wave * 16384);
    const int gw = F.vcu * 8 + F.wave, NGW = F.G * 8;
    convert_run(l, cv_base(4, F.G) + gw, CV_PER_L, NGW, scr, F.lane);
}

__device__ __forceinline__ void phase_prologue() {
    const Frame F = mkframe(); unsigned char* ws = F.ws;
    const int gw = F.vcu * 8 + F.wave, NGW = F.G * 8;
    { ytype* Y = (ytype*)(ws + WS_Y);
      for (int m = gw; m < M; m += NGW) { const float* src = m < M_LAT ? INP(IX) + (size_t)m * D : INP(ICTX) + (size_t)(m - M_LAT) * D; const GAS f32x4* s = (const GAS f32x4*)src + F.lane;
#pragma unroll
          for (int j = 0; j < 8; ++j) y_st4(Y + (size_t)m * D + 4 * (64 * j + F.lane), s[64 * j]); } }
    if (blockIdx.x == 0) { float* LB = (float*)(ws + WS_LB);
        for (int i = F.tid; i < 2 * WK; i += 512) { float lg[DEPTH], mx = -1e30f;
#pragma unroll
            for (int l = 0; l < DEPTH; ++l) { lg[l] = INP(ILB)[l * 2 * WK + i]; mx = fmaxf(mx, lg[l]); }
            float s = 0.f;
#pragma unroll
            for (int l = 0; l < DEPTH; ++l) { lg[l] = __expf(lg[l] - mx); s += lg[l]; }
            float cum = 0.f; const float inv = 1.0f / s;
#pragma unroll
            for (int l = 0; l < DEPTH; ++l) { LB[l * 2 * WK + i] = cum; if (l + 1 < DEPTH) cum += lg[l + 1] * inv; } } }
    { LAS float* sc = (LAS float*)F.lds;
      LAS float* red = (LAS float*)(F.lds + 5 * D * 4);
      for (int i = F.tid; i < NGRP * D; i += 512) { const int g = i / D, k = i % D; const float v = g < 4 ? INP(IC)[g * D + k] : INP(ICCTX)[k]; sc[i] = siluf_(v); }
      __syncthreads();
      float* MOD = (float*)(ws + WS_MOD);
      constexpr int NU = DEPTH * (MODW / 128);
      for (int u = F.vcu; u < NU; u += F.G) { const int l = u / (MODW / 128), n0 = (u % (MODW / 128)) * 128;
          const float* Wp = INP(IWMOD) + (size_t)l * D * MODW + n0 + 2 * F.lane;
          float a0[NGRP], a1[NGRP];
#pragma unroll
          for (int g = 0; g < NGRP; ++g) { a0[g] = 0.f; a1[g] = 0.f; }
          const int kb = F.wave * 256;
#pragma unroll 16
          for (int k = kb; k < kb + 256; ++k) { typedef float f32x2v __attribute__((ext_vector_type(2))); const f32x2v w = __builtin_nontemporal_load((const GAS f32x2v*)(Wp + (size_t)k * MODW));
#pragma unroll
              for (int g = 0; g < NGRP; ++g) { const float s = sc[g * D + k]; a0[g] += s * w.x; a1[g] += s * w.y; } }
#pragma unroll
          for (int g = 0; g < NGRP; ++g) { red[(F.wave * NGRP + g) * 128 + 2 * F.lane] = a0[g]; red[(F.wave * NGRP + g) * 128 + 2 * F.lane + 1] = a1[g]; }
          __syncthreads();
          for (int i = F.tid; i < NGRP * 128; i += 512) { const int g = i / 128, n = i % 128; float s = 0.f;
#pragma unroll
              for (int w = 0; w < 8; ++w) s += red[(w * NGRP + g) * 128 + n];
              MOD[((size_t)l * NGRP + g) * MODW + n0 + n] = s + INP(IBMOD)[l * MODW + n0 + n]; }
          __syncthreads(); }
    }
    __syncthreads();
    { LAS float* scr = (LAS float*)(F.lds + F.wave * 16384);
      convert_run(0, gw, CV_PER_L, NGW, scr, F.lane); }
}

__device__ __forceinline__ float wave_sum_fast(float x) {
    x = row16_sum(x);
    const float a = __builtin_bit_cast(float, __builtin_amdgcn_readlane(__builtin_bit_cast(int, x), 0)), b = __builtin_bit_cast(float, __builtin_amdgcn_readlane(__builtin_bit_cast(int, x), 16));
    const float c = __builtin_bit_cast(float, __builtin_amdgcn_readlane(__builtin_bit_cast(int, x), 32)), d = __builtin_bit_cast(float, __builtin_amdgcn_readlane(__builtin_bit_cast(int, x), 48));
    return (a + b) + (c + d);
}
__device__ __forceinline__ void phase_norm(int l, int which, int mlim, int red, int rgate_l, int rgate_idx, float rcoef) {
    const Frame F = mkframe(); ytype* Y = (ytype*)(F.ws + WS_Y); bf16* H = (bf16*)(F.ws + WS_H);
    const float* g = INP(INORMG) + (size_t)(l * 3 + which) * D; const float* mod_l = (const float*)(F.ws + WS_MOD) + (size_t)l * NGRP * MODW; const int shift_idx = 3 * which;
    const int gw = F.vcu * 8 + F.wave, NGW = F.G * 8, lane = F.lane;
    typedef pg8::eh16x8 h8; typedef pg8::ef32x8 f8;
    f32x4 gs[4][2], sh[4][2];
    auto load_vecs = [&](int grp) { const float* mp = mod_l + (size_t)grp * MODW + shift_idx * D;
#pragma unroll
        for (int j = 0; j < 4; ++j)
#pragma unroll
            for (int e = 0; e < 2; ++e) { const int c = 8 * lane + 512 * j + 4 * e; gs[j][e] = *(const GAS f32x4*)(g + c) * (1.0f + *(const GAS f32x4*)(mp + D + c)); sh[j][e] = *(const GAS f32x4*)(mp + c); } };
    auto finish_row = [&](int m, f8 (&v)[4]) { float ss = 0.f;
#pragma unroll
        for (int j = 0; j < 4; ++j)
#pragma unroll
            for (int e = 0; e < 8; ++e) ss += v[j][e] * v[j][e];
        const float rstd = 1.0f / sqrtf(wave_sum_fast(ss) * (1.0f / D) + EPS);
#pragma unroll
        for (int j = 0; j < 4; ++j) { v4u o; const f32x4 a = (f32x4){v[j][0], v[j][1], v[j][2], v[j][3]} * rstd * gs[j][0] + sh[j][0], b = (f32x4){v[j][4], v[j][5], v[j][6], v[j][7]} * rstd * gs[j][1] + sh[j][1];
            o.x = pk2(a[0], a[1]); o.y = pk2(a[2], a[3]); o.z = pk2(b[0], b[1]); o.w = pk2(b[2], b[3]); *(GAS v4u*)(H + (size_t)m * D + 8 * lane + 512 * j) = o; } };
    if (NGW * 8 == M_LAT) {
        load_vecs(gw >> 9);
        h8 cur[4], nxt[4];
#pragma unroll
        for (int j = 0; j < 4; ++j) cur[j] = *(const GAS h8*)(Y + (size_t)(8 * gw) * D + 8 * lane + 512 * j);
#pragma unroll 1
        for (int r = 0; r < 8; ++r) { const int m = 8 * gw + r, mn = r < 7 ? m + 1 : m;
#pragma unroll
            for (int j = 0; j < 4; ++j) nxt[j] = *(const GAS h8*)(Y + (size_t)mn * D + 8 * lane + 512 * j);
            f8 v[4];
#pragma unroll
            for (int j = 0; j < 4; ++j) v[j] = __builtin_convertvector(cur[j], f8);
            finish_row(m, v);
#pragma unroll
            for (int j = 0; j < 4; ++j) cur[j] = nxt[j]; }
    } else {
        for (int m = gw; m < M_LAT; m += NGW) { load_vecs(m >> 12); f8 v[4];
#pragma unroll
            for (int j = 0; j < 4; ++j) v[j] = __builtin_convertvector(*(const GAS h8*)(Y + (size_t)m * D + 8 * lane + 512 * j), f8);
            finish_row(m, v); } }
    if (mlim > M_LAT) {
        load_vecs(4);
        for (int m = M_LAT + (gw >> 1) + ((gw & 1) ? (NGW >> 1) : 0); m < mlim; m += NGW) { f8 v[4];
#pragma unroll
            for (int j = 0; j < 4; ++j) v[j] = __builtin_convertvector(*(const GAS h8*)(Y + (size_t)m * D + 8 * lane + 512 * j), f8);
            if (red) { const _Float16* sl = (const _Float16*)(F.ws + WS_MF32) + (size_t)(m - M_LAT) * D; const float* rg = (const float*)(F.ws + WS_MOD) + ((size_t)rgate_l * NGRP + 4) * MODW + rgate_idx * D;
#pragma unroll
                for (int jh = 0; jh < 2; ++jh) { h8 part[2][8];
#pragma unroll
                    for (int jj = 0; jj < 2; ++jj)
#pragma unroll
                        for (int p = 0; p < 8; ++p) part[jj][p] = *(const GAS h8*)(sl + (size_t)p * M_CTX * D + 8 * lane + 512 * (2 * jh + jj));
#pragma unroll
                    for (int jj = 0; jj < 2; ++jj) { const int j = 2 * jh + jj, c = 8 * lane + 512 * j; f8 a = __builtin_convertvector(part[jj][0], f8);
#pragma unroll
                        for (int p = 1; p < 8; ++p) a = a + __builtin_convertvector(part[jj][p], f8);
                        const f32x4 g0 = *(const GAS f32x4*)(rg + c) * rcoef, g1 = *(const GAS f32x4*)(rg + c + 4) * rcoef;
#pragma unroll
                        for (int e = 0; e < 4; ++e) { v[j][e] += g0[e] * a[e]; v[j][4 + e] += g1[e] * a[4 + e]; }
                        *(GAS h8*)(Y + (size_t)m * D + c) = __builtin_convertvector(v[j], h8); }
                    asm volatile("" ::: "memory"); } }
            finish_row(m, v); } }
}

__device__ __forceinline__ void phase_final() {
    const Frame F = mkframe(); const ytype* Y = (const ytype*)(F.ws + WS_Y); float* out = kargs()->out; const float* g = INP(IFINALG);
    const int gw = F.vcu * 8 + F.wave, NGW = F.G * 8, lane = F.lane;
    typedef pg8::eh16x8 h8; typedef pg8::ef32x8 f8;
    f32x4 gs[4][2];
#pragma unroll
    for (int j = 0; j < 4; ++j)
#pragma unroll
        for (int e = 0; e < 2; ++e) gs[j][e] = *(const GAS f32x4*)(g + 8 * lane + 512 * j + 4 * e);
    const int per = (M_LAT + NGW - 1) / NGW, m0 = gw * per, m1 = (m0 + per < M_LAT) ? m0 + per : M_LAT;
    if (m0 >= m1) return;
    h8 cur[4], nxt[4];
#pragma unroll
    for (int j = 0; j < 4; ++j) cur[j] = *(const GAS h8*)(Y + (size_t)m0 * D + 8 * lane + 512 * j);
#pragma unroll 1
    for (int m = m0; m < m1; ++m) { const int mn = m + 1 < m1 ? m + 1 : m;
#pragma unroll
        for (int j = 0; j < 4; ++j) nxt[j] = *(const GAS h8*)(Y + (size_t)mn * D + 8 * lane + 512 * j);
        f8 v[4]; float ss = 0.f;
#pragma unroll
        for (int j = 0; j < 4; ++j) { v[j] = __builtin_convertvector(cur[j], f8);
#pragma unroll
            for (int e = 0; e < 8; ++e) ss += v[j][e] * v[j][e]; }
        const float rstd = 1.0f / sqrtf(wave_sum_fast(ss) * (1.0f / D) + EPS);
#pragma unroll
        for (int j = 0; j < 4; ++j) { float* o = out + (size_t)m * D + 8 * lane + 512 * j;
            *(GAS f32x4*)o = (f32x4){v[j][0], v[j][1], v[j][2], v[j][3]} * rstd * gs[j][0]; *(GAS f32x4*)(o + 4) = (f32x4){v[j][4], v[j][5], v[j][6], v[j][7]} * rstd * gs[j][1]; }
#pragma unroll
        for (int j = 0; j < 4; ++j) cur[j] = nxt[j]; }
}

struct ElemC { float lg[8], lbv[8], cw0[8], cw1[8], cw2[8]; };
__device__ __forceinline__ void elem_vn(const v4u raw, const ElemC& C, bf16* VN, int m, int lane) {
    float x[8];
    x[0] = gelu_tanh(bflo(raw.x)); x[1] = gelu_tanh(bfhi(raw.x)); x[2] = gelu_tanh(bflo(raw.y)); x[3] = gelu_tanh(bfhi(raw.y));
    x[4] = gelu_tanh(bflo(raw.z)); x[5] = gelu_tanh(bfhi(raw.z)); x[6] = gelu_tanh(bflo(raw.w)); x[7] = gelu_tanh(bfhi(raw.w));
    float s = 0.f;
#pragma unroll
    for (int e = 0; e < 8; ++e) s += x[e];
    const float mean = wave_sum_fast(s) * (1.0f / BW); float q = 0.f;
#pragma unroll
    for (int e = 0; e < 8; ++e) { x[e] -= mean; q += x[e] * x[e]; }
    const float rstd = 1.0f / sqrtf(wave_sum_fast(q) * (1.0f / BW) + EPS); float y[8];
#pragma unroll
    for (int e = 0; e < 8; ++e) y[e] = x[e] * rstd * C.lg[e] + C.lbv[e];
    v4u o; o.x = pk2(y[0], y[1]); o.y = pk2(y[2], y[3]); o.z = pk2(y[4], y[5]); o.w = pk2(y[6], y[7]);
    *(GAS v4u*)(VN + (size_t)m * BW + 8 * lane) = o;
}
__device__ __forceinline__ void elem_t(const v4u hc, const v4u gc, float zz, float (&t)[8]) {
    t[0] = zz * bflo(hc.x) * bflo(gc.x); t[1] = zz * bfhi(hc.x) * bfhi(gc.x); t[2] = zz * bflo(hc.y) * bflo(gc.y); t[3] = zz * bfhi(hc.y) * bfhi(gc.y);
    t[4] = zz * bflo(hc.z) * bflo(gc.z); t[5] = zz * bfhi(hc.z) * bfhi(gc.z); t[6] = zz * bflo(hc.w) * bflo(gc.w); t[7] = zz * bfhi(hc.w) * bfhi(gc.w);
}
__device__ __forceinline__ void elem_conv(const float (&t0)[8], const float (&t1)[8], const float (&t2)[8], const v4u gbr, const ElemC& C, bf16* YABC, int m, int lane) {
    float gb[8], y[8];
    gb[0] = bflo(gbr.x); gb[1] = bfhi(gbr.x); gb[2] = bflo(gbr.y); gb[3] = bfhi(gbr.y); gb[4] = bflo(gbr.z); gb[5] = bfhi(gbr.z); gb[6] = bflo(gbr.w); gb[7] = bfhi(gbr.w);
#pragma unroll
    for (int e = 0; e < 8; ++e) y[e] = gb[e] * (C.cw0[e] * t0[e] + C.cw1[e] * t1[e] + C.cw2[e] * t2[e]);
    v4u o; o.x = pk2(y[0], y[1]); o.y = pk2(y[2], y[3]); o.z = pk2(y[4], y[5]); o.w = pk2(y[6], y[7]);
    *(GAS v4u*)(YABC + (size_t)m * 2048 + 1536 + 8 * lane) = o;
}
__device__ __forceinline__ void elem_row(const bf16* Z2, const ElemC& C, bf16* VN, bf16* YABC, int m, int lane) {
    bool hp, hn; if (m < M_LAT) { const int p = m & 63; hp = p != 0; hn = p != 63; } else { const int p = (m - M_LAT) & 255; hp = p != 0; hn = p != 255; }
    const size_t mp = (size_t)(hp ? m - 1 : m), mn = (size_t)(hn ? m + 1 : m);
    const v4u raw = *(const GAS v4u*)(Z2 + (size_t)m * Z2W + Z2_V + 8 * lane);
    const v4u hc0 = *(const GAS v4u*)(Z2 + mp * Z2W + Z2_HC + 8 * lane), gc0 = *(const GAS v4u*)(Z2 + mp * Z2W + Z2_GC + 8 * lane);
    const v4u hc1 = *(const GAS v4u*)(Z2 + (size_t)m * Z2W + Z2_HC + 8 * lane), gc1 = *(const GAS v4u*)(Z2 + (size_t)m * Z2W + Z2_GC + 8 * lane);
    const v4u hc2 = *(const GAS v4u*)(Z2 + mn * Z2W + Z2_HC + 8 * lane), gc2 = *(const GAS v4u*)(Z2 + mn * Z2W + Z2_GC + 8 * lane);
    const v4u gbr = *(const GAS v4u*)(Z2 + (size_t)m * Z2W + Z2_GB + 8 * lane);
    elem_vn(raw, C, VN, m, lane);
    float t0[8], t1[8], t2[8]; elem_t(hc0, gc0, hp ? 1.0f : 0.0f, t0); elem_t(hc1, gc1, 1.0f, t1); elem_t(hc2, gc2, hn ? 1.0f : 0.0f, t2);
    elem_conv(t0, t1, t2, gbr, C, YABC, m, lane);
}
__device__ __forceinline__ void phase_mix_elem(int l) {
    const Frame F = mkframe(); unsigned char* ws = F.ws;
    const bf16* Z2 = (const bf16*)(ws + WS_Z2);
    bf16* VN = (bf16*)(ws + WS_VN); bf16* YABC = (bf16*)(ws + WS_YABC);
    const int gw = F.vcu * 8 + F.wave, NGW = F.G * 8, lane = F.lane;
    ElemC C;
    { const float* gp = INP(ILNG) + l * BW + 8 * lane; const float* bp = INP(ILNB) + l * BW + 8 * lane; const float* cw = INP(ICONV) + (size_t)l * 3 * CWD + 8 * lane;
#pragma unroll
      for (int e = 0; e < 8; ++e) { C.lg[e] = gp[e]; C.lbv[e] = bp[e]; C.cw0[e] = cw[e]; C.cw1[e] = cw[CWD + e]; C.cw2[e] = cw[2 * CWD + e]; } }
    if (NGW * 8 == M_LAT) {
#pragma unroll 1
        for (int h = 0; h < 4; ++h) { const int r0 = 8 * gw + 2 * h; const bool vp = (r0 & 63) != 0, vn = ((r0 + 1) & 63) != 63;
            v4u hc[4], gc[4], vv[2], gb[2];
#pragma unroll
            for (int i = 0; i < 4; ++i) { const int row = (i == 0 && !vp) ? r0 : (i == 3 && !vn) ? r0 + 1 : r0 - 1 + i;
                hc[i] = *(const GAS v4u*)(Z2 + (size_t)row * Z2W + Z2_HC + 8 * lane); gc[i] = *(const GAS v4u*)(Z2 + (size_t)row * Z2W + Z2_GC + 8 * lane); }
#pragma unroll
            for (int i = 0; i < 2; ++i) { vv[i] = *(const GAS v4u*)(Z2 + (size_t)(r0 + i) * Z2W + Z2_V + 8 * lane); gb[i] = *(const GAS v4u*)(Z2 + (size_t)(r0 + i) * Z2W + Z2_GB + 8 * lane); }
            float t[4][8];
#pragma unroll
            for (int i = 0; i < 4; ++i) elem_t(hc[i], gc[i], (i == 0 && !vp) || (i == 3 && !vn) ? 0.0f : 1.0f, t[i]);
#pragma unroll
            for (int i = 0; i < 2; ++i) { elem_vn(vv[i], C, VN, r0 + i, lane); elem_conv(t[i], t[i + 1], t[i + 2], gb[i], C, YABC, r0 + i, lane); } }
    } else {
        for (int m = gw; m < M_LAT; m += NGW) elem_row(Z2, C, VN, YABC, m, lane); }
    for (int m = M_LAT + (gw >> 1) + ((gw & 1) ? (NGW >> 1) : 0); m < M; m += NGW) elem_row(Z2, C, VN, YABC, m, lane);
}

template <int N> __device__ __forceinline__ float row_shl1(float v) { return __builtin_bit_cast(float, __builtin_amdgcn_update_dpp(0x3f800000, __builtin_bit_cast(int, v), 0x100 + N, 0xf, 0xf, false)); }
template <int N> __device__ __forceinline__ float row_shr1(float v) { return __builtin_bit_cast(float, __builtin_amdgcn_update_dpp(0x3f800000, __builtin_bit_cast(int, v), 0x110 + N, 0xf, 0xf, false)); }
template <int N> __device__ __forceinline__ float row_shr(float v) { return __builtin_bit_cast(float, __builtin_amdgcn_update_dpp(0, __builtin_bit_cast(int, v), 0x110 + N, 0xf, 0xf, true)); }
__device__ __forceinline__ float row16_prod(float x) { x *= dppf<0xB1>(x); x *= dppf<0x4E>(x); x *= dppf<0x124>(x); x *= dppf<0x128>(x); return x; }
__device__ __forceinline__ void phase_hgrn_prep(int l) {
    const Frame F = mkframe(); unsigned char* ws = F.ws;
    const _Float16* ZF = (const _Float16*)(ws + WS_ZF); const bf16* QS = (const bf16*)(ws + WS_QS); const float* LB = (const float*)(ws + WS_LB) + (size_t)l * 2 * WK;
    const int gw = F.vcu * 8 + F.wave, NGW = F.G * 8, lane = F.lane, fr = lane & 15, cq = lane >> 4;
    constexpr int NIT = (M / 32) * 32;
    const int per = (NIT + NGW - 1) / NGW, it0 = gw * per, it1 = (it0 + per < NIT) ? it0 + per : NIT;
#pragma unroll 2
    for (int it = it0; it < it1; ++it) { const int sc = it >> 5, jj = it & 31; const size_t rlo = (size_t)sc * 32 + fr, rhi = rlo + 16; const int c0 = 32 * jj + 8 * cq;
        const v4u qlo_r = *(const GAS v4u*)(QS + rlo * WK + c0), qhi_r = *(const GAS v4u*)(QS + rhi * WK + c0);
        const float qlo[8] = {bflo(qlo_r.x), bfhi(qlo_r.x), bflo(qlo_r.y), bfhi(qlo_r.y), bflo(qlo_r.z), bfhi(qlo_r.z), bflo(qlo_r.w), bfhi(qlo_r.w)};
        const float qhi[8] = {bflo(qhi_r.x), bfhi(qhi_r.x), bflo(qhi_r.y), bfhi(qhi_r.y), bflo(qhi_r.z), bfhi(qhi_r.z), bflo(qhi_r.w), bfhi(qhi_r.w)};
#pragma unroll
        for (int dir = 0; dir < 2; ++dir) {
            const pg8::ef32x8 zlo = __builtin_convertvector(*(const GAS pg8::eh16x8*)(ZF + rlo * 2048 + dir * WK + c0), pg8::ef32x8), zhi = __builtin_convertvector(*(const GAS pg8::eh16x8*)(ZF + rhi * 2048 + dir * WK + c0), pg8::ef32x8);
            const f32x4 b0 = *(const GAS f32x4*)(LB + dir * WK + c0), b1 = *(const GAS f32x4*)(LB + dir * WK + c0 + 4);
            float qtl[8], qth[8], ktl[8], kth[8], gt[8];
            float fl0, fl1, fl2, fl3, fl4, fl5, fl6, fl7, fh0, fh1, fh2, fh3, fh4, fh5, fh6, fh7;
#define HP_F(e_, dl, dh) { const float lb = (e_) < 4 ? b0[(e_) & 3] : b1[(e_) & 3]; const float oml = 1.0f - lb; dl = fmaxf(__builtin_fmaf(oml, __builtin_amdgcn_rcpf(1.0f + __builtin_amdgcn_exp2f(zlo[e_])), lb), 1e-30f); dh = fmaxf(__builtin_fmaf(oml, __builtin_amdgcn_rcpf(1.0f + __builtin_amdgcn_exp2f(zhi[e_])), lb), 1e-30f); }
            HP_F(0, fl0, fh0) HP_F(1, fl1, fh1) HP_F(2, fl2, fh2) HP_F(3, fl3, fh3) HP_F(4, fl4, fh4) HP_F(5, fl5, fh5) HP_F(6, fl6, fh6) HP_F(7, fl7, fh7)
#undef HP_F
#define HP_STEP(ctrl) "v_mul_f32_dpp %0, %0, %0 " ctrl " row_mask:0xf bank_mask:0xf\n\tv_mul_f32_dpp %1, %1, %1 " ctrl " row_mask:0xf bank_mask:0xf\n\tv_mul_f32_dpp %2, %2, %2 " ctrl " row_mask:0xf bank_mask:0xf\n\t" \
                      "v_mul_f32_dpp %3, %3, %3 " ctrl " row_mask:0xf bank_mask:0xf\n\tv_mul_f32_dpp %4, %4, %4 " ctrl " row_mask:0xf bank_mask:0xf\n\tv_mul_f32_dpp %5, %5, %5 " ctrl " row_mask:0xf bank_mask:0xf\n\t" \
                      "v_mul_f32_dpp %6, %6, %6 " ctrl " row_mask:0xf bank_mask:0xf\n\tv_mul_f32_dpp %7, %7, %7 " ctrl " row_mask:0xf bank_mask:0xf\n\t"
#define HP_OPS8(a) "+v"(a##0), "+v"(a##1), "+v"(a##2), "+v"(a##3), "+v"(a##4), "+v"(a##5), "+v"(a##6), "+v"(a##7)
#define HP_PROD8(a) asm("s_nop 1\n\t" HP_STEP("quad_perm:[1,0,3,2]") HP_STEP("quad_perm:[2,3,0,1]") HP_STEP("row_ror:4") HP_STEP("row_ror:8") "s_nop 1" : HP_OPS8(a))
#define HP_SCANL8(a) asm("s_nop 1\n\t" HP_STEP("row_shl:1") HP_STEP("row_shl:2") HP_STEP("row_shl:4") HP_STEP("row_shl:8") "s_nop 1" : HP_OPS8(a))
#define HP_SCANR8(a) asm("s_nop 1\n\t" HP_STEP("row_shr:1") HP_STEP("row_shr:2") HP_STEP("row_shr:4") HP_STEP("row_shr:8") "s_nop 1" : HP_OPS8(a))
#define HP_FIN8(ctrl, X, p, m) asm("s_nop 1\n\t" \
                "v_mul_f32_dpp %0, %8, %16 " ctrl " row_mask:0xf bank_mask:0xf\n\tv_mul_f32_dpp %1, %9, %17 " ctrl " row_mask:0xf bank_mask:0xf\n\tv_mul_f32_dpp %2, %10, %18 " ctrl " row_mask:0xf bank_mask:0xf\n\t" \
                "v_mul_f32_dpp %3, %11, %19 " ctrl " row_mask:0xf bank_mask:0xf\n\tv_mul_f32_dpp %4, %12, %20 " ctrl " row_mask:0xf bank_mask:0xf\n\tv_mul_f32_dpp %5, %13, %21 " ctrl " row_mask:0xf bank_mask:0xf\n\t" \
                "v_mul_f32_dpp %6, %14, %22 " ctrl " row_mask:0xf bank_mask:0xf\n\tv_mul_f32_dpp %7, %15, %23 " ctrl " row_mask:0xf bank_mask:0xf\n\ts_nop 1" \
                : "+&v"(X##0), "+&v"(X##1), "+&v"(X##2), "+&v"(X##3), "+&v"(X##4), "+&v"(X##5), "+&v"(X##6), "+&v"(X##7) : "v"(p##0), "v"(p##1), "v"(p##2), "v"(p##3), "v"(p##4), "v"(p##5), "v"(p##6), "v"(p##7), "v"(m##0), "v"(m##1), "v"(m##2), "v"(m##3), "v"(m##4), "v"(m##5), "v"(m##6), "v"(m##7))
            float tl0 = fl0, tl1 = fl1, tl2 = fl2, tl3 = fl3, tl4 = fl4, tl5 = fl5, tl6 = fl6, tl7 = fl7, th0 = fh0, th1 = fh1, th2 = fh2, th3 = fh3, th4 = fh4, th5 = fh5, th6 = fh6, th7 = fh7;
            HP_PROD8(tl); HP_PROD8(th);
            float pl0 = fl0, pl1 = fl1, pl2 = fl2, pl3 = fl3, pl4 = fl4, pl5 = fl5, pl6 = fl6, pl7 = fl7, ph0 = fh0, ph1 = fh1, ph2 = fh2, ph3 = fh3, ph4 = fh4, ph5 = fh5, ph6 = fh6, ph7 = fh7;
            const float one0 = 1.0f, one1 = 1.0f, one2 = 1.0f, one3 = 1.0f, one4 = 1.0f, one5 = 1.0f, one6 = 1.0f, one7 = 1.0f;
            float Xl0, Xl1, Xl2, Xl3, Xl4, Xl5, Xl6, Xl7, Xh0, Xh1, Xh2, Xh3, Xh4, Xh5, Xh6, Xh7;
            if (dir == 0) { HP_SCANL8(pl); HP_SCANL8(ph);
                Xl0 = th0; Xl1 = th1; Xl2 = th2; Xl3 = th3; Xl4 = th4; Xl5 = th5; Xl6 = th6; Xl7 = th7; HP_FIN8("row_shl:1", Xl, pl, th);
                Xh0 = 1.0f; Xh1 = 1.0f; Xh2 = 1.0f; Xh3 = 1.0f; Xh4 = 1.0f; Xh5 = 1.0f; Xh6 = 1.0f; Xh7 = 1.0f; HP_FIN8("row_shl:1", Xh, ph, one); }
            else { HP_SCANR8(pl); HP_SCANR8(ph);
                Xl0 = 1.0f; Xl1 = 1.0f; Xl2 = 1.0f; Xl3 = 1.0f; Xl4 = 1.0f; Xl5 = 1.0f; Xl6 = 1.0f; Xl7 = 1.0f; HP_FIN8("row_shr:1", Xl, pl, one);
                Xh0 = tl0; Xh1 = tl1; Xh2 = tl2; Xh3 = tl3; Xh4 = tl4; Xh5 = tl5; Xh6 = tl6; Xh7 = tl7; HP_FIN8("row_shr:1", Xh, ph, tl); }
#define HP_OUT(e_) ktl[e_] = __builtin_fmaf(-fl##e_, Xl##e_, Xl##e_); kth[e_] = __builtin_fmaf(-fh##e_, Xh##e_, Xh##e_); qtl[e_] = qlo[e_] * __builtin_amdgcn_rcpf(fmaxf(Xl##e_, 1e-35f)); qth[e_] = qhi[e_] * __builtin_amdgcn_rcpf(fmaxf(Xh##e_, 1e-35f)); gt[e_] = tl##e_ * th##e_;
            HP_OUT(0) HP_OUT(1) HP_OUT(2) HP_OUT(3) HP_OUT(4) HP_OUT(5) HP_OUT(6) HP_OUT(7)
#undef HP_OUT
#undef HP_FIN8
#undef HP_SCANR8
#undef HP_SCANL8
#undef HP_PROD8
#undef HP_OPS8
#undef HP_STEP
            bf16* Qd = (bf16*)(ws + (dir ? WS_QB : WS_QF)); bf16* Kd = (bf16*)(ws + (dir ? WS_KB : WS_KF)); float* Gd = (float*)(ws + (dir ? WS_GB : WS_GF));
            v4u o; o.x = pk2(qtl[0], qtl[1]); o.y = pk2(qtl[2], qtl[3]); o.z = pk2(qtl[4], qtl[5]); o.w = pk2(qtl[6], qtl[7]); *(GAS v4u*)(Qd + rlo * WK + c0) = o;
            o.x = pk2(qth[0], qth[1]); o.y = pk2(qth[2], qth[3]); o.z = pk2(qth[4], qth[5]); o.w = pk2(qth[6], qth[7]); *(GAS v4u*)(Qd + rhi * WK + c0) = o;
            o.x = pk2(ktl[0], ktl[1]); o.y = pk2(ktl[2], ktl[3]); o.z = pk2(ktl[4], ktl[5]); o.w = pk2(ktl[6], ktl[7]); *(GAS v4u*)(Kd + rlo * WK + c0) = o;
            o.x = pk2(kth[0], kth[1]); o.y = pk2(kth[2], kth[3]); o.z = pk2(kth[4], kth[5]); o.w = pk2(kth[6], kth[7]); *(GAS v4u*)(Kd + rhi * WK + c0) = o;
            if (fr == 0) { *(GAS f32x4*)(Gd + (size_t)sc * WK + c0) = (f32x4){gt[0], gt[1], gt[2], gt[3]}; *(GAS f32x4*)(Gd + (size_t)sc * WK + c0 + 4) = (f32x4){gt[4], gt[5], gt[6], gt[7]}; }
        } }
}

typedef short s16x4 __attribute__((ext_vector_type(4)));
typedef short hb16x8 __attribute__((ext_vector_type(8)));
constexpr int HG_P = 272;
constexpr int HG_QI = 0, HG_KI = 32 * HG_P, HG_VI = 64 * HG_P, HG_GI = 96 * HG_P, HG_BUF = 96 * HG_P + 512 + 256;
constexpr int HG_NSTEP = (CTXL + SEQ) / 32, HG_NSEG = 4, HG_SEGLEN = HG_NSTEP / HG_NSEG, HG_NCTX = CTXL / 32;
static_assert(HG_SEGLEN * HG_NSEG == HG_NSTEP && HG_SEGLEN % 2 == 0, "segment loop below is unrolled by 2");
__device__ __forceinline__ int hg_row0(int s, int cstep, int cbase, int lbase2) { return cstep * s + (s < HG_NCTX ? cbase : lbase2); }
struct HgReg { v4u a, b, c, d; };
template <bool FULL> __device__ __forceinline__ void hg_gload(HgReg& R, int r0, const bf16* Qp, const bf16* Kp, const bf16* Vp, const float* Gp, int tid) {
    const int row = tid >> 4, ch = tid & 15; const size_t o = (size_t)(r0 + row) * WK + 8 * ch;
    if (FULL) R.a = *(const GAS v4u*)(Qp + o);
    R.b = *(const GAS v4u*)(Kp + o); R.c = *(const GAS v4u*)(Vp + o);
    R.d = *(const GAS v4u*)(Gp + (size_t)(r0 >> 5) * WK + 4 * (tid & 31));
}
template <bool FULL> __device__ __forceinline__ void hg_lwrite(const HgReg& R, LAS unsigned char* buf, int tid) {
    const int row = tid >> 4, ch = tid & 15;
    if (FULL) *(LAS v4u*)(buf + HG_QI + row * HG_P + 16 * ch) = R.a;
    *(LAS v4u*)(buf + HG_KI + row * HG_P + 16 * ch) = R.b; *(LAS v4u*)(buf + HG_VI + row * HG_P + 16 * ch) = R.c;
    if (tid < 32) *(LAS v4u*)(buf + HG_GI + 16 * tid) = R.d;
}
template <bool FULL> __device__ __forceinline__ void hg_step(const LAS unsigned char* buf, int r0, int w, f32x4 (&S)[8], f32x4& GA, _Float16* Op, int lane, int dir) {
    const int idx = lane & 15, rq = lane >> 4;
    v2u q[2][8], k[2][8];
    f32x4 P[2][2];
    if (FULL) {
#pragma unroll
        for (int tb = 0; tb < 2; ++tb)
#pragma unroll
            for (int j = 0; j < 8; ++j) { q[tb][j] = *(const LAS v2u*)(buf + HG_QI + (16 * tb + idx) * HG_P + (16 * j + 4 * rq) * 2); k[tb][j] = *(const LAS v2u*)(buf + HG_KI + (16 * tb + idx) * HG_P + (16 * j + 4 * rq) * 2); }
#pragma unroll
        for (int sb = 0; sb < 2; ++sb)
#pragma unroll
            for (int tb = 0; tb < 2; ++tb) { f32x4 p = (f32x4){0.f, 0.f, 0.f, 0.f};
#pragma unroll
                for (int ks = 0; ks < 4; ++ks) { v4u a, b; a.x = k[sb][2 * ks].x; a.y = k[sb][2 * ks].y; a.z = k[sb][2 * ks + 1].x; a.w = k[sb][2 * ks + 1].y; b.x = q[tb][2 * ks].x; b.y = q[tb][2 * ks].y; b.z = q[tb][2 * ks + 1].x; b.w = q[tb][2 * ks + 1].y;
                    p = __builtin_amdgcn_mfma_f32_16x16x32_bf16(__builtin_bit_cast(hb16x8, a), __builtin_bit_cast(hb16x8, b), p, 0, 0, 0); }
                P[sb][tb] = p; } }
#pragma unroll
    for (int kb = 0; kb < 8; ++kb) { const f32x4 gv = *(const LAS f32x4*)(buf + HG_GI + (16 * kb + 4 * rq) * 4); S[kb] = S[kb] * gv; if (kb == w) GA = GA * gv; }
    f32x4 o[2];
    o[0] = (f32x4){0.f, 0.f, 0.f, 0.f}; o[1] = (f32x4){0.f, 0.f, 0.f, 0.f};
    if (FULL) {
#pragma unroll
    for (int ks = 0; ks < 4; ++ks) { v4u a; a.x = pg8::cvt_pk_bf16(S[2 * ks][0], S[2 * ks][1]); a.y = pg8::cvt_pk_bf16(S[2 * ks][2], S[2 * ks][3]); a.z = pg8::cvt_pk_bf16(S[2 * ks + 1][0], S[2 * ks + 1][1]); a.w = pg8::cvt_pk_bf16(S[2 * ks + 1][2], S[2 * ks + 1][3]);
#pragma unroll
        for (int tb = 0; tb < 2; ++tb) { v4u b; b.x = q[tb][2 * ks].x; b.y = q[tb][2 * ks].y; b.z = q[tb][2 * ks + 1].x; b.w = q[tb][2 * ks + 1].y;
            o[tb] = __builtin_amdgcn_mfma_f32_16x16x32_bf16(__builtin_bit_cast(hb16x8, a), __builtin_bit_cast(hb16x8, b), o[tb], 0, 0, 0); } } }
    s16x4 vt0, vt1, k0[8], k1[8];
    { const unsigned q_ = (unsigned)(idx >> 2), p_ = (unsigned)(idx & 3);
      const unsigned va = (unsigned)(size_t)(buf + HG_VI) + (4u * rq + q_) * HG_P + 32u * (unsigned)w + 8u * p_, ka = (unsigned)(size_t)(buf + HG_KI) + (4u * rq + q_) * HG_P + 8u * p_;
      asm volatile("s_waitcnt lgkmcnt(0)\n\t"
                   "ds_read_b64_tr_b16 %0, %18\n\t"
                   "ds_read_b64_tr_b16 %1, %18 offset:4352\n\t"
                   "ds_read_b64_tr_b16 %2, %19\n\t"
                   "ds_read_b64_tr_b16 %3, %19 offset:32\n\t"
                   "ds_read_b64_tr_b16 %4, %19 offset:64\n\t"
                   "ds_read_b64_tr_b16 %5, %19 offset:96\n\t"
                   "ds_read_b64_tr_b16 %6, %19 offset:128\n\t"
                   "ds_read_b64_tr_b16 %7, %19 offset:160\n\t"
                   "ds_read_b64_tr_b16 %8, %19 offset:192\n\t"
                   "ds_read_b64_tr_b16 %9, %19 offset:224\n\t"
                   "ds_read_b64_tr_b16 %10, %19 offset:4352\n\t"
                   "ds_read_b64_tr_b16 %11, %19 offset:4384\n\t"
                   "ds_read_b64_tr_b16 %12, %19 offset:4416\n\t"
                   "ds_read_b64_tr_b16 %13, %19 offset:4448\n\t"
                   "ds_read_b64_tr_b16 %14, %19 offset:4480\n\t"
                   "ds_read_b64_tr_b16 %15, %19 offset:4512\n\t"
                   "ds_read_b64_tr_b16 %16, %19 offset:4544\n\t"
                   "ds_read_b64_tr_b16 %17, %19 offset:4576\n\t"
                   "s_waitcnt lgkmcnt(0)"
                   : "=&v"(vt0), "=&v"(vt1), "=&v"(k0[0]), "=&v"(k0[1]), "=&v"(k0[2]), "=&v"(k0[3]), "=&v"(k0[4]), "=&v"(k0[5]), "=&v"(k0[6]), "=&v"(k0[7]),
                     "=&v"(k1[0]), "=&v"(k1[1]), "=&v"(k1[2]), "=&v"(k1[3]), "=&v"(k1[4]), "=&v"(k1[5]), "=&v"(k1[6]), "=&v"(k1[7])
                   : "v"(va), "v"(ka) : "memory"); }
    static_assert(16 * HG_P == 4352, "tr-read row offsets above");
    const hb16x8 vfrag = __builtin_shufflevector(vt0, vt1, 0, 1, 2, 3, 4, 5, 6, 7);
    if (FULL) {
#pragma unroll
      for (int tb = 0; tb < 2; ++tb) { v4u pb; float pm[2][4];
#pragma unroll
        for (int sb = 0; sb < 2; ++sb)
#pragma unroll
            for (int i = 0; i < 4; ++i) { const int s_ = 16 * sb + 4 * rq + i, t_ = 16 * tb + idx; const bool keep = dir ? (s_ >= t_) : (s_ <= t_); pm[sb][i] = keep ? P[sb][tb][i] : 0.f; }
        pb.x = pg8::cvt_pk_bf16(pm[0][0], pm[0][1]); pb.y = pg8::cvt_pk_bf16(pm[0][2], pm[0][3]); pb.z = pg8::cvt_pk_bf16(pm[1][0], pm[1][1]); pb.w = pg8::cvt_pk_bf16(pm[1][2], pm[1][3]);
        o[tb] = __builtin_amdgcn_mfma_f32_16x16x32_bf16(vfrag, __builtin_bit_cast(hb16x8, pb), o[tb], 0, 0, 0); } }
#pragma unroll
    for (int kb = 0; kb < 8; ++kb) { const hb16x8 kfrag = __builtin_shufflevector(k0[kb], k1[kb], 0, 1, 2, 3, 4, 5, 6, 7);
        S[kb] = __builtin_amdgcn_mfma_f32_16x16x32_bf16(kfrag, vfrag, S[kb], 0, 0, 0); }
    if (FULL) {
#pragma unroll
        for (int tb = 0; tb < 2; ++tb) *(GAS h16x4*)(Op + (size_t)(r0 + 16 * tb + idx) * WK + 4 * rq) = __builtin_convertvector(o[tb], h16x4); }
}
#define HG_BARRIER() do { asm volatile("s_waitcnt lgkmcnt(0)" ::: "memory"); __builtin_amdgcn_s_barrier(); asm volatile("" ::: "memory"); } while (0)
template <int PASS> __device__ __forceinline__ void phase_hgrn() {
    const Frame F = mkframe(); unsigned char* ws = F.ws;
    const int lane = F.lane, tid = F.tid, w = F.wave;
    constexpr bool FULL = PASS == 1;
    for (int task = F.vcu; task < 64 * HG_NSEG; task += F.G) {
        const int chain = task >> 2, seg = task & 3, b = chain >> 4, h = (chain >> 1) & 7, dir = chain & 1;
        if (PASS == 0 && seg == HG_NSEG - 1) continue;
        const bf16* Qp = (const bf16*)(ws + (dir ? WS_QB : WS_QF)) + h * DK; const bf16* Kp = (const bf16*)(ws + (dir ? WS_KB : WS_KF)) + h * DK;
        const bf16* Vp = (const bf16*)(ws + WS_VV) + h * DV; const float* Gp = (const float*)(ws + (dir ? WS_GB : WS_GF)) + h * DK;
        _Float16* Op = (_Float16*)(ws + (dir ? WS_OB : WS_OF)) + h * DV + 16 * w;
        f32x4* SL = (f32x4*)(ws + WS_SLOC);
        LAS unsigned char* buf0 = F.lds; LAS unsigned char* buf1 = F.lds + HG_BUF;
        const int cstep = dir ? -32 : 32, cbase = M_LAT + b * CTXL + (dir ? CTXL - 32 : 0), lbase2 = b * SEQ + (dir ? SEQ - 32 : 0) - HG_NCTX * cstep;
        f32x4 S[8], GA = (f32x4){1.f, 1.f, 1.f, 1.f};
#pragma unroll
        for (int kb = 0; kb < 8; ++kb) S[kb] = (f32x4){0.f, 0.f, 0.f, 0.f};
        if (PASS == 1) {
#pragma unroll 1
            for (int k = 0; k < seg; ++k) { const f32x4* p = SL + (size_t)(task - seg + k) * 4608 + lane;
#pragma unroll
                for (int kb = 0; kb < 8; ++kb) S[kb] = S[kb] * p[4096 + kb * 64] + p[(w * 8 + kb) * 64]; } }
        const int s0 = seg * HG_SEGLEN, slast = s0 + HG_SEGLEN - 1;
#define HG_ROW(s_) hg_row0((s_) < slast ? (s_) : slast, cstep, cbase, lbase2)
        HgReg R0, R1;
        __syncthreads();
        hg_gload<FULL>(R0, HG_ROW(s0), Qp, Kp, Vp, Gp, tid); hg_lwrite<FULL>(R0, buf0, tid);
        hg_gload<FULL>(R1, HG_ROW(s0 + 1), Qp, Kp, Vp, Gp, tid);
        HG_BARRIER();
#pragma unroll 1
        for (int s = s0; s < s0 + HG_SEGLEN; s += 2) {
            hg_gload<FULL>(R0, HG_ROW(s + 2), Qp, Kp, Vp, Gp, tid);
            hg_step<FULL>(buf0, hg_row0(s, cstep, cbase, lbase2), w, S, GA, Op, lane, dir);
            hg_lwrite<FULL>(R1, buf1, tid); HG_BARRIER();
            hg_gload<FULL>(R1, HG_ROW(s + 3), Qp, Kp, Vp, Gp, tid);
            hg_step<FULL>(buf1, hg_row0(s + 1, cstep, cbase, lbase2), w, S, GA, Op, lane, dir);
            hg_lwrite<FULL>(R0, buf0, tid); HG_BARRIER();
        }
#undef HG_ROW
        if (PASS == 0) { f32x4* p = SL + (size_t)task * 4608 + lane;
#pragma unroll
            for (int kb = 0; kb < 8; ++kb) p[(w * 8 + kb) * 64] = S[kb];
            p[4096 + w * 64] = GA; }
    }
}

constexpr int GM_P = 272, GM_WI = 0, GM_VI = 128 * GM_P;
__device__ __forceinline__ void phase_gmlp(int l) {
    const Frame F = mkframe(); unsigned char* ws = F.ws;
    const bf16* Z2 = (const bf16*)(ws + WS_Z2); const bf16* VN = (const bf16*)(ws + WS_VN); bf16* YABC = (bf16*)(ws + WS_YABC);
    const int tid = F.tid, lane = F.lane, w = F.wave, idx = lane & 15, rq = lane >> 4;
    if ((F.vcu & 3) != HG_NSEG - 1) return;
    const int jw = F.vcu >> 2, g = jw & 3, nper = F.G >> 4;
    if ((jw >> 2) >= M / 128) return;
    __syncthreads();
    { const float* wsrc = INP(IWS) + ((size_t)l * 4 + g) * 128 * 128;
#pragma unroll
      for (int i = 0; i < 8; ++i) { const int e = (i * 512 + tid) * 4, t = e >> 7, s0 = e & 127; const f32x4 v = *(const GAS f32x4*)(wsrc + e);
          *(LAS v2u*)(F.lds + GM_WI + t * GM_P + 2 * s0) = (v2u){pk2(v[0], v[1]), pk2(v[2], v[3])}; } }
    for (int chunk = jw >> 2; chunk < M / 128; chunk += nper) { const size_t r0 = (size_t)chunk * 128;
        __syncthreads();
#pragma unroll
        for (int i = 0; i < 4; ++i) { const int e = i * 512 + tid, srow = e >> 4, c8 = e & 15;
            *(LAS v4u*)(F.lds + GM_VI + srow * GM_P + 16 * c8) = *(const GAS v4u*)(VN + (r0 + srow) * BW + g * 128 + 8 * c8); }
        __syncthreads();
        v4u bfr[4];
#pragma unroll
        for (int ks = 0; ks < 4; ++ks) bfr[ks] = *(const LAS v4u*)(F.lds + GM_WI + (16 * w + idx) * GM_P + (32 * ks + 8 * rq) * 2);
        const float bs = INP(IBS)[((size_t)l * 4 + g) * 128 + 16 * w + idx];
        v2u urv[8];
#pragma unroll
        for (int cb = 0; cb < 8; ++cb) urv[cb] = *(const GAS v2u*)(Z2 + (r0 + 16 * w + idx) * Z2W + Z2_U + g * 128 + 16 * cb + 4 * rq);
        const unsigned q_ = (unsigned)(idx >> 2), p_ = (unsigned)(idx & 3);
        const unsigned va = (unsigned)(size_t)(F.lds + GM_VI) + (8u * rq + q_) * GM_P + 8u * p_;
#pragma unroll
        for (int cb = 0; cb < 8; ++cb) {
            s16x4 t0[4], t1[4];
            asm volatile("ds_read_b64_tr_b16 %0, %8\n\t"
                         "ds_read_b64_tr_b16 %1, %8 offset:1088\n\t"
                         "ds_read_b64_tr_b16 %2, %9\n\t"
                         "ds_read_b64_tr_b16 %3, %9 offset:1088\n\t"
                         "ds_read_b64_tr_b16 %4, %10\n\t"
                         "ds_read_b64_tr_b16 %5, %10 offset:1088\n\t"
                         "ds_read_b64_tr_b16 %6, %11\n\t"
                         "ds_read_b64_tr_b16 %7, %11 offset:1088\n\t"
                         "s_waitcnt lgkmcnt(0)"
                         : "=&v"(t0[0]), "=&v"(t1[0]), "=&v"(t0[1]), "=&v"(t1[1]), "=&v"(t0[2]), "=&v"(t1[2]), "=&v"(t0[3]), "=&v"(t1[3])
                         : "v"(va + 32u * cb), "v"(va + 32u * cb + 32u * GM_P), "v"(va + 32u * cb + 64u * GM_P), "v"(va + 32u * cb + 96u * GM_P) : "memory");
            f32x4 acc = (f32x4){0.f, 0.f, 0.f, 0.f};
#pragma unroll
            for (int ks = 0; ks < 4; ++ks) { const hb16x8 afr = __builtin_shufflevector(t0[ks], t1[ks], 0, 1, 2, 3, 4, 5, 6, 7);
                acc = __builtin_amdgcn_mfma_f32_16x16x32_bf16(afr, __builtin_bit_cast(hb16x8, bfr[ks]), acc, 0, 0, 0); }
            const size_t row = r0 + 16 * w + idx; const int ch = g * 128 + 16 * cb + 4 * rq;
            const v2u ur = urv[cb];
            const float y0 = gelu_tanh(bflo(ur.x)) * (acc[0] + bs), y1 = gelu_tanh(bfhi(ur.x)) * (acc[1] + bs), y2 = gelu_tanh(bflo(ur.y)) * (acc[2] + bs), y3 = gelu_tanh(bfhi(ur.y)) * (acc[3] + bs);
            *(GAS v2u*)(YABC + row * 2048 + 1024 + ch) = (v2u){pk2(y0, y1), pk2(y2, y3)};
        }
    }
    __syncthreads();
}

struct RoRow { pg8::eh16x8 f0, f1, b0, b1; v4u g0, g1; };
__device__ __forceinline__ void ro_load(RoRow& R, const _Float16* OFp, const _Float16* OBp, const bf16* Z2, int m, int lane) {
    R.f0 = *(const GAS pg8::eh16x8*)(OFp + (size_t)m * WK + 16 * lane); R.f1 = *(const GAS pg8::eh16x8*)(OFp + (size_t)m * WK + 16 * lane + 8);
    R.b0 = *(const GAS pg8::eh16x8*)(OBp + (size_t)m * WK + 16 * lane); R.b1 = *(const GAS pg8::eh16x8*)(OBp + (size_t)m * WK + 16 * lane + 8);
    R.g0 = *(const GAS v4u*)(Z2 + (size_t)m * Z2W + Z2_GA + 16 * lane); R.g1 = *(const GAS v4u*)(Z2 + (size_t)m * Z2W + Z2_GA + 16 * lane + 8);
}
__device__ __forceinline__ void ro_finish(const RoRow& R, const float (&ag)[16], bf16* YABC, int m, int lane) {
    const pg8::ef32x8 a0 = __builtin_convertvector(R.f0, pg8::ef32x8), a1 = __builtin_convertvector(R.f1, pg8::ef32x8), c0 = __builtin_convertvector(R.b0, pg8::ef32x8), c1 = __builtin_convertvector(R.b1, pg8::ef32x8);
    float o[16]; float ss = 0.f;
#pragma unroll
    for (int e = 0; e < 8; ++e) { o[e] = a0[e] + c0[e]; o[8 + e] = a1[e] + c1[e]; ss += o[e] * o[e] + o[8 + e] * o[8 + e]; }
    ss += dppf<0xB1>(ss); ss += dppf<0x4E>(ss); ss += dppf<0x141>(ss);
    const float rstd = 1.0f / sqrtf(ss * (1.0f / DV) + EPS);
    const v4u g0 = R.g0, g1 = R.g1; float ga[16];
    ga[0] = bflo(g0.x); ga[1] = bfhi(g0.x); ga[2] = bflo(g0.y); ga[3] = bfhi(g0.y); ga[4] = bflo(g0.z); ga[5] = bfhi(g0.z); ga[6] = bflo(g0.w); ga[7] = bfhi(g0.w);
    ga[8] = bflo(g1.x); ga[9] = bfhi(g1.x); ga[10] = bflo(g1.y); ga[11] = bfhi(g1.y); ga[12] = bflo(g1.z); ga[13] = bfhi(g1.z); ga[14] = bflo(g1.w); ga[15] = bfhi(g1.w);
    float y[16];
#pragma unroll
    for (int e = 0; e < 16; ++e) y[e] = o[e] * rstd * ag[e] * siluf_(ga[e]);
    v4u w0, w1; w0.x = pk2(y[0], y[1]); w0.y = pk2(y[2], y[3]); w0.z = pk2(y[4], y[5]); w0.w = pk2(y[6], y[7]); w1.x = pk2(y[8], y[9]); w1.y = pk2(y[10], y[11]); w1.z = pk2(y[12], y[13]); w1.w = pk2(y[14], y[15]);
    *(GAS v4u*)(YABC + (size_t)m * 2048 + 16 * lane) = w0; *(GAS v4u*)(YABC + (size_t)m * 2048 + 16 * lane + 8) = w1;
}
__device__ __forceinline__ void phase_readout(int l) {
    const Frame F = mkframe(); unsigned char* ws = F.ws;
    const _Float16* OFp = (const _Float16*)(ws + WS_OF); const _Float16* OBp = (const _Float16*)(ws + WS_OB); const bf16* Z2 = (const bf16*)(ws + WS_Z2); bf16* YABC = (bf16*)(ws + WS_YABC);
    const int gw = F.vcu * 8 + F.wave, NGW = F.G * 8, lane = F.lane;
    float ag[16];
    { const float* agp = INP(IANORM) + l * DV + (16 * lane & 127);
#pragma unroll
      for (int e = 0; e < 16; ++e) ag[e] = agp[e]; }
    const int per = (M_LAT + NGW - 1) / NGW, m0 = gw * per, m1 = (m0 + per < M_LAT) ? m0 + per : M_LAT;
    if (m0 < m1) { RoRow cur, nxt; ro_load(cur, OFp, OBp, Z2, m0, lane);
#pragma unroll 1
        for (int m = m0; m < m1; ++m) { ro_load(nxt, OFp, OBp, Z2, m + 1 < m1 ? m + 1 : m, lane); ro_finish(cur, ag, YABC, m, lane); cur = nxt; } }
    for (int m = M_LAT + (gw >> 1) + ((gw & 1) ? (NGW >> 1) : 0); m < M; m += NGW) { RoRow cur; ro_load(cur, OFp, OBp, Z2, m, lane); ro_finish(cur, ag, YABC, m, lane); }
}

constexpr int PH_PER_LAYER = 13, N_PHASES = 1 + DEPTH * PH_PER_LAYER + 1;
__device__ __forceinline__ void grid_seam() {
    extern __shared__ __attribute__((aligned(16))) unsigned char lds_dyn[];
    XcdBarrier bar; bar.bar = (unsigned*)(kargs()->ws + WS_CTL) + CW_BAR; bar.x = xb_xcc_id(); bar.st = (volatile LAS unsigned*)((LAS unsigned char*)lds_dyn + MISC_OFF) + 8;
    xcd_barrier(bar);
}
__global__ void __launch_bounds__(512, 2) fwd_kernel(Args args_unused) {
    extern __shared__ __attribute__((aligned(16))) unsigned char lds_dyn[];
    { LAS unsigned char* lds = (LAS unsigned char*)lds_dyn;
      for (int u = threadIdx.x; u < (LDS_BYTES - LDSCTL_OFF) / 4; u += 512) ((LAS unsigned*)(lds + LDSCTL_OFF))[u] = 0u;
      __syncthreads();
      if (kargs()->ph_hi - kargs()->ph_lo > 1) (void)xcd_barrier_post((unsigned*)(kargs()->ws + WS_CTL) + CW_BAR, (volatile LAS unsigned*)(lds + MISC_OFF) + 8); }
    const int lo = kargs()->ph_lo, hi = kargs()->ph_hi;
#define IN(k) (lo <= (k) && (k) < hi)
#define SEAM(k) do { if (IN((k) + 1)) grid_seam(); } while (0)
#define LDSP ((LAS unsigned char*)lds_dyn)
#define WSP(off) (kargs()->ws + (off))

    if (IN(0)) { phase_prologue(); __syncthreads(); SEAM(0); }

#pragma unroll 1
    for (int l = 0; l < DEPTH; ++l) {
        const int pb = 1 + l * PH_PER_LAYER;
        if (hi <= pb || lo >= pb + PH_PER_LAYER) continue;
#pragma unroll 1
        for (int j = 0; j < 2; ++j) {
            const int p0 = pb + (j ? 10 : 0);
            const bool noctx = (l == DEPTH - 1) && j == 1;
            if (IN(p0)) { if (j) phase_norm(l, 2, noctx ? M_LAT : M, noctx ? 0 : 1, l, 5, 1.0f); else { if (l > 0) convert_rest(l); phase_norm(l, 0, M, l > 0 ? 1 : 0, l - 1, 8, 0.5f); } SEAM(p0); }
            if (IN(p0 + 1)) { pg8::Gemm g{(const bf16*)WSP(WS_H), (const bf16*)WSP(WS_WGU) + (size_t)(l * 2 + j) * (2 * DFF) * D, M, 2 * DFF, D, D, D};
                pg8::StaticOrder S; S.init(noctx ? M_LAT : M, 2 * DFF, (int)gridDim.x, (int)blockIdx.x, D); pg8::EpiSwiGLU E{(bf16*)WSP(WS_ACT)};
                pg8::gemm_phase<pg8::EpiSwiGLU, pg8::StaticOrder, true, true>(LDSP, g, S, E);
                if (l < DEPTH - 1) convert_slot(l + 1, j ? 3 : 0, (M / 256) * (2 * DFF / 256), CV_Q_GU);
                SEAM(p0 + 1); }
            if (IN(p0 + 2)) { pg8::Gemm g{(const bf16*)WSP(WS_ACT), (const bf16*)WSP(WS_WD) + (size_t)(l * 2 + j) * D * DFF, M, D, DFF, DFF, DFF};
                pg8::SplitOrder S; S.init((int)gridDim.x, (int)blockIdx.x, DFF, !noctx); pg8::EpiResid E{(ytype*)WSP(WS_Y), (const float*)WSP(WS_MOD) + (size_t)l * NGRP * MODW + (j ? 8 : 2) * D, 0.5f, (float*)WSP(WS_MF32)};
                pg8::gemm_phase<pg8::EpiResid, pg8::SplitOrder, true, true>(LDSP, g, S, E); SEAM(p0 + 2); }
            if (j == 0) {
                const bool lastl = (l == DEPTH - 1);
                if (IN(pb + 3)) { phase_norm(l, 1, M, 1, l, 2, 0.5f); SEAM(pb + 3); }
                if (IN(pb + 4)) { pg8::Gemm g{(const bf16*)WSP(WS_H), (const bf16*)WSP(WS_WIN) + (size_t)l * INW * D, M, INW, D, D, D};
                    pg8::InprojOrder S; S.init((int)gridDim.x, (int)blockIdx.x, D, lastl ? 16 : 54); pg8::EpiInproj E{(bf16*)WSP(WS_QS), (bf16*)WSP(WS_VV), (_Float16*)WSP(WS_ZF), (bf16*)WSP(WS_Z2)};
                    pg8::gemm_phase<pg8::EpiInproj, pg8::InprojOrder, true, true>(LDSP, g, S, E);
                    if (!lastl) convert_slot(l + 1, 1, 64 * 54 + 4 * 54, CV_Q_IN);
                    SEAM(pb + 4); }
                if (IN(pb + 5)) { phase_hgrn_prep(l); phase_mix_elem(l); SEAM(pb + 5); }
                if (IN(pb + 6)) { phase_hgrn<0>(); phase_gmlp(l); grid_seam(); phase_hgrn<1>(); SEAM(pb + 6); }
                if (IN(pb + 7)) { phase_readout(l); SEAM(pb + 7); }
                if (IN(pb + 8)) { pg8::Gemm g{(const bf16*)WSP(WS_YABC), (const bf16*)WSP(WS_WP) + (size_t)l * D * 2048, M, D, 2048, 2048, 2048};
                    pg8::StaticOrder S; S.init(lastl ? M_LAT : M, D, (int)gridDim.x, (int)blockIdx.x, 2048); pg8::EpiProjF E{(bf16*)WSP(WS_MRG), (const bf16*)WSP(WS_Z2)};
                    pg8::gemm_phase<pg8::EpiProjF, pg8::StaticOrder, true, true>(LDSP, g, S, E);
                    if (!lastl) convert_slot(l + 1, 2, (M / 256) * (D / 256), CV_Q_PJ);
                    SEAM(pb + 8); }
                if (IN(pb + 9)) { pg8::Gemm g{(const bf16*)WSP(WS_MRG), (const bf16*)WSP(WS_WO) + (size_t)l * D * D, M, D, D, D, D};
                    pg8::SplitOrder S; S.init((int)gridDim.x, (int)blockIdx.x, D, !lastl); pg8::EpiResid E{(ytype*)WSP(WS_Y), (const float*)WSP(WS_MOD) + (size_t)l * NGRP * MODW + 5 * D, 1.0f, (float*)WSP(WS_MF32)};
                    pg8::gemm_phase<pg8::EpiResid, pg8::SplitOrder, true, true>(LDSP, g, S, E); SEAM(pb + 9); }
            }
        }
    }
    if (IN(N_PHASES - 1)) phase_final();
#undef IN
#undef SEAM
}

#ifndef MK_PER_PHASE
#define MK_PER_PHASE 0
#endif
extern "C" void kernel_launch(void* const* d_in, const int* in_sizes, int n_in, void* d_out, int out_size, void* d_ws, size_t ws_size, hipStream_t stream) {
    static int grid = 0;
    if (grid == 0) {
        if (n_in != 23 || out_size != M_LAT * D || ws_size < WS_END) { fprintf(stderr, "kernel_launch: unexpected sizes n_in %d out %d ws %zu (need %zu)\n", n_in, out_size, ws_size, (size_t)WS_END); grid = -1; return; }
        int dev = 0, cus = 0, per_cu = 0;
        if (hipGetDevice(&dev) != hipSuccess || hipDeviceGetAttribute(&cus, hipDeviceAttributeMultiprocessorCount, dev) != hipSuccess) { grid = -1; return; }
        if (hipFuncSetAttribute((const void*)fwd_kernel, hipFuncAttributeMaxDynamicSharedMemorySize, LDS_BYTES) != hipSuccess) { fprintf(stderr, "kernel_launch: hipFuncSetAttribute failed\n"); grid = -1; return; }
        if (hipOccupancyMaxActiveBlocksPerMultiprocessor(&per_cu, (const void*)fwd_kernel, 512, LDS_BYTES) != hipSuccess || per_cu < 1) { fprintf(stderr, "kernel_launch: occupancy query says %d\n", per_cu); }
        (void)hipGetLastError();
        grid = cus;
    }
    if (grid < 0) return;
    (void)hipMemsetAsync((char*)d_ws + WS_CTL, 0, CTL_ZERO_BYTES, stream);
    Args a{};
    for (int i = 0; i < 23; ++i) a.in[i] = (const float*)d_in[i];
    a.out = (float*)d_out; a.ws = (unsigned char*)d_ws;
#if MK_PER_PHASE
    for (int p = 0; p < N_PHASES; ++p) { a.ph_lo = p; a.ph_hi = p + 1; hipLaunchKernelGGL(fwd_kernel, dim3(grid), dim3(512), LDS_BYTES, stream, a); }
#else
    a.ph_lo = 0; a.ph_hi = N_PHASES; hipLaunchKernelGGL(fwd_kernel, dim3(grid), dim3(512), LDS_BYTES, stream, a);
#endif
}
```

```cpp
#include <hip/hip_runtime.h>
#include <cstdio>
#include <cstdint>
namespace pg8 {
#define PG8_LAS __attribute__((address_space(3)))
typedef unsigned short bf16_t;
typedef short bf16x8 __attribute__((ext_vector_type(8)));
typedef float f32x4 __attribute__((ext_vector_type(4)));
typedef float f32x2 __attribute__((ext_vector_type(2)));
typedef unsigned u32x4 __attribute__((ext_vector_type(4)));
typedef unsigned u32x2 __attribute__((ext_vector_type(2)));
constexpr int BM = 256, BK = 64, HALF = 128, HTB = HALF * BK * 2  , STAGE_BYTES = 8 * HTB, NXCD = 8, WGM = 8;

__host__ __device__ __forceinline__ int lds_byte(int r, int c) { const int st = (r >> 4) * 2 + (c >> 5), rr = r & 15, cc = c & 31, ob = rr * 64 + cc * 2; return st * 1024 + (ob ^ (((ob >> 9) & 1) << 5)); }
__host__ __device__ __forceinline__ void stage_rc(int b, int& R, int& C) { const int st = b / 1024, sb = b % 1024, swz = sb ^ (((sb >> 9) & 1) << 5); R = (st >> 1) * 16 + swz / 64; C = (st & 1) * 32 + (swz % 64) / 2; }
__host__ __device__ __forceinline__ int perm32(int rho) { const int n = rho >> 4, i = rho & 15; return 8 * (i >> 2) + 4 * n + (i & 3); }

struct Unit { int pm, pn, meta;
    __host__ __device__ __forceinline__ int kt0() const { return meta & 255; } __host__ __device__ __forceinline__ int nt() const { return (meta >> 8) & 255; } __host__ __device__ __forceinline__ int part() const { return meta >> 16; }
    __host__ __device__ __forceinline__ void set(int kt0_, int nt_, int part_) { meta = kt0_ | (nt_ << 8) | (part_ << 16); } };
struct Gemm { const bf16_t* A; const bf16_t* Bt; int M, N, K, lda, ldb; };

__host__ __device__ __forceinline__ int xcd_block_pos(int L, int nwg, int G) {
    if (G != 256) return L;
    const int i = L >> 8, c = L & 255;
    if (((i + 1) << 8) <= nwg) return (i << 8) + ((c & 7) << 5) + (c >> 3);
    const int rem = nwg - (i << 8);
    return (rem & 7) ? L : (i << 8) + (c & 7) * (rem >> 3) + (c >> 3);
}
__host__ __device__ __forceinline__ void tile_of(int wgid, int nM, int nN, int& pm, int& pn) {
    const int nig = WGM * nN, gid = wgid / nig, fm = gid * WGM, gsz = (nM - fm) < WGM ? (nM - fm) : WGM;
    pm = fm + ((wgid % nig) % gsz); pn = (wgid % nig) / gsz;
}
struct StaticOrder {
    int nM, nN, nwg, G, c, ntK;
    __host__ __device__ void init(int M, int N, int G_, int c_, int K) { nM = M / BM; nN = N / BM; nwg = nM * nN; G = G_; c = c_; ntK = K / BK; }
    __host__ __device__ bool next(int i, Unit& u) const {
        const long L = (long)i * G + c; if (L >= nwg) return false;
        u.set(0, ntK, 0);
        const int wgid = xcd_block_pos((int)L, nwg, G);
        const int nig = WGM * nN, gid = wgid / nig, fm = gid * WGM, gsz = (nM - fm) < WGM ? (nM - fm) : WGM;
        u.pm = fm + ((wgid % nig) % gsz); u.pn = (wgid % nig) / gsz; return true;
    }
    __device__ __forceinline__ void a_ready(const Unit&) const {}
    __device__ __forceinline__ void done(const Unit&) const {}
};

struct SplitOrder {
    int G, c, ntK, nctx;
    __host__ __device__ void init(int G_, int c_, int K, bool with_ctx) { G = G_; c = c_; ntK = K / BK; nctx = with_ctx ? 256 : 0; }
    __host__ __device__ bool next(int i, Unit& u) const {
        const long L = (long)i * G + c; if (L >= 512 + nctx) return false;
        if (L < 512) { tile_of(xcd_block_pos((int)(L < 256 ? L + 256 : L - 256), 512, G), 64, 8, u.pm, u.pn); u.set(0, ntK, 0); return true; }
        const int q = (int)L - 512, tile = q >> 3, p = q & 7; u.pm = 64 + (tile >> 3); u.pn = tile & 7;
        if (ntK == 88) u.set((p >> 1) * 22 + (p & 1) * 12, (p & 1) ? 10 : 12, 1 + p); else u.set(p * (ntK >> 3), ntK >> 3, 1 + p);
        return true;
    }
    __device__ __forceinline__ void a_ready(const Unit&) const {}
    __device__ __forceinline__ void done(const Unit&) const {}
};

struct InprojOrder {
    int G, c, ntK, nctx;
    __host__ __device__ void init(int G_, int c_, int K, int nctx_pn) { G = G_; c = c_; ntK = K / BK; nctx = 4 * nctx_pn; }
    __host__ __device__ bool next(int i, Unit& u) const {
        const long L = (long)i * G + c; if (L >= 64 * 54 + nctx) return false;
        u.set(0, ntK, 0);
        if (L < 64 * 54) { tile_of(xcd_block_pos((int)L, 64 * 54, G), 64, 54, u.pm, u.pn); return true; }
        const int q = (int)L - 64 * 54; u.pm = 64 + (q & 3); u.pn = q >> 2; return true;
    }
    __device__ __forceinline__ void a_ready(const Unit&) const {}
    __device__ __forceinline__ void done(const Unit&) const {}
};

__device__ __forceinline__ unsigned cvt_pk_bf16(float lo, float hi) { unsigned r; asm volatile("v_cvt_pk_bf16_f32 %0, %1, %2" : "=v"(r) : "v"(lo), "v"(hi)); return r; }

template <class Epi, class Sched, bool ALIGN_EPI = false, bool SP2 = false>
__device__ __forceinline__ void gemm_phase(PG8_LAS unsigned char* lds, const Gemm g, const Sched& S, const Epi& E) {
    int tid_ = threadIdx.x; asm volatile("" : "+v"(tid_));
    const int tid = tid_, wid = __builtin_amdgcn_readfirstlane(tid >> 6), lane = tid & 63, wr = wid >> 2, wc = wid & 3, fr = lane & 15, fq = lane >> 4;
    unsigned voffA[2], voffB[2];
#pragma unroll
    for (int i = 0; i < 2; ++i) { int R, C; stage_rc(tid * 16 + i * 8192, R, C); const int Rb = Epi::PERM ? ((R & ~31) + perm32(R & 31)) : R;
        voffA[i] = (unsigned)(R * g.lda + C) * 2u; voffB[i] = (unsigned)(Rb * g.ldb + C) * 2u; }
    const unsigned kstep = (unsigned)(BK * 2);
    const unsigned hstepA = (unsigned)HALF * g.lda * 2u, hstepB = (unsigned)HALF * g.ldb * 2u;
    const unsigned tstepA = 2u * hstepA, tstepB = 2u * hstepB;
    const unsigned ldsw = (unsigned)wid * 1024u;
    const int aoff = lds_byte(wr * 64 + fr, fq * 8), boff = lds_byte(wc * 32 + fr, fq * 8);
#define PG8_SA(b, h) (((b) * 2 + (h)) * HTB)
#define PG8_SB(b, h) ((4 + (b) * 2 + (h)) * HTB)
#define PG8_STAGE(bufoff, gbase, voff) do { _Pragma("unroll") for (int _i = 0; _i < 2; ++_i) \
        __builtin_amdgcn_global_load_lds((const unsigned*)((const char*)(gbase) + (voff)[_i]), (PG8_LAS unsigned*)(lds + (bufoff) + ldsw + _i * 8192), 16, 0, 0); } while (0)
#define PG8_LDA(dst, b, h) do { _Pragma("unroll") for (int m = 0; m < 4; ++m) _Pragma("unroll") for (int k = 0; k < 2; ++k) dst[m][k] = *(const PG8_LAS bf16x8*)(lds + PG8_SA(b, h) + aoff + m * 2048 + k * 1024); } while (0)
#define PG8_LDB(dst, b, h) do { _Pragma("unroll") for (int n = 0; n < 2; ++n) _Pragma("unroll") for (int k = 0; k < 2; ++k) dst[n][k] = *(const PG8_LAS bf16x8*)(lds + PG8_SB(b, h) + boff + n * 2048 + k * 1024); } while (0)
#define PG8_MMA(ai, bj, At, Bt) do { __builtin_amdgcn_s_setprio(1); _Pragma("unroll") for (int m = 0; m < 4; ++m) _Pragma("unroll") for (int n = 0; n < 2; ++n) _Pragma("unroll") for (int k = 0; k < 2; ++k) \
        acc[ai][bj][m][n] = __builtin_amdgcn_mfma_f32_16x16x32_bf16(Bt[n][k], At[m][k], acc[ai][bj][m][n], 0, 0, 0); __builtin_amdgcn_s_setprio(0); } while (0)
#define PG8_WAIT_V(n) asm volatile("s_waitcnt vmcnt(" #n ")" ::: "memory")
#define PG8_WAIT_L(n) asm volatile("s_waitcnt lgkmcnt(" #n ")" ::: "memory")
#define PG8_BAR __builtin_amdgcn_s_barrier()
#define PG8_SCHED __builtin_amdgcn_sched_barrier(0)
    Unit cur, nxt; int ui = 0;
    if (!S.next(0, cur)) return;
    f32x4 acc[2][2][4][2];
#pragma unroll
    for (int a = 0; a < 2; ++a)
#pragma unroll
        for (int b = 0; b < 2; ++b)
#pragma unroll
            for (int m = 0; m < 4; ++m)
#pragma unroll
                for (int n = 0; n < 2; ++n) acc[a][b][m][n] = (f32x4){0.f, 0.f, 0.f, 0.f};
    bf16x8 At[4][2], B0[2][2], B1[2][2];
    const char* cA = (const char*)g.A + (size_t)((unsigned)cur.pm * tstepA) + (size_t)((unsigned)cur.kt0() * kstep); const char* cB = (const char*)g.Bt + (size_t)((unsigned)cur.pn * tstepB) + (size_t)((unsigned)cur.kt0() * kstep);
    S.a_ready(cur);
    if constexpr (SP2) {
        PG8_STAGE(PG8_SB(0, 0), cB, voffB); PG8_STAGE(PG8_SB(0, 1), cB + hstepB, voffB); PG8_STAGE(PG8_SA(0, 0), cA, voffA); PG8_STAGE(PG8_SA(0, 1), cA + hstepA, voffA);
        if (wr == 1) PG8_BAR;
        PG8_WAIT_V(2); PG8_BAR;
        PG8_STAGE(PG8_SB(1, 0), cB + kstep, voffB); PG8_STAGE(PG8_SA(1, 0), cA + kstep, voffA); PG8_STAGE(PG8_SB(1, 1), cB + hstepB + kstep, voffB);
        PG8_WAIT_V(6); PG8_BAR;
    } else {
        PG8_STAGE(PG8_SB(0, 0), cB, voffB); PG8_STAGE(PG8_SA(0, 0), cA, voffA); PG8_STAGE(PG8_SB(0, 1), cB + hstepB, voffB); PG8_STAGE(PG8_SA(0, 1), cA + hstepA, voffA);
        if (wr == 1) PG8_BAR;
        PG8_WAIT_V(4); PG8_BAR;
        PG8_STAGE(PG8_SB(1, 0), cB + kstep, voffB); PG8_STAGE(PG8_SA(1, 0), cA + kstep, voffA); PG8_STAGE(PG8_SB(1, 1), cB + hstepB + kstep, voffB);
        PG8_WAIT_V(6); PG8_BAR;
    }
    for (;;) {
        const bool has_next = S.next(ui + 1, nxt);
        const char* nA = has_next ? (const char*)g.A + (size_t)((unsigned)nxt.pm * tstepA) + (size_t)((unsigned)nxt.kt0() * kstep) : cA; const char* nB = has_next ? (const char*)g.Bt + (size_t)((unsigned)nxt.pn * tstepB) + (size_t)((unsigned)nxt.kt0() * kstep) : cB;
        const int nt = cur.nt();
        for (int t = 0; t < nt; t += 2) {
            if constexpr (Epi::HOOK) { if (t == Epi::H1 || t == Epi::H2) E.khook(acc, cur, t, wr, wc, fr, fq); }
            const bool last = (t == nt - 2);
            const char* a1 = cA + (size_t)((unsigned)(t + 1) * kstep);
            const char* a2 = last ? nA : cA + (size_t)((unsigned)(t + 2) * kstep); const char* b2 = last ? nB : cB + (size_t)((unsigned)(t + 2) * kstep);
            const char* a3 = a2 + kstep; const char* b3 = b2 + kstep;
            if (last && has_next) S.a_ready(nxt);
            if constexpr (SP2) {
            PG8_LDB(B0, 0, 0); PG8_LDB(B1, 0, 1); PG8_SCHED; PG8_LDA(At, 0, 0); PG8_STAGE(PG8_SA(1, 1), a1 + hstepA, voffA);
            PG8_WAIT_V(8); PG8_WAIT_L(0); PG8_BAR; PG8_MMA(0, 0, At, B0); PG8_MMA(0, 1, At, B1); PG8_BAR; PG8_SCHED;
            PG8_LDA(At, 0, 1); PG8_STAGE(PG8_SB(0, 0), b2, voffB); PG8_STAGE(PG8_SB(0, 1), b2 + hstepB, voffB); PG8_STAGE(PG8_SA(0, 0), a2, voffA);
            PG8_WAIT_V(8); PG8_WAIT_L(0); PG8_BAR; PG8_MMA(1, 0, At, B0); PG8_MMA(1, 1, At, B1); PG8_BAR; PG8_SCHED;
            PG8_LDB(B0, 1, 0); PG8_LDB(B1, 1, 1); PG8_SCHED; PG8_LDA(At, 1, 0); PG8_STAGE(PG8_SA(0, 1), a2 + hstepA, voffA);
            PG8_WAIT_V(8); PG8_WAIT_L(0); PG8_BAR; PG8_MMA(0, 0, At, B0); PG8_MMA(0, 1, At, B1); PG8_BAR; PG8_SCHED;
            PG8_LDA(At, 1, 1); PG8_STAGE(PG8_SB(1, 0), b3, voffB); PG8_STAGE(PG8_SB(1, 1), b3 + hstepB, voffB); PG8_STAGE(PG8_SA(1, 0), a3, voffA);
            PG8_WAIT_V(8); PG8_WAIT_L(0); PG8_BAR; PG8_MMA(1, 0, At, B0); PG8_MMA(1, 1, At, B1); PG8_BAR; PG8_SCHED;
            } else {
            PG8_LDB(B0, 0, 0); PG8_SCHED; PG8_LDA(At, 0, 0); PG8_STAGE(PG8_SA(1, 1), a1 + hstepA, voffA);
            PG8_WAIT_L(8); PG8_BAR; PG8_WAIT_L(0); PG8_MMA(0, 0, At, B0); PG8_BAR; PG8_SCHED;
            PG8_LDB(B1, 0, 1); PG8_STAGE(PG8_SB(0, 0), b2, voffB);
            PG8_BAR; PG8_WAIT_L(0); PG8_MMA(0, 1, At, B1); PG8_BAR;
            PG8_LDA(At, 0, 1); PG8_STAGE(PG8_SA(0, 0), a2, voffA);
            PG8_BAR; PG8_WAIT_L(0); PG8_MMA(1, 0, At, B0); PG8_BAR; PG8_SCHED;
            PG8_STAGE(PG8_SB(0, 1), b2 + hstepB, voffB);
            PG8_WAIT_V(6); PG8_BAR; PG8_MMA(1, 1, At, B1); PG8_BAR;
            PG8_LDB(B0, 1, 0); PG8_SCHED; PG8_LDA(At, 1, 0); PG8_STAGE(PG8_SA(0, 1), a2 + hstepA, voffA);
            PG8_WAIT_L(8); PG8_BAR; PG8_WAIT_L(0); PG8_MMA(0, 0, At, B0); PG8_BAR; PG8_SCHED;
            PG8_LDB(B1, 1, 1); PG8_STAGE(PG8_SB(1, 0), b3, voffB);
            PG8_BAR; PG8_WAIT_L(0); PG8_MMA(0, 1, At, B1); PG8_BAR;
            PG8_LDA(At, 1, 1); PG8_STAGE(PG8_SA(1, 0), a3, voffA);
            PG8_BAR; PG8_WAIT_L(0); PG8_MMA(1, 0, At, B0); PG8_BAR; PG8_SCHED;
            PG8_STAGE(PG8_SB(1, 1), b3 + hstepB, voffB);
            PG8_WAIT_V(6); PG8_BAR; PG8_MMA(1, 1, At, B1); PG8_BAR;
            }
        }
        if constexpr (ALIGN_EPI) { if (wr == 0) PG8_BAR; }
        E(acc, cur, wr, wc, fr, fq); S.done(cur);
        if (!has_next) break;
#pragma unroll
        for (int a = 0; a < 2; ++a)
#pragma unroll
            for (int b = 0; b < 2; ++b)
#pragma unroll
                for (int m = 0; m < 4; ++m)
#pragma unroll
                    for (int n = 0; n < 2; ++n) acc[a][b][m][n] = (f32x4){0.f, 0.f, 0.f, 0.f};
        cur = nxt; cA = nA; cB = nB; ++ui;
        if constexpr (ALIGN_EPI) { if (wr == 1) PG8_BAR; }
    }
    PG8_WAIT_V(0);
    if constexpr (!ALIGN_EPI) { if (wr == 0) PG8_BAR; }
    PG8_BAR;
#undef PG8_SA
#undef PG8_SB
#undef PG8_STAGE
#undef PG8_LDA
#undef PG8_LDB
#undef PG8_MMA
#undef PG8_WAIT_V
#undef PG8_WAIT_L
#undef PG8_BAR
#undef PG8_SCHED
}
}
#define XB_TMO      128
#define XB_XCNT(j)  (256  + 64 * (j))
#define XB_XSUB(j)  (1280 + 64 * (j))
#define XB_XGEN(j)  (2304 + 64 * (j))
#define XB_TOP      3328
#define XB_TOPGEN   3392
#define XCD_BAR_WORDS 3456
#define XB_SPIN_CAP (1u << 18)
#define LAS __attribute__((address_space(3)))

__device__ __forceinline__ unsigned xb_ld(unsigned* p)              { return __hip_atomic_load(p, __ATOMIC_RELAXED, __HIP_MEMORY_SCOPE_AGENT); }
__device__ __forceinline__ unsigned xb_add(unsigned* p, unsigned v) { return __hip_atomic_fetch_add(p, v, __ATOMIC_RELAXED, __HIP_MEMORY_SCOPE_AGENT); }
__device__ __forceinline__ unsigned xb_xcc_id() { return (unsigned)__builtin_amdgcn_s_getreg((3 << 11) | 20) & 0xFu; }
#define XB_SPIN(cond, bar) do { unsigned _sp = 0; while (cond) { __builtin_amdgcn_s_sleep(1); \
    if ((++_sp & 255u) == 0u) { if (xb_ld(&(bar)[XB_TMO])) break; if (_sp > XB_SPIN_CAP) { atomicAdd(&(bar)[XB_TMO], 1u); break; } } } } while (0)

struct XcdBarrier {
    unsigned* bar; unsigned x;
    volatile LAS unsigned* st;
};

__device__ __forceinline__ XcdBarrier xcd_barrier_post(unsigned* bar, volatile LAS unsigned* st) {
    XcdBarrier b; b.bar = bar; b.x = xb_xcc_id(); b.st = st;
    if (threadIdx.x == 0) (void)xb_add(&bar[XB_XCNT(b.x)], 1u);
    return b;
}
__device__ __forceinline__ void xcd_barrier_complete(unsigned* bar, unsigned x, unsigned& nloc, unsigned& nx) {
    const unsigned G = gridDim.x * gridDim.y * gridDim.z;
    unsigned sum, cnt, mine, sp = 0u;
    for (;;) {
        sum = 0u; cnt = 0u; mine = 0u;
#pragma unroll
        for (unsigned j = 0; j < 16; ++j) { const unsigned c = xb_ld(&bar[XB_XCNT(j)]); sum += c; cnt += (c > 0u) ? 1u : 0u; mine = (j == x) ? c : mine; }
        if (sum == G) break;
        __builtin_amdgcn_s_sleep(1);
        if ((++sp & 255u) == 0u) { if (xb_ld(&bar[XB_TMO])) break; if (sp > XB_SPIN_CAP) { atomicAdd(&bar[XB_TMO], 1u); break; } }
    }
    nloc = mine > 0u ? mine : 1u; nx = cnt > 0u ? cnt : 1u;
}

__device__ __forceinline__ void xcd_barrier(const XcdBarrier& b) {
    asm volatile("s_waitcnt vmcnt(0)" ::: "memory");
    __syncthreads();
    if (threadIdx.x == 0) {
        unsigned* bar = b.bar;
        __builtin_amdgcn_s_waitcnt(0);
        unsigned nloc = b.st[0], nx = b.st[1];
        if (nloc == 0u) { xcd_barrier_complete(bar, b.x, nloc, nx); b.st[0] = nloc; b.st[1] = nx; }
        const unsigned old = xb_add(&bar[XB_XSUB(b.x)], 1u);
        const unsigned gen = old / nloc;
        if (old + 1u == (gen + 1u) * nloc) {
            __builtin_amdgcn_fence(__ATOMIC_RELEASE, "agent");
            asm volatile("s_waitcnt vmcnt(0)" ::: "memory");
            const unsigned og = xb_add(&bar[XB_TOP], 1u);
            const unsigned tg = og / nx;
            if (og + 1u == (tg + 1u) * nx) xb_add(&bar[XB_TOPGEN], 1u);
            else XB_SPIN(xb_ld(&bar[XB_TOPGEN]) == tg, bar);
            __builtin_amdgcn_fence(__ATOMIC_ACQUIRE, "agent");
            xb_add(&bar[XB_XGEN(b.x)], 1u);
            asm volatile("s_waitcnt vmcnt(0)" ::: "memory");
        } else {
            XB_SPIN(xb_ld(&bar[XB_XGEN(b.x)]) == gen, bar);
            __builtin_amdgcn_fence(__ATOMIC_ACQUIRE, "agent");
            asm volatile("s_waitcnt vmcnt(0)" ::: "memory");
        }
    }
    __syncthreads();
}

constexpr int D = 2048, NB = 4, SEQ = 4096, DEPTH = 4, CTXL = 256, NMOD = 9, DFF = 5632, NH = 8, DK = 128, DV = 128, WK = 1024;
constexpr int BW = 512, CWD = 512, INW = 13824;
constexpr int M_LAT = NB * SEQ, M_CTX = NB * CTXL, M = M_LAT + M_CTX;
constexpr int MODW = NMOD * D;
constexpr int NGRP = 5;
constexpr float EPS = 1e-6f;
constexpr int Z1W = 4096, Z2W = INW - Z1W;
constexpr int Z2_GA = 0, Z2_U = 1024, Z2_V = 1536, Z2_HC = 2048, Z2_GB = 2560, Z2_GC = 3072, Z2_MA = 3584, Z2_MB = 5632, Z2_MC = 7680;

constexpr size_t MiB = 1u << 20;
constexpr size_t WS_CTL = 0ull * MiB, CTL_ZERO_BYTES = 32 * 1024;
constexpr size_t WS_MOD = 1ull * MiB;
constexpr size_t WS_LB = 3ull * MiB;
constexpr size_t WS_WGU = 4ull * MiB;
constexpr size_t WS_WD = 356ull * MiB;
constexpr size_t WS_WIN = 532ull * MiB;
constexpr size_t WS_WP = 748ull * MiB;
constexpr size_t WS_WO = 780ull * MiB;
constexpr size_t WS_Y = 812ull * MiB;
constexpr size_t WS_H = 948ull * MiB;
constexpr size_t WS_MRG = 1016ull * MiB;
constexpr size_t WS_YABC = 1084ull * MiB;
constexpr size_t WS_MF32 = 1152ull * MiB;
constexpr size_t WS_OF = 1288ull * MiB;
constexpr size_t WS_OB = 1356ull * MiB;
constexpr size_t WS_FF = 1424ull * MiB;
constexpr size_t WS_FB = 1492ull * MiB;
constexpr size_t WS_VN = 1560ull * MiB;
constexpr size_t WS_Z1 = 1577ull * MiB;
constexpr size_t WS_ZF = WS_Z1, WS_QS = WS_Z1 + 68ull * MiB;
constexpr size_t WS_Z2 = 1849ull * MiB;
constexpr size_t WS_ACT = WS_Z1;
constexpr size_t WS_QF = WS_FF, WS_KF = WS_FF + 34ull * MiB, WS_QB = WS_FB, WS_KB = WS_FB + 34ull * MiB;
constexpr size_t WS_VV = 2172ull * MiB;
constexpr size_t WS_GF = 2206ull * MiB;
constexpr size_t WS_GB = 2211ull * MiB;
constexpr size_t WS_SLOC = 2216ull * MiB;
constexpr size_t WS_END = 2248ull * MiB;
constexpr int CW_BAR = 4096;
static_assert((CW_BAR + 3456) * 4 <= (int)CTL_ZERO_BYTES, "barrier words inside the per-call memset");

constexpr int RING_BYTES = 131072;
constexpr int LDSCTL_OFF = RING_BYTES, MISC_OFF = LDSCTL_OFF + 320;
constexpr int LDS_BYTES = 147456;

#define GAS __attribute__((address_space(1)))
typedef unsigned short bf16;
typedef unsigned v4u __attribute__((ext_vector_type(4)));
typedef unsigned v2u __attribute__((ext_vector_type(2)));
typedef float f32x4 __attribute__((ext_vector_type(4)));
#define LDS_WAIT() asm volatile("s_waitcnt lgkmcnt(0)" ::: "memory")
#define VM_WAIT() asm volatile("s_waitcnt vmcnt(0)" ::: "memory")
__device__ __forceinline__ unsigned f2bf(float f) { unsigned u = __builtin_bit_cast(unsigned, f); return (u + 0x7fffu + ((u >> 16) & 1u)) >> 16; }
__device__ __forceinline__ unsigned pk2(float lo, float hi) { unsigned r; asm("v_cvt_pk_bf16_f32 %0, %1, %2" : "=v"(r) : "v"(lo), "v"(hi)); return r; }
__device__ __forceinline__ float bflo(unsigned w) { return __builtin_bit_cast(float, w << 16); }
__device__ __forceinline__ float bfhi(unsigned w) { return __builtin_bit_cast(float, w & 0xffff0000u); }
__device__ __forceinline__ float sigmoidf_(float x) { return __builtin_amdgcn_rcpf(1.0f + __expf(-x)); }
__device__ __forceinline__ float siluf_(float x) { return x * sigmoidf_(x); }
__device__ __forceinline__ float gelu_tanh(float x) { const float u = 0.7978845608028654f * (x + 0.044715f * x * x * x); return x * sigmoidf_(2.0f * u); }
template <int CTRL> __device__ __forceinline__ float dppf(float x) { return __builtin_bit_cast(float, __builtin_amdgcn_mov_dpp(__builtin_bit_cast(int, x), CTRL, 0xf, 0xf, true)); }
__device__ __forceinline__ float row16_sum(float x) { x += dppf<0xB1>(x); x += dppf<0x4E>(x); x += dppf<0x124>(x); x += dppf<0x128>(x); return x; }
__device__ __forceinline__ float wave_sum(float v) {
#pragma unroll
    for (int o = 1; o < 64; o <<= 1) v += __shfl_xor(v, o);
    return v;
}
__device__ __forceinline__ int grp_of_row(int m) { return m < M_LAT ? (m >> 12) : 4; }
#ifndef YBF16
#define YBF16 1
#endif
#if YBF16
typedef _Float16 ytype;
typedef _Float16 h16x4 __attribute__((ext_vector_type(4)));
__device__ __forceinline__ f32x4 y_ld4(const ytype* p) { const h16x4 w = *(const GAS h16x4*)p; return __builtin_convertvector(w, f32x4); }
__device__ __forceinline__ void y_st4(ytype* p, f32x4 v) { *(GAS h16x4*)p = __builtin_convertvector(v, h16x4); }
#else
typedef float ytype;
__device__ __forceinline__ f32x4 y_ld4(const ytype* p) { return *(const GAS f32x4*)p; }
__device__ __forceinline__ void y_st4(ytype* p, f32x4 v) { *(GAS f32x4*)p = v; }
#endif

struct Frame {
    LAS unsigned char* lds;
    int tid, lane, wave, vcu, G;
    unsigned char* ws;
};
struct Args { const float* in[23]; float* out; unsigned char* ws; int ph_lo, ph_hi; };
typedef const __attribute__((address_space(4))) Args* KArgs;
__device__ __forceinline__ KArgs kargs() { auto p = __builtin_amdgcn_kernarg_segment_ptr(); asm volatile("" : "+s"(p)); return (KArgs)p; }
__device__ __forceinline__ Frame mkframe() {
    extern __shared__ __attribute__((aligned(16))) unsigned char lds_dyn[];
    Frame F; F.lds = (LAS unsigned char*)lds_dyn; { int t = threadIdx.x; asm volatile("" : "+v"(t)); F.tid = t; } F.lane = F.tid & 63; F.wave = __builtin_amdgcn_readfirstlane(F.tid >> 6);
    { int gg = gridDim.x; asm volatile("" : "+s"(gg)); F.G = gg; } { int bx = blockIdx.x; asm volatile("" : "+s"(bx)); F.vcu = (F.G % 8 == 0) ? (bx % 8) * (F.G / 8) + bx / 8 : bx; }
    F.ws = kargs()->ws; return F;
}

namespace pg8 {
#define TRANS8(op, a) asm(op " %0, %0\n\t" op " %1, %1\n\t" op " %2, %2\n\t" op " %3, %3\n\t" op " %4, %4\n\t" op " %5, %5\n\t" op " %6, %6\n\t" op " %7, %7\n\ts_nop 0" \
    : "+v"(a##0), "+v"(a##1), "+v"(a##2), "+v"(a##3), "+v"(a##4), "+v"(a##5), "+v"(a##6), "+v"(a##7))
struct EpiSwiGLU { static constexpr bool PERM = true, HOOK = false; static constexpr int H1 = -1, H2 = -1;
    bf16_t* O;
    __device__ __forceinline__ void operator()(const f32x4 (&acc)[2][2][4][2], const Unit& u, int wr, int wc, int fr, int fq) const {
        const int row0 = u.pm * BM + wr * 64 + fr, col0 = u.pn * HALF + wc * 32 + 8 * fq;
#pragma unroll
        for (int ai = 0; ai < 2; ++ai)
#pragma unroll
            for (int m = 0; m < 4; ++m) { bf16_t* rowp = O + (size_t)(row0 + ai * HALF + m * 16) * DFF + col0;
                const f32x4 g0 = acc[ai][0][m][0], g1 = acc[ai][0][m][1], u0 = acc[ai][1][m][0], u1 = acc[ai][1][m][1];
                constexpr float NL2E = -1.4426950408889634f;
                float t0 = g0[0] * NL2E, t1 = g0[1] * NL2E, t2 = g0[2] * NL2E, t3 = g0[3] * NL2E, t4 = g1[0] * NL2E, t5 = g1[1] * NL2E, t6 = g1[2] * NL2E, t7 = g1[3] * NL2E;
                TRANS8("v_exp_f32", t);
                t0 += 1.0f; t1 += 1.0f; t2 += 1.0f; t3 += 1.0f; t4 += 1.0f; t5 += 1.0f; t6 += 1.0f; t7 += 1.0f;
                TRANS8("v_rcp_f32", t);
                u32x4 w; w.x = cvt_pk_bf16(g0[0] * u0[0] * t0, g0[1] * u0[1] * t1); w.y = cvt_pk_bf16(g0[2] * u0[2] * t2, g0[3] * u0[3] * t3);
                w.z = cvt_pk_bf16(g1[0] * u1[0] * t4, g1[1] * u1[1] * t5); w.w = cvt_pk_bf16(g1[2] * u1[2] * t6, g1[3] * u1[3] * t7);
                *(u32x4*)rowp = w; }
    }
};
#if YBF16
typedef _Float16 yh16x8 __attribute__((ext_vector_type(8)));
typedef float yf32x8 __attribute__((ext_vector_type(8)));
#endif
struct EpiResid { static constexpr bool PERM = true, HOOK = false; static constexpr int H1 = -1, H2 = -1;
    ytype* Y; const float* gate; float coef; float* slab;
    __device__ __forceinline__ void operator()(const f32x4 (&acc)[2][2][4][2], const Unit& u, int wr, int wc, int fr, int fq) const {
        const int row0 = u.pm * BM + wr * 64 + fr, col0 = u.pn * BM + wc * 32 + 8 * fq; const int grp = u.pm < 64 ? (u.pm >> 4) : 4;
        if (u.part() == 0) {
        const float* gp = gate + (size_t)grp * MODW + col0; f32x4 gv[2][2];
#pragma unroll
        for (int bj = 0; bj < 2; ++bj)
#pragma unroll
            for (int n = 0; n < 2; ++n) gv[bj][n] = *(const f32x4*)(gp + bj * HALF + 4 * n) * coef;
#if YBF16
#pragma unroll
        for (int ai = 0; ai < 2; ++ai) { yh16x8 old[4][2];
#pragma unroll
            for (int m = 0; m < 4; ++m)
#pragma unroll
                for (int bj = 0; bj < 2; ++bj) old[m][bj] = *(const yh16x8*)(Y + (size_t)(row0 + ai * HALF + m * 16) * D + col0 + bj * HALF);
#pragma unroll
            for (int m = 0; m < 4; ++m)
#pragma unroll
                for (int bj = 0; bj < 2; ++bj) { const yf32x8 o = __builtin_convertvector(old[m][bj], yf32x8); const f32x4 a0 = gv[bj][0] * acc[ai][bj][m][0], a1 = gv[bj][1] * acc[ai][bj][m][1];
                    const yf32x8 r = {o[0] + a0[0], o[1] + a0[1], o[2] + a0[2], o[3] + a0[3], o[4] + a1[0], o[5] + a1[1], o[6] + a1[2], o[7] + a1[3]};
                    *(yh16x8*)(Y + (size_t)(row0 + ai * HALF + m * 16) * D + col0 + bj * HALF) = __builtin_convertvector(r, yh16x8); }
            asm volatile("" ::: "memory"); }
#else
#pragma unroll
        for (int ai = 0; ai < 2; ++ai)
#pragma unroll
            for (int m = 0; m < 4; ++m) { float* rowp = Y + (size_t)(row0 + ai * HALF + m * 16) * D + col0;
#pragma unroll
                for (int bj = 0; bj < 2; ++bj)
#pragma unroll
                    for (int n = 0; n < 2; ++n) { float* p = rowp + bj * HALF + 4 * n; const f32x4 o = *(const f32x4*)p; *(f32x4*)p = o + gv[bj][n] * acc[ai][bj][m][n]; }
                asm volatile("" ::: "memory"); }
#endif
        } else {
#pragma unroll
        for (int ai = 0; ai < 2; ++ai)
#pragma unroll
            for (int m = 0; m < 4; ++m) { _Float16* rowp = (_Float16*)slab + ((size_t)(u.part() - 1) * M_CTX + (size_t)(row0 + ai * HALF + m * 16 - M_LAT)) * D + col0;
#pragma unroll
                for (int bj = 0; bj < 2; ++bj) { const f32x4 v0 = acc[ai][bj][m][0], v1 = acc[ai][bj][m][1]; const yf32x8 v = {v0[0], v0[1], v0[2], v0[3], v1[0], v1[1], v1[2], v1[3]};
                    *(yh16x8*)(rowp + bj * HALF) = __builtin_convertvector(v, yh16x8); } }
        }
    }
};
typedef _Float16 eh16x8 __attribute__((ext_vector_type(8)));
typedef float ef32x8 __attribute__((ext_vector_type(8)));
struct EpiInproj { static constexpr bool PERM = true, HOOK = false; static constexpr int H1 = -1, H2 = -1;
    bf16_t* QS; bf16_t* VV; _Float16* ZF; bf16_t* Z2;
    __device__ __forceinline__ void operator()(const f32x4 (&acc)[2][2][4][2], const Unit& u, int wr, int wc, int fr, int fq) const {
        const int row0 = u.pm * BM + wr * 64 + fr;
        if (u.pn < 8) { bf16_t* base = u.pn < 4 ? QS : VV; const float sc = u.pn < 4 ? 0.08838834764831845f : 1.0f; const int col0 = (u.pn & 3) * BM + wc * 32 + 8 * fq;
#pragma unroll
            for (int ai = 0; ai < 2; ++ai)
#pragma unroll
                for (int m = 0; m < 4; ++m) { bf16_t* rowp = base + (size_t)(row0 + ai * HALF + m * 16) * WK + col0;
#pragma unroll
                    for (int bj = 0; bj < 2; ++bj) { const f32x4 v0 = acc[ai][bj][m][0] * sc, v1 = acc[ai][bj][m][1] * sc;
                        u32x4 w; w.x = cvt_pk_bf16(v0[0], v0[1]); w.y = cvt_pk_bf16(v0[2], v0[3]); w.z = cvt_pk_bf16(v1[0], v1[1]); w.w = cvt_pk_bf16(v1[2], v1[3]);
                        *(u32x4*)(rowp + bj * HALF) = w; } }
        } else if (u.pn < 16) { const int col0 = (u.pn - 8) * BM + wc * 32 + 8 * fq;
#pragma unroll
            for (int ai = 0; ai < 2; ++ai)
#pragma unroll
                for (int m = 0; m < 4; ++m) { _Float16* rowp = ZF + (size_t)(row0 + ai * HALF + m * 16) * 2048 + col0;
#pragma unroll
                    for (int bj = 0; bj < 2; ++bj) { const f32x4 v0 = acc[ai][bj][m][0], v1 = acc[ai][bj][m][1];
                        const ef32x8 v = {v0[0], v0[1], v0[2], v0[3], v1[0], v1[1], v1[2], v1[3]}; *(eh16x8*)(rowp + bj * HALF) = __builtin_convertvector(v * -1.4426950408889634f, eh16x8); } }
        } else if (u.pn < 30) { const int col0 = (u.pn - 16) * BM + wc * 32 + 8 * fq;
#pragma unroll
            for (int ai = 0; ai < 2; ++ai)
#pragma unroll
                for (int m = 0; m < 4; ++m) { bf16_t* rowp = Z2 + (size_t)(row0 + ai * HALF + m * 16) * Z2W + col0;
#pragma unroll
                    for (int bj = 0; bj < 2; ++bj) { const f32x4 v0 = acc[ai][bj][m][0], v1 = acc[ai][bj][m][1];
                        u32x4 w; w.x = cvt_pk_bf16(v0[0], v0[1]); w.y = cvt_pk_bf16(v0[2], v0[3]); w.z = cvt_pk_bf16(v1[0], v1[1]); w.w = cvt_pk_bf16(v1[2], v1[3]);
                        *(u32x4*)(rowp + bj * HALF) = w; } }
        } else { const int col0 = (u.pn - 16) * BM + wc * 32 + 8 * fq;
            constexpr float NL2E = -1.4426950408889634f;
#pragma unroll
            for (int ai = 0; ai < 2; ++ai)
#pragma unroll
                for (int m = 0; m < 4; ++m) { bf16_t* rowp = Z2 + (size_t)(row0 + ai * HALF + m * 16) * Z2W + col0;
#pragma unroll
                    for (int bj = 0; bj < 2; ++bj) { const f32x4 v0 = acc[ai][bj][m][0], v1 = acc[ai][bj][m][1];
                        float t0 = __builtin_amdgcn_fmed3f(v0[0], -30.f, 30.f) * NL2E, t1 = __builtin_amdgcn_fmed3f(v0[1], -30.f, 30.f) * NL2E, t2 = __builtin_amdgcn_fmed3f(v0[2], -30.f, 30.f) * NL2E, t3 = __builtin_amdgcn_fmed3f(v0[3], -30.f, 30.f) * NL2E;
                        float t4 = __builtin_amdgcn_fmed3f(v1[0], -30.f, 30.f) * NL2E, t5 = __builtin_amdgcn_fmed3f(v1[1], -30.f, 30.f) * NL2E, t6 = __builtin_amdgcn_fmed3f(v1[2], -30.f, 30.f) * NL2E, t7 = __builtin_amdgcn_fmed3f(v1[3], -30.f, 30.f) * NL2E;
                        TRANS8("v_exp_f32", t);
                        u32x4 w; w.x = cvt_pk_bf16(t0 + 1.0f, t1 + 1.0f); w.y = cvt_pk_bf16(t2 + 1.0f, t3 + 1.0f); w.z = cvt_pk_bf16(t4 + 1.0f, t5 + 1.0f); w.w = cvt_pk_bf16(t6 + 1.0f, t7 + 1.0f);
                        *(u32x4*)(rowp + bj * HALF) = w; } }
        }
    }
};
struct EpiProjF { static constexpr bool PERM = true, HOOK = true; static constexpr int H1 = 16, H2 = 24;
    bf16_t* MRG; const bf16_t* Z2;
    __device__ __forceinline__ void khook(f32x4 (&acc)[2][2][4][2], const Unit& u, int t, int wr, int wc, int fr_, int fq_) const {
        int fr = fr_, fq = fq_; asm volatile("" : "+v"(fr), "+v"(fq));
        const int row0 = u.pm * BM + wr * 64 + fr, col0 = u.pn * BM + wc * 32 + 8 * fq; const int onum = (t == H1) ? Z2_MB : Z2_MC, oden = (t == H1) ? Z2_MA : Z2_MB;
#pragma unroll
        for (int ai = 0; ai < 2; ++ai) { u32x4 wn[4][2], wd[4][2];
#pragma unroll
            for (int m = 0; m < 4; ++m) { const bf16_t* rp = Z2 + (size_t)(row0 + ai * HALF + m * 16) * Z2W + col0;
#pragma unroll
                for (int bj = 0; bj < 2; ++bj) { wn[m][bj] = *(const u32x4*)(rp + onum + bj * HALF); wd[m][bj] = *(const u32x4*)(rp + oden + bj * HALF); } }
#pragma unroll
            for (int m = 0; m < 4; ++m)
#pragma unroll
                for (int bj = 0; bj < 2; ++bj) { const u32x4 a = wn[m][bj], b = wd[m][bj]; f32x4 r0, r1;
                    r0[0] = bflo(a.x) * __builtin_amdgcn_rcpf(bflo(b.x)); r0[1] = bfhi(a.x) * __builtin_amdgcn_rcpf(bfhi(b.x)); r0[2] = bflo(a.y) * __builtin_amdgcn_rcpf(bflo(b.y)); r0[3] = bfhi(a.y) * __builtin_amdgcn_rcpf(bfhi(b.y));
                    r1[0] = bflo(a.z) * __builtin_amdgcn_rcpf(bflo(b.z)); r1[1] = bfhi(a.z) * __builtin_amdgcn_rcpf(bfhi(b.z)); r1[2] = bflo(a.w) * __builtin_amdgcn_rcpf(bflo(b.w)); r1[3] = bfhi(a.w) * __builtin_amdgcn_rcpf(bfhi(b.w));
                    acc[ai][bj][m][0] = acc[ai][bj][m][0] * r0; acc[ai][bj][m][1] = acc[ai][bj][m][1] * r1; }
            asm volatile("" ::: "memory"); }
    }
    __device__ __forceinline__ void operator()(const f32x4 (&acc)[2][2][4][2], const Unit& u, int wr, int wc, int fr, int fq) const {
        const int row0 = u.pm * BM + wr * 64 + fr, col0 = u.pn * BM + wc * 32 + 8 * fq;
#pragma unroll
        for (int ai = 0; ai < 2; ++ai) { u32x4 wc_[4][2];
#pragma unroll
            for (int m = 0; m < 4; ++m)
#pragma unroll
                for (int bj = 0; bj < 2; ++bj) wc_[m][bj] = *(const u32x4*)(Z2 + (size_t)(row0 + ai * HALF + m * 16) * Z2W + Z2_MC + col0 + bj * HALF);
#pragma unroll
            for (int m = 0; m < 4; ++m)
#pragma unroll
                for (int bj = 0; bj < 2; ++bj) { const u32x4 c = wc_[m][bj]; const f32x4 v0 = acc[ai][bj][m][0], v1 = acc[ai][bj][m][1]; u32x4 w;
                    w.x = cvt_pk_bf16(v0[0] * __builtin_amdgcn_rcpf(bflo(c.x)), v0[1] * __builtin_amdgcn_rcpf(bfhi(c.x))); w.y = cvt_pk_bf16(v0[2] * __builtin_amdgcn_rcpf(bflo(c.y)), v0[3] * __builtin_amdgcn_rcpf(bfhi(c.y)));
                    w.z = cvt_pk_bf16(v1[0] * __builtin_amdgcn_rcpf(bflo(c.z)), v1[1] * __builtin_amdgcn_rcpf(bfhi(c.z))); w.w = cvt_pk_bf16(v1[2] * __builtin_amdgcn_rcpf(bflo(c.w)), v1[3] * __builtin_amdgcn_rcpf(bfhi(c.w)));
                    *(u32x4*)(MRG + (size_t)(row0 + ai * HALF + m * 16) * D + col0 + bj * HALF) = w; }
            asm volatile("" ::: "memory"); }
    }
};
}

struct CvItem { const float* W; bf16* dst; int ldw, k0, n0, ldk, drow0, dk0; };
__device__ __forceinline__ void transpose_load(const CvItem& I, float (&wv)[32], int lane) {
#pragma unroll
    for (int i = 0; i < 32; ++i) wv[i] = __builtin_nontemporal_load(I.W + (size_t)(I.k0 + 2 * i + (lane >> 5)) * I.ldw + I.n0 + (lane & 31));
}
__device__ __forceinline__ void transpose_store(const CvItem& I, const float (&wv)[32], LAS float* scr, int lane) {
#pragma unroll
    for (int i = 0; i < 32; ++i) scr[(2 * i + (lane >> 5)) * 33 + (lane & 31)] = wv[i];
    LDS_WAIT(); asm volatile("" ::: "memory");
    const int c = lane & 7;
#pragma unroll
    for (int j = 0; j < 4; ++j) { const int n = (lane >> 3) + 8 * j; const LAS float* s = scr + (8 * c) * 33 + n;
        v4u o; o.x = pk2(s[0 * 33], s[1 * 33]); o.y = pk2(s[2 * 33], s[3 * 33]); o.z = pk2(s[4 * 33], s[5 * 33]); o.w = pk2(s[6 * 33], s[7 * 33]);
        __builtin_nontemporal_store(o, (GAS v4u*)(I.dst + (size_t)(I.drow0 + n) * I.ldk + I.dk0 + I.k0 + 8 * c)); }
    LDS_WAIT(); asm volatile("" ::: "memory");
}

enum { IX = 0, IC, ICTX, ICCTX, IWMOD, IBMOD, INORMG, IFINALG, IWGATE, IWUP, IWDOWN, IWIN, ILB, IANORM, ILNG, ILNB, IWS, IBS, ICONV, IWPA, IWPB, IWPC, IWOUT };
#define INP(k) (kargs()->in[(k)])

constexpr int CV_I_FF = (D / 64) * (DFF / 32);
constexpr int CV_I_IN = (D / 64) * (INW / 32);
constexpr int CV_I_PA = (1024 / 64) * (D / 32), CV_I_PB = (512 / 64) * (D / 32);
constexpr int CV_I_WO = (D / 64) * (D / 32);
constexpr int CV_PER_L = 6 * CV_I_FF + CV_I_IN + CV_I_PA + 2 * CV_I_PB + CV_I_WO;
__device__ __forceinline__ CvItem cv_decode(int l, int r) {
    unsigned char* ws = kargs()->ws; CvItem I;
    if (r < 6 * CV_I_FF) { const int j = r / (3 * CV_I_FF); r %= 3 * CV_I_FF; const int which = r / CV_I_FF; r %= CV_I_FF; const size_t lj = (size_t)(l * 2 + j);
        if (which < 2) { const int nblk = DFF / 32, kb = r / nblk, nb = r % nblk, n0 = 32 * nb;
            I.W = (which == 0 ? INP(IWGATE) : INP(IWUP)) + lj * D * DFF; I.ldw = DFF; I.k0 = 64 * kb; I.n0 = n0; I.dst = (bf16*)(ws + WS_WGU) + lj * (size_t)(2 * DFF) * D; I.ldk = D; I.drow0 = 256 * (n0 >> 7) + (n0 & 127) + 128 * which; I.dk0 = 0;
        } else { const int nblk = D / 32, kb = r / nblk, nb = r % nblk;
            I.W = INP(IWDOWN) + lj * DFF * D; I.ldw = D; I.k0 = 64 * kb; I.n0 = 32 * nb; I.dst = (bf16*)(ws + WS_WD) + lj * (size_t)D * DFF; I.ldk = DFF; I.drow0 = 32 * nb; I.dk0 = 0; }
        return I; }
    r -= 6 * CV_I_FF;
    if (r < CV_I_IN) { const int nblk = INW / 32, kb = r / nblk, nb = r % nblk; I.W = INP(IWIN) + (size_t)l * D * INW; I.ldw = INW; I.k0 = 64 * kb; I.n0 = 32 * nb; I.dst = (bf16*)(ws + WS_WIN) + (size_t)l * INW * D; I.ldk = D; I.drow0 = 32 * nb; I.dk0 = 0; return I; }
    r -= CV_I_IN;
    bf16* WP = (bf16*)(ws + WS_WP) + (size_t)l * D * 2048; const int nblk = D / 32;
    if (r < CV_I_PA) { const int kb = r / nblk, nb = r % nblk; I.W = INP(IWPA) + (size_t)l * 1024 * D; I.ldw = D; I.k0 = 64 * kb; I.n0 = 32 * nb; I.dst = WP; I.ldk = 2048; I.drow0 = 32 * nb; I.dk0 = 0; return I; }
    r -= CV_I_PA;
    if (r < CV_I_PB) { const int kb = r / nblk, nb = r % nblk; I.W = INP(IWPB) + (size_t)l * 512 * D; I.ldw = D; I.k0 = 64 * kb; I.n0 = 32 * nb; I.dst = WP; I.ldk = 2048; I.drow0 = 32 * nb; I.dk0 = 1024; return I; }
    r -= CV_I_PB;
    if (r < CV_I_PB) { const int kb = r / nblk, nb = r % nblk; I.W = INP(IWPC) + (size_t)l * 512 * D; I.ldw = D; I.k0 = 64 * kb; I.n0 = 32 * nb; I.dst = WP; I.ldk = 2048; I.drow0 = 32 * nb; I.dk0 = 1536; return I; }
    r -= CV_I_PB;
    { const int kb = r / nblk, nb = r % nblk; I.W = INP(IWOUT) + (size_t)l * D * D; I.ldw = D; I.k0 = 64 * kb; I.n0 = 32 * nb; I.dst = (bf16*)(ws + WS_WO) + (size_t)l * D * D; I.ldk = D; I.drow0 = 32 * nb; I.dk0 = 0; }
    return I;
}
__device__ __forceinline__ void convert_run(int l, int first, int end, int stride, LAS float* scr, int lane) {
#pragma unroll 1
    for (int it = first; it < end; it += 2 * stride) { const bool two = it + stride < end;
        const CvItem A = cv_decode(l, it), B = cv_decode(l, two ? it + stride : it);
        float wa[32], wb[32];
        transpose_load(A, wa, lane); if (two) transpose_load(B, wb, lane);
        transpose_store(A, wa, scr, lane); if (two) transpose_store(B, wb, scr, lane); }
}
constexpr int CV_Q_GU = 128, CV_Q_IN = 64, CV_Q_PJ = 96;
__device__ __forceinline__ int cv_nidle(int nwg, int G) { const int rem = nwg % G; return rem ? G - rem : 0; }
__device__ __forceinline__ int cv_base(int slot, int G) {
    const int n_gu = cv_nidle((M / 256) * (2 * DFF / 256), G), n_in = cv_nidle(64 * 54 + 4 * 54, G), n_pj = cv_nidle((M / 256) * (D / 256), G);
    int b = 0; if (slot > 0) b += n_gu * CV_Q_GU; if (slot > 1) b += n_in * CV_Q_IN; if (slot > 2) b += n_pj * CV_Q_PJ; if (slot > 3) b += n_gu * CV_Q_GU; return b < CV_PER_L ? b : CV_PER_L;
}
__device__ __forceinline__ void convert_slot(int l, int slot, int nwg, int q) {
    int G = gridDim.x, c = blockIdx.x; asm volatile("" : "+s"(G), "+s"(c));
    const int rem = nwg % G; if (rem == 0 || c < rem) return;
    const Frame F = mkframe(); LAS float* scr = (LAS float*)(F.lds + F.wave * 16384);
    const int first = cv_base(slot, G) + (c - rem) * q; int end = first + q; if (end > CV_PER_L) end = CV_PER_L;
    convert_run(l, first + F.wave, end, 8, scr, F.lane);
}
__device__ __forceinline__ void convert_rest(int l) {
    const Frame F = mkframe(); LAS float* scr = (LAS float*)(F.lds + F.wave * 16384);
    const int gw = F.vcu * 8 + F.wave, NGW = F.G * 8;
    convert_run(l, cv_base(4, F.G) + gw, CV_PER_L, NGW, scr, F.lane);
}

__device__ __forceinline__ void phase_prologue() {
    const Frame F = mkframe(); unsigned char* ws = F.ws;
    const int gw = F.vcu * 8 + F.wave, NGW = F.G * 8;
    { ytype* Y = (ytype*)(ws + WS_Y);
      for (int m = gw; m < M; m += NGW) { const float* src = m < M_LAT ? INP(IX) + (size_t)m * D : INP(ICTX) + (size_t)(m - M_LAT) * D; const GAS f32x4* s = (const GAS f32x4*)src + F.lane;
#pragma unroll
          for (int j = 0; j < 8; ++j) y_st4(Y + (size_t)m * D + 4 * (64 * j + F.lane), s[64 * j]); } }
    if (blockIdx.x == 0) { float* LB = (float*)(ws + WS_LB);
        for (int i = F.tid; i < 2 * WK; i += 512) { float lg[DEPTH], mx = -1e30f;
#pragma unroll
            for (int l = 0; l < DEPTH; ++l) { lg[l] = INP(ILB)[l * 2 * WK + i]; mx = fmaxf(mx, lg[l]); }
            float s = 0.f;
#pragma unroll
            for (int l = 0; l < DEPTH; ++l) { lg[l] = __expf(lg[l] - mx); s += lg[l]; }
            float cum = 0.f; const float inv = 1.0f / s;
#pragma unroll
            for (int l = 0; l < DEPTH; ++l) { LB[l * 2 * WK + i] = cum; if (l + 1 < DEPTH) cum += lg[l + 1] * inv; } } }
    { LAS float* sc = (LAS float*)F.lds;
      LAS float* red = (LAS float*)(F.lds + 5 * D * 4);
      for (int i = F.tid; i < NGRP * D; i += 512) { const int g = i / D, k = i % D; const float v = g < 4 ? INP(IC)[g * D + k] : INP(ICCTX)[k]; sc[i] = siluf_(v); }
      __syncthreads();
      float* MOD = (float*)(ws + WS_MOD);
      constexpr int NU = DEPTH * (MODW / 128);
      for (int u = F.vcu; u < NU; u += F.G) { const int l = u / (MODW / 128), n0 = (u % (MODW / 128)) * 128;
          const float* Wp = INP(IWMOD) + (size_t)l * D * MODW + n0 + 2 * F.lane;
          float a0[NGRP], a1[NGRP];
#pragma unroll
          for (int g = 0; g < NGRP; ++g) { a0[g] = 0.f; a1[g] = 0.f; }
          const int kb = F.wave * 256;
#pragma unroll 16
          for (int k = kb; k < kb + 256; ++k) { typedef float f32x2v __attribute__((ext_vector_type(2))); const f32x2v w = __builtin_nontemporal_load((const GAS f32x2v*)(Wp + (size_t)k * MODW));
#pragma unroll
              for (int g = 0; g < NGRP; ++g) { const float s = sc[g * D + k]; a0[g] += s * w.x; a1[g] += s * w.y; } }
#pragma unroll
          for (int g = 0; g < NGRP; ++g) { red[(F.wave * NGRP + g) * 128 + 2 * F.lane] = a0[g]; red[(F.wave * NGRP + g) * 128 + 2 * F.lane + 1] = a1[g]; }
          __syncthreads();
          for (int i = F.tid; i < NGRP * 128; i += 512) { const int g = i / 128, n = i % 128; float s = 0.f;
#pragma unroll
              for (int w = 0; w < 8; ++w) s += red[(w * NGRP + g) * 128 + n];
              MOD[((size_t)l * NGRP + g) * MODW + n0 + n] = s + INP(IBMOD)[l * MODW + n0 + n]; }
          __syncthreads(); }
    }
    __syncthreads();
    { LAS float* scr = (LAS float*)(F.lds + F.wave * 16384);
      convert_run(0, gw, CV_PER_L, NGW, scr, F.lane); }
}

__device__ __forceinline__ float wave_sum_fast(float x) {
    x = row16_sum(x);
    const float a = __builtin_bit_cast(float, __builtin_amdgcn_readlane(__builtin_bit_cast(int, x), 0)), b = __builtin_bit_cast(float, __builtin_amdgcn_readlane(__builtin_bit_cast(int, x), 16));
    const float c = __builtin_bit_cast(float, __builtin_amdgcn_readlane(__builtin_bit_cast(int, x), 32)), d = __builtin_bit_cast(float, __builtin_amdgcn_readlane(__builtin_bit_cast(int, x), 48));
    return (a + b) + (c + d);
}
__device__ __forceinline__ void phase_norm(int l, int which, int mlim, int red, int rgate_l, int rgate_idx, float rcoef) {
    const Frame F = mkframe(); ytype* Y = (ytype*)(F.ws + WS_Y); bf16* H = (bf16*)(F.ws + WS_H);
    const float* g = INP(INORMG) + (size_t)(l * 3 + which) * D; const float* mod_l = (const float*)(F.ws + WS_MOD) + (size_t)l * NGRP * MODW; const int shift_idx = 3 * which;
    const int gw = F.vcu * 8 + F.wave, NGW = F.G * 8, lane = F.lane;
    typedef pg8::eh16x8 h8; typedef pg8::ef32x8 f8;
    f32x4 gs[4][2], sh[4][2];
    auto load_vecs = [&](int grp) { const float* mp = mod_l + (size_t)grp * MODW + shift_idx * D;
#pragma unroll
        for (int j = 0; j < 4; ++j)
#pragma unroll
            for (int e = 0; e < 2; ++e) { const int c = 8 * lane + 512 * j + 4 * e; gs[j][e] = *(const GAS f32x4*)(g + c) * (1.0f + *(const GAS f32x4*)(mp + D + c)); sh[j][e] = *(const GAS f32x4*)(mp + c); } };
    auto finish_row = [&](int m, f8 (&v)[4]) { float ss = 0.f;
#pragma unroll
        for (int j = 0; j < 4; ++j)
#pragma unroll
            for (int e = 0; e < 8; ++e) ss += v[j][e] * v[j][e];
        const float rstd = 1.0f / sqrtf(wave_sum_fast(ss) * (1.0f / D) + EPS);
#pragma unroll
        for (int j = 0; j < 4; ++j) { v4u o; const f32x4 a = (f32x4){v[j][0], v[j][1], v[j][2], v[j][3]} * rstd * gs[j][0] + sh[j][0], b = (f32x4){v[j][4], v[j][5], v[j][6], v[j][7]} * rstd * gs[j][1] + sh[j][1];
            o.x = pk2(a[0], a[1]); o.y = pk2(a[2], a[3]); o.z = pk2(b[0], b[1]); o.w = pk2(b[2], b[3]); *(GAS v4u*)(H + (size_t)m * D + 8 * lane + 512 * j) = o; } };
    if (NGW * 8 == M_LAT) {
        load_vecs(gw >> 9);
        h8 cur[4], nxt[4];
#pragma unroll
        for (int j = 0; j < 4; ++j) cur[j] = *(const GAS h8*)(Y + (size_t)(8 * gw) * D + 8 * lane + 512 * j);
#pragma unroll 1
        for (int r = 0; r < 8; ++r) { const int m = 8 * gw + r, mn = r < 7 ? m + 1 : m;
#pragma unroll
            for (int j = 0; j < 4; ++j) nxt[j] = *(const GAS h8*)(Y + (size_t)mn * D + 8 * lane + 512 * j);
            f8 v[4];
#pragma unroll
            for (int j = 0; j < 4; ++j) v[j] = __builtin_convertvector(cur[j], f8);
            finish_row(m, v);
#pragma unroll
            for (int j = 0; j < 4; ++j) cur[j] = nxt[j]; }
    } else {
        for (int m = gw; m < M_LAT; m += NGW) { load_vecs(m >> 12); f8 v[4];
#pragma unroll
            for (int j = 0; j < 4; ++j) v[j] = __builtin_convertvector(*(const GAS h8*)(Y + (size_t)m * D + 8 * lane + 512 * j), f8);
            finish_row(m, v); } }
    if (mlim > M_LAT) {
        load_vecs(4);
        for (int m = M_LAT + (gw >> 1) + ((gw & 1) ? (NGW >> 1) : 0); m < mlim; m += NGW) { f8 v[4];
#pragma unroll
            for (int j = 0; j < 4; ++j) v[j] = __builtin_convertvector(*(const GAS h8*)(Y + (size_t)m * D + 8 * lane + 512 * j), f8);
            if (red) { const _Float16* sl = (const _Float16*)(F.ws + WS_MF32) + (size_t)(m - M_LAT) * D; const float* rg = (const float*)(F.ws + WS_MOD) + ((size_t)rgate_l * NGRP + 4) * MODW + rgate_idx * D;
#pragma unroll
                for (int jh = 0; jh < 2; ++jh) { h8 part[2][8];
#pragma unroll
                    for (int jj = 0; jj < 2; ++jj)
#pragma unroll
                        for (int p = 0; p < 8; ++p) part[jj][p] = *(const GAS h8*)(sl + (size_t)p * M_CTX * D + 8 * lane + 512 * (2 * jh + jj));
#pragma unroll
                    for (int jj = 0; jj < 2; ++jj) { const int j = 2 * jh + jj, c = 8 * lane + 512 * j; f8 a = __builtin_convertvector(part[jj][0], f8);
#pragma unroll
                        for (int p = 1; p < 8; ++p) a = a + __builtin_convertvector(part[jj][p], f8);
                        const f32x4 g0 = *(const GAS f32x4*)(rg + c) * rcoef, g1 = *(const GAS f32x4*)(rg + c + 4) * rcoef;
#pragma unroll
                        for (int e = 0; e < 4; ++e) { v[j][e] += g0[e] * a[e]; v[j][4 + e] += g1[e] * a[4 + e]; }
                        *(GAS h8*)(Y + (size_t)m * D + c) = __builtin_convertvector(v[j], h8); }
                    asm volatile("" ::: "memory"); } }
            finish_row(m, v); } }
}

__device__ __forceinline__ void phase_final() {
    const Frame F = mkframe(); const ytype* Y = (const ytype*)(F.ws + WS_Y); float* out = kargs()->out; const float* g = INP(IFINALG);
    const int gw = F.vcu * 8 + F.wave, NGW = F.G * 8, lane = F.lane;
    typedef pg8::eh16x8 h8; typedef pg8::ef32x8 f8;
    f32x4 gs[4][2];
#pragma unroll
    for (int j = 0; j < 4; ++j)
#pragma unroll
        for (int e = 0; e < 2; ++e) gs[j][e] = *(const GAS f32x4*)(g + 8 * lane + 512 * j + 4 * e);
    const int per = (M_LAT + NGW - 1) / NGW, m0 = gw * per, m1 = (m0 + per < M_LAT) ? m0 + per : M_LAT;
    if (m0 >= m1) return;
    h8 cur[4], nxt[4];
#pragma unroll
    for (int j = 0; j < 4; ++j) cur[j] = *(const GAS h8*)(Y + (size_t)m0 * D + 8 * lane + 512 * j);
#pragma unroll 1
    for (int m = m0; m < m1; ++m) { const int mn = m + 1 < m1 ? m + 1 : m;
#pragma unroll
        for (int j = 0; j < 4; ++j) nxt[j] = *(const GAS h8*)(Y + (size_t)mn * D + 8 * lane + 512 * j);
        f8 v[4]; float ss = 0.f;
#pragma unroll
        for (int j = 0; j < 4; ++j) { v[j] = __builtin_convertvector(cur[j], f8);
#pragma unroll
            for (int e = 0; e < 8; ++e) ss += v[j][e] * v[j][e]; }
        const float rstd = 1.0f / sqrtf(wave_sum_fast(ss) * (1.0f / D) + EPS);
#pragma unroll
        for (int j = 0; j < 4; ++j) { float* o = out + (size_t)m * D + 8 * lane + 512 * j;
            *(GAS f32x4*)o = (f32x4){v[j][0], v[j][1], v[j][2], v[j][3]} * rstd * gs[j][0]; *(GAS f32x4*)(o + 4) = (f32x4){v[j][4], v[j][5], v[j][6], v[j][7]} * rstd * gs[j][1]; }
#pragma unroll
        for (int j = 0; j < 4; ++j) cur[j] = nxt[j]; }
}

struct ElemC { float lg[8], lbv[8], cw0[8], cw1[8], cw2[8]; };
__device__ __forceinline__ void elem_vn(const v4u raw, const ElemC& C, bf16* VN, int m, int lane) {
    float x[8];
    x[0] = gelu_tanh(bflo(raw.x)); x[1] = gelu_tanh(bfhi(raw.x)); x[2] = gelu_tanh(bflo(raw.y)); x[3] = gelu_tanh(bfhi(raw.y));
    x[4] = gelu_tanh(bflo(raw.z)); x[5] = gelu_tanh(bfhi(raw.z)); x[6] = gelu_tanh(bflo(raw.w)); x[7] = gelu_tanh(bfhi(raw.w));
    float s = 0.f;
#pragma unroll
    for (int e = 0; e < 8; ++e) s += x[e];
    const float mean = wave_sum_fast(s) * (1.0f / BW); float q = 0.f;
#pragma unroll
    for (int e = 0; e < 8; ++e) { x[e] -= mean; q += x[e] * x[e]; }
    const float rstd = 1.0f / sqrtf(wave_sum_fast(q) * (1.0f / BW) + EPS); float y[8];
#pragma unroll
    for (int e = 0; e < 8; ++e) y[e] = x[e] * rstd * C.lg[e] + C.lbv[e];
    v4u o; o.x = pk2(y[0], y[1]); o.y = pk2(y[2], y[3]); o.z = pk2(y[4], y[5]); o.w = pk2(y[6], y[7]);
    *(GAS v4u*)(VN + (size_t)m * BW + 8 * lane) = o;
}
__device__ __forceinline__ void elem_t(const v4u hc, const v4u gc, float zz, float (&t)[8]) {
    t[0] = zz * bflo(hc.x) * bflo(gc.x); t[1] = zz * bfhi(hc.x) * bfhi(gc.x); t[2] = zz * bflo(hc.y) * bflo(gc.y); t[3] = zz * bfhi(hc.y) * bfhi(gc.y);
    t[4] = zz * bflo(hc.z) * bflo(gc.z); t[5] = zz * bfhi(hc.z) * bfhi(gc.z); t[6] = zz * bflo(hc.w) * bflo(gc.w); t[7] = zz * bfhi(hc.w) * bfhi(gc.w);
}
__device__ __forceinline__ void elem_conv(const float (&t0)[8], const float (&t1)[8], const float (&t2)[8], const v4u gbr, const ElemC& C, bf16* YABC, int m, int lane) {
    float gb[8], y[8];
    gb[0] = bflo(gbr.x); gb[1] = bfhi(gbr.x); gb[2] = bflo(gbr.y); gb[3] = bfhi(gbr.y); gb[4] = bflo(gbr.z); gb[5] = bfhi(gbr.z); gb[6] = bflo(gbr.w); gb[7] = bfhi(gbr.w);
#pragma unroll
    for (int e = 0; e < 8; ++e) y[e] = gb[e] * (C.cw0[e] * t0[e] + C.cw1[e] * t1[e] + C.cw2[e] * t2[e]);
    v4u o; o.x = pk2(y[0], y[1]); o.y = pk2(y[2], y[3]); o.z = pk2(y[4], y[5]); o.w = pk2(y[6], y[7]);
    *(GAS v4u*)(YABC + (size_t)m * 2048 + 1536 + 8 * lane) = o;
}
__device__ __forceinline__ void elem_row(const bf16* Z2, const ElemC& C, bf16* VN, bf16* YABC, int m, int lane) {
    bool hp, hn; if (m < M_LAT) { const int p = m & 63; hp = p != 0; hn = p != 63; } else { const int p = (m - M_LAT) & 255; hp = p != 0; hn = p != 255; }
    const size_t mp = (size_t)(hp ? m - 1 : m), mn = (size_t)(hn ? m + 1 : m);
    const v4u raw = *(const GAS v4u*)(Z2 + (size_t)m * Z2W + Z2_V + 8 * lane);
    const v4u hc0 = *(const GAS v4u*)(Z2 + mp * Z2W + Z2_HC + 8 * lane), gc0 = *(const GAS v4u*)(Z2 + mp * Z2W + Z2_GC + 8 * lane);
    const v4u hc1 = *(const GAS v4u*)(Z2 + (size_t)m * Z2W + Z2_HC + 8 * lane), gc1 = *(const GAS v4u*)(Z2 + (size_t)m * Z2W + Z2_GC + 8 * lane);
    const v4u hc2 = *(const GAS v4u*)(Z2 + mn * Z2W + Z2_HC + 8 * lane), gc2 = *(const GAS v4u*)(Z2 + mn * Z2W + Z2_GC + 8 * lane);
    const v4u gbr = *(const GAS v4u*)(Z2 + (size_t)m * Z2W + Z2_GB + 8 * lane);
    elem_vn(raw, C, VN, m, lane);
    float t0[8], t1[8], t2[8]; elem_t(hc0, gc0, hp ? 1.0f : 0.0f, t0); elem_t(hc1, gc1, 1.0f, t1); elem_t(hc2, gc2, hn ? 1.0f : 0.0f, t2);
    elem_conv(t0, t1, t2, gbr, C, YABC, m, lane);
}
__device__ __forceinline__ void phase_mix_elem(int l) {
    const Frame F = mkframe(); unsigned char* ws = F.ws;
    const bf16* Z2 = (const bf16*)(ws + WS_Z2);
    bf16* VN = (bf16*)(ws + WS_VN); bf16* YABC = (bf16*)(ws + WS_YABC);
    const int gw = F.vcu * 8 + F.wave, NGW = F.G * 8, lane = F.lane;
    ElemC C;
    { const float* gp = INP(ILNG) + l * BW + 8 * lane; const float* bp = INP(ILNB) + l * BW + 8 * lane; const float* cw = INP(ICONV) + (size_t)l * 3 * CWD + 8 * lane;
#pragma unroll
      for (int e = 0; e < 8; ++e) { C.lg[e] = gp[e]; C.lbv[e] = bp[e]; C.cw0[e] = cw[e]; C.cw1[e] = cw[CWD + e]; C.cw2[e] = cw[2 * CWD + e]; } }
    if (NGW * 8 == M_LAT) {
#pragma unroll 1
        for (int h = 0; h < 4; ++h) { const int r0 = 8 * gw + 2 * h; const bool vp = (r0 & 63) != 0, vn = ((r0 + 1) & 63) != 63;
            v4u hc[4], gc[4], vv[2], gb[2];
#pragma unroll
            for (int i = 0; i < 4; ++i) { const int row = (i == 0 && !vp) ? r0 : (i == 3 && !vn) ? r0 + 1 : r0 - 1 + i;
                hc[i] = *(const GAS v4u*)(Z2 + (size_t)row * Z2W + Z2_HC + 8 * lane); gc[i] = *(const GAS v4u*)(Z2 + (size_t)row * Z2W + Z2_GC + 8 * lane); }
#pragma unroll
            for (int i = 0; i < 2; ++i) { vv[i] = *(const GAS v4u*)(Z2 + (size_t)(r0 + i) * Z2W + Z2_V + 8 * lane); gb[i] = *(const GAS v4u*)(Z2 + (size_t)(r0 + i) * Z2W + Z2_GB + 8 * lane); }
            float t[4][8];
#pragma unroll
            for (int i = 0; i < 4; ++i) elem_t(hc[i], gc[i], (i == 0 && !vp) || (i == 3 && !vn) ? 0.0f : 1.0f, t[i]);
#pragma unroll
            for (int i = 0; i < 2; ++i) { elem_vn(vv[i], C, VN, r0 + i, lane); elem_conv(t[i], t[i + 1], t[i + 2], gb[i], C, YABC, r0 + i, lane); } }
    } else {
        for (int m = gw; m < M_LAT; m += NGW) elem_row(Z2, C, VN, YABC, m, lane); }
    for (int m = M_LAT + (gw >> 1) + ((gw & 1) ? (NGW >> 1) : 0); m < M; m += NGW) elem_row(Z2, C, VN, YABC, m, lane);
}

template <int N> __device__ __forceinline__ float row_shl1(float v) { return __builtin_bit_cast(float, __builtin_amdgcn_update_dpp(0x3f800000, __builtin_bit_cast(int, v), 0x100 + N, 0xf, 0xf, false)); }
template <int N> __device__ __forceinline__ float row_shr1(float v) { return __builtin_bit_cast(float, __builtin_amdgcn_update_dpp(0x3f800000, __builtin_bit_cast(int, v), 0x110 + N, 0xf, 0xf, false)); }
template <int N> __device__ __forceinline__ float row_shr(float v) { return __builtin_bit_cast(float, __builtin_amdgcn_update_dpp(0, __builtin_bit_cast(int, v), 0x110 + N, 0xf, 0xf, true)); }
__device__ __forceinline__ float row16_prod(float x) { x *= dppf<0xB1>(x); x *= dppf<0x4E>(x); x *= dppf<0x124>(x); x *= dppf<0x128>(x); return x; }
__device__ __forceinline__ void phase_hgrn_prep(int l) {
    const Frame F = mkframe(); unsigned char* ws = F.ws;
    const _Float16* ZF = (const _Float16*)(ws + WS_ZF); const bf16* QS = (const bf16*)(ws + WS_QS); const float* LB = (const float*)(ws + WS_LB) + (size_t)l * 2 * WK;
    const int gw = F.vcu * 8 + F.wave, NGW = F.G * 8, lane = F.lane, fr = lane & 15, cq = lane >> 4;
    constexpr int NIT = (M / 32) * 32;
    const int per = (NIT + NGW - 1) / NGW, it0 = gw * per, it1 = (it0 + per < NIT) ? it0 + per : NIT;
#pragma unroll 2
    for (int it = it0; it < it1; ++it) { const int sc = it >> 5, jj = it & 31; const size_t rlo = (size_t)sc * 32 + fr, rhi = rlo + 16; const int c0 = 32 * jj + 8 * cq;
        const v4u qlo_r = *(const GAS v4u*)(QS + rlo * WK + c0), qhi_r = *(const GAS v4u*)(QS + rhi * WK + c0);
        const float qlo[8] = {bflo(qlo_r.x), bfhi(qlo_r.x), bflo(qlo_r.y), bfhi(qlo_r.y), bflo(qlo_r.z), bfhi(qlo_r.z), bflo(qlo_r.w), bfhi(qlo_r.w)};
        const float qhi[8] = {bflo(qhi_r.x), bfhi(qhi_r.x), bflo(qhi_r.y), bfhi(qhi_r.y), bflo(qhi_r.z), bfhi(qhi_r.z), bflo(qhi_r.w), bfhi(qhi_r.w)};
#pragma unroll
        for (int dir = 0; dir < 2; ++dir) {
            const pg8::ef32x8 zlo = __builtin_convertvector(*(const GAS pg8::eh16x8*)(ZF + rlo * 2048 + dir * WK + c0), pg8::ef32x8), zhi = __builtin_convertvector(*(const GAS pg8::eh16x8*)(ZF + rhi * 2048 + dir * WK + c0), pg8::ef32x8);
            const f32x4 b0 = *(const GAS f32x4*)(LB + dir * WK + c0), b1 = *(const GAS f32x4*)(LB + dir * WK + c0 + 4);
            float qtl[8], qth[8], ktl[8], kth[8], gt[8];
            float fl0, fl1, fl2, fl3, fl4, fl5, fl6, fl7, fh0, fh1, fh2, fh3, fh4, fh5, fh6, fh7;
#define HP_F(e_, dl, dh) { const float lb = (e_) < 4 ? b0[(e_) & 3] : b1[(e_) & 3]; const float oml = 1.0f - lb; dl = fmaxf(__builtin_fmaf(oml, __builtin_amdgcn_rcpf(1.0f + __builtin_amdgcn_exp2f(zlo[e_])), lb), 1e-30f); dh = fmaxf(__builtin_fmaf(oml, __builtin_amdgcn_rcpf(1.0f + __builtin_amdgcn_exp2f(zhi[e_])), lb), 1e-30f); }
            HP_F(0, fl0, fh0) HP_F(1, fl1, fh1) HP_F(2, fl2, fh2) HP_F(3, fl3, fh3) HP_F(4, fl4, fh4) HP_F(5, fl5, fh5) HP_F(6, fl6, fh6) HP_F(7, fl7, fh7)
#undef HP_F
#define HP_STEP(ctrl) "v_mul_f32_dpp %0, %0, %0 " ctrl " row_mask:0xf bank_mask:0xf\n\tv_mul_f32_dpp %1, %1, %1 " ctrl " row_mask:0xf bank_mask:0xf\n\tv_mul_f32_dpp %2, %2, %2 " ctrl " row_mask:0xf bank_mask:0xf\n\t" \
                      "v_mul_f32_dpp %3, %3, %3 " ctrl " row_mask:0xf bank_mask:0xf\n\tv_mul_f32_dpp %4, %4, %4 " ctrl " row_mask:0xf bank_mask:0xf\n\tv_mul_f32_dpp %5, %5, %5 " ctrl " row_mask:0xf bank_mask:0xf\n\t" \
                      "v_mul_f32_dpp %6, %6, %6 " ctrl " row_mask:0xf bank_mask:0xf\n\tv_mul_f32_dpp %7, %7, %7 " ctrl " row_mask:0xf bank_mask:0xf\n\t"
#define HP_OPS8(a) "+v"(a##0), "+v"(a##1), "+v"(a##2), "+v"(a##3), "+v"(a##4), "+v"(a##5), "+v"(a##6), "+v"(a##7)
#define HP_PROD8(a) asm("s_nop 1\n\t" HP_STEP("quad_perm:[1,0,3,2]") HP_STEP("quad_perm:[2,3,0,1]") HP_STEP("row_ror:4") HP_STEP("row_ror:8") "s_nop 1" : HP_OPS8(a))
#define HP_SCANL8(a) asm("s_nop 1\n\t" HP_STEP("row_shl:1") HP_STEP("row_shl:2") HP_STEP("row_shl:4") HP_STEP("row_shl:8") "s_nop 1" : HP_OPS8(a))
#define HP_SCANR8(a) asm("s_nop 1\n\t" HP_STEP("row_shr:1") HP_STEP("row_shr:2") HP_STEP("row_shr:4") HP_STEP("row_shr:8") "s_nop 1" : HP_OPS8(a))
#define HP_FIN8(ctrl, X, p, m) asm("s_nop 1\n\t" \
                "v_mul_f32_dpp %0, %8, %16 " ctrl " row_mask:0xf bank_mask:0xf\n\tv_mul_f32_dpp %1, %9, %17 " ctrl " row_mask:0xf bank_mask:0xf\n\tv_mul_f32_dpp %2, %10, %18 " ctrl " row_mask:0xf bank_mask:0xf\n\t" \
                "v_mul_f32_dpp %3, %11, %19 " ctrl " row_mask:0xf bank_mask:0xf\n\tv_mul_f32_dpp %4, %12, %20 " ctrl " row_mask:0xf bank_mask:0xf\n\tv_mul_f32_dpp %5, %13, %21 " ctrl " row_mask:0xf bank_mask:0xf\n\t" \
                "v_mul_f32_dpp %6, %14, %22 " ctrl " row_mask:0xf bank_mask:0xf\n\tv_mul_f32_dpp %7, %15, %23 " ctrl " row_mask:0xf bank_mask:0xf\n\ts_nop 1" \
                : "+&v"(X##0), "+&v"(X##1), "+&v"(X##2), "+&v"(X##3), "+&v"(X##4), "+&v"(X##5), "+&v"(X##6), "+&v"(X##7) : "v"(p##0), "v"(p##1), "v"(p##2), "v"(p##3), "v"(p##4), "v"(p##5), "v"(p##6), "v"(p##7), "v"(m##0), "v"(m##1), "v"(m##2), "v"(m##3), "v"(m##4), "v"(m##5), "v"(m##6), "v"(m##7))
            float tl0 = fl0, tl1 = fl1, tl2 = fl2, tl3 = fl3, tl4 = fl4, tl5 = fl5, tl6 = fl6, tl7 = fl7, th0 = fh0, th1 = fh1, th2 = fh2, th3 = fh3, th4 = fh4, th5 = fh5, th6 = fh6, th7 = fh7;
            HP_PROD8(tl); HP_PROD8(th);
            float pl0 = fl0, pl1 = fl1, pl2 = fl2, pl3 = fl3, pl4 = fl4, pl5 = fl5, pl6 = fl6, pl7 = fl7, ph0 = fh0, ph1 = fh1, ph2 = fh2, ph3 = fh3, ph4 = fh4, ph5 = fh5, ph6 = fh6, ph7 = fh7;
            const float one0 = 1.0f, one1 = 1.0f, one2 = 1.0f, one3 = 1.0f, one4 = 1.0f, one5 = 1.0f, one6 = 1.0f, one7 = 1.0f;
            float Xl0, Xl1, Xl2, Xl3, Xl4, Xl5, Xl6, Xl7, Xh0, Xh1, Xh2, Xh3, Xh4, Xh5, Xh6, Xh7;
            if (dir == 0) { HP_SCANL8(pl); HP_SCANL8(ph);
                Xl0 = th0; Xl1 = th1; Xl2 = th2; Xl3 = th3; Xl4 = th4; Xl5 = th5; Xl6 = th6; Xl7 = th7; HP_FIN8("row_shl:1", Xl, pl, th);
                Xh0 = 1.0f; Xh1 = 1.0f; Xh2 = 1.0f; Xh3 = 1.0f; Xh4 = 1.0f; Xh5 = 1.0f; Xh6 = 1.0f; Xh7 = 1.0f; HP_FIN8("row_shl:1", Xh, ph, one); }
            else { HP_SCANR8(pl); HP_SCANR8(ph);
                Xl0 = 1.0f; Xl1 = 1.0f; Xl2 = 1.0f; Xl3 = 1.0f; Xl4 = 1.0f; Xl5 = 1.0f; Xl6 = 1.0f; Xl7 = 1.0f; HP_FIN8("row_shr:1", Xl, pl, one);
                Xh0 = tl0; Xh1 = tl1; Xh2 = tl2; Xh3 = tl3; Xh4 = tl4; Xh5 = tl5; Xh6 = tl6; Xh7 = tl7; HP_FIN8("row_shr:1", Xh, ph, tl); }
#define HP_OUT(e_) ktl[e_] = __builtin_fmaf(-fl##e_, Xl##e_, Xl##e_); kth[e_] = __builtin_fmaf(-fh##e_, Xh##e_, Xh##e_); qtl[e_] = qlo[e_] * __builtin_amdgcn_rcpf(fmaxf(Xl##e_, 1e-35f)); qth[e_] = qhi[e_] * __builtin_amdgcn_rcpf(fmaxf(Xh##e_, 1e-35f)); gt[e_] = tl##e_ * th##e_;
            HP_OUT(0) HP_OUT(1) HP_OUT(2) HP_OUT(3) HP_OUT(4) HP_OUT(5) HP_OUT(6) HP_OUT(7)
#undef HP_OUT
#undef HP_FIN8
#undef HP_SCANR8
#undef HP_SCANL8
#undef HP_PROD8
#undef HP_OPS8
#undef HP_STEP
            bf16* Qd = (bf16*)(ws + (dir ? WS_QB : WS_QF)); bf16* Kd = (bf16*)(ws + (dir ? WS_KB : WS_KF)); float* Gd = (float*)(ws + (dir ? WS_GB : WS_GF));
            v4u o; o.x = pk2(qtl[0], qtl[1]); o.y = pk2(qtl[2], qtl[3]); o.z = pk2(qtl[4], qtl[5]); o.w = pk2(qtl[6], qtl[7]); *(GAS v4u*)(Qd + rlo * WK + c0) = o;
            o.x = pk2(qth[0], qth[1]); o.y = pk2(qth[2], qth[3]); o.z = pk2(qth[4], qth[5]); o.w = pk2(qth[6], qth[7]); *(GAS v4u*)(Qd + rhi * WK + c0) = o;
            o.x = pk2(ktl[0], ktl[1]); o.y = pk2(ktl[2], ktl[3]); o.z = pk2(ktl[4], ktl[5]); o.w = pk2(ktl[6], ktl[7]); *(GAS v4u*)(Kd + rlo * WK + c0) = o;
            o.x = pk2(kth[0], kth[1]); o.y = pk2(kth[2], kth[3]); o.z = pk2(kth[4], kth[5]); o.w = pk2(kth[6], kth[7]); *(GAS v4u*)(Kd + rhi * WK + c0) = o;
            if (fr == 0) { *(GAS f32x4*)(Gd + (size_t)sc * WK + c0) = (f32x4){gt[0], gt[1], gt[2], gt[3]}; *(GAS f32x4*)(Gd + (size_t)sc * WK + c0 + 4) = (f32x4){gt[4], gt[5], gt[6], gt[7]}; }
        } }
}

typedef short s16x4 __attribute__((ext_vector_type(4)));
typedef short hb16x8 __attribute__((ext_vector_type(8)));
constexpr int HG_P = 272;
constexpr int HG_QI = 0, HG_KI = 32 * HG_P, HG_VI = 64 * HG_P, HG_GI = 96 * HG_P, HG_BUF = 96 * HG_P + 512 + 256;
constexpr int HG_NSTEP = (CTXL + SEQ) / 32, HG_NSEG = 4, HG_SEGLEN = HG_NSTEP / HG_NSEG, HG_NCTX = CTXL / 32;
static_assert(HG_SEGLEN * HG_NSEG == HG_NSTEP && HG_SEGLEN % 2 == 0, "segment loop below is unrolled by 2");
__device__ __forceinline__ int hg_row0(int s, int cstep, int cbase, int lbase2) { return cstep * s + (s < HG_NCTX ? cbase : lbase2); }
struct HgReg { v4u a, b, c, d; };
template <bool FULL> __device__ __forceinline__ void hg_gload(HgReg& R, int r0, const bf16* Qp, const bf16* Kp, const bf16* Vp, const float* Gp, int tid) {
    const int row = tid >> 4, ch = tid & 15; const size_t o = (size_t)(r0 + row) * WK + 8 * ch;
    if (FULL) R.a = *(const GAS v4u*)(Qp + o);
    R.b = *(const GAS v4u*)(Kp + o); R.c = *(const GAS v4u*)(Vp + o);
    R.d = *(const GAS v4u*)(Gp + (size_t)(r0 >> 5) * WK + 4 * (tid & 31));
}
template <bool FULL> __device__ __forceinline__ void hg_lwrite(const HgReg& R, LAS unsigned char* buf, int tid) {
    const int row = tid >> 4, ch = tid & 15;
    if (FULL) *(LAS v4u*)(buf + HG_QI + row * HG_P + 16 * ch) = R.a;
    *(LAS v4u*)(buf + HG_KI + row * HG_P + 16 * ch) = R.b; *(LAS v4u*)(buf + HG_VI + row * HG_P + 16 * ch) = R.c;
    if (tid < 32) *(LAS v4u*)(buf + HG_GI + 16 * tid) = R.d;
}
template <bool FULL> __device__ __forceinline__ void hg_step(const LAS unsigned char* buf, int r0, int w, f32x4 (&S)[8], f32x4& GA, _Float16* Op, int lane, int dir) {
    const int idx = lane & 15, rq = lane >> 4;
    v2u q[2][8], k[2][8];
    f32x4 P[2][2];
    if (FULL) {
#pragma unroll
        for (int tb = 0; tb < 2; ++tb)
#pragma unroll
            for (int j = 0; j < 8; ++j) { q[tb][j] = *(const LAS v2u*)(buf + HG_QI + (16 * tb + idx) * HG_P + (16 * j + 4 * rq) * 2); k[tb][j] = *(const LAS v2u*)(buf + HG_KI + (16 * tb + idx) * HG_P + (16 * j + 4 * rq) * 2); }
#pragma unroll
        for (int sb = 0; sb < 2; ++sb)
#pragma unroll
            for (int tb = 0; tb < 2; ++tb) { f32x4 p = (f32x4){0.f, 0.f, 0.f, 0.f};
#pragma unroll
                for (int ks = 0; ks < 4; ++ks) { v4u a, b; a.x = k[sb][2 * ks].x; a.y = k[sb][2 * ks].y; a.z = k[sb][2 * ks + 1].x; a.w = k[sb][2 * ks + 1].y; b.x = q[tb][2 * ks].x; b.y = q[tb][2 * ks].y; b.z = q[tb][2 * ks + 1].x; b.w = q[tb][2 * ks + 1].y;
                    p = __builtin_amdgcn_mfma_f32_16x16x32_bf16(__builtin_bit_cast(hb16x8, a), __builtin_bit_cast(hb16x8, b), p, 0, 0, 0); }
                P[sb][tb] = p; } }
#pragma unroll
    for (int kb = 0; kb < 8; ++kb) { const f32x4 gv = *(const LAS f32x4*)(buf + HG_GI + (16 * kb + 4 * rq) * 4); S[kb] = S[kb] * gv; if (kb == w) GA = GA * gv; }
    f32x4 o[2];
    o[0] = (f32x4){0.f, 0.f, 0.f, 0.f}; o[1] = (f32x4){0.f, 0.f, 0.f, 0.f};
    if (FULL) {
#pragma unroll
    for (int ks = 0; ks < 4; ++ks) { v4u a; a.x = pg8::cvt_pk_bf16(S[2 * ks][0], S[2 * ks][1]); a.y = pg8::cvt_pk_bf16(S[2 * ks][2], S[2 * ks][3]); a.z = pg8::cvt_pk_bf16(S[2 * ks + 1][0], S[2 * ks + 1][1]); a.w = pg8::cvt_pk_bf16(S[2 * ks + 1][2], S[2 * ks + 1][3]);
#pragma unroll
        for (int tb = 0; tb < 2; ++tb) { v4u b; b.x = q[tb][2 * ks].x; b.y = q[tb][2 * ks].y; b.z = q[tb][2 * ks + 1].x; b.w = q[tb][2 * ks + 1].y;
            o[tb] = __builtin_amdgcn_mfma_f32_16x16x32_bf16(__builtin_bit_cast(hb16x8, a), __builtin_bit_cast(hb16x8, b), o[tb], 0, 0, 0); } } }
    s16x4 vt0, vt1, k0[8], k1[8];
    { const unsigned q_ = (unsigned)(idx >> 2), p_ = (unsigned)(idx & 3);
      const unsigned va = (unsigned)(size_t)(buf + HG_VI) + (4u * rq + q_) * HG_P + 32u * (unsigned)w + 8u * p_, ka = (unsigned)(size_t)(buf + HG_KI) + (4u * rq + q_) * HG_P + 8u * p_;
      asm volatile("s_waitcnt lgkmcnt(0)\n\t"
                   "ds_read_b64_tr_b16 %0, %18\n\t"
                   "ds_read_b64_tr_b16 %1, %18 offset:4352\n\t"
                   "ds_read_b64_tr_b16 %2, %19\n\t"
                   "ds_read_b64_tr_b16 %3, %19 offset:32\n\t"
                   "ds_read_b64_tr_b16 %4, %19 offset:64\n\t"
                   "ds_read_b64_tr_b16 %5, %19 offset:96\n\t"
                   "ds_read_b64_tr_b16 %6, %19 offset:128\n\t"
                   "ds_read_b64_tr_b16 %7, %19 offset:160\n\t"
                   "ds_read_b64_tr_b16 %8, %19 offset:192\n\t"
                   "ds_read_b64_tr_b16 %9, %19 offset:224\n\t"
                   "ds_read_b64_tr_b16 %10, %19 offset:4352\n\t"
                   "ds_read_b64_tr_b16 %11, %19 offset:4384\n\t"
                   "ds_read_b64_tr_b16 %12, %19 offset:4416\n\t"
                   "ds_read_b64_tr_b16 %13, %19 offset:4448\n\t"
                   "ds_read_b64_tr_b16 %14, %19 offset:4480\n\t"
                   "ds_read_b64_tr_b16 %15, %19 offset:4512\n\t"
                   "ds_read_b64_tr_b16 %16, %19 offset:4544\n\t"
                   "ds_read_b64_tr_b16 %17, %19 offset:4576\n\t"
                   "s_waitcnt lgkmcnt(0)"
                   : "=&v"(vt0), "=&v"(vt1), "=&v"(k0[0]), "=&v"(k0[1]), "=&v"(k0[2]), "=&v"(k0[3]), "=&v"(k0[4]), "=&v"(k0[5]), "=&v"(k0[6]), "=&v"(k0[7]),
                     "=&v"(k1[0]), "=&v"(k1[1]), "=&v"(k1[2]), "=&v"(k1[3]), "=&v"(k1[4]), "=&v"(k1[5]), "=&v"(k1[6]), "=&v"(k1[7])
                   : "v"(va), "v"(ka) : "memory"); }
    static_assert(16 * HG_P == 4352, "tr-read row offsets above");
    const hb16x8 vfrag = __builtin_shufflevector(vt0, vt1, 0, 1, 2, 3, 4, 5, 6, 7);
    if (FULL) {
#pragma unroll
      for (int tb = 0; tb < 2; ++tb) { v4u pb; float pm[2][4];
#pragma unroll
        for (int sb = 0; sb < 2; ++sb)
#pragma unroll
            for (int i = 0; i < 4; ++i) { const int s_ = 16 * sb + 4 * rq + i, t_ = 16 * tb + idx; const bool keep = dir ? (s_ >= t_) : (s_ <= t_); pm[sb][i] = keep ? P[sb][tb][i] : 0.f; }
        pb.x = pg8::cvt_pk_bf16(pm[0][0], pm[0][1]); pb.y = pg8::cvt_pk_bf16(pm[0][2], pm[0][3]); pb.z = pg8::cvt_pk_bf16(pm[1][0], pm[1][1]); pb.w = pg8::cvt_pk_bf16(pm[1][2], pm[1][3]);
        o[tb] = __builtin_amdgcn_mfma_f32_16x16x32_bf16(vfrag, __builtin_bit_cast(hb16x8, pb), o[tb], 0, 0, 0); } }
#pragma unroll
    for (int kb = 0; kb < 8; ++kb) { const hb16x8 kfrag = __builtin_shufflevector(k0[kb], k1[kb], 0, 1, 2, 3, 4, 5, 6, 7);
        S[kb] = __builtin_amdgcn_mfma_f32_16x16x32_bf16(kfrag, vfrag, S[kb], 0, 0, 0); }
    if (FULL) {
#pragma unroll
        for (int tb = 0; tb < 2; ++tb) *(GAS h16x4*)(Op + (size_t)(r0 + 16 * tb + idx) * WK + 4 * rq) = __builtin_convertvector(o[tb], h16x4); }
}
#define HG_BARRIER() do { asm volatile("s_waitcnt lgkmcnt(0)" ::: "memory"); __builtin_amdgcn_s_barrier(); asm volatile("" ::: "memory"); } while (0)
template <int PASS> __device__ __forceinline__ void phase_hgrn() {
    const Frame F = mkframe(); unsigned char* ws = F.ws;
    const int lane = F.lane, tid = F.tid, w = F.wave;
    constexpr bool FULL = PASS == 1;
    for (int task = F.vcu; task < 64 * HG_NSEG; task += F.G) {
        const int chain = task >> 2, seg = task & 3, b = chain >> 4, h = (chain >> 1) & 7, dir = chain & 1;
        if (PASS == 0 && seg == HG_NSEG - 1) continue;
        const bf16* Qp = (const bf16*)(ws + (dir ? WS_QB : WS_QF)) + h * DK; const bf16* Kp = (const bf16*)(ws + (dir ? WS_KB : WS_KF)) + h * DK;
        const bf16* Vp = (const bf16*)(ws + WS_VV) + h * DV; const float* Gp = (const float*)(ws + (dir ? WS_GB : WS_GF)) + h * DK;
        _Float16* Op = (_Float16*)(ws + (dir ? WS_OB : WS_OF)) + h * DV + 16 * w;
        f32x4* SL = (f32x4*)(ws + WS_SLOC);
        LAS unsigned char* buf0 = F.lds; LAS unsigned char* buf1 = F.lds + HG_BUF;
        const int cstep = dir ? -32 : 32, cbase = M_LAT + b * CTXL + (dir ? CTXL - 32 : 0), lbase2 = b * SEQ + (dir ? SEQ - 32 : 0) - HG_NCTX * cstep;
        f32x4 S[8], GA = (f32x4){1.f, 1.f, 1.f, 1.f};
#pragma unroll
        for (int kb = 0; kb < 8; ++kb) S[kb] = (f32x4){0.f, 0.f, 0.f, 0.f};
        if (PASS == 1) {
#pragma unroll 1
            for (int k = 0; k < seg; ++k) { const f32x4* p = SL + (size_t)(task - seg + k) * 4608 + lane;
#pragma unroll
                for (int kb = 0; kb < 8; ++kb) S[kb] = S[kb] * p[4096 + kb * 64] + p[(w * 8 + kb) * 64]; } }
        const int s0 = seg * HG_SEGLEN, slast = s0 + HG_SEGLEN - 1;
#define HG_ROW(s_) hg_row0((s_) < slast ? (s_) : slast, cstep, cbase, lbase2)
        HgReg R0, R1;
        __syncthreads();
        hg_gload<FULL>(R0, HG_ROW(s0), Qp, Kp, Vp, Gp, tid); hg_lwrite<FULL>(R0, buf0, tid);
        hg_gload<FULL>(R1, HG_ROW(s0 + 1), Qp, Kp, Vp, Gp, tid);
        HG_BARRIER();
#pragma unroll 1
        for (int s = s0; s < s0 + HG_SEGLEN; s += 2) {
            hg_gload<FULL>(R0, HG_ROW(s + 2), Qp, Kp, Vp, Gp, tid);
            hg_step<FULL>(buf0, hg_row0(s, cstep, cbase, lbase2), w, S, GA, Op, lane, dir);
            hg_lwrite<FULL>(R1, buf1, tid); HG_BARRIER();
            hg_gload<FULL>(R1, HG_ROW(s + 3), Qp, Kp, Vp, Gp, tid);
            hg_step<FULL>(buf1, hg_row0(s + 1, cstep, cbase, lbase2), w, S, GA, Op, lane, dir);
            hg_lwrite<FULL>(R0, buf0, tid); HG_BARRIER();
        }
#undef HG_ROW
        if (PASS == 0) { f32x4* p = SL + (size_t)task * 4608 + lane;
#pragma unroll
            for (int kb = 0; kb < 8; ++kb) p[(w * 8 + kb) * 64] = S[kb];
            p[4096 + w * 64] = GA; }
    }
}

constexpr int GM_P = 272, GM_WI = 0, GM_VI = 128 * GM_P;
__device__ __forceinline__ void phase_gmlp(int l) {
    const Frame F = mkframe(); unsigned char* ws = F.ws;
    const bf16* Z2 = (const bf16*)(ws + WS_Z2); const bf16* VN = (const bf16*)(ws + WS_VN); bf16* YABC = (bf16*)(ws + WS_YABC);
    const int tid = F.tid, lane = F.lane, w = F.wave, idx = lane & 15, rq = lane >> 4;
    if ((F.vcu & 3) != HG_NSEG - 1) return;
    const int jw = F.vcu >> 2, g = jw & 3, nper = F.G >> 4;
    if ((jw >> 2) >= M / 128) return;
    __syncthreads();
    { const float* wsrc = INP(IWS) + ((size_t)l * 4 + g) * 128 * 128;
#pragma unroll
      for (int i = 0; i < 8; ++i) { const int e = (i * 512 + tid) * 4, t = e >> 7, s0 = e & 127; const f32x4 v = *(const GAS f32x4*)(wsrc + e);
          *(LAS v2u*)(F.lds + GM_WI + t * GM_P + 2 * s0) = (v2u){pk2(v[0], v[1]), pk2(v[2], v[3])}; } }
    for (int chunk = jw >> 2; chunk < M / 128; chunk += nper) { const size_t r0 = (size_t)chunk * 128;
        __syncthreads();
#pragma unroll
        for (int i = 0; i < 4; ++i) { const int e = i * 512 + tid, srow = e >> 4, c8 = e & 15;
            *(LAS v4u*)(F.lds + GM_VI + srow * GM_P + 16 * c8) = *(const GAS v4u*)(VN + (r0 + srow) * BW + g * 128 + 8 * c8); }
        __syncthreads();
        v4u bfr[4];
#pragma unroll
        for (int ks = 0; ks < 4; ++ks) bfr[ks] = *(const LAS v4u*)(F.lds + GM_WI + (16 * w + idx) * GM_P + (32 * ks + 8 * rq) * 2);
        const float bs = INP(IBS)[((size_t)l * 4 + g) * 128 + 16 * w + idx];
        v2u urv[8];
#pragma unroll
        for (int cb = 0; cb < 8; ++cb) urv[cb] = *(const GAS v2u*)(Z2 + (r0 + 16 * w + idx) * Z2W + Z2_U + g * 128 + 16 * cb + 4 * rq);
        const unsigned q_ = (unsigned)(idx >> 2), p_ = (unsigned)(idx & 3);
        const unsigned va = (unsigned)(size_t)(F.lds + GM_VI) + (8u * rq + q_) * GM_P + 8u * p_;
#pragma unroll
        for (int cb = 0; cb < 8; ++cb) {
            s16x4 t0[4], t1[4];
            asm volatile("ds_read_b64_tr_b16 %0, %8\n\t"
                         "ds_read_b64_tr_b16 %1, %8 offset:1088\n\t"
                         "ds_read_b64_tr_b16 %2, %9\n\t"
                         "ds_read_b64_tr_b16 %3, %9 offset:1088\n\t"
                         "ds_read_b64_tr_b16 %4, %10\n\t"
                         "ds_read_b64_tr_b16 %5, %10 offset:1088\n\t"
                         "ds_read_b64_tr_b16 %6, %11\n\t"
                         "ds_read_b64_tr_b16 %7, %11 offset:1088\n\t"
                         "s_waitcnt lgkmcnt(0)"
                         : "=&v"(t0[0]), "=&v"(t1[0]), "=&v"(t0[1]), "=&v"(t1[1]), "=&v"(t0[2]), "=&v"(t1[2]), "=&v"(t0[3]), "=&v"(t1[3])
                         : "v"(va + 32u * cb), "v"(va + 32u * cb + 32u * GM_P), "v"(va + 32u * cb + 64u * GM_P), "v"(va + 32u * cb + 96u * GM_P) : "memory");
            f32x4 acc = (f32x4){0.f, 0.f, 0.f, 0.f};
#pragma unroll
            for (int ks = 0; ks < 4; ++ks) { const hb16x8 afr = __builtin_shufflevector(t0[ks], t1[ks], 0, 1, 2, 3, 4, 5, 6, 7);
                acc = __builtin_amdgcn_mfma_f32_16x16x32_bf16(afr, __builtin_bit_cast(hb16x8, bfr[ks]), acc, 0, 0, 0); }
            const size_t row = r0 + 16 * w + idx; const int ch = g * 128 + 16 * cb + 4 * rq;
            const v2u ur = urv[cb];
            const float y0 = gelu_tanh(bflo(ur.x)) * (acc[0] + bs), y1 = gelu_tanh(bfhi(ur.x)) * (acc[1] + bs), y2 = gelu_tanh(bflo(ur.y)) * (acc[2] + bs), y3 = gelu_tanh(bfhi(ur.y)) * (acc[3] + bs);
            *(GAS v2u*)(YABC + row * 2048 + 1024 + ch) = (v2u){pk2(y0, y1), pk2(y2, y3)};
        }
    }
    __syncthreads();
}

struct RoRow { pg8::eh16x8 f0, f1, b0, b1; v4u g0, g1; };
__device__ __forceinline__ void ro_load(RoRow& R, const _Float16* OFp, const _Float16* OBp, const bf16* Z2, int m, int lane) {
    R.f0 = *(const GAS pg8::eh16x8*)(OFp + (size_t)m * WK + 16 * lane); R.f1 = *(const GAS pg8::eh16x8*)(OFp + (size_t)m * WK + 16 * lane + 8);
    R.b0 = *(const GAS pg8::eh16x8*)(OBp + (size_t)m * WK + 16 * lane); R.b1 = *(const GAS pg8::eh16x8*)(OBp + (size_t)m * WK + 16 * lane + 8);
    R.g0 = *(const GAS v4u*)(Z2 + (size_t)m * Z2W + Z2_GA + 16 * lane); R.g1 = *(const GAS v4u*)(Z2 + (size_t)m * Z2W + Z2_GA + 16 * lane + 8);
}
__device__ __forceinline__ void ro_finish(const RoRow& R, const float (&ag)[16], bf16* YABC, int m, int lane) {
    const pg8::ef32x8 a0 = __builtin_convertvector(R.f0, pg8::ef32x8), a1 = __builtin_convertvector(R.f1, pg8::ef32x8), c0 = __builtin_convertvector(R.b0, pg8::ef32x8), c1 = __builtin_convertvector(R.b1, pg8::ef32x8);
    float o[16]; float ss = 0.f;
#pragma unroll
    for (int e = 0; e < 8; ++e) { o[e] = a0[e] + c0[e]; o[8 + e] = a1[e] + c1[e]; ss += o[e] * o[e] + o[8 + e] * o[8 + e]; }
    ss += dppf<0xB1>(ss); ss += dppf<0x4E>(ss); ss += dppf<0x141>(ss);
    const float rstd = 1.0f / sqrtf(ss * (1.0f / DV) + EPS);
    const v4u g0 = R.g0, g1 = R.g1; float ga[16];
    ga[0] = bflo(g0.x); ga[1] = bfhi(g0.x); ga[2] = bflo(g0.y); ga[3] = bfhi(g0.y); ga[4] = bflo(g0.z); ga[5] = bfhi(g0.z); ga[6] = bflo(g0.w); ga[7] = bfhi(g0.w);
    ga[8] = bflo(g1.x); ga[9] = bfhi(g1.x); ga[10] = bflo(g1.y); ga[11] = bfhi(g1.y); ga[12] = bflo(g1.z); ga[13] = bfhi(g1.z); ga[14] = bflo(g1.w); ga[15] = bfhi(g1.w);
    float y[16];
#pragma unroll
    for (int e = 0; e < 16; ++e) y[e] = o[e] * rstd * ag[e] * siluf_(ga[e]);
    v4u w0, w1; w0.x = pk2(y[0], y[1]); w0.y = pk2(y[2], y[3]); w0.z = pk2(y[4], y[5]); w0.w = pk2(y[6], y[7]); w1.x = pk2(y[8], y[9]); w1.y = pk2(y[10], y[11]); w1.z = pk2(y[12], y[13]); w1.w = pk2(y[14], y[15]);
    *(GAS v4u*)(YABC + (size_t)m * 2048 + 16 * lane) = w0; *(GAS v4u*)(YABC + (size_t)m * 2048 + 16 * lane + 8) = w1;
}
__device__ __forceinline__ void phase_readout(int l) {
    const Frame F = mkframe(); unsigned char* ws = F.ws;
    const _Float16* OFp = (const _Float16*)(ws + WS_OF); const _Float16* OBp = (const _Float16*)(ws + WS_OB); const bf16* Z2 = (const bf16*)(ws + WS_Z2); bf16* YABC = (bf16*)(ws + WS_YABC);
    const int gw = F.vcu * 8 + F.wave, NGW = F.G * 8, lane = F.lane;
    float ag[16];
    { const float* agp = INP(IANORM) + l * DV + (16 * lane & 127);
#pragma unroll
      for (int e = 0; e < 16; ++e) ag[e] = agp[e]; }
    const int per = (M_LAT + NGW - 1) / NGW, m0 = gw * per, m1 = (m0 + per < M_LAT) ? m0 + per : M_LAT;
    if (m0 < m1) { RoRow cur, nxt; ro_load(cur, OFp, OBp, Z2, m0, lane);
#pragma unroll 1
        for (int m = m0; m < m1; ++m) { ro_load(nxt, OFp, OBp, Z2, m + 1 < m1 ? m + 1 : m, lane); ro_finish(cur, ag, YABC, m, lane); cur = nxt; } }
    for (int m = M_LAT + (gw >> 1) + ((gw & 1) ? (NGW >> 1) : 0); m < M; m += NGW) { RoRow cur; ro_load(cur, OFp, OBp, Z2, m, lane); ro_finish(cur, ag, YABC, m, lane); }
}

constexpr int PH_PER_LAYER = 13, N_PHASES = 1 + DEPTH * PH_PER_LAYER + 1;
__device__ __forceinline__ void grid_seam() {
    extern __shared__ __attribute__((aligned(16))) unsigned char lds_dyn[];
    XcdBarrier bar; bar.bar = (unsigned*)(kargs()->ws + WS_CTL) + CW_BAR; bar.x = xb_xcc_id(); bar.st = (volatile LAS unsigned*)((LAS unsigned char*)lds_dyn + MISC_OFF) + 8;
    xcd_barrier(bar);
}
__global__ void __launch_bounds__(512, 2) fwd_kernel(Args args_unused) {
    extern __shared__ __attribute__((aligned(16))) unsigned char lds_dyn[];
    { LAS unsigned char* lds = (LAS unsigned char*)lds_dyn;
      for (int u = threadIdx.x; u < (LDS_BYTES - LDSCTL_OFF) / 4; u += 512) ((LAS unsigned*)(lds + LDSCTL_OFF))[u] = 0u;
      __syncthreads();
      if (kargs()->ph_hi - kargs()->ph_lo > 1) (void)xcd_barrier_post((unsigned*)(kargs()->ws + WS_CTL) + CW_BAR, (volatile LAS unsigned*)(lds + MISC_OFF) + 8); }
    const int lo = kargs()->ph_lo, hi = kargs()->ph_hi;
#define IN(k) (lo <= (k) && (k) < hi)
#define SEAM(k) do { if (IN((k) + 1)) grid_seam(); } while (0)
#define LDSP ((LAS unsigned char*)lds_dyn)
#define WSP(off) (kargs()->ws + (off))

    if (IN(0)) { phase_prologue(); __syncthreads(); SEAM(0); }

#pragma unroll 1
    for (int l = 0; l < DEPTH; ++l) {
        const int pb = 1 + l * PH_PER_LAYER;
        if (hi <= pb || lo >= pb + PH_PER_LAYER) continue;
#pragma unroll 1
        for (int j = 0; j < 2; ++j) {
            const int p0 = pb + (j ? 10 : 0);
            const bool noctx = (l == DEPTH - 1) && j == 1;
            if (IN(p0)) { if (j) phase_norm(l, 2, noctx ? M_LAT : M, noctx ? 0 : 1, l, 5, 1.0f); else { if (l > 0) convert_rest(l); phase_norm(l, 0, M, l > 0 ? 1 : 0, l - 1, 8, 0.5f); } SEAM(p0); }
            if (IN(p0 + 1)) { pg8::Gemm g{(const bf16*)WSP(WS_H), (const bf16*)WSP(WS_WGU) + (size_t)(l * 2 + j) * (2 * DFF) * D, M, 2 * DFF, D, D, D};
                pg8::StaticOrder S; S.init(noctx ? M_LAT : M, 2 * DFF, (int)gridDim.x, (int)blockIdx.x, D); pg8::EpiSwiGLU E{(bf16*)WSP(WS_ACT)};
                pg8::gemm_phase<pg8::EpiSwiGLU, pg8::StaticOrder, true, true>(LDSP, g, S, E);
                if (l < DEPTH - 1) convert_slot(l + 1, j ? 3 : 0, (M / 256) * (2 * DFF / 256), CV_Q_GU);
                SEAM(p0 + 1); }
            if (IN(p0 + 2)) { pg8::Gemm g{(const bf16*)WSP(WS_ACT), (const bf16*)WSP(WS_WD) + (size_t)(l * 2 + j) * D * DFF, M, D, DFF, DFF, DFF};
                pg8::SplitOrder S; S.init((int)gridDim.x, (int)blockIdx.x, DFF, !noctx); pg8::EpiResid E{(ytype*)WSP(WS_Y), (const float*)WSP(WS_MOD) + (size_t)l * NGRP * MODW + (j ? 8 : 2) * D, 0.5f, (float*)WSP(WS_MF32)};
                pg8::gemm_phase<pg8::EpiResid, pg8::SplitOrder, true, true>(LDSP, g, S, E); SEAM(p0 + 2); }
            if (j == 0) {
                const bool lastl = (l == DEPTH - 1);
                if (IN(pb + 3)) { phase_norm(l, 1, M, 1, l, 2, 0.5f); SEAM(pb + 3); }
                if (IN(pb + 4)) { pg8::Gemm g{(const bf16*)WSP(WS_H), (const bf16*)WSP(WS_WIN) + (size_t)l * INW * D, M, INW, D, D, D};
                    pg8::InprojOrder S; S.init((int)gridDim.x, (int)blockIdx.x, D, lastl ? 16 : 54); pg8::EpiInproj E{(bf16*)WSP(WS_QS), (bf16*)WSP(WS_VV), (_Float16*)WSP(WS_ZF), (bf16*)WSP(WS_Z2)};
                    pg8::gemm_phase<pg8::EpiInproj, pg8::InprojOrder, true, true>(LDSP, g, S, E);
                    if (!lastl) convert_slot(l + 1, 1, 64 * 54 + 4 * 54, CV_Q_IN);
                    SEAM(pb + 4); }
                if (IN(pb + 5)) { phase_hgrn_prep(l); phase_mix_elem(l); SEAM(pb + 5); }
                if (IN(pb + 6)) { phase_hgrn<0>(); phase_gmlp(l); grid_seam(); phase_hgrn<1>(); SEAM(pb + 6); }
                if (IN(pb + 7)) { phase_readout(l); SEAM(pb + 7); }
                if (IN(pb + 8)) { pg8::Gemm g{(const bf16*)WSP(WS_YABC), (const bf16*)WSP(WS_WP) + (size_t)l * D * 2048, M, D, 2048, 2048, 2048};
                    pg8::StaticOrder S; S.init(lastl ? M_LAT : M, D, (int)gridDim.x, (int)blockIdx.x, 2048); pg8::EpiProjF E{(bf16*)WSP(WS_MRG), (const bf16*)WSP(WS_Z2)};
                    pg8::gemm_phase<pg8::EpiProjF, pg8::StaticOrder, true, true>(LDSP, g, S, E);
                    if (!lastl) convert_slot(l + 1, 2, (M / 256) * (D / 256), CV_Q_PJ);
                    SEAM(pb + 8); }
                if (IN(pb + 9)) { pg8::Gemm g{(const bf16*)WSP(WS_MRG), (const bf16*)WSP(WS_WO) + (size_t)l * D * D, M, D, D, D, D};
                    pg8::SplitOrder S; S.init((int)gridDim.x, (int)blockIdx.x, D, !lastl); pg8::EpiResid E{(ytype*)WSP(WS_Y), (const float*)WSP(WS_MOD) + (size_t)l * NGRP * MODW + 5 * D, 1.0f, (float*)WSP(WS_MF32)};
                    pg8::gemm_phase<pg8::EpiResid, pg8::SplitOrder, true, true>(LDSP, g, S, E); SEAM(pb + 9); }
            }
        }
    }
    if (IN(N_PHASES - 1)) phase_final();
#undef IN
#undef SEAM
}

#ifndef MK_PER_PHASE
#define MK_PER_PHASE 0
#endif
extern "C" void kernel_launch(void* const* d_in, const int* in_sizes, int n_in, void* d_out, int out_size, void* d_ws, size_t ws_size, hipStream_t stream) {
    static int grid = 0;
    if (grid == 0) {
        if (n_in != 23 || out_size != M_LAT * D || ws_size < WS_END) { fprintf(stderr, "kernel_launch: unexpected sizes n_in %d out %d ws %zu (need %zu)\n", n_in, out_size, ws_size, (size_t)WS_END); grid = -1; return; }
        int dev = 0, cus = 0, per_cu = 0;
        if (hipGetDevice(&dev) != hipSuccess || hipDeviceGetAttribute(&cus, hipDeviceAttributeMultiprocessorCount, dev) != hipSuccess) { grid = -1; return; }
        if (hipFuncSetAttribute((const void*)fwd_kernel, hipFuncAttributeMaxDynamicSharedMemorySize, LDS_BYTES) != hipSuccess) { fprintf(stderr, "kernel_launch: hipFuncSetAttribute failed\n"); grid = -1; return; }
        if (hipOccupancyMaxActiveBlocksPerMultiprocessor(&per_cu, (const void*)fwd_kernel, 512, LDS_BYTES) != hipSuccess || per_cu < 1) { fprintf(stderr, "kernel_launch: occupancy query says %d\n", per_cu); }
        (void)hipGetLastError();
        grid = cus;
    }
    if (grid < 0) return;
    (void)hipMemsetAsync((char*)d_ws + WS_CTL, 0, CTL_ZERO_BYTES, stream);
    Args a{};
    for (int i = 0; i < 23; ++i) a.in[i] = (const float*)d_in[i];
    a.out = (float*)d_out; a.ws = (unsigned char*)d_ws;
#if MK_PER_PHASE
    for (int p = 0; p < N_PHASES; ++p) { a.ph_lo = p; a.ph_hi = p + 1; hipLaunchKernelGGL(fwd_kernel, dim3(grid), dim3(512), LDS_BYTES, stream, a); }
#else
    a.ph_lo = 0; a.ph_hi = N_PHASES; hipLaunchKernelGGL(fwd_kernel, dim3(grid), dim3(512), LDS_BYTES, stream, a);
#endif
}
```

```cpp
#include <hip/hip_runtime.h>
#include <cstdio>
#include <cstdint>
namespace pg8 {
#define PG8_LAS __attribute__((address_space(3)))
typedef unsigned short bf16_t;
typedef short bf16x8 __attribute__((ext_vector_type(8)));
typedef float f32x4 __attribute__((ext_vector_type(4)));
typedef float f32x2 __attribute__((ext_vector_type(2)));
typedef unsigned u32x4 __attribute__((ext_vector_type(4)));
typedef unsigned u32x2 __attribute__((ext_vector_type(2)));
constexpr int BM = 256, BK = 64, HALF = 128, HTB = HALF * BK * 2  , STAGE_BYTES = 8 * HTB, NXCD = 8, WGM = 8;

__host__ __device__ __forceinline__ int lds_byte(int r, int c) { const int st = (r >> 4) * 2 + (c >> 5), rr = r & 15, cc = c & 31, ob = rr * 64 + cc * 2; return st * 1024 + (ob ^ (((ob >> 9) & 1) << 5)); }
__host__ __device__ __forceinline__ void stage_rc(int b, int& R, int& C) { const int st = b / 1024, sb = b % 1024, swz = sb ^ (((sb >> 9) & 1) << 5); R = (st >> 1) * 16 + swz / 64; C = (st & 1) * 32 + (swz % 64) / 2; }
__host__ __device__ __forceinline__ int perm32(int rho) { const int n = rho >> 4, i = rho & 15; return 8 * (i >> 2) + 4 * n + (i & 3); }

struct Unit { int pm, pn, meta;
    __host__ __device__ __forceinline__ int kt0() const { return meta & 255; } __host__ __device__ __forceinline__ int nt() const { return (meta >> 8) & 255; } __host__ __device__ __forceinline__ int part() const { return meta >> 16; }
    __host__ __device__ __forceinline__ void set(int kt0_, int nt_, int part_) { meta = kt0_ | (nt_ << 8) | (part_ << 16); } };
struct Gemm { const bf16_t* A; const bf16_t* Bt; int M, N, K, lda, ldb; };

__host__ __device__ __forceinline__ int xcd_block_pos(int L, int nwg, int G) {
    if (G != 256) return L;
    const int i = L >> 8, c = L & 255;
    if (((i + 1) << 8) <= nwg) return (i << 8) + ((c & 7) << 5) + (c >> 3);
    const int rem = nwg - (i << 8);
    return (rem & 7) ? L : (i << 8) + (c & 7) * (rem >> 3) + (c >> 3);
}
__host__ __device__ __forceinline__ void tile_of(int wgid, int nM, int nN, int& pm, int& pn) {
    const int nig = WGM * nN, gid = wgid / nig, fm = gid * WGM, gsz = (nM - fm) < WGM ? (nM - fm) : WGM;
    pm = fm + ((wgid % nig) % gsz); pn = (wgid % nig) / gsz;
}
struct StaticOrder {
    int nM, nN, nwg, G, c, ntK;
    __host__ __device__ void init(int M, int N, int G_, int c_, int K) { nM = M / BM; nN = N / BM; nwg = nM * nN; G = G_; c = c_; ntK = K / BK; }
    __host__ __device__ bool next(int i, Unit& u) const {
        const long L = (long)i * G + c; if (L >= nwg) return false;
        u.set(0, ntK, 0);
        const int wgid = xcd_block_pos((int)L, nwg, G);
        const int nig = WGM * nN, gid = wgid / nig, fm = gid * WGM, gsz = (nM - fm) < WGM ? (nM - fm) : WGM;
        u.pm = fm + ((wgid % nig) % gsz); u.pn = (wgid % nig) / gsz; return true;
    }
    __device__ __forceinline__ void a_ready(const Unit&) const {}
    __device__ __forceinline__ void done(const Unit&) const {}
};

struct SplitOrder {
    int G, c, ntK, nctx;
    __host__ __device__ void init(int G_, int c_, int K, bool with_ctx) { G = G_; c = c_; ntK = K / BK; nctx = with_ctx ? 256 : 0; }
    __host__ __device__ bool next(int i, Unit& u) const {
        const long L = (long)i * G + c; if (L >= 512 + nctx) return false;
        if (L < 512) { tile_of(xcd_block_pos((int)(L < 256 ? L + 256 : L - 256), 512, G), 64, 8, u.pm, u.pn); u.set(0, ntK, 0); return true; }
        const int q = (int)L - 512, tile = q >> 3, p = q & 7; u.pm = 64 + (tile >> 3); u.pn = tile & 7;
        if (ntK == 88) u.set((p >> 1) * 22 + (p & 1) * 12, (p & 1) ? 10 : 12, 1 + p); else u.set(p * (ntK >> 3), ntK >> 3, 1 + p);
        return true;
    }
    __device__ __forceinline__ void a_ready(const Unit&) const {}
    __device__ __forceinline__ void done(const Unit&) const {}
};

struct InprojOrder {
    int G, c, ntK, nctx;
    __host__ __device__ void init(int G_, int c_, int K, int nctx_pn) { G = G_; c = c_; ntK = K / BK; nctx = 4 * nctx_pn; }
    __host__ __device__ bool next(int i, Unit& u) const {
        const long L = (long)i * G + c; if (L >= 64 * 54 + nctx) return false;
        u.set(0, ntK, 0);
        if (L < 64 * 54) { tile_of(xcd_block_pos((int)L, 64 * 54, G), 64, 54, u.pm, u.pn); return true; }
        const int q = (int)L - 64 * 54; u.pm = 64 + (q & 3); u.pn = q >> 2; return true;
    }
    __device__ __forceinline__ void a_ready(const Unit&) const {}
    __device__ __forceinline__ void done(const Unit&) const {}
};

__device__ __forceinline__ unsigned cvt_pk_bf16(float lo, float hi) { unsigned r; asm volatile("v_cvt_pk_bf16_f32 %0, %1, %2" : "=v"(r) : "v"(lo), "v"(hi)); return r; }

template <class Epi, class Sched, bool ALIGN_EPI = false, bool SP2 = false>
__device__ __forceinline__ void gemm_phase(PG8_LAS unsigned char* lds, const Gemm g, const Sched& S, const Epi& E) {
    int tid_ = threadIdx.x; asm volatile("" : "+v"(tid_));
    const int tid = tid_, wid = __builtin_amdgcn_readfirstlane(tid >> 6), lane = tid & 63, wr = wid >> 2, wc = wid & 3, fr = lane & 15, fq = lane >> 4;
    unsigned voffA[2], voffB[2];
#pragma unroll
    for (int i = 0; i < 2; ++i) { int R, C; stage_rc(tid * 16 + i * 8192, R, C); const int Rb = Epi::PERM ? ((R & ~31) + perm32(R & 31)) : R;
        voffA[i] = (unsigned)(R * g.lda + C) * 2u; voffB[i] = (unsigned)(Rb * g.ldb + C) * 2u; }
    const unsigned kstep = (unsigned)(BK * 2);
    const unsigned hstepA = (unsigned)HALF * g.lda * 2u, hstepB = (unsigned)HALF * g.ldb * 2u;
    const unsigned tstepA = 2u * hstepA, tstepB = 2u * hstepB;
    const unsigned ldsw = (unsigned)wid * 1024u;
    const int aoff = lds_byte(wr * 64 + fr, fq * 8), boff = lds_byte(wc * 32 + fr, fq * 8);
#define PG8_SA(b, h) (((b) * 2 + (h)) * HTB)
#define PG8_SB(b, h) ((4 + (b) * 2 + (h)) * HTB)
#define PG8_STAGE(bufoff, gbase, voff) do { _Pragma("unroll") for (int _i = 0; _i < 2; ++_i) \
        __builtin_amdgcn_global_load_lds((const unsigned*)((const char*)(gbase) + (voff)[_i]), (PG8_LAS unsigned*)(lds + (bufoff) + ldsw + _i * 8192), 16, 0, 0); } while (0)
#define PG8_LDA(dst, b, h) do { _Pragma("unroll") for (int m = 0; m < 4; ++m) _Pragma("unroll") for (int k = 0; k < 2; ++k) dst[m][k] = *(const PG8_LAS bf16x8*)(lds + PG8_SA(b, h) + aoff + m * 2048 + k * 1024); } while (0)
#define PG8_LDB(dst, b, h) do { _Pragma("unroll") for (int n = 0; n < 2; ++n) _Pragma("unroll") for (int k = 0; k < 2; ++k) dst[n][k] = *(const PG8_LAS bf16x8*)(lds + PG8_SB(b, h) + boff + n * 2048 + k * 1024); } while (0)
#define PG8_MMA(ai, bj, At, Bt) do { __builtin_amdgcn_s_setprio(1); _Pragma("unroll") for (int m = 0; m < 4; ++m) _Pragma("unroll") for (int n = 0; n < 2; ++n) _Pragma("unroll") for (int k = 0; k < 2; ++k) \
        acc[ai][bj][m][n] = __builtin_amdgcn_mfma_f32_16x16x32_bf16(Bt[n][k], At[m][k], acc[ai][bj][m][n], 0, 0, 0); __builtin_amdgcn_s_setprio(0); } while (0)
#define PG8_WAIT_V(n) asm volatile("s_waitcnt vmcnt(" #n ")" ::: "memory")
#define PG8_WAIT_L(n) asm volatile("s_waitcnt lgkmcnt(" #n ")" ::: "memory")
#define PG8_BAR __builtin_amdgcn_s_barrier()
#define PG8_SCHED __builtin_amdgcn_sched_barrier(0)
    Unit cur, nxt; int ui = 0;
    if (!S.next(0, cur)) return;
    f32x4 acc[2][2][4][2];
#pragma unroll
    for (int a = 0; a < 2; ++a)
#pragma unroll
        for (int b = 0; b < 2; ++b)
#pragma unroll
            for (int m = 0; m < 4; ++m)
#pragma unroll
                for (int n = 0; n < 2; ++n) acc[a][b][m][n] = (f32x4){0.f, 0.f, 0.f, 0.f};
    bf16x8 At[4][2], B0[2][2], B1[2][2];
    const char* cA = (const char*)g.A + (size_t)((unsigned)cur.pm * tstepA) + (size_t)((unsigned)cur.kt0() * kstep); const char* cB = (const char*)g.Bt + (size_t)((unsigned)cur.pn * tstepB) + (size_t)((unsigned)cur.kt0() * kstep);
    S.a_ready(cur);
    if constexpr (SP2) {
        PG8_STAGE(PG8_SB(0, 0), cB, voffB); PG8_STAGE(PG8_SB(0, 1), cB + hstepB, voffB); PG8_STAGE(PG8_SA(0, 0), cA, voffA); PG8_STAGE(PG8_SA(0, 1), cA + hstepA, voffA);
        if (wr == 1) PG8_BAR;
        PG8_WAIT_V(2); PG8_BAR;
        PG8_STAGE(PG8_SB(1, 0), cB + kstep, voffB); PG8_STAGE(PG8_SA(1, 0), cA + kstep, voffA); PG8_STAGE(PG8_SB(1, 1), cB + hstepB + kstep, voffB);
        PG8_WAIT_V(6); PG8_BAR;
    } else {
        PG8_STAGE(PG8_SB(0, 0), cB, voffB); PG8_STAGE(PG8_SA(0, 0), cA, voffA); PG8_STAGE(PG8_SB(0, 1), cB + hstepB, voffB); PG8_STAGE(PG8_SA(0, 1), cA + hstepA, voffA);
        if (wr == 1) PG8_BAR;
        PG8_WAIT_V(4); PG8_BAR;
        PG8_STAGE(PG8_SB(1, 0), cB + kstep, voffB); PG8_STAGE(PG8_SA(1, 0), cA + kstep, voffA); PG8_STAGE(PG8_SB(1, 1), cB + hstepB + kstep, voffB);
        PG8_WAIT_V(6); PG8_BAR;
    }
    for (;;) {
        const bool has_next = S.next(ui + 1, nxt);
        const char* nA = has_next ? (const char*)g.A + (size_t)((unsigned)nxt.pm * tstepA) + (size_t)((unsigned)nxt.kt0() * kstep) : cA; const char* nB = has_next ? (const char*)g.Bt + (size_t)((unsigned)nxt.pn * tstepB) + (size_t)((unsigned)nxt.kt0() * kstep) : cB;
        const int nt = cur.nt();
        for (int t = 0; t < nt; t += 2) {
            if constexpr (Epi::HOOK) { if (t == Epi::H1 || t == Epi::H2) E.khook(acc, cur, t, wr, wc, fr, fq); }
            const bool last = (t == nt - 2);
            const char* a1 = cA + (size_t)((unsigned)(t + 1) * kstep);
            const char* a2 = last ? nA : cA + (size_t)((unsigned)(t + 2) * kstep); const char* b2 = last ? nB : cB + (size_t)((unsigned)(t + 2) * kstep);
            const char* a3 = a2 + kstep; const char* b3 = b2 + kstep;
            if (last && has_next) S.a_ready(nxt);
            if constexpr (SP2) {
            PG8_LDB(B0, 0, 0); PG8_LDB(B1, 0, 1); PG8_SCHED; PG8_LDA(At, 0, 0); PG8_STAGE(PG8_SA(1, 1), a1 + hstepA, voffA);
            PG8_WAIT_V(8); PG8_WAIT_L(0); PG8_BAR; PG8_MMA(0, 0, At, B0); PG8_MMA(0, 1, At, B1); PG8_BAR; PG8_SCHED;
            PG8_LDA(At, 0, 1); PG8_STAGE(PG8_SB(0, 0), b2, voffB); PG8_STAGE(PG8_SB(0, 1), b2 + hstepB, voffB); PG8_STAGE(PG8_SA(0, 0), a2, voffA);
            PG8_WAIT_V(8); PG8_WAIT_L(0); PG8_BAR; PG8_MMA(1, 0, At, B0); PG8_MMA(1, 1, At, B1); PG8_BAR; PG8_SCHED;
            PG8_LDB(B0, 1, 0); PG8_LDB(B1, 1, 1); PG8_SCHED; PG8_LDA(At, 1, 0); PG8_STAGE(PG8_SA(0, 1), a2 + hstepA, voffA);
            PG8_WAIT_V(8); PG8_WAIT_L(0); PG8_BAR; PG8_MMA(0, 0, At, B0); PG8_MMA(0, 1, At, B1); PG8_BAR; PG8_SCHED;
            PG8_LDA(At, 1, 1); PG8_STAGE(PG8_SB(1, 0), b3, voffB); PG8_STAGE(PG8_SB(1, 1), b3 + hstepB, voffB); PG8_STAGE(PG8_SA(1, 0), a3, voffA);
            PG8_WAIT_V(8); PG8_WAIT_L(0); PG8_BAR; PG8_MMA(1, 0, At, B0); PG8_MMA(1, 1, At, B1); PG8_BAR; PG8_SCHED;
            } else {
            PG8_LDB(B0, 0, 0); PG8_SCHED; PG8_LDA(At, 0, 0); PG8_STAGE(PG8_SA(1, 1), a1 + hstepA, voffA);
            PG8_WAIT_L(8); PG8_BAR; PG8_WAIT_L(0); PG8_MMA(0, 0, At, B0); PG8_BAR; PG8_SCHED;
            PG8_LDB(B1, 0, 1); PG8_STAGE(PG8_SB(0, 0), b2, voffB);
            PG8_BAR; PG8_WAIT_L(0); PG8_MMA(0, 1, At, B1); PG8_BAR;
            PG8_LDA(At, 0, 1); PG8_STAGE(PG8_SA(0, 0), a2, voffA);
            PG8_BAR; PG8_WAIT_L(0); PG8_MMA(1, 0, At, B0); PG8_BAR; PG8_SCHED;
            PG8_STAGE(PG8_SB(0, 1), b2 + hstepB, voffB);
            PG8_WAIT_V(6); PG8_BAR; PG8_MMA(1, 1, At, B1); PG8_BAR;
            PG8_LDB(B0, 1, 0); PG8_SCHED; PG8_LDA(At, 1, 0); PG8_STAGE(PG8_SA(0, 1), a2 + hstepA, voffA);
            PG8_WAIT_L(8); PG8_BAR; PG8_WAIT_L(0); PG8_MMA(0, 0, At, B0); PG8_BAR; PG8_SCHED;
            PG8_LDB(B1, 1, 1); PG8_STAGE(PG8_SB(1, 0), b3, voffB);
            PG8_BAR; PG8_WAIT_L(0); PG8_MMA(0, 1, At, B1); PG8_BAR;
            PG8_LDA(At, 1, 1); PG8_STAGE(PG8_SA(1, 0), a3, voffA);
            PG8_BAR; PG8_WAIT_L(0); PG8_MMA(1, 0, At, B0); PG8_BAR; PG8_SCHED;
            PG8_STAGE(PG8_SB(1, 1), b3 + hstepB, voffB);
            PG8_WAIT_V(6); PG8_BAR; PG8_MMA(1, 1, At, B1); PG8_BAR;
            }
        }
        if constexpr (ALIGN_EPI) { if (wr == 0) PG8_BAR; }
        E(acc, cur, wr, wc, fr, fq); S.done(cur);
        if (!has_next) break;
#pragma unroll
        for (int a = 0; a < 2; ++a)
#pragma unroll
            for (int b = 0; b < 2; ++b)
#pragma unroll
                for (int m = 0; m < 4; ++m)
#pragma unroll
                    for (int n = 0; n < 2; ++n) acc[a][b][m][n] = (f32x4){0.f, 0.f, 0.f, 0.f};
        cur = nxt; cA = nA; cB = nB; ++ui;
        if constexpr (ALIGN_EPI) { if (wr == 1) PG8_BAR; }
    }
    PG8_WAIT_V(0);
    if constexpr (!ALIGN_EPI) { if (wr == 0) PG8_BAR; }
    PG8_BAR;
#undef PG8_SA
#undef PG8_SB
#undef PG8_STAGE
#undef PG8_LDA
#undef PG8_LDB
#undef PG8_MMA
#undef PG8_WAIT_V
#undef PG8_WAIT_L
#undef PG8_BAR
#undef PG8_SCHED
}
}
#define XB_TMO      128
#define XB_XCNT(j)  (256  + 64 * (j))
#define XB_XSUB(j)  (1280 + 64 * (j))
#define XB_XGEN(j)  (2304 + 64 * (j))
#define XB_TOP      3328
#define XB_TOPGEN   3392
#define XCD_BAR_WORDS 3456
#define XB_SPIN_CAP (1u << 18)
#define LAS __attribute__((address_space(3)))

__device__ __forceinline__ unsigned xb_ld(unsigned* p)              { return __hip_atomic_load(p, __ATOMIC_RELAXED, __HIP_MEMORY_SCOPE_AGENT); }
__device__ __forceinline__ unsigned xb_add(unsigned* p, unsigned v) { return __hip_atomic_fetch_add(p, v, __ATOMIC_RELAXED, __HIP_MEMORY_SCOPE_AGENT); }
__device__ __forceinline__ unsigned xb_xcc_id() { return (unsigned)__builtin_amdgcn_s_getreg((3 << 11) | 20) & 0xFu; }
#define XB_SPIN(cond, bar) do { unsigned _sp = 0; while (cond) { __builtin_amdgcn_s_sleep(1); \
    if ((++_sp & 255u) == 0u) { if (xb_ld(&(bar)[XB_TMO])) break; if (_sp > XB_SPIN_CAP) { atomicAdd(&(bar)[XB_TMO], 1u); break; } } } } while (0)

struct XcdBarrier {
    unsigned* bar; unsigned x;
    volatile LAS unsigned* st;
};

__device__ __forceinline__ XcdBarrier xcd_barrier_post(unsigned* bar, volatile LAS unsigned* st) {
    XcdBarrier b; b.bar = bar; b.x = xb_xcc_id(); b.st = st;
    if (threadIdx.x == 0) (void)xb_add(&bar[XB_XCNT(b.x)], 1u);
    return b;
}
__device__ __forceinline__ void xcd_barrier_complete(unsigned* bar, unsigned x, unsigned& nloc, unsigned& nx) {
    const unsigned G = gridDim.x * gridDim.y * gridDim.z;
    unsigned sum, cnt, mine, sp = 0u;
    for (;;) {
        sum = 0u; cnt = 0u; mine = 0u;
#pragma unroll
        for (unsigned j = 0; j < 16; ++j) { const unsigned c = xb_ld(&bar[XB_XCNT(j)]); sum += c; cnt += (c > 0u) ? 1u : 0u; mine = (j == x) ? c : mine; }
        if (sum == G) break;
        __builtin_amdgcn_s_sleep(1);
        if ((++sp & 255u) == 0u) { if (xb_ld(&bar[XB_TMO])) break; if (sp > XB_SPIN_CAP) { atomicAdd(&bar[XB_TMO], 1u); break; } }
    }
    nloc = mine > 0u ? mine : 1u; nx = cnt > 0u ? cnt : 1u;
}

__device__ __forceinline__ void xcd_barrier(const XcdBarrier& b) {
    asm volatile("s_waitcnt vmcnt(0)" ::: "memory");
    __syncthreads();
    if (threadIdx.x == 0) {
        unsigned* bar = b.bar;
        __builtin_amdgcn_s_waitcnt(0);
        unsigned nloc = b.st[0], nx = b.st[1];
        if (nloc == 0u) { xcd_barrier_complete(bar, b.x, nloc, nx); b.st[0] = nloc; b.st[1] = nx; }
        const unsigned old = xb_add(&bar[XB_XSUB(b.x)], 1u);
        const unsigned gen = old / nloc;
        if (old + 1u == (gen + 1u) * nloc) {
            __builtin_amdgcn_fence(__ATOMIC_RELEASE, "agent");
            asm volatile("s_waitcnt vmcnt(0)" ::: "memory");
            const unsigned og = xb_add(&bar[XB_TOP], 1u);
            const unsigned tg = og / nx;
            if (og + 1u == (tg + 1u) * nx) xb_add(&bar[XB_TOPGEN], 1u);
            else XB_SPIN(xb_ld(&bar[XB_TOPGEN]) == tg, bar);
            __builtin_amdgcn_fence(__ATOMIC_ACQUIRE, "agent");
            xb_add(&bar[XB_XGEN(b.x)], 1u);
            asm volatile("s_waitcnt vmcnt(0)" ::: "memory");
        } else {
            XB_SPIN(xb_ld(&bar[XB_XGEN(b.x)]) == gen, bar);
            __builtin_amdgcn_fence(__ATOMIC_ACQUIRE, "agent");
            asm volatile("s_waitcnt vmcnt(0)" ::: "memory");
        }
    }
    __syncthreads();
}

constexpr int D = 2048, NB = 4, SEQ = 4096, DEPTH = 4, CTXL = 256, NMOD = 9, DFF = 5632, NH = 8, DK = 128, DV = 128, WK = 1024;
constexpr int BW = 512, CWD = 512, INW = 13824;
constexpr int M_LAT = NB * SEQ, M_CTX = NB * CTXL, M = M_LAT + M_CTX;
constexpr int MODW = NMOD * D;
constexpr int NGRP = 5;
constexpr float EPS = 1e-6f;
constexpr int Z1W = 4096, Z2W = INW - Z1W;
constexpr int Z2_GA = 0, Z2_U = 1024, Z2_V = 1536, Z2_HC = 2048, Z2_GB = 2560, Z2_GC = 3072, Z2_MA = 3584, Z2_MB = 5632, Z2_MC = 7680;

constexpr size_t MiB = 1u << 20;
constexpr size_t WS_CTL = 0ull * MiB, CTL_ZERO_BYTES = 32 * 1024;
constexpr size_t WS_MOD = 1ull * MiB;
constexpr size_t WS_LB = 3ull * MiB;
constexpr size_t WS_WGU = 4ull * MiB;
constexpr size_t WS_WD = 356ull * MiB;
constexpr size_t WS_WIN = 532ull * MiB;
constexpr size_t WS_WP = 748ull * MiB;
constexpr size_t WS_WO = 780ull * MiB;
constexpr size_t WS_Y = 812ull * MiB;
constexpr size_t WS_H = 948ull * MiB;
constexpr size_t WS_MRG = 1016ull * MiB;
constexpr size_t WS_YABC = 1084ull * MiB;
constexpr size_t WS_MF32 = 1152ull * MiB;
constexpr size_t WS_OF = 1288ull * MiB;
constexpr size_t WS_OB = 1356ull * MiB;
constexpr size_t WS_FF = 1424ull * MiB;
constexpr size_t WS_FB = 1492ull * MiB;
constexpr size_t WS_VN = 1560ull * MiB;
constexpr size_t WS_Z1 = 1577ull * MiB;
constexpr size_t WS_ZF = WS_Z1, WS_QS = WS_Z1 + 68ull * MiB;
constexpr size_t WS_Z2 = 1849ull * MiB;
constexpr size_t WS_ACT = WS_Z1;
constexpr size_t WS_QF = WS_FF, WS_KF = WS_FF + 34ull * MiB, WS_QB = WS_FB, WS_KB = WS_FB + 34ull * MiB;
constexpr size_t WS_VV = 2172ull * MiB;
constexpr size_t WS_GF = 2206ull * MiB;
constexpr size_t WS_GB = 2211ull * MiB;
constexpr size_t WS_SLOC = 2216ull * MiB;
constexpr size_t WS_END = 2248ull * MiB;
constexpr int CW_BAR = 4096;
static_assert((CW_BAR + 3456) * 4 <= (int)CTL_ZERO_BYTES, "barrier words inside the per-call memset");

constexpr int RING_BYTES = 131072;
constexpr int LDSCTL_OFF = RING_BYTES, MISC_OFF = LDSCTL_OFF + 320;
constexpr int LDS_BYTES = 147456;

#define GAS __attribute__((address_space(1)))
typedef unsigned short bf16;
typedef unsigned v4u __attribute__((ext_vector_type(4)));
typedef unsigned v2u __attribute__((ext_vector_type(2)));
typedef float f32x4 __attribute__((ext_vector_type(4)));
#define LDS_WAIT() asm volatile("s_waitcnt lgkmcnt(0)" ::: "memory")
#define VM_WAIT() asm volatile("s_waitcnt vmcnt(0)" ::: "memory")
__device__ __forceinline__ unsigned f2bf(float f) { unsigned u = __builtin_bit_cast(unsigned, f); return (u + 0x7fffu + ((u >> 16) & 1u)) >> 16; }
__device__ __forceinline__ unsigned pk2(float lo, float hi) { unsigned r; asm("v_cvt_pk_bf16_f32 %0, %1, %2" : "=v"(r) : "v"(lo), "v"(hi)); return r; }
__device__ __forceinline__ float bflo(unsigned w) { return __builtin_bit_cast(float, w << 16); }
__device__ __forceinline__ float bfhi(unsigned w) { return __builtin_bit_cast(float, w & 0xffff0000u); }
__device__ __forceinline__ float sigmoidf_(float x) { return __builtin_amdgcn_rcpf(1.0f + __expf(-x)); }
__device__ __forceinline__ float siluf_(float x) { return x * sigmoidf_(x); }
__device__ __forceinline__ float gelu_tanh(float x) { const float u = 0.7978845608028654f * (x + 0.044715f * x * x * x); return x * sigmoidf_(2.0f * u); }
template <int CTRL> __device__ __forceinline__ float dppf(float x) { return __builtin_bit_cast(float, __builtin_amdgcn_mov_dpp(__builtin_bit_cast(int, x), CTRL, 0xf, 0xf, true)); }
__device__ __forceinline__ float row16_sum(float x) { x += dppf<0xB1>(x); x += dppf<0x4E>(x); x += dppf<0x124>(x); x += dppf<0x128>(x); return x; }
__device__ __forceinline__ float wave_sum(float v) {
#pragma unroll
    for (int o = 1; o < 64; o <<= 1) v += __shfl_xor(v, o);
    return v;
}
__device__ __forceinline__ int grp_of_row(int m) { return m < M_LAT ? (m >> 12) : 4; }
#ifndef YBF16
#define YBF16 1
#endif
#if YBF16
typedef _Float16 ytype;
typedef _Float16 h16x4 __attribute__((ext_vector_type(4)));
__device__ __forceinline__ f32x4 y_ld4(const ytype* p) { const h16x4 w = *(const GAS h16x4*)p; return __builtin_convertvector(w, f32x4); }
__device__ __forceinline__ void y_st4(ytype* p, f32x4 v) { *(GAS h16x4*)p = __builtin_convertvector(v, h16x4); }
#else
typedef float ytype;
__device__ __forceinline__ f32x4 y_ld4(const ytype* p) { return *(const GAS f32x4*)p; }
__device__ __forceinline__ void y_st4(ytype* p, f32x4 v) { *(GAS f32x4*)p = v; }
#endif

struct Frame {
    LAS unsigned char* lds;
    int tid, lane, wave, vcu, G;
    unsigned char* ws;
};
struct Args { const float* in[23]; float* out; unsigned char* ws; int ph_lo, ph_hi; };
typedef const __attribute__((address_space(4))) Args* KArgs;
__device__ __forceinline__ KArgs kargs() { auto p = __builtin_amdgcn_kernarg_segment_ptr(); asm volatile("" : "+s"(p)); return (KArgs)p; }
__device__ __forceinline__ Frame mkframe() {
    extern __shared__ __attribute__((aligned(16))) unsigned char lds_dyn[];
    Frame F; F.lds = (LAS unsigned char*)lds_dyn; { int t = threadIdx.x; asm volatile("" : "+v"(t)); F.tid = t; } F.lane = F.tid & 63; F.wave = __builtin_amdgcn_readfirstlane(F.tid >> 6);
    { int gg = gridDim.x; asm volatile("" : "+s"(gg)); F.G = gg; } { int bx = blockIdx.x; asm volatile("" : "+s"(bx)); F.vcu = (F.G % 8 == 0) ? (bx % 8) * (F.G / 8) + bx / 8 : bx; }
    F.ws = kargs()->ws; return F;
}

namespace pg8 {
#define TRANS8(op, a) asm(op " %0, %0\n\t" op " %1, %1\n\t" op " %2, %2\n\t" op " %3, %3\n\t" op " %4, %4\n\t" op " %5, %5\n\t" op " %6, %6\n\t" op " %7, %7\n\ts_nop 0" \
    : "+v"(a##0), "+v"(a##1), "+v"(a##2), "+v"(a##3), "+v"(a##4), "+v"(a##5), "+v"(a##6), "+v"(a##7))
struct EpiSwiGLU { static constexpr bool PERM = true, HOOK = false; static constexpr int H1 = -1, H2 = -1;
    bf16_t* O;
    __device__ __forceinline__ void operator()(const f32x4 (&acc)[2][2][4][2], const Unit& u, int wr, int wc, int fr, int fq) const {
        const int row0 = u.pm * BM + wr * 64 + fr, col0 = u.pn * HALF + wc * 32 + 8 * fq;
#pragma unroll
        for (int ai = 0; ai < 2; ++ai)
#pragma unroll
            for (int m = 0; m < 4; ++m) { bf16_t* rowp = O + (size_t)(row0 + ai * HALF + m * 16) * DFF + col0;
                const f32x4 g0 = acc[ai][0][m][0], g1 = acc[ai][0][m][1], u0 = acc[ai][1][m][0], u1 = acc[ai][1][m][1];
                constexpr float NL2E = -1.4426950408889634f;
                float t0 = g0[0] * NL2E, t1 = g0[1] * NL2E, t2 = g0[2] * NL2E, t3 = g0[3] * NL2E, t4 = g1[0] * NL2E, t5 = g1[1] * NL2E, t6 = g1[2] * NL2E, t7 = g1[3] * NL2E;
                TRANS8("v_exp_f32", t);
                t0 += 1.0f; t1 += 1.0f; t2 += 1.0f; t3 += 1.0f; t4 += 1.0f; t5 += 1.0f; t6 += 1.0f; t7 += 1.0f;
                TRANS8("v_rcp_f32", t);
                u32x4 w; w.x = cvt_pk_bf16(g0[0] * u0[0] * t0, g0[1] * u0[1] * t1); w.y = cvt_pk_bf16(g0[2] * u0[2] * t2, g0[3] * u0[3] * t3);
                w.z = cvt_pk_bf16(g1[0] * u1[0] * t4, g1[1] * u1[1] * t5); w.w = cvt_pk_bf16(g1[2] * u1[2] * t6, g1[3] * u1[3] * t7);
                *(u32x4*)rowp = w; }
    }
};
#if YBF16
typedef _Float16 yh16x8 __attribute__((ext_vector_type(8)));
typedef float yf32x8 __attribute__((ext_vector_type(8)));
#endif
struct EpiResid { static constexpr bool PERM = true, HOOK = false; static constexpr int H1 = -1, H2 = -1;
    ytype* Y; const float* gate; float coef; float* slab;
    __device__ __forceinline__ void operator()(const f32x4 (&acc)[2][2][4][2], const Unit& u, int wr, int wc, int fr, int fq) const {
        const int row0 = u.pm * BM + wr * 64 + fr, col0 = u.pn * BM + wc * 32 + 8 * fq; const int grp = u.pm < 64 ? (u.pm >> 4) : 4;
        if (u.part() == 0) {
        const float* gp = gate + (size_t)grp * MODW + col0; f32x4 gv[2][2];
#pragma unroll
        for (int bj = 0; bj < 2; ++bj)
#pragma unroll
            for (int n = 0; n < 2; ++n) gv[bj][n] = *(const f32x4*)(gp + bj * HALF + 4 * n) * coef;
#if YBF16
#pragma unroll
        for (int ai = 0; ai < 2; ++ai) { yh16x8 old[4][2];
#pragma unroll
            for (int m = 0; m < 4; ++m)
#pragma unroll
                for (int bj = 0; bj < 2; ++bj) old[m][bj] = *(const yh16x8*)(Y + (size_t)(row0 + ai * HALF + m * 16) * D + col0 + bj * HALF);
#pragma unroll
            for (int m = 0; m < 4; ++m)
#pragma unroll
                for (int bj = 0; bj < 2; ++bj) { const yf32x8 o = __builtin_convertvector(old[m][bj], yf32x8); const f32x4 a0 = gv[bj][0] * acc[ai][bj][m][0], a1 = gv[bj][1] * acc[ai][bj][m][1];
                    const yf32x8 r = {o[0] + a0[0], o[1] + a0[1], o[2] + a0[2], o[3] + a0[3], o[4] + a1[0], o[5] + a1[1], o[6] + a1[2], o[7] + a1[3]};
                    *(yh16x8*)(Y + (size_t)(row0 + ai * HALF + m * 16) * D + col0 + bj * HALF) = __builtin_convertvector(r, yh16x8); }
            asm volatile("" ::: "memory"); }
#else
#pragma unroll
        for (int ai = 0; ai < 2; ++ai)
#pragma unroll
            for (int m = 0; m < 4; ++m) { float* rowp = Y + (size_t)(row0 + ai * HALF + m * 16) * D + col0;
#pragma unroll
                for (int bj = 0; bj < 2; ++bj)
#pragma unroll
                    for (int n = 0; n < 2; ++n) { float* p = rowp + bj * HALF + 4 * n; const f32x4 o = *(const f32x4*)p; *(f32x4*)p = o + gv[bj][n] * acc[ai][bj][m][n]; }
                asm volatile("" ::: "memory"); }
#endif
        } else {
#pragma unroll
        for (int ai = 0; ai < 2; ++ai)
#pragma unroll
            for (int m = 0; m < 4; ++m) { _Float16* rowp = (_Float16*)slab + ((size_t)(u.part() - 1) * M_CTX + (size_t)(row0 + ai * HALF + m * 16 - M_LAT)) * D + col0;
#pragma unroll
                for (int bj = 0; bj < 2; ++bj) { const f32x4 v0 = acc[ai][bj][m][0], v1 = acc[ai][bj][m][1]; const yf32x8 v = {v0[0], v0[1], v0[2], v0[3], v1[0], v1[1], v1[2], v1[3]};
                    *(yh16x8*)(rowp + bj * HALF) = __builtin_convertvector(v, yh16x8); } }
        }
    }
};
typedef _Float16 eh16x8 __attribute__((ext_vector_type(8)));
typedef float ef32x8 __attribute__((ext_vector_type(8)));
struct EpiInproj { static constexpr bool PERM = true, HOOK = false; static constexpr int H1 = -1, H2 = -1;
    bf16_t* QS; bf16_t* VV; _Float16* ZF; bf16_t* Z2;
    __device__ __forceinline__ void operator()(const f32x4 (&acc)[2][2][4][2], const Unit& u, int wr, int wc, int fr, int fq) const {
        const int row0 = u.pm * BM + wr * 64 + fr;
        if (u.pn < 8) { bf16_t* base = u.pn < 4 ? QS : VV; const float sc = u.pn < 4 ? 0.08838834764831845f : 1.0f; const int col0 = (u.pn & 3) * BM + wc * 32 + 8 * fq;
#pragma unroll
            for (int ai = 0; ai < 2; ++ai)
#pragma unroll
                for (int m = 0; m < 4; ++m) { bf16_t* rowp = base + (size_t)(row0 + ai * HALF + m * 16) * WK + col0;
#pragma unroll
                    for (int bj = 0; bj < 2; ++bj) { const f32x4 v0 = acc[ai][bj][m][0] * sc, v1 = acc[ai][bj][m][1] * sc;
                        u32x4 w; w.x = cvt_pk_bf16(v0[0], v0[1]); w.y = cvt_pk_bf16(v0[2], v0[3]); w.z = cvt_pk_bf16(v1[0], v1[1]); w.w = cvt_pk_bf16(v1[2], v1[3]);
                        *(u32x4*)(rowp + bj * HALF) = w; } }
        } else if (u.pn < 16) { const int col0 = (u.pn - 8) * BM + wc * 32 + 8 * fq;
#pragma unroll
            for (int ai = 0; ai < 2; ++ai)
#pragma unroll
                for (int m = 0; m < 4; ++m) { _Float16* rowp = ZF + (size_t)(row0 + ai * HALF + m * 16) * 2048 + col0;
#pragma unroll
                    for (int bj = 0; bj < 2; ++bj) { const f32x4 v0 = acc[ai][bj][m][0], v1 = acc[ai][bj][m][1];
                        const ef32x8 v = {v0[0], v0[1], v0[2], v0[3], v1[0], v1[1], v1[2], v1[3]}; *(eh16x8*)(rowp + bj * HALF) = __builtin_convertvector(v * -1.4426950408889634f, eh16x8); } }
        } else if (u.pn < 30) { const int col0 = (u.pn - 16) * BM + wc * 32 + 8 * fq;
#pragma unroll
            for (int ai = 0; ai < 2; ++ai)
#pragma unroll
                for (int m = 0; m < 4; ++m) { bf16_t* rowp = Z2 + (size_t)(row0 + ai * HALF + m * 16) * Z2W + col0;
#pragma unroll
                    for (int bj = 0; bj < 2; ++bj) { const f32x4 v0 = acc[ai][bj][m][0], v1 = acc[ai][bj][m][1];
                        u32x4 w; w.x = cvt_pk_bf16(v0[0], v0[1]); w.y = cvt_pk_bf16(v0[2], v0[3]); w.z = cvt_pk_bf16(v1[0], v1[1]); w.w = cvt_pk_bf16(v1[2], v1[3]);
                        *(u32x4*)(rowp + bj * HALF) = w; } }
        } else { const int col0 = (u.pn - 16) * BM + wc * 32 + 8 * fq;
            constexpr float NL2E = -1.4426950408889634f;
#pragma unroll
            for (int ai = 0; ai < 2; ++ai)
#pragma unroll
                for (int m = 0; m < 4; ++m) { bf16_t* rowp = Z2 + (size_t)(row0 + ai * HALF + m * 16) * Z2W + col0;
#pragma unroll
                    for (int bj = 0; bj < 2; ++bj) { const f32x4 v0 = acc[ai][bj][m][0], v1 = acc[ai][bj][m][1];
                        float t0 = __builtin_amdgcn_fmed3f(v0[0], -30.f, 30.f) * NL2E, t1 = __builtin_amdgcn_fmed3f(v0[1], -30.f, 30.f) * NL2E, t2 = __builtin_amdgcn_fmed3f(v0[2], -30.f, 30.f) * NL2E, t3 = __builtin_amdgcn_fmed3f(v0[3], -30.f, 30.f) * NL2E;
                        float t4 = __builtin_amdgcn_fmed3f(v1[0], -30.f, 30.f) * NL2E, t5 = __builtin_amdgcn_fmed3f(v1[1], -30.f, 30.f) * NL2E, t6 = __builtin_amdgcn_fmed3f(v1[2], -30.f, 30.f) * NL2E, t7 = __builtin_amdgcn_fmed3f(v1[3], -30.f, 30.f) * NL2E;
                        TRANS8("v_exp_f32", t);
                        u32x4 w; w.x = cvt_pk_bf16(t0 + 1.0f, t1 + 1.0f); w.y = cvt_pk_bf16(t2 + 1.0f, t3 + 1.0f); w.z = cvt_pk_bf16(t4 + 1.0f, t5 + 1.0f); w.w = cvt_pk_bf16(t6 + 1.0f, t7 + 1.0f);
                        *(u32x4*)(rowp + bj * HALF) = w; } }
        }
    }
};
struct EpiProjF { static constexpr bool PERM = true, HOOK = true; static constexpr int H1 = 16, H2 = 24;
    bf16_t* MRG; const bf16_t* Z2;
    __device__ __forceinline__ void khook(f32x4 (&acc)[2][2][4][2], const Unit& u, int t, int wr, int wc, int fr_, int fq_) const {
        int fr = fr_, fq = fq_; asm volatile("" : "+v"(fr), "+v"(fq));
        const int row0 = u.pm * BM + wr * 64 + fr, col0 = u.pn * BM + wc * 32 + 8 * fq; const int onum = (t == H1) ? Z2_MB : Z2_MC, oden = (t == H1) ? Z2_MA : Z2_MB;
#pragma unroll
        for (int ai = 0; ai < 2; ++ai) { u32x4 wn[4][2], wd[4][2];
#pragma unroll
            for (int m = 0; m < 4; ++m) { const bf16_t* rp = Z2 + (size_t)(row0 + ai * HALF + m * 16) * Z2W + col0;
#pragma unroll
                for (int bj = 0; bj < 2; ++bj) { wn[m][bj] = *(const u32x4*)(rp + onum + bj * HALF); wd[m][bj] = *(const u32x4*)(rp + oden + bj * HALF); } }
#pragma unroll
            for (int m = 0; m < 4; ++m)
#pragma unroll
                for (int bj = 0; bj < 2; ++bj) { const u32x4 a = wn[m][bj], b = wd[m][bj]; f32x4 r0, r1;
                    r0[0] = bflo(a.x) * __builtin_amdgcn_rcpf(bflo(b.x)); r0[1] = bfhi(a.x) * __builtin_amdgcn_rcpf(bfhi(b.x)); r0[2] = bflo(a.y) * __builtin_amdgcn_rcpf(bflo(b.y)); r0[3] = bfhi(a.y) * __builtin_amdgcn_rcpf(bfhi(b.y));
                    r1[0] = bflo(a.z) * __builtin_amdgcn_rcpf(bflo(b.z)); r1[1] = bfhi(a.z) * __builtin_amdgcn_rcpf(bfhi(b.z)); r1[2] = bflo(a.w) * __builtin_amdgcn_rcpf(bflo(b.w)); r1[3] = bfhi(a.w) * __builtin_amdgcn_rcpf(bfhi(b.w));
                    acc[ai][bj][m][0] = acc[ai][bj][m][0] * r0; acc[ai][bj][m][1] = acc[ai][bj][m][1] * r1; }
            asm volatile("" ::: "memory"); }
    }
    __device__ __forceinline__ void operator()(const f32x4 (&acc)[2][2][4][2], const Unit& u, int wr, int wc, int fr, int fq) const {
        const int row0 = u.pm * BM + wr * 64 + fr, col0 = u.pn * BM + wc * 32 + 8 * fq;
#pragma unroll
        for (int ai = 0; ai < 2; ++ai) { u32x4 wc_[4][2];
#pragma unroll
            for (int m = 0; m < 4; ++m)
#pragma unroll
                for (int bj = 0; bj < 2; ++bj) wc_[m][bj] = *(const u32x4*)(Z2 + (size_t)(row0 + ai * HALF + m * 16) * Z2W + Z2_MC + col0 + bj * HALF);
#pragma unroll
            for (int m = 0; m < 4; ++m)
#pragma unroll
                for (int bj = 0; bj < 2; ++bj) { const u32x4 c = wc_[m][bj]; const f32x4 v0 = acc[ai][bj][m][0], v1 = acc[ai][bj][m][1]; u32x4 w;
                    w.x = cvt_pk_bf16(v0[0] * __builtin_amdgcn_rcpf(bflo(c.x)), v0[1] * __builtin_amdgcn_rcpf(bfhi(c.x))); w.y = cvt_pk_bf16(v0[2] * __builtin_amdgcn_rcpf(bflo(c.y)), v0[3] * __builtin_amdgcn_rcpf(bfhi(c.y)));
                    w.z = cvt_pk_bf16(v1[0] * __builtin_amdgcn_rcpf(bflo(c.z)), v1[1] * __builtin_amdgcn_rcpf(bfhi(c.z))); w.w = cvt_pk_bf16(v1[2] * __builtin_amdgcn_rcpf(bflo(c.w)), v1[3] * __builtin_amdgcn_rcpf(bfhi(c.w)));
                    *(u32x4*)(MRG + (size_t)(row0 + ai * HALF + m * 16) * D + col0 + bj * HALF) = w; }
            asm volatile("" ::: "memory"); }
    }
};
}

struct CvItem { const float* W; bf16* dst; int ldw, k0, n0, ldk, drow0, dk0; };
__device__ __forceinline__ void transpose_load(const CvItem& I, float (&wv)[32], int lane) {
#pragma unroll
    for (int i = 0; i < 32; ++i) wv[i] = __builtin_nontemporal_load(I.W + (size_t)(I.k0 + 2 * i + (lane >> 5)) * I.ldw + I.n0 + (lane & 31));
}
__device__ __forceinline__ void transpose_store(const CvItem& I, const float (&wv)[32], LAS float* scr, int lane) {
#pragma unroll
    for (int i = 0; i < 32; ++i) scr[(2 * i + (lane >> 5)) * 33 + (lane & 31)] = wv[i];
    LDS_WAIT(); asm volatile("" ::: "memory");
    const int c = lane & 7;
#pragma unroll
    for (int j = 0; j < 4; ++j) { const int n = (lane >> 3) + 8 * j; const LAS float* s = scr + (8 * c) * 33 + n;
        v4u o; o.x = pk2(s[0 * 33], s[1 * 33]); o.y = pk2(s[2 * 33], s[3 * 33]); o.z = pk2(s[4 * 33], s[5 * 33]); o.w = pk2(s[6 * 33], s[7 * 33]);
        __builtin_nontemporal_store(o, (GAS v4u*)(I.dst + (size_t)(I.drow0 + n) * I.ldk + I.dk0 + I.k0 + 8 * c)); }
    LDS_WAIT(); asm volatile("" ::: "memory");
}

enum { IX = 0, IC, ICTX, ICCTX, IWMOD, IBMOD, INORMG, IFINALG, IWGATE, IWUP, IWDOWN, IWIN, ILB, IANORM, ILNG, ILNB, IWS, IBS, ICONV, IWPA, IWPB, IWPC, IWOUT };
#define INP(k) (kargs()->in[(k)])

constexpr int CV_I_FF = (D / 64) * (DFF / 32);
constexpr int CV_I_IN = (D / 64) * (INW / 32);
constexpr int CV_I_PA = (1024 / 64) * (D / 32), CV_I_PB = (512 / 64) * (D / 32);
constexpr int CV_I_WO = (D / 64) * (D / 32);
constexpr int CV_PER_L = 6 * CV_I_FF + CV_I_IN + CV_I_PA + 2 * CV_I_PB + CV_I_WO;
__device__ __forceinline__ CvItem cv_decode(int l, int r) {
    unsigned char* ws = kargs()->ws; CvItem I;
    if (r < 6 * CV_I_FF) { const int j = r / (3 * CV_I_FF); r %= 3 * CV_I_FF; const int which = r / CV_I_FF; r %= CV_I_FF; const size_t lj = (size_t)(l * 2 + j);
        if (which < 2) { const int nblk = DFF / 32, kb = r / nblk, nb = r % nblk, n0 = 32 * nb;
            I.W = (which == 0 ? INP(IWGATE) : INP(IWUP)) + lj * D * DFF; I.ldw = DFF; I.k0 = 64 * kb; I.n0 = n0; I.dst = (bf16*)(ws + WS_WGU) + lj * (size_t)(2 * DFF) * D; I.ldk = D; I.drow0 = 256 * (n0 >> 7) + (n0 & 127) + 128 * which; I.dk0 = 0;
        } else { const int nblk = D / 32, kb = r / nblk, nb = r % nblk;
            I.W = INP(IWDOWN) + lj * DFF * D; I.ldw = D; I.k0 = 64 * kb; I.n0 = 32 * nb; I.dst = (bf16*)(ws + WS_WD) + lj * (size_t)D * DFF; I.ldk = DFF; I.drow0 = 32 * nb; I.dk0 = 0; }
        return I; }
    r -= 6 * CV_I_FF;
    if (r < CV_I_IN) { const int nblk = INW / 32, kb = r / nblk, nb = r % nblk; I.W = INP(IWIN) + (size_t)l * D * INW; I.ldw = INW; I.k0 = 64 * kb; I.n0 = 32 * nb; I.dst = (bf16*)(ws + WS_WIN) + (size_t)l * INW * D; I.ldk = D; I.drow0 = 32 * nb; I.dk0 = 0; return I; }
    r -= CV_I_IN;
    bf16* WP = (bf16*)(ws + WS_WP) + (size_t)l * D * 2048; const int nblk = D / 32;
    if (r < CV_I_PA) { const int kb = r / nblk, nb = r % nblk; I.W = INP(IWPA) + (size_t)l * 1024 * D; I.ldw = D; I.k0 = 64 * kb; I.n0 = 32 * nb; I.dst = WP; I.ldk = 2048; I.drow0 = 32 * nb; I.dk0 = 0; return I; }
    r -= CV_I_PA;
    if (r < CV_I_PB) { const int kb = r / nblk, nb = r % nblk; I.W = INP(IWPB) + (size_t)l * 512 * D; I.ldw = D; I.k0 = 64 * kb; I.n0 = 32 * nb; I.dst = WP; I.ldk = 2048; I.drow0 = 32 * nb; I.dk0 = 1024; return I; }
    r -= CV_I_PB;
    if (r < CV_I_PB) { const int kb = r / nblk, nb = r % nblk; I.W = INP(IWPC) + (size_t)l * 512 * D; I.ldw = D; I.k0 = 64 * kb; I.n0 = 32 * nb; I.dst = WP; I.ldk = 2048; I.drow0 = 32 * nb; I.dk0 = 1536; return I; }
    r -= CV_I_PB;
    { const int kb = r / nblk, nb = r % nblk; I.W = INP(IWOUT) + (size_t)l * D * D; I.ldw = D; I.k0 = 64 * kb; I.n0 = 32 * nb; I.dst = (bf16*)(ws + WS_WO) + (size_t)l * D * D; I.ldk = D; I.drow0 = 32 * nb; I.dk0 = 0; }
    return I;
}
__device__ __forceinline__ void convert_run(int l, int first, int end, int stride, LAS float* scr, int lane) {
#pragma unroll 1
    for (int it = first; it < end; it += 2 * stride) { const bool two = it + stride < end;
        const CvItem A = cv_decode(l, it), B = cv_decode(l, two ? it + stride : it);
        float wa[32], wb[32];
        transpose_load(A, wa, lane); if (two) transpose_load(B, wb, lane);
        transpose_store(A, wa, scr, lane); if (two) transpose_store(B, wb, scr, lane); }
}
constexpr int CV_Q_GU = 160, CV_Q_IN = 64, CV_Q_PJ = 72;
__device__ __forceinline__ int cv_nidle(int nwg, int G) { const int rem = nwg % G; return rem ? G - rem : 0; }
__device__ __forceinline__ int cv_base(int slot, int G) {
    const int n_gu = cv_nidle((M / 256) * (2 * DFF / 256), G), n_in = cv_nidle(64 * 54 + 4 * 54, G), n_pj = cv_nidle((M / 256) * (D / 256), G);
    int b = 0; if (slot > 0) b += n_gu * CV_Q_GU; if (slot > 1) b += n_in * CV_Q_IN; if (slot > 2) b += n_pj * CV_Q_PJ; if (slot > 3) b += n_gu * CV_Q_GU; return b < CV_PER_L ? b : CV_PER_L;
}
__device__ __forceinline__ void convert_slot(int l, int slot, int nwg, int q) {
    int G = gridDim.x, c = blockIdx.x; asm volatile("" : "+s"(G), "+s"(c));
    const int rem = nwg % G; if (rem == 0 || c < rem) return;
    const Frame F = mkframe(); LAS float* scr = (LAS float*)(F.lds + F.wave * 16384);
    const int first = cv_base(slot, G) + (c - rem) * q; int end = first + q; if (end > CV_PER_L) end = CV_PER_L;
    convert_run(l, first + F.wave, end, 8, scr, F.lane);
}
__device__ __forceinline__ void convert_rest(int l) {
    const Frame F = mkframe(); LAS float* scr = (LAS float*)(F.lds + F.wave * 16384);
    const int gw = F.vcu * 8 + F.wave, NGW = F.G * 8;
    convert_run(l, cv_base(4, F.G) + gw, CV_PER_L, NGW, scr, F.lane);
}

__device__ __forceinline__ void phase_prologue() {
    const Frame F = mkframe(); unsigned char* ws = F.ws;
    const int gw = F.vcu * 8 + F.wave, NGW = F.G * 8;
    { ytype* Y = (ytype*)(ws + WS_Y);
      for (int m = gw; m < M; m += NGW) { const float* src = m < M_LAT ? INP(IX) + (size_t)m * D : INP(ICTX) + (size_t)(m - M_LAT) * D; const GAS f32x4* s = (const GAS f32x4*)src + F.lane;
#pragma unroll
          for (int j = 0; j < 8; ++j) y_st4(Y + (size_t)m * D + 4 * (64 * j + F.lane), s[64 * j]); } }
    if (blockIdx.x == 0) { float* LB = (float*)(ws + WS_LB);
        for (int i = F.tid; i < 2 * WK; i += 512) { float lg[DEPTH], mx = -1e30f;
#pragma unroll
            for (int l = 0; l < DEPTH; ++l) { lg[l] = INP(ILB)[l * 2 * WK + i]; mx = fmaxf(mx, lg[l]); }
            float s = 0.f;
#pragma unroll
            for (int l = 0; l < DEPTH; ++l) { lg[l] = __expf(lg[l] - mx); s += lg[l]; }
            float cum = 0.f; const float inv = 1.0f / s;
#pragma unroll
            for (int l = 0; l < DEPTH; ++l) { LB[l * 2 * WK + i] = cum; if (l + 1 < DEPTH) cum += lg[l + 1] * inv; } } }
    { LAS float* sc = (LAS float*)F.lds;
      LAS float* red = (LAS float*)(F.lds + 5 * D * 4);
      for (int i = F.tid; i < NGRP * D; i += 512) { const int g = i / D, k = i % D; const float v = g < 4 ? INP(IC)[g * D + k] : INP(ICCTX)[k]; sc[i] = siluf_(v); }
      __syncthreads();
      float* MOD = (float*)(ws + WS_MOD);
      constexpr int NU = DEPTH * (MODW / 128);
      for (int u = F.vcu; u < NU; u += F.G) { const int l = u / (MODW / 128), n0 = (u % (MODW / 128)) * 128;
          const float* Wp = INP(IWMOD) + (size_t)l * D * MODW + n0 + 2 * F.lane;
          float a0[NGRP], a1[NGRP];
#pragma unroll
          for (int g = 0; g < NGRP; ++g) { a0[g] = 0.f; a1[g] = 0.f; }
          const int kb = F.wave * 256;
#pragma unroll 16
          for (int k = kb; k < kb + 256; ++k) { typedef float f32x2v __attribute__((ext_vector_type(2))); const f32x2v w = __builtin_nontemporal_load((const GAS f32x2v*)(Wp + (size_t)k * MODW));
#pragma unroll
              for (int g = 0; g < NGRP; ++g) { const float s = sc[g * D + k]; a0[g] += s * w.x; a1[g] += s * w.y; } }
#pragma unroll
          for (int g = 0; g < NGRP; ++g) { red[(F.wave * NGRP + g) * 128 + 2 * F.lane] = a0[g]; red[(F.wave * NGRP + g) * 128 + 2 * F.lane + 1] = a1[g]; }
          __syncthreads();
          for (int i = F.tid; i < NGRP * 128; i += 512) { const int g = i / 128, n = i % 128; float s = 0.f;
#pragma unroll
              for (int w = 0; w < 8; ++w) s += red[(w * NGRP + g) * 128 + n];
              MOD[((size_t)l * NGRP + g) * MODW + n0 + n] = s + INP(IBMOD)[l * MODW + n0 + n]; }
          __syncthreads(); }
    }
    __syncthreads();
    { LAS float* scr = (LAS float*)(F.lds + F.wave * 16384);
      convert_run(0, gw, CV_PER_L, NGW, scr, F.lane); }
}

__device__ __forceinline__ float wave_sum_fast(float x) {
    x = row16_sum(x);
    const float a = __builtin_bit_cast(float, __builtin_amdgcn_readlane(__builtin_bit_cast(int, x), 0)), b = __builtin_bit_cast(float, __builtin_amdgcn_readlane(__builtin_bit_cast(int, x), 16));
    const float c = __builtin_bit_cast(float, __builtin_amdgcn_readlane(__builtin_bit_cast(int, x), 32)), d = __builtin_bit_cast(float, __builtin_amdgcn_readlane(__builtin_bit_cast(int, x), 48));
    return (a + b) + (c + d);
}
__device__ __forceinline__ void phase_norm(int l, int which, int mlim, int red, int rgate_l, int rgate_idx, float rcoef) {
    const Frame F = mkframe(); ytype* Y = (ytype*)(F.ws + WS_Y); bf16* H = (bf16*)(F.ws + WS_H);
    const float* g = INP(INORMG) + (size_t)(l * 3 + which) * D; const float* mod_l = (const float*)(F.ws + WS_MOD) + (size_t)l * NGRP * MODW; const int shift_idx = 3 * which;
    const int gw = F.vcu * 8 + F.wave, NGW = F.G * 8, lane = F.lane;
    typedef pg8::eh16x8 h8; typedef pg8::ef32x8 f8;
    f32x4 gs[4][2], sh[4][2];
    auto load_vecs = [&](int grp) { const float* mp = mod_l + (size_t)grp * MODW + shift_idx * D;
#pragma unroll
        for (int j = 0; j < 4; ++j)
#pragma unroll
            for (int e = 0; e < 2; ++e) { const int c = 8 * lane + 512 * j + 4 * e; gs[j][e] = *(const GAS f32x4*)(g + c) * (1.0f + *(const GAS f32x4*)(mp + D + c)); sh[j][e] = *(const GAS f32x4*)(mp + c); } };
    auto finish_row = [&](int m, f8 (&v)[4]) { float ss = 0.f;
#pragma unroll
        for (int j = 0; j < 4; ++j)
#pragma unroll
            for (int e = 0; e < 8; ++e) ss += v[j][e] * v[j][e];
        const float rstd = 1.0f / sqrtf(wave_sum_fast(ss) * (1.0f / D) + EPS);
#pragma unroll
        for (int j = 0; j < 4; ++j) { v4u o; const f32x4 a = (f32x4){v[j][0], v[j][1], v[j][2], v[j][3]} * rstd * gs[j][0] + sh[j][0], b = (f32x4){v[j][4], v[j][5], v[j][6], v[j][7]} * rstd * gs[j][1] + sh[j][1];
            o.x = pk2(a[0], a[1]); o.y = pk2(a[2], a[3]); o.z = pk2(b[0], b[1]); o.w = pk2(b[2], b[3]); *(GAS v4u*)(H + (size_t)m * D + 8 * lane + 512 * j) = o; } };
    if (NGW * 8 == M_LAT) {
        load_vecs(gw >> 9);
        h8 cur[4], nxt[4];
#pragma unroll
        for (int j = 0; j < 4; ++j) cur[j] = *(const GAS h8*)(Y + (size_t)(8 * gw) * D + 8 * lane + 512 * j);
#pragma unroll 1
        for (int r = 0; r < 8; ++r) { const int m = 8 * gw + r, mn = r < 7 ? m + 1 : m;
#pragma unroll
            for (int j = 0; j < 4; ++j) nxt[j] = *(const GAS h8*)(Y + (size_t)mn * D + 8 * lane + 512 * j);
            f8 v[4];
#pragma unroll
            for (int j = 0; j < 4; ++j) v[j] = __builtin_convertvector(cur[j], f8);
            finish_row(m, v);
#pragma unroll
            for (int j = 0; j < 4; ++j) cur[j] = nxt[j]; }
    } else {
        for (int m = gw; m < M_LAT; m += NGW) { load_vecs(m >> 12); f8 v[4];
#pragma unroll
            for (int j = 0; j < 4; ++j) v[j] = __builtin_convertvector(*(const GAS h8*)(Y + (size_t)m * D + 8 * lane + 512 * j), f8);
            finish_row(m, v); } }
    if (mlim > M_LAT) {
        load_vecs(4);
        for (int m = M_LAT + (gw >> 1) + ((gw & 1) ? (NGW >> 1) : 0); m < mlim; m += NGW) { f8 v[4];
#pragma unroll
            for (int j = 0; j < 4; ++j) v[j] = __builtin_convertvector(*(const GAS h8*)(Y + (size_t)m * D + 8 * lane + 512 * j), f8);
            if (red) { const _Float16* sl = (const _Float16*)(F.ws + WS_MF32) + (size_t)(m - M_LAT) * D; const float* rg = (const float*)(F.ws + WS_MOD) + ((size_t)rgate_l * NGRP + 4) * MODW + rgate_idx * D;
#pragma unroll
                for (int jh = 0; jh < 2; ++jh) { h8 part[2][8];
#pragma unroll
                    for (int jj = 0; jj < 2; ++jj)
#pragma unroll
                        for (int p = 0; p < 8; ++p) part[jj][p] = *(const GAS h8*)(sl + (size_t)p * M_CTX * D + 8 * lane + 512 * (2 * jh + jj));
#pragma unroll
                    for (int jj = 0; jj < 2; ++jj) { const int j = 2 * jh + jj, c = 8 * lane + 512 * j; f8 a = __builtin_convertvector(part[jj][0], f8);
#pragma unroll
                        for (int p = 1; p < 8; ++p) a = a + __builtin_convertvector(part[jj][p], f8);
                        const f32x4 g0 = *(const GAS f32x4*)(rg + c) * rcoef, g1 = *(const GAS f32x4*)(rg + c + 4) * rcoef;
#pragma unroll
                        for (int e = 0; e < 4; ++e) { v[j][e] += g0[e] * a[e]; v[j][4 + e] += g1[e] * a[4 + e]; }
                        *(GAS h8*)(Y + (size_t)m * D + c) = __builtin_convertvector(v[j], h8); }
                    asm volatile("" ::: "memory"); } }
            finish_row(m, v); } }
}

__device__ __forceinline__ void phase_final() {
    const Frame F = mkframe(); const ytype* Y = (const ytype*)(F.ws + WS_Y); float* out = kargs()->out; const float* g = INP(IFINALG);
    const int gw = F.vcu * 8 + F.wave, NGW = F.G * 8, lane = F.lane;
    typedef pg8::eh16x8 h8; typedef pg8::ef32x8 f8;
    f32x4 gs[4][2];
#pragma unroll
    for (int j = 0; j < 4; ++j)
#pragma unroll
        for (int e = 0; e < 2; ++e) gs[j][e] = *(const GAS f32x4*)(g + 8 * lane + 512 * j + 4 * e);
    const int per = (M_LAT + NGW - 1) / NGW, m0 = gw * per, m1 = (m0 + per < M_LAT) ? m0 + per : M_LAT;
    if (m0 >= m1) return;
    h8 cur[4], nxt[4];
#pragma unroll
    for (int j = 0; j < 4; ++j) cur[j] = *(const GAS h8*)(Y + (size_t)m0 * D + 8 * lane + 512 * j);
#pragma unroll 1
    for (int m = m0; m < m1; ++m) { const int mn = m + 1 < m1 ? m + 1 : m;
#pragma unroll
        for (int j = 0; j < 4; ++j) nxt[j] = *(const GAS h8*)(Y + (size_t)mn * D + 8 * lane + 512 * j);
        f8 v[4]; float ss = 0.f;
#pragma unroll
        for (int j = 0; j < 4; ++j) { v[j] = __builtin_convertvector(cur[j], f8);
#pragma unroll
            for (int e = 0; e < 8; ++e) ss += v[j][e] * v[j][e]; }
        const float rstd = 1.0f / sqrtf(wave_sum_fast(ss) * (1.0f / D) + EPS);
#pragma unroll
        for (int j = 0; j < 4; ++j) { float* o = out + (size_t)m * D + 8 * lane + 512 * j;
            *(GAS f32x4*)o = (f32x4){v[j][0], v[j][1], v[j][2], v[j][3]} * rstd * gs[j][0]; *(GAS f32x4*)(o + 4) = (f32x4){v[j][4], v[j][5], v[j][6], v[j][7]} * rstd * gs[j][1]; }
#pragma unroll
        for (int j = 0; j < 4; ++j) cur[j] = nxt[j]; }
}

struct ElemC { float lg[8], lbv[8], cw0[8], cw1[8], cw2[8]; };
__device__ __forceinline__ void elem_vn(const v4u raw, const ElemC& C, bf16* VN, int m, int lane) {
    float x[8];
    x[0] = gelu_tanh(bflo(raw.x)); x[1] = gelu_tanh(bfhi(raw.x)); x[2] = gelu_tanh(bflo(raw.y)); x[3] = gelu_tanh(bfhi(raw.y));
    x[4] = gelu_tanh(bflo(raw.z)); x[5] = gelu_tanh(bfhi(raw.z)); x[6] = gelu_tanh(bflo(raw.w)); x[7] = gelu_tanh(bfhi(raw.w));
    float s = 0.f;
#pragma unroll
    for (int e = 0; e < 8; ++e) s += x[e];
    const float mean = wave_sum_fast(s) * (1.0f / BW); float q = 0.f;
#pragma unroll
    for (int e = 0; e < 8; ++e) { x[e] -= mean; q += x[e] * x[e]; }
    const float rstd = 1.0f / sqrtf(wave_sum_fast(q) * (1.0f / BW) + EPS); float y[8];
#pragma unroll
    for (int e = 0; e < 8; ++e) y[e] = x[e] * rstd * C.lg[e] + C.lbv[e];
    v4u o; o.x = pk2(y[0], y[1]); o.y = pk2(y[2], y[3]); o.z = pk2(y[4], y[5]); o.w = pk2(y[6], y[7]);
    *(GAS v4u*)(VN + (size_t)m * BW + 8 * lane) = o;
}
__device__ __forceinline__ void elem_t(const v4u hc, const v4u gc, float zz, float (&t)[8]) {
    t[0] = zz * bflo(hc.x) * bflo(gc.x); t[1] = zz * bfhi(hc.x) * bfhi(gc.x); t[2] = zz * bflo(hc.y) * bflo(gc.y); t[3] = zz * bfhi(hc.y) * bfhi(gc.y);
    t[4] = zz * bflo(hc.z) * bflo(gc.z); t[5] = zz * bfhi(hc.z) * bfhi(gc.z); t[6] = zz * bflo(hc.w) * bflo(gc.w); t[7] = zz * bfhi(hc.w) * bfhi(gc.w);
}
__device__ __forceinline__ void elem_conv(const float (&t0)[8], const float (&t1)[8], const float (&t2)[8], const v4u gbr, const ElemC& C, bf16* YABC, int m, int lane) {
    float gb[8], y[8];
    gb[0] = bflo(gbr.x); gb[1] = bfhi(gbr.x); gb[2] = bflo(gbr.y); gb[3] = bfhi(gbr.y); gb[4] = bflo(gbr.z); gb[5] = bfhi(gbr.z); gb[6] = bflo(gbr.w); gb[7] = bfhi(gbr.w);
#pragma unroll
    for (int e = 0; e < 8; ++e) y[e] = gb[e] * (C.cw0[e] * t0[e] + C.cw1[e] * t1[e] + C.cw2[e] * t2[e]);
    v4u o; o.x = pk2(y[0], y[1]); o.y = pk2(y[2], y[3]); o.z = pk2(y[4], y[5]); o.w = pk2(y[6], y[7]);
    *(GAS v4u*)(YABC + (size_t)m * 2048 + 1536 + 8 * lane) = o;
}
__device__ __forceinline__ void elem_row(const bf16* Z2, const ElemC& C, bf16* VN, bf16* YABC, int m, int lane) {
    bool hp, hn; if (m < M_LAT) { const int p = m & 63; hp = p != 0; hn = p != 63; } else { const int p = (m - M_LAT) & 255; hp = p != 0; hn = p != 255; }
    const size_t mp = (size_t)(hp ? m - 1 : m), mn = (size_t)(hn ? m + 1 : m);
    const v4u raw = *(const GAS v4u*)(Z2 + (size_t)m * Z2W + Z2_V + 8 * lane);
    const v4u hc0 = *(const GAS v4u*)(Z2 + mp * Z2W + Z2_HC + 8 * lane), gc0 = *(const GAS v4u*)(Z2 + mp * Z2W + Z2_GC + 8 * lane);
    const v4u hc1 = *(const GAS v4u*)(Z2 + (size_t)m * Z2W + Z2_HC + 8 * lane), gc1 = *(const GAS v4u*)(Z2 + (size_t)m * Z2W + Z2_GC + 8 * lane);
    const v4u hc2 = *(const GAS v4u*)(Z2 + mn * Z2W + Z2_HC + 8 * lane), gc2 = *(const GAS v4u*)(Z2 + mn * Z2W + Z2_GC + 8 * lane);
    const v4u gbr = *(const GAS v4u*)(Z2 + (size_t)m * Z2W + Z2_GB + 8 * lane);
    elem_vn(raw, C, VN, m, lane);
    float t0[8], t1[8], t2[8]; elem_t(hc0, gc0, hp ? 1.0f : 0.0f, t0); elem_t(hc1, gc1, 1.0f, t1); elem_t(hc2, gc2, hn ? 1.0f : 0.0f, t2);
    elem_conv(t0, t1, t2, gbr, C, YABC, m, lane);
}
__device__ __forceinline__ void phase_mix_elem(int l) {
    const Frame F = mkframe(); unsigned char* ws = F.ws;
    const bf16* Z2 = (const bf16*)(ws + WS_Z2);
    bf16* VN = (bf16*)(ws + WS_VN); bf16* YABC = (bf16*)(ws + WS_YABC);
    const int gw = F.vcu * 8 + F.wave, NGW = F.G * 8, lane = F.lane;
    ElemC C;
    { const float* gp = INP(ILNG) + l * BW + 8 * lane; const float* bp = INP(ILNB) + l * BW + 8 * lane; const float* cw = INP(ICONV) + (size_t)l * 3 * CWD + 8 * lane;
#pragma unroll
      for (int e = 0; e < 8; ++e) { C.lg[e] = gp[e]; C.lbv[e] = bp[e]; C.cw0[e] = cw[e]; C.cw1[e] = cw[CWD + e]; C.cw2[e] = cw[2 * CWD + e]; } }
    if (NGW * 8 == M_LAT) {
#pragma unroll 1
        for (int h = 0; h < 4; ++h) { const int r0 = 8 * gw + 2 * h; const bool vp = (r0 & 63) != 0, vn = ((r0 + 1) & 63) != 63;
            v4u hc[4], gc[4], vv[2], gb[2];
#pragma unroll
            for (int i = 0; i < 4; ++i) { const int row = (i == 0 && !vp) ? r0 : (i == 3 && !vn) ? r0 + 1 : r0 - 1 + i;
                hc[i] = *(const GAS v4u*)(Z2 + (size_t)row * Z2W + Z2_HC + 8 * lane); gc[i] = *(const GAS v4u*)(Z2 + (size_t)row * Z2W + Z2_GC + 8 * lane); }
#pragma unroll
            for (int i = 0; i < 2; ++i) { vv[i] = *(const GAS v4u*)(Z2 + (size_t)(r0 + i) * Z2W + Z2_V + 8 * lane); gb[i] = *(const GAS v4u*)(Z2 + (size_t)(r0 + i) * Z2W + Z2_GB + 8 * lane); }
            float t[4][8];
#pragma unroll
            for (int i = 0; i < 4; ++i) elem_t(hc[i], gc[i], (i == 0 && !vp) || (i == 3 && !vn) ? 0.0f : 1.0f, t[i]);
#pragma unroll
            for (int i = 0; i < 2; ++i) { elem_vn(vv[i], C, VN, r0 + i, lane); elem_conv(t[i], t[i + 1], t[i + 2], gb[i], C, YABC, r0 + i, lane); } }
    } else {
        for (int m = gw; m < M_LAT; m += NGW) elem_row(Z2, C, VN, YABC, m, lane); }
    for (int m = M_LAT + (gw >> 1) + ((gw & 1) ? (NGW >> 1) : 0); m < M; m += NGW) elem_row(Z2, C, VN, YABC, m, lane);
}

template <int N> __device__ __forceinline__ float row_shl1(float v) { return __builtin_bit_cast(float, __builtin_amdgcn_update_dpp(0x3f800000, __builtin_bit_cast(int, v), 0x100 + N, 0xf, 0xf, false)); }
template <int N> __device__ __forceinline__ float row_shr1(float v) { return __builtin_bit_cast(float, __builtin_amdgcn_update_dpp(0x3f800000, __builtin_bit_cast(int, v), 0x110 + N, 0xf, 0xf, false)); }
template <int N> __device__ __forceinline__ float row_shr(float v) { return __builtin_bit_cast(float, __builtin_amdgcn_update_dpp(0, __builtin_bit_cast(int, v), 0x110 + N, 0xf, 0xf, true)); }
__device__ __forceinline__ float row16_prod(float x) { x *= dppf<0xB1>(x); x *= dppf<0x4E>(x); x *= dppf<0x124>(x); x *= dppf<0x128>(x); return x; }
__device__ __forceinline__ void phase_hgrn_prep(int l) {
    const Frame F = mkframe(); unsigned char* ws = F.ws;
    const _Float16* ZF = (const _Float16*)(ws + WS_ZF); const bf16* QS = (const bf16*)(ws + WS_QS); const float* LB = (const float*)(ws + WS_LB) + (size_t)l * 2 * WK;
    const int gw = F.vcu * 8 + F.wave, NGW = F.G * 8, lane = F.lane, fr = lane & 15, cq = lane >> 4;
    constexpr int NIT = (M / 32) * 32;
    const int per = (NIT + NGW - 1) / NGW, it0 = gw * per, it1 = (it0 + per < NIT) ? it0 + per : NIT;
#pragma unroll 2
    for (int it = it0; it < it1; ++it) { const int sc = it >> 5, jj = it & 31; const size_t rlo = (size_t)sc * 32 + fr, rhi = rlo + 16; const int c0 = 32 * jj + 8 * cq;
        const v4u qlo_r = *(const GAS v4u*)(QS + rlo * WK + c0), qhi_r = *(const GAS v4u*)(QS + rhi * WK + c0);
        const float qlo[8] = {bflo(qlo_r.x), bfhi(qlo_r.x), bflo(qlo_r.y), bfhi(qlo_r.y), bflo(qlo_r.z), bfhi(qlo_r.z), bflo(qlo_r.w), bfhi(qlo_r.w)};
        const float qhi[8] = {bflo(qhi_r.x), bfhi(qhi_r.x), bflo(qhi_r.y), bfhi(qhi_r.y), bflo(qhi_r.z), bfhi(qhi_r.z), bflo(qhi_r.w), bfhi(qhi_r.w)};
#pragma unroll
        for (int dir = 0; dir < 2; ++dir) {
            const pg8::ef32x8 zlo = __builtin_convertvector(*(const GAS pg8::eh16x8*)(ZF + rlo * 2048 + dir * WK + c0), pg8::ef32x8), zhi = __builtin_convertvector(*(const GAS pg8::eh16x8*)(ZF + rhi * 2048 + dir * WK + c0), pg8::ef32x8);
            const f32x4 b0 = *(const GAS f32x4*)(LB + dir * WK + c0), b1 = *(const GAS f32x4*)(LB + dir * WK + c0 + 4);
            float qtl[8], qth[8], ktl[8], kth[8], gt[8];
            float fl0, fl1, fl2, fl3, fl4, fl5, fl6, fl7, fh0, fh1, fh2, fh3, fh4, fh5, fh6, fh7;
#define HP_F(e_, dl, dh) { const float lb = (e_) < 4 ? b0[(e_) & 3] : b1[(e_) & 3]; const float oml = 1.0f - lb; dl = fmaxf(__builtin_fmaf(oml, __builtin_amdgcn_rcpf(1.0f + __builtin_amdgcn_exp2f(zlo[e_])), lb), 1e-30f); dh = fmaxf(__builtin_fmaf(oml, __builtin_amdgcn_rcpf(1.0f + __builtin_amdgcn_exp2f(zhi[e_])), lb), 1e-30f); }
            HP_F(0, fl0, fh0) HP_F(1, fl1, fh1) HP_F(2, fl2, fh2) HP_F(3, fl3, fh3) HP_F(4, fl4, fh4) HP_F(5, fl5, fh5) HP_F(6, fl6, fh6) HP_F(7, fl7, fh7)
#undef HP_F
#define HP_STEP(ctrl) "v_mul_f32_dpp %0, %0, %0 " ctrl " row_mask:0xf bank_mask:0xf\n\tv_mul_f32_dpp %1, %1, %1 " ctrl " row_mask:0xf bank_mask:0xf\n\tv_mul_f32_dpp %2, %2, %2 " ctrl " row_mask:0xf bank_mask:0xf\n\t" \
                      "v_mul_f32_dpp %3, %3, %3 " ctrl " row_mask:0xf bank_mask:0xf\n\tv_mul_f32_dpp %4, %4, %4 " ctrl " row_mask:0xf bank_mask:0xf\n\tv_mul_f32_dpp %5, %5, %5 " ctrl " row_mask:0xf bank_mask:0xf\n\t" \
                      "v_mul_f32_dpp %6, %6, %6 " ctrl " row_mask:0xf bank_mask:0xf\n\tv_mul_f32_dpp %7, %7, %7 " ctrl " row_mask:0xf bank_mask:0xf\n\t"
#define HP_OPS8(a) "+v"(a##0), "+v"(a##1), "+v"(a##2), "+v"(a##3), "+v"(a##4), "+v"(a##5), "+v"(a##6), "+v"(a##7)
#define HP_PROD8(a) asm("s_nop 1\n\t" HP_STEP("quad_perm:[1,0,3,2]") HP_STEP("quad_perm:[2,3,0,1]") HP_STEP("row_ror:4") HP_STEP("row_ror:8") "s_nop 1" : HP_OPS8(a))
#define HP_SCANL8(a) asm("s_nop 1\n\t" HP_STEP("row_shl:1") HP_STEP("row_shl:2") HP_STEP("row_shl:4") HP_STEP("row_shl:8") "s_nop 1" : HP_OPS8(a))
#define HP_SCANR8(a) asm("s_nop 1\n\t" HP_STEP("row_shr:1") HP_STEP("row_shr:2") HP_STEP("row_shr:4") HP_STEP("row_shr:8") "s_nop 1" : HP_OPS8(a))
#define HP_FIN8(ctrl, X, p, m) asm("s_nop 1\n\t" \
                "v_mul_f32_dpp %0, %8, %16 " ctrl " row_mask:0xf bank_mask:0xf\n\tv_mul_f32_dpp %1, %9, %17 " ctrl " row_mask:0xf bank_mask:0xf\n\tv_mul_f32_dpp %2, %10, %18 " ctrl " row_mask:0xf bank_mask:0xf\n\t" \
                "v_mul_f32_dpp %3, %11, %19 " ctrl " row_mask:0xf bank_mask:0xf\n\tv_mul_f32_dpp %4, %12, %20 " ctrl " row_mask:0xf bank_mask:0xf\n\tv_mul_f32_dpp %5, %13, %21 " ctrl " row_mask:0xf bank_mask:0xf\n\t" \
                "v_mul_f32_dpp %6, %14, %22 " ctrl " row_mask:0xf bank_mask:0xf\n\tv_mul_f32_dpp %7, %15, %23 " ctrl " row_mask:0xf bank_mask:0xf\n\ts_nop 1" \
                : "+&v"(X##0), "+&v"(X##1), "+&v"(X##2), "+&v"(X##3), "+&v"(X##4), "+&v"(X##5), "+&v"(X##6), "+&v"(X##7) : "v"(p##0), "v"(p##1), "v"(p##2), "v"(p##3), "v"(p##4), "v"(p##5), "v"(p##6), "v"(p##7), "v"(m##0), "v"(m##1), "v"(m##2), "v"(m##3), "v"(m##4), "v"(m##5), "v"(m##6), "v"(m##7))
            float tl0 = fl0, tl1 = fl1, tl2 = fl2, tl3 = fl3, tl4 = fl4, tl5 = fl5, tl6 = fl6, tl7 = fl7, th0 = fh0, th1 = fh1, th2 = fh2, th3 = fh3, th4 = fh4, th5 = fh5, th6 = fh6, th7 = fh7;
            HP_PROD8(tl); HP_PROD8(th);
            float pl0 = fl0, pl1 = fl1, pl2 = fl2, pl3 = fl3, pl4 = fl4, pl5 = fl5, pl6 = fl6, pl7 = fl7, ph0 = fh0, ph1 = fh1, ph2 = fh2, ph3 = fh3, ph4 = fh4, ph5 = fh5, ph6 = fh6, ph7 = fh7;
            const float one0 = 1.0f, one1 = 1.0f, one2 = 1.0f, one3 = 1.0f, one4 = 1.0f, one5 = 1.0f, one6 = 1.0f, one7 = 1.0f;
            float Xl0, Xl1, Xl2, Xl3, Xl4, Xl5, Xl6, Xl7, Xh0, Xh1, Xh2, Xh3, Xh4, Xh5, Xh6, Xh7;
            if (dir == 0) { HP_SCANL8(pl); HP_SCANL8(ph);
                Xl0 = th0; Xl1 = th1; Xl2 = th2; Xl3 = th3; Xl4 = th4; Xl5 = th5; Xl6 = th6; Xl7 = th7; HP_FIN8("row_shl:1", Xl, pl, th);
                Xh0 = 1.0f; Xh1 = 1.0f; Xh2 = 1.0f; Xh3 = 1.0f; Xh4 = 1.0f; Xh5 = 1.0f; Xh6 = 1.0f; Xh7 = 1.0f; HP_FIN8("row_shl:1", Xh, ph, one); }
            else { HP_SCANR8(pl); HP_SCANR8(ph);
                Xl0 = 1.0f; Xl1 = 1.0f; Xl2 = 1.0f; Xl3 = 1.0f; Xl4 = 1.0f; Xl5 = 1.0f; Xl6 = 1.0f; Xl7 = 1.0f; HP_FIN8("row_shr:1", Xl, pl, one);
                Xh0 = tl0; Xh1 = tl1; Xh2 = tl2; Xh3 = tl3; Xh4 = tl4; Xh5 = tl5; Xh6 = tl6; Xh7 = tl7; HP_FIN8("row_shr:1", Xh, ph, tl); }
#define HP_OUT(e_) ktl[e_] = __builtin_fmaf(-fl##e_, Xl##e_, Xl##e_); kth[e_] = __builtin_fmaf(-fh##e_, Xh##e_, Xh##e_); qtl[e_] = qlo[e_] * __builtin_amdgcn_rcpf(fmaxf(Xl##e_, 1e-35f)); qth[e_] = qhi[e_] * __builtin_amdgcn_rcpf(fmaxf(Xh##e_, 1e-35f)); gt[e_] = tl##e_ * th##e_;
            HP_OUT(0) HP_OUT(1) HP_OUT(2) HP_OUT(3) HP_OUT(4) HP_OUT(5) HP_OUT(6) HP_OUT(7)
#undef HP_OUT
#undef HP_FIN8
#undef HP_SCANR8
#undef HP_SCANL8
#undef HP_PROD8
#undef HP_OPS8
#undef HP_STEP
            bf16* Qd = (bf16*)(ws + (dir ? WS_QB : WS_QF)); bf16* Kd = (bf16*)(ws + (dir ? WS_KB : WS_KF)); float* Gd = (float*)(ws + (dir ? WS_GB : WS_GF));
            v4u o; o.x = pk2(qtl[0], qtl[1]); o.y = pk2(qtl[2], qtl[3]); o.z = pk2(qtl[4], qtl[5]); o.w = pk2(qtl[6], qtl[7]); *(GAS v4u*)(Qd + rlo * WK + c0) = o;
            o.x = pk2(qth[0], qth[1]); o.y = pk2(qth[2], qth[3]); o.z = pk2(qth[4], qth[5]); o.w = pk2(qth[6], qth[7]); *(GAS v4u*)(Qd + rhi * WK + c0) = o;
            o.x = pk2(ktl[0], ktl[1]); o.y = pk2(ktl[2], ktl[3]); o.z = pk2(ktl[4], ktl[5]); o.w = pk2(ktl[6], ktl[7]); *(GAS v4u*)(Kd + rlo * WK + c0) = o;
            o.x = pk2(kth[0], kth[1]); o.y = pk2(kth[2], kth[3]); o.z = pk2(kth[4], kth[5]); o.w = pk2(kth[6], kth[7]); *(GAS v4u*)(Kd + rhi * WK + c0) = o;
            if (fr == 0) { *(GAS f32x4*)(Gd + (size_t)sc * WK + c0) = (f32x4){gt[0], gt[1], gt[2], gt[3]}; *(GAS f32x4*)(Gd + (size_t)sc * WK + c0 + 4) = (f32x4){gt[4], gt[5], gt[6], gt[7]}; }
        } }
}

typedef short s16x4 __attribute__((ext_vector_type(4)));
typedef short hb16x8 __attribute__((ext_vector_type(8)));
constexpr int HG_P = 272;
constexpr int HG_QI = 0, HG_KI = 32 * HG_P, HG_VI = 64 * HG_P, HG_GI = 96 * HG_P, HG_BUF = 96 * HG_P + 512 + 256;
constexpr int HG_NSTEP = (CTXL + SEQ) / 32, HG_NSEG = 4, HG_SEGLEN = HG_NSTEP / HG_NSEG, HG_NCTX = CTXL / 32;
static_assert(HG_SEGLEN * HG_NSEG == HG_NSTEP && HG_SEGLEN % 2 == 0, "segment loop below is unrolled by 2");
__device__ __forceinline__ int hg_row0(int s, int cstep, int cbase, int lbase2) { return cstep * s + (s < HG_NCTX ? cbase : lbase2); }
struct HgReg { v4u a, b, c, d; };
template <bool FULL> __device__ __forceinline__ void hg_gload(HgReg& R, int r0, const bf16* Qp, const bf16* Kp, const bf16* Vp, const float* Gp, int tid) {
    const int row = tid >> 4, ch = tid & 15; const size_t o = (size_t)(r0 + row) * WK + 8 * ch;
    if (FULL) R.a = *(const GAS v4u*)(Qp + o);
    R.b = *(const GAS v4u*)(Kp + o); R.c = *(const GAS v4u*)(Vp + o);
    R.d = *(const GAS v4u*)(Gp + (size_t)(r0 >> 5) * WK + 4 * (tid & 31));
}
template <bool FULL> __device__ __forceinline__ void hg_lwrite(const HgReg& R, LAS unsigned char* buf, int tid) {
    const int row = tid >> 4, ch = tid & 15;
    if (FULL) *(LAS v4u*)(buf + HG_QI + row * HG_P + 16 * ch) = R.a;
    *(LAS v4u*)(buf + HG_KI + row * HG_P + 16 * ch) = R.b; *(LAS v4u*)(buf + HG_VI + row * HG_P + 16 * ch) = R.c;
    if (tid < 32) *(LAS v4u*)(buf + HG_GI + 16 * tid) = R.d;
}
template <bool FULL> __device__ __forceinline__ void hg_step(const LAS unsigned char* buf, int r0, int w, f32x4 (&S)[8], f32x4& GA, _Float16* Op, int lane, int dir) {
    const int idx = lane & 15, rq = lane >> 4;
    v2u q[2][8], k[2][8];
    f32x4 P[2][2];
    if (FULL) {
#pragma unroll
        for (int tb = 0; tb < 2; ++tb)
#pragma unroll
            for (int j = 0; j < 8; ++j) { q[tb][j] = *(const LAS v2u*)(buf + HG_QI + (16 * tb + idx) * HG_P + (16 * j + 4 * rq) * 2); k[tb][j] = *(const LAS v2u*)(buf + HG_KI + (16 * tb + idx) * HG_P + (16 * j + 4 * rq) * 2); }
#pragma unroll
        for (int sb = 0; sb < 2; ++sb)
#pragma unroll
            for (int tb = 0; tb < 2; ++tb) { f32x4 p = (f32x4){0.f, 0.f, 0.f, 0.f};
#pragma unroll
                for (int ks = 0; ks < 4; ++ks) { v4u a, b; a.x = k[sb][2 * ks].x; a.y = k[sb][2 * ks].y; a.z = k[sb][2 * ks + 1].x; a.w = k[sb][2 * ks + 1].y; b.x = q[tb][2 * ks].x; b.y = q[tb][2 * ks].y; b.z = q[tb][2 * ks + 1].x; b.w = q[tb][2 * ks + 1].y;
                    p = __builtin_amdgcn_mfma_f32_16x16x32_bf16(__builtin_bit_cast(hb16x8, a), __builtin_bit_cast(hb16x8, b), p, 0, 0, 0); }
                P[sb][tb] = p; } }
#pragma unroll
    for (int kb = 0; kb < 8; ++kb) { const f32x4 gv = *(const LAS f32x4*)(buf + HG_GI + (16 * kb + 4 * rq) * 4); S[kb] = S[kb] * gv; if (kb == w) GA = GA * gv; }
    f32x4 o[2];
    o[0] = (f32x4){0.f, 0.f, 0.f, 0.f}; o[1] = (f32x4){0.f, 0.f, 0.f, 0.f};
    if (FULL) {
#pragma unroll
    for (int ks = 0; ks < 4; ++ks) { v4u a; a.x = pg8::cvt_pk_bf16(S[2 * ks][0], S[2 * ks][1]); a.y = pg8::cvt_pk_bf16(S[2 * ks][2], S[2 * ks][3]); a.z = pg8::cvt_pk_bf16(S[2 * ks + 1][0], S[2 * ks + 1][1]); a.w = pg8::cvt_pk_bf16(S[2 * ks + 1][2], S[2 * ks + 1][3]);
#pragma unroll
        for (int tb = 0; tb < 2; ++tb) { v4u b; b.x = q[tb][2 * ks].x; b.y = q[tb][2 * ks].y; b.z = q[tb][2 * ks + 1].x; b.w = q[tb][2 * ks + 1].y;
            o[tb] = __builtin_amdgcn_mfma_f32_16x16x32_bf16(__builtin_bit_cast(hb16x8, a), __builtin_bit_cast(hb16x8, b), o[tb], 0, 0, 0); } } }
    s16x4 vt0, vt1, k0[8], k1[8];
    { const unsigned q_ = (unsigned)(idx >> 2), p_ = (unsigned)(idx & 3);
      const unsigned va = (unsigned)(size_t)(buf + HG_VI) + (4u * rq + q_) * HG_P + 32u * (unsigned)w + 8u * p_, ka = (unsigned)(size_t)(buf + HG_KI) + (4u * rq + q_) * HG_P + 8u * p_;
      asm volatile("s_waitcnt lgkmcnt(0)\n\t"
                   "ds_read_b64_tr_b16 %0, %18\n\t"
                   "ds_read_b64_tr_b16 %1, %18 offset:4352\n\t"
                   "ds_read_b64_tr_b16 %2, %19\n\t"
                   "ds_read_b64_tr_b16 %3, %19 offset:32\n\t"
                   "ds_read_b64_tr_b16 %4, %19 offset:64\n\t"
                   "ds_read_b64_tr_b16 %5, %19 offset:96\n\t"
                   "ds_read_b64_tr_b16 %6, %19 offset:128\n\t"
                   "ds_read_b64_tr_b16 %7, %19 offset:160\n\t"
                   "ds_read_b64_tr_b16 %8, %19 offset:192\n\t"
                   "ds_read_b64_tr_b16 %9, %19 offset:224\n\t"
                   "ds_read_b64_tr_b16 %10, %19 offset:4352\n\t"
                   "ds_read_b64_tr_b16 %11, %19 offset:4384\n\t"
                   "ds_read_b64_tr_b16 %12, %19 offset:4416\n\t"
                   "ds_read_b64_tr_b16 %13, %19 offset:4448\n\t"
                   "ds_read_b64_tr_b16 %14, %19 offset:4480\n\t"
                   "ds_read_b64_tr_b16 %15, %19 offset:4512\n\t"
                   "ds_read_b64_tr_b16 %16, %19 offset:4544\n\t"
                   "ds_read_b64_tr_b16 %17, %19 offset:4576\n\t"
                   "s_waitcnt lgkmcnt(0)"
                   : "=&v"(vt0), "=&v"(vt1), "=&v"(k0[0]), "=&v"(k0[1]), "=&v"(k0[2]), "=&v"(k0[3]), "=&v"(k0[4]), "=&v"(k0[5]), "=&v"(k0[6]), "=&v"(k0[7]),
                     "=&v"(k1[0]), "=&v"(k1[1]), "=&v"(k1[2]), "=&v"(k1[3]), "=&v"(k1[4]), "=&v"(k1[5]), "=&v"(k1[6]), "=&v"(k1[7])
                   : "v"(va), "v"(ka) : "memory"); }
    static_assert(16 * HG_P == 4352, "tr-read row offsets above");
    const hb16x8 vfrag = __builtin_shufflevector(vt0, vt1, 0, 1, 2, 3, 4, 5, 6, 7);
    if (FULL) {
#pragma unroll
      for (int tb = 0; tb < 2; ++tb) { v4u pb; float pm[2][4];
#pragma unroll
        for (int sb = 0; sb < 2; ++sb)
#pragma unroll
            for (int i = 0; i < 4; ++i) { const int s_ = 16 * sb + 4 * rq + i, t_ = 16 * tb + idx; const bool keep = dir ? (s_ >= t_) : (s_ <= t_); pm[sb][i] = keep ? P[sb][tb][i] : 0.f; }
        pb.x = pg8::cvt_pk_bf16(pm[0][0], pm[0][1]); pb.y = pg8::cvt_pk_bf16(pm[0][2], pm[0][3]); pb.z = pg8::cvt_pk_bf16(pm[1][0], pm[1][1]); pb.w = pg8::cvt_pk_bf16(pm[1][2], pm[1][3]);
        o[tb] = __builtin_amdgcn_mfma_f32_16x16x32_bf16(vfrag, __builtin_bit_cast(hb16x8, pb), o[tb], 0, 0, 0); } }
#pragma unroll
    for (int kb = 0; kb < 8; ++kb) { const hb16x8 kfrag = __builtin_shufflevector(k0[kb], k1[kb], 0, 1, 2, 3, 4, 5, 6, 7);
        S[kb] = __builtin_amdgcn_mfma_f32_16x16x32_bf16(kfrag, vfrag, S[kb], 0, 0, 0); }
    if (FULL) {
#pragma unroll
        for (int tb = 0; tb < 2; ++tb) *(GAS h16x4*)(Op + (size_t)(r0 + 16 * tb + idx) * WK + 4 * rq) = __builtin_convertvector(o[tb], h16x4); }
}
#define HG_BARRIER() do { asm volatile("s_waitcnt lgkmcnt(0)" ::: "memory"); __builtin_amdgcn_s_barrier(); asm volatile("" ::: "memory"); } while (0)
template <int PASS> __device__ __forceinline__ void phase_hgrn() {
    const Frame F = mkframe(); unsigned char* ws = F.ws;
    const int lane = F.lane, tid = F.tid, w = F.wave;
    constexpr bool FULL = PASS == 1;
    for (int task = F.vcu; task < 64 * HG_NSEG; task += F.G) {
        const int chain = task >> 2, seg = task & 3, b = chain >> 4, h = (chain >> 1) & 7, dir = chain & 1;
        if (PASS == 0 && seg == HG_NSEG - 1) continue;
        const bf16* Qp = (const bf16*)(ws + (dir ? WS_QB : WS_QF)) + h * DK; const bf16* Kp = (const bf16*)(ws + (dir ? WS_KB : WS_KF)) + h * DK;
        const bf16* Vp = (const bf16*)(ws + WS_VV) + h * DV; const float* Gp = (const float*)(ws + (dir ? WS_GB : WS_GF)) + h * DK;
        _Float16* Op = (_Float16*)(ws + (dir ? WS_OB : WS_OF)) + h * DV + 16 * w;
        f32x4* SL = (f32x4*)(ws + WS_SLOC);
        LAS unsigned char* buf0 = F.lds; LAS unsigned char* buf1 = F.lds + HG_BUF;
        const int cstep = dir ? -32 : 32, cbase = M_LAT + b * CTXL + (dir ? CTXL - 32 : 0), lbase2 = b * SEQ + (dir ? SEQ - 32 : 0) - HG_NCTX * cstep;
        f32x4 S[8], GA = (f32x4){1.f, 1.f, 1.f, 1.f};
#pragma unroll
        for (int kb = 0; kb < 8; ++kb) S[kb] = (f32x4){0.f, 0.f, 0.f, 0.f};
        if (PASS == 1) {
#pragma unroll 1
            for (int k = 0; k < seg; ++k) { const f32x4* p = SL + (size_t)(task - seg + k) * 4608 + lane;
#pragma unroll
                for (int kb = 0; kb < 8; ++kb) S[kb] = S[kb] * p[4096 + kb * 64] + p[(w * 8 + kb) * 64]; } }
        const int s0 = seg * HG_SEGLEN, slast = s0 + HG_SEGLEN - 1;
#define HG_ROW(s_) hg_row0((s_) < slast ? (s_) : slast, cstep, cbase, lbase2)
        HgReg R0, R1;
        __syncthreads();
        hg_gload<FULL>(R0, HG_ROW(s0), Qp, Kp, Vp, Gp, tid); hg_lwrite<FULL>(R0, buf0, tid);
        hg_gload<FULL>(R1, HG_ROW(s0 + 1), Qp, Kp, Vp, Gp, tid);
        HG_BARRIER();
#pragma unroll 1
        for (int s = s0; s < s0 + HG_SEGLEN; s += 2) {
            hg_gload<FULL>(R0, HG_ROW(s + 2), Qp, Kp, Vp, Gp, tid);
            hg_step<FULL>(buf0, hg_row0(s, cstep, cbase, lbase2), w, S, GA, Op, lane, dir);
            hg_lwrite<FULL>(R1, buf1, tid); HG_BARRIER();
            hg_gload<FULL>(R1, HG_ROW(s + 3), Qp, Kp, Vp, Gp, tid);
            hg_step<FULL>(buf1, hg_row0(s + 1, cstep, cbase, lbase2), w, S, GA, Op, lane, dir);
            hg_lwrite<FULL>(R0, buf0, tid); HG_BARRIER();
        }
#undef HG_ROW
        if (PASS == 0) { f32x4* p = SL + (size_t)task * 4608 + lane;
#pragma unroll
            for (int kb = 0; kb < 8; ++kb) p[(w * 8 + kb) * 64] = S[kb];
            p[4096 + w * 64] = GA; }
    }
}

constexpr int GM_P = 272, GM_WI = 0, GM_VI = 128 * GM_P;
__device__ __forceinline__ void phase_gmlp(int l) {
    const Frame F = mkframe(); unsigned char* ws = F.ws;
    const bf16* Z2 = (const bf16*)(ws + WS_Z2); const bf16* VN = (const bf16*)(ws + WS_VN); bf16* YABC = (bf16*)(ws + WS_YABC);
    const int tid = F.tid, lane = F.lane, w = F.wave, idx = lane & 15, rq = lane >> 4;
    if ((F.vcu & 3) != HG_NSEG - 1) return;
    const int jw = F.vcu >> 2, g = jw & 3, nper = F.G >> 4;
    if ((jw >> 2) >= M / 128) return;
    __syncthreads();
    { const float* wsrc = INP(IWS) + ((size_t)l * 4 + g) * 128 * 128;
#pragma unroll
      for (int i = 0; i < 8; ++i) { const int e = (i * 512 + tid) * 4, t = e >> 7, s0 = e & 127; const f32x4 v = *(const GAS f32x4*)(wsrc + e);
          *(LAS v2u*)(F.lds + GM_WI + t * GM_P + 2 * s0) = (v2u){pk2(v[0], v[1]), pk2(v[2], v[3])}; } }
    for (int chunk = jw >> 2; chunk < M / 128; chunk += nper) { const size_t r0 = (size_t)chunk * 128;
        __syncthreads();
#pragma unroll
        for (int i = 0; i < 4; ++i) { const int e = i * 512 + tid, srow = e >> 4, c8 = e & 15;
            *(LAS v4u*)(F.lds + GM_VI + srow * GM_P + 16 * c8) = *(const GAS v4u*)(VN + (r0 + srow) * BW + g * 128 + 8 * c8); }
        __syncthreads();
        v4u bfr[4];
#pragma unroll
        for (int ks = 0; ks < 4; ++ks) bfr[ks] = *(const LAS v4u*)(F.lds + GM_WI + (16 * w + idx) * GM_P + (32 * ks + 8 * rq) * 2);
        const float bs = INP(IBS)[((size_t)l * 4 + g) * 128 + 16 * w + idx];
        v2u urv[8];
#pragma unroll
        for (int cb = 0; cb < 8; ++cb) urv[cb] = *(const GAS v2u*)(Z2 + (r0 + 16 * w + idx) * Z2W + Z2_U + g * 128 + 16 * cb + 4 * rq);
        const unsigned q_ = (unsigned)(idx >> 2), p_ = (unsigned)(idx & 3);
        const unsigned va = (unsigned)(size_t)(F.lds + GM_VI) + (8u * rq + q_) * GM_P + 8u * p_;
#pragma unroll
        for (int cb = 0; cb < 8; ++cb) {
            s16x4 t0[4], t1[4];
            asm volatile("ds_read_b64_tr_b16 %0, %8\n\t"
                         "ds_read_b64_tr_b16 %1, %8 offset:1088\n\t"
                         "ds_read_b64_tr_b16 %2, %9\n\t"
                         "ds_read_b64_tr_b16 %3, %9 offset:1088\n\t"
                         "ds_read_b64_tr_b16 %4, %10\n\t"
                         "ds_read_b64_tr_b16 %5, %10 offset:1088\n\t"
                         "ds_read_b64_tr_b16 %6, %11\n\t"
                         "ds_read_b64_tr_b16 %7, %11 offset:1088\n\t"
                         "s_waitcnt lgkmcnt(0)"
                         : "=&v"(t0[0]), "=&v"(t1[0]), "=&v"(t0[1]), "=&v"(t1[1]), "=&v"(t0[2]), "=&v"(t1[2]), "=&v"(t0[3]), "=&v"(t1[3])
                         : "v"(va + 32u * cb), "v"(va + 32u * cb + 32u * GM_P), "v"(va + 32u * cb + 64u * GM_P), "v"(va + 32u * cb + 96u * GM_P) : "memory");
            f32x4 acc = (f32x4){0.f, 0.f, 0.f, 0.f};
#pragma unroll
            for (int ks = 0; ks < 4; ++ks) { const hb16x8 afr = __builtin_shufflevector(t0[ks], t1[ks], 0, 1, 2, 3, 4, 5, 6, 7);
                acc = __builtin_amdgcn_mfma_f32_16x16x32_bf16(afr, __builtin_bit_cast(hb16x8, bfr[ks]), acc, 0, 0, 0); }
            const size_t row = r0 + 16 * w + idx; const int ch = g * 128 + 16 * cb + 4 * rq;
            const v2u ur = urv[cb];
            const float y0 = gelu_tanh(bflo(ur.x)) * (acc[0] + bs), y1 = gelu_tanh(bfhi(ur.x)) * (acc[1] + bs), y2 = gelu_tanh(bflo(ur.y)) * (acc[2] + bs), y3 = gelu_tanh(bfhi(ur.y)) * (acc[3] + bs);
            *(GAS v2u*)(YABC + row * 2048 + 1024 + ch) = (v2u){pk2(y0, y1), pk2(y2, y3)};
        }
    }
    __syncthreads();
}

struct RoRow { pg8::eh16x8 f0, f1, b0, b1; v4u g0, g1; };
__device__ __forceinline__ void ro_load(RoRow& R, const _Float16* OFp, const _Float16* OBp, const bf16* Z2, int m, int lane) {
    R.f0 = *(const GAS pg8::eh16x8*)(OFp + (size_t)m * WK + 16 * lane); R.f1 = *(const GAS pg8::eh16x8*)(OFp + (size_t)m * WK + 16 * lane + 8);
    R.b0 = *(const GAS pg8::eh16x8*)(OBp + (size_t)m * WK + 16 * lane); R.b1 = *(const GAS pg8::eh16x8*)(OBp + (size_t)m * WK + 16 * lane + 8);
    R.g0 = *(const GAS v4u*)(Z2 + (size_t)m * Z2W + Z2_GA + 16 * lane); R.g1 = *(const GAS v4u*)(Z2 + (size_t)m * Z2W + Z2_GA + 16 * lane + 8);
}
__device__ __forceinline__ void ro_finish(const RoRow& R, const float (&ag)[16], bf16* YABC, int m, int lane) {
    const pg8::ef32x8 a0 = __builtin_convertvector(R.f0, pg8::ef32x8), a1 = __builtin_convertvector(R.f1, pg8::ef32x8), c0 = __builtin_convertvector(R.b0, pg8::ef32x8), c1 = __builtin_convertvector(R.b1, pg8::ef32x8);
    float o[16]; float ss = 0.f;
#pragma unroll
    for (int e = 0; e < 8; ++e) { o[e] = a0[e] + c0[e]; o[8 + e] = a1[e] + c1[e]; ss += o[e] * o[e] + o[8 + e] * o[8 + e]; }
    ss += dppf<0xB1>(ss); ss += dppf<0x4E>(ss); ss += dppf<0x141>(ss);
    const float rstd = 1.0f / sqrtf(ss * (1.0f / DV) + EPS);
    const v4u g0 = R.g0, g1 = R.g1; float ga[16];
    ga[0] = bflo(g0.x); ga[1] = bfhi(g0.x); ga[2] = bflo(g0.y); ga[3] = bfhi(g0.y); ga[4] = bflo(g0.z); ga[5] = bfhi(g0.z); ga[6] = bflo(g0.w); ga[7] = bfhi(g0.w);
    ga[8] = bflo(g1.x); ga[9] = bfhi(g1.x); ga[10] = bflo(g1.y); ga[11] = bfhi(g1.y); ga[12] = bflo(g1.z); ga[13] = bfhi(g1.z); ga[14] = bflo(g1.w); ga[15] = bfhi(g1.w);
    float y[16];
#pragma unroll
    for (int e = 0; e < 16; ++e) y[e] = o[e] * rstd * ag[e] * siluf_(ga[e]);
    v4u w0, w1; w0.x = pk2(y[0], y[1]); w0.y = pk2(y[2], y[3]); w0.z = pk2(y[4], y[5]); w0.w = pk2(y[6], y[7]); w1.x = pk2(y[8], y[9]); w1.y = pk2(y[10], y[11]); w1.z = pk2(y[12], y[13]); w1.w = pk2(y[14], y[15]);
    *(GAS v4u*)(YABC + (size_t)m * 2048 + 16 * lane) = w0; *(GAS v4u*)(YABC + (size_t)m * 2048 + 16 * lane + 8) = w1;
}
__device__ __forceinline__ void phase_readout(int l) {
    const Frame F = mkframe(); unsigned char* ws = F.ws;
    const _Float16* OFp = (const _Float16*)(ws + WS_OF); const _Float16* OBp = (const _Float16*)(ws + WS_OB); const bf16* Z2 = (const bf16*)(ws + WS_Z2); bf16* YABC = (bf16*)(ws + WS_YABC);
    const int gw = F.vcu * 8 + F.wave, NGW = F.G * 8, lane = F.lane;
    float ag[16];
    { const float* agp = INP(IANORM) + l * DV + (16 * lane & 127);
#pragma unroll
      for (int e = 0; e < 16; ++e) ag[e] = agp[e]; }
    const int per = (M_LAT + NGW - 1) / NGW, m0 = gw * per, m1 = (m0 + per < M_LAT) ? m0 + per : M_LAT;
    if (m0 < m1) { RoRow cur, nxt; ro_load(cur, OFp, OBp, Z2, m0, lane);
#pragma unroll 1
        for (int m = m0; m < m1; ++m) { ro_load(nxt, OFp, OBp, Z2, m + 1 < m1 ? m + 1 : m, lane); ro_finish(cur, ag, YABC, m, lane); cur = nxt; } }
    for (int m = M_LAT + (gw >> 1) + ((gw & 1) ? (NGW >> 1) : 0); m < M; m += NGW) { RoRow cur; ro_load(cur, OFp, OBp, Z2, m, lane); ro_finish(cur, ag, YABC, m, lane); }
}

constexpr int PH_PER_LAYER = 13, N_PHASES = 1 + DEPTH * PH_PER_LAYER + 1;
__device__ __forceinline__ void grid_seam() {
    extern __shared__ __attribute__((aligned(16))) unsigned char lds_dyn[];
    XcdBarrier bar; bar.bar = (unsigned*)(kargs()->ws + WS_CTL) + CW_BAR; bar.x = xb_xcc_id(); bar.st = (volatile LAS unsigned*)((LAS unsigned char*)lds_dyn + MISC_OFF) + 8;
    xcd_barrier(bar);
}
__global__ void __launch_bounds__(512, 2) fwd_kernel(Args args_unused) {
    extern __shared__ __attribute__((aligned(16))) unsigned char lds_dyn[];
    { LAS unsigned char* lds = (LAS unsigned char*)lds_dyn;
      for (int u = threadIdx.x; u < (LDS_BYTES - LDSCTL_OFF) / 4; u += 512) ((LAS unsigned*)(lds + LDSCTL_OFF))[u] = 0u;
      __syncthreads();
      if (kargs()->ph_hi - kargs()->ph_lo > 1) (void)xcd_barrier_post((unsigned*)(kargs()->ws + WS_CTL) + CW_BAR, (volatile LAS unsigned*)(lds + MISC_OFF) + 8); }
    const int lo = kargs()->ph_lo, hi = kargs()->ph_hi;
#define IN(k) (lo <= (k) && (k) < hi)
#define SEAM(k) do { if (IN((k) + 1)) grid_seam(); } while (0)
#define LDSP ((LAS unsigned char*)lds_dyn)
#define WSP(off) (kargs()->ws + (off))

    if (IN(0)) { phase_prologue(); __syncthreads(); SEAM(0); }

#pragma unroll 1
    for (int l = 0; l < DEPTH; ++l) {
        const int pb = 1 + l * PH_PER_LAYER;
        if (hi <= pb || lo >= pb + PH_PER_LAYER) continue;
#pragma unroll 1
        for (int j = 0; j < 2; ++j) {
            const int p0 = pb + (j ? 10 : 0);
            const bool noctx = (l == DEPTH - 1) && j == 1;
            if (IN(p0)) { if (j) phase_norm(l, 2, noctx ? M_LAT : M, noctx ? 0 : 1, l, 5, 1.0f); else { if (l > 0) convert_rest(l); phase_norm(l, 0, M, l > 0 ? 1 : 0, l - 1, 8, 0.5f); } SEAM(p0); }
            if (IN(p0 + 1)) { pg8::Gemm g{(const bf16*)WSP(WS_H), (const bf16*)WSP(WS_WGU) + (size_t)(l * 2 + j) * (2 * DFF) * D, M, 2 * DFF, D, D, D};
                pg8::StaticOrder S; S.init(noctx ? M_LAT : M, 2 * DFF, (int)gridDim.x, (int)blockIdx.x, D); pg8::EpiSwiGLU E{(bf16*)WSP(WS_ACT)};
                pg8::gemm_phase<pg8::EpiSwiGLU, pg8::StaticOrder, true, true>(LDSP, g, S, E);
                if (l < DEPTH - 1) convert_slot(l + 1, j ? 3 : 0, (M / 256) * (2 * DFF / 256), CV_Q_GU);
                SEAM(p0 + 1); }
            if (IN(p0 + 2)) { pg8::Gemm g{(const bf16*)WSP(WS_ACT), (const bf16*)WSP(WS_WD) + (size_t)(l * 2 + j) * D * DFF, M, D, DFF, DFF, DFF};
                pg8::SplitOrder S; S.init((int)gridDim.x, (int)blockIdx.x, DFF, !noctx); pg8::EpiResid E{(ytype*)WSP(WS_Y), (const float*)WSP(WS_MOD) + (size_t)l * NGRP * MODW + (j ? 8 : 2) * D, 0.5f, (float*)WSP(WS_MF32)};
                pg8::gemm_phase<pg8::EpiResid, pg8::SplitOrder, true, true>(LDSP, g, S, E); SEAM(p0 + 2); }
            if (j == 0) {
                const bool lastl = (l == DEPTH - 1);
                if (IN(pb + 3)) { phase_norm(l, 1, M, 1, l, 2, 0.5f); SEAM(pb + 3); }
                if (IN(pb + 4)) { pg8::Gemm g{(const bf16*)WSP(WS_H), (const bf16*)WSP(WS_WIN) + (size_t)l * INW * D, M, INW, D, D, D};
                    pg8::InprojOrder S; S.init((int)gridDim.x, (int)blockIdx.x, D, lastl ? 16 : 54); pg8::EpiInproj E{(bf16*)WSP(WS_QS), (bf16*)WSP(WS_VV), (_Float16*)WSP(WS_ZF), (bf16*)WSP(WS_Z2)};
                    pg8::gemm_phase<pg8::EpiInproj, pg8::InprojOrder, true, true>(LDSP, g, S, E);
                    if (!lastl) convert_slot(l + 1, 1, 64 * 54 + 4 * 54, CV_Q_IN);
                    SEAM(pb + 4); }
                if (IN(pb + 5)) { phase_hgrn_prep(l); phase_mix_elem(l); SEAM(pb + 5); }
                if (IN(pb + 6)) { phase_hgrn<0>(); phase_gmlp(l); grid_seam(); phase_hgrn<1>(); SEAM(pb + 6); }
                if (IN(pb + 7)) { phase_readout(l); SEAM(pb + 7); }
                if (IN(pb + 8)) { pg8::Gemm g{(const bf16*)WSP(WS_YABC), (const bf16*)WSP(WS_WP) + (size_t)l * D * 2048, M, D, 2048, 2048, 2048};
                    pg8::StaticOrder S; S.init(lastl ? M_LAT : M, D, (int)gridDim.x, (int)blockIdx.x, 2048); pg8::EpiProjF E{(bf16*)WSP(WS_MRG), (const bf16*)WSP(WS_Z2)};
                    pg8::gemm_phase<pg8::EpiProjF, pg8::StaticOrder, true, true>(LDSP, g, S, E);
                    if (!lastl) convert_slot(l + 1, 2, (M / 256) * (D / 256), CV_Q_PJ);
                    SEAM(pb + 8); }
                if (IN(pb + 9)) { pg8::Gemm g{(const bf16*)WSP(WS_MRG), (const bf16*)WSP(WS_WO) + (size_t)l * D * D, M, D, D, D, D};
                    pg8::SplitOrder S; S.init((int)gridDim.x, (int)blockIdx.x, D, !lastl); pg8::EpiResid E{(ytype*)WSP(WS_Y), (const float*)WSP(WS_MOD) + (size_t)l * NGRP * MODW + 5 * D, 1.0f, (float*)WSP(WS_MF32)};
                    pg8::gemm_phase<pg8::EpiResid, pg8::SplitOrder, true, true>(LDSP, g, S, E); SEAM(pb + 9); }
            }
        }
    }
    if (IN(N_PHASES - 1)) phase_final();
#undef IN
#undef SEAM
}

#ifndef MK_PER_PHASE
#define MK_PER_PHASE 0
#endif
extern "C" void kernel_launch(void* const* d_in, const int* in_sizes, int n_in, void* d_out, int out_size, void* d_ws, size_t ws_size, hipStream_t stream) {
    static int grid = 0;
    if (grid == 0) {
        if (n_in != 23 || out_size != M_LAT * D || ws_size < WS_END) { fprintf(stderr, "kernel_launch: unexpected sizes n_in %d out %d ws %zu (need %zu)\n", n_in, out_size, ws_size, (size_t)WS_END); grid = -1; return; }
        int dev = 0, cus = 0, per_cu = 0;
        if (hipGetDevice(&dev) != hipSuccess || hipDeviceGetAttribute(&cus, hipDeviceAttributeMultiprocessorCount, dev) != hipSuccess) { grid = -1; return; }
        if (hipFuncSetAttribute((const void*)fwd_kernel, hipFuncAttributeMaxDynamicSharedMemorySize, LDS_BYTES) != hipSuccess) { fprintf(stderr, "kernel_launch: hipFuncSetAttribute failed\n"); grid = -1; return; }
        if (hipOccupancyMaxActiveBlocksPerMultiprocessor(&per_cu, (const void*)fwd_kernel, 512, LDS_BYTES) != hipSuccess || per_cu < 1) { fprintf(stderr, "kernel_launch: occupancy query says %d\n", per_cu); }
        (void)hipGetLastError();
        grid = cus;
    }
    if (grid < 0) return;
    (void)hipMemsetAsync((char*)d_ws + WS_CTL, 0, CTL_ZERO_BYTES, stream);
    Args a{};
    for (int i = 0; i < 23; ++i) a.in[i] = (const float*)d_in[i];
    a.out = (float*)d_out; a.ws = (unsigned char*)d_ws;
#if MK_PER_PHASE
    for (int p = 0; p < N_PHASES; ++p) { a.ph_lo = p; a.ph_hi = p + 1; hipLaunchKernelGGL(fwd_kernel, dim3(grid), dim3(512), LDS_BYTES, stream, a); }
#else
    a.ph_lo = 0; a.ph_hi = N_PHASES; hipLaunchKernelGGL(fwd_kernel, dim3(grid), dim3(512), LDS_BYTES, stream, a);
#endif
}
```
